# Optimizing an MI355X kernel written in HIP

```python
import jax, jax.numpy as jnp
from jax import lax
import numpy as np

D_MODEL = 2048
BATCH = 1
SEQ = 16384
DEPTH = 4

CONV_WIDTH = D_MODEL // 2
CONV_K = 3
N_HEADS = 16
N_KV_GROUPS = 4
HEADS_PER_GROUP = N_HEADS // N_KV_GROUPS
HEAD_DIM = D_MODEL // N_HEADS
KV_WIDTH = N_KV_GROUPS * HEAD_DIM
ROPE_DIM = HEAD_DIM // 4
ROPE_THETA = 500000.0
CMP_BLOCK = 32
CMP_STRIDE = 16
CMP_HIDDEN = 2 * HEAD_DIM
SEL_BLOCK = 64
SEL_TOP = 16
WINDOW = 512
Q_BLOCK = 128
D_FF = 4 * D_MODEL
NORM_EPS = 1e-6
NEG = -1e30
FORCE = 1e30
MIX_SPLITS = (CONV_WIDTH, CONV_WIDTH, CONV_WIDTH, N_HEADS * HEAD_DIM, 6 * KV_WIDTH, 3 * N_HEADS, D_MODEL, D_MODEL)
IN_WIDTH = 3 * CONV_WIDTH + N_HEADS * HEAD_DIM + 6 * KV_WIDTH + 3 * N_HEADS + 2 * D_MODEL

kernel_name = "hybrid_shortconv_nsa_adaln_block"


def rms_norm(x, g):
    xf = x.astype(jnp.float32)
    y = xf * lax.rsqrt(jnp.mean(xf * xf, axis=-1, keepdims=True) + NORM_EPS)
    return (y * g.astype(jnp.float32)).astype(x.dtype)


def rope_tables(positions):
    inv_freq = ROPE_THETA ** (-jnp.arange(0, ROPE_DIM, 2, dtype=jnp.float32) / ROPE_DIM)
    ang = positions.astype(jnp.float32)[..., None] * inv_freq
    return jnp.cos(ang), jnp.sin(ang)


def partial_rope(x, cos, sin):
    half = ROPE_DIM // 2
    xr = x[..., :ROPE_DIM].astype(jnp.float32)
    x1, x2 = xr[..., :half], xr[..., half:]
    c = cos[:, :, None, :]
    s = sin[:, :, None, :]
    rot = jnp.concatenate([x1 * c - x2 * s, x2 * c + x1 * s], axis=-1).astype(x.dtype)
    return jnp.concatenate([rot, x[..., ROPE_DIM:]], axis=-1)


def short_conv_mixer(b_gate, c_gate, xa, conv_w, w_out):
    u = c_gate * xa
    z = lax.conv_general_dilated(u, conv_w[:, None, :].astype(u.dtype), window_strides=(1,),
                                 padding=[(CONV_K - 1, 0)], dimension_numbers=('NWC', 'WIO', 'NWC'),
                                 feature_group_count=CONV_WIDTH)
    return (b_gate * z) @ w_out


def compress(kv, pe, w1, b1, w2, b2):
    B, S, G, dh = kv.shape
    n_cmp = (S - CMP_BLOCK) // CMP_STRIDE + 1
    idx = jnp.arange(n_cmp)[:, None] * CMP_STRIDE + jnp.arange(CMP_BLOCK)[None, :]
    blocks = kv[:, idx] + pe[None, None, :, None, :]
    blocks = blocks.transpose(0, 1, 3, 2, 4).reshape(B, n_cmp, G, CMP_BLOCK * dh)
    h = jax.nn.gelu(blocks @ w1 + b1)
    return h @ w2 + b2


def nsa_attention(q, kc, vc, ks, vs, kw, vw, gate):
    B, S, H, dh = q.shape
    G, R = N_KV_GROUPS, HEADS_PER_GROUP
    n_cmp = kc.shape[1]
    n_slc = S // SEL_BLOCK
    top = min(SEL_TOP, n_slc)
    n_qb = S // Q_BLOCK
    scale = dh ** -0.5
    qg = q.reshape(B, S, G, R, dh)
    gate = gate.reshape(B, S, G, R, 3)
    cmp_end = jnp.arange(n_cmp) * CMP_STRIDE + CMP_BLOCK - 1
    cs = jnp.arange(n_cmp)[:, None] * CMP_STRIDE
    ss = jnp.arange(n_slc)[None, :] * SEL_BLOCK
    overlap = jnp.clip(jnp.minimum(cs + CMP_BLOCK, ss + SEL_BLOCK) - jnp.maximum(cs, ss), 0, None).astype(jnp.float32) / CMP_BLOCK
    ks_blk = ks.reshape(B, n_slc, SEL_BLOCK, G, dh).transpose(0, 3, 1, 2, 4)
    vs_blk = vs.reshape(B, n_slc, SEL_BLOCK, G, dh).transpose(0, 3, 1, 2, 4)
    kw_pad = jnp.pad(kw, ((0, 0), (WINDOW, 0), (0, 0), (0, 0)))
    vw_pad = jnp.pad(vw, ((0, 0), (WINDOW, 0), (0, 0), (0, 0)))
    b_ix = jnp.arange(B)[:, None, None, None]
    g_ix = jnp.arange(G)[None, :, None, None]
    blk_ids = jnp.arange(n_slc)

    def one_block(i):
        s0 = i * Q_BLOCK
        t = s0 + jnp.arange(Q_BLOCK)
        qb = lax.dynamic_slice_in_dim(qg, s0, Q_BLOCK, axis=1)
        gb = lax.dynamic_slice_in_dim(gate, s0, Q_BLOCK, axis=1)
        sc = jnp.einsum('btgrd,bngd->bgrtn', qb, kc, preferred_element_type=jnp.float32) * scale
        m_c = cmp_end[None, :] <= t[:, None]
        p_c = jnp.where(m_c, jax.nn.softmax(jnp.where(m_c, sc, NEG), axis=-1), 0.0)
        o_c = jnp.einsum('bgrtn,bngd->btgrd', p_c.astype(vc.dtype), vc)
        imp = jnp.einsum('bgrtn,nj->bgtj', p_c, overlap)
        cur = t // SEL_BLOCK
        forced = (blk_ids[None, :] == cur[:, None]) | (blk_ids[None, :] == 0)
        valid = blk_ids[None, :] <= cur[:, None]
        imp = jnp.where(forced, FORCE, jnp.where(valid, imp, NEG))
        _, sel = lax.top_k(imp, top)
        k_sel = ks_blk[b_ix, g_ix, sel]
        v_sel = vs_blk[b_ix, g_ix, sel]
        kpos = sel[..., None] * SEL_BLOCK + jnp.arange(SEL_BLOCK)
        m_s = (kpos <= t[None, None, :, None, None]).reshape(B, G, 1, Q_BLOCK, top * SEL_BLOCK)
        s_s = jnp.einsum('btgrd,bgtkld->bgrtkl', qb, k_sel, preferred_element_type=jnp.float32)
        s_s = s_s.reshape(B, G, R, Q_BLOCK, top * SEL_BLOCK) * scale
        p_s = jax.nn.softmax(jnp.where(m_s, s_s, NEG), axis=-1).reshape(B, G, R, Q_BLOCK, top, SEL_BLOCK)
        o_s = jnp.einsum('bgrtkl,bgtkld->btgrd', p_s.astype(v_sel.dtype), v_sel)
        kwb = lax.dynamic_slice_in_dim(kw_pad, s0, Q_BLOCK + WINDOW, axis=1)
        vwb = lax.dynamic_slice_in_dim(vw_pad, s0, Q_BLOCK + WINDOW, axis=1)
        wpos = s0 - WINDOW + jnp.arange(Q_BLOCK + WINDOW)
        diff = t[:, None] - wpos[None, :]
        m_w = (diff >= 0) & (diff < WINDOW) & (wpos[None, :] >= 0)
        s_w = jnp.einsum('btgrd,bkgd->bgrtk', qb, kwb, preferred_element_type=jnp.float32) * scale
        p_w = jax.nn.softmax(jnp.where(m_w, s_w, NEG), axis=-1)
        o_w = jnp.einsum('bgrtk,bkgd->btgrd', p_w.astype(vwb.dtype), vwb)
        return gb[..., 0:1] * o_c + gb[..., 1:2] * o_s + gb[..., 2:3] * o_w

    out = lax.map(one_block, jnp.arange(n_qb))
    return out.transpose(1, 0, 2, 3, 4, 5).reshape(B, S, H * dh)


def hybrid_mixer(h, cos, sin, w_in, conv_w, w_conv_out, cmp_pe, cmp_w1, cmp_b1, cmp_w2, cmp_b2, w_nsa_out, w_out):
    B, S, _ = h.shape
    points = [int(p) for p in np.cumsum(MIX_SPLITS)[:-1]]
    bg, cg, xa, q, kv, g_nsa, g_a, g_b = jnp.split(h @ w_in, points, axis=-1)
    y_a = short_conv_mixer(bg, cg, xa, conv_w, w_conv_out)
    q = partial_rope(q.reshape(B, S, N_HEADS, HEAD_DIM), cos, sin)
    kv = kv.reshape(B, S, 6, N_KV_GROUPS, HEAD_DIM)
    kc_raw = partial_rope(kv[:, :, 0], cos, sin)
    vc_raw = kv[:, :, 1]
    ks = partial_rope(kv[:, :, 2], cos, sin)
    vs = kv[:, :, 3]
    kw = partial_rope(kv[:, :, 4], cos, sin)
    vw = kv[:, :, 5]
    kc = compress(kc_raw, cmp_pe[0], cmp_w1[0], cmp_b1[0], cmp_w2[0], cmp_b2[0])
    vc = compress(vc_raw, cmp_pe[1], cmp_w1[1], cmp_b1[1], cmp_w2[1], cmp_b2[1])
    gate = jax.nn.sigmoid(g_nsa).reshape(B, S, N_HEADS, 3)
    y_b = nsa_attention(q, kc, vc, ks, vs, kw, vw, gate) @ w_nsa_out
    merged = jax.nn.sigmoid(g_a) * y_a + jax.nn.sigmoid(g_b) * y_b
    return merged @ w_out


def setup_inputs(seed: int = 0) -> dict:
    key = jax.random.key(seed)
    ks = jax.random.split(key, 20)
    f32 = jnp.float32
    nrm = lambda k, shape, s: jax.random.normal(k, shape, f32) * s
    return {
        "x": nrm(ks[0], (BATCH, SEQ, D_MODEL), 1.0),
        "c": nrm(ks[1], (BATCH, D_MODEL), 1.0),
        "positions": jnp.broadcast_to(jnp.arange(SEQ, dtype=jnp.int32), (BATCH, SEQ)),
        "ada_w": nrm(ks[2], (DEPTH, D_MODEL, 6 * D_MODEL), 0.5 * D_MODEL ** -0.5),
        "ada_b": nrm(ks[3], (DEPTH, 6 * D_MODEL), 0.02),
        "norm_gains": 1.0 + nrm(ks[4], (DEPTH, 4, D_MODEL), 0.05),
        "w_in": nrm(ks[5], (DEPTH, D_MODEL, IN_WIDTH), D_MODEL ** -0.5),
        "conv_w": nrm(ks[6], (DEPTH, CONV_K, CONV_WIDTH), CONV_K ** -0.5),
        "w_conv_out": nrm(ks[7], (DEPTH, CONV_WIDTH, D_MODEL), CONV_WIDTH ** -0.5),
        "cmp_pe": nrm(ks[8], (DEPTH, 2, CMP_BLOCK, HEAD_DIM), 0.1),
        "cmp_w1": nrm(ks[9], (DEPTH, 2, CMP_BLOCK * HEAD_DIM, CMP_HIDDEN), (CMP_BLOCK * HEAD_DIM) ** -0.5),
        "cmp_b1": nrm(ks[10], (DEPTH, 2, CMP_HIDDEN), 0.02),
        "cmp_w2": nrm(ks[11], (DEPTH, 2, CMP_HIDDEN, HEAD_DIM), CMP_HIDDEN ** -0.5),
        "cmp_b2": nrm(ks[12], (DEPTH, 2, HEAD_DIM), 0.02),
        "w_nsa_out": nrm(ks[13], (DEPTH, N_HEADS * HEAD_DIM, D_MODEL), (N_HEADS * HEAD_DIM) ** -0.5),
        "w_out": nrm(ks[14], (DEPTH, D_MODEL, D_MODEL), D_MODEL ** -0.5),
        "w_mlp_up": nrm(ks[15], (DEPTH, D_MODEL, D_FF), D_MODEL ** -0.5),
        "w_mlp_down": nrm(ks[16], (DEPTH, D_FF, D_MODEL), D_FF ** -0.5),
    }


def reference(x, c, positions, ada_w, ada_b, norm_gains, w_in, conv_w, w_conv_out, cmp_pe, cmp_w1, cmp_b1,
              cmp_w2, cmp_b2, w_nsa_out, w_out, w_mlp_up, w_mlp_down):
    cos, sin = rope_tables(positions)
    c_act = jax.nn.silu(c)
    for l in range(DEPTH):
        mod = c_act @ ada_w[l] + ada_b[l]
        sh1, sc1, g1, sh2, sc2, g2 = jnp.split(mod, 6, axis=-1)
        h = rms_norm(x, norm_gains[l, 0]) * (1.0 + sc1[:, None, :]) + sh1[:, None, :]
        y = hybrid_mixer(h, cos, sin, w_in[l], conv_w[l], w_conv_out[l], cmp_pe[l], cmp_w1[l], cmp_b1[l],
                         cmp_w2[l], cmp_b2[l], w_nsa_out[l], w_out[l])
        x = x + g1[:, None, :] * rms_norm(y, norm_gains[l, 1])
        h = rms_norm(x, norm_gains[l, 2]) * (1.0 + sc2[:, None, :]) + sh2[:, None, :]
        u = jnp.square(jax.nn.relu(h @ w_mlp_up[l]))
        x = x + g2[:, None, :] * rms_norm(u @ w_mlp_down[l], norm_gains[l, 3])
    return x
```

```cpp
#include <hip/hip_runtime.h>
#include <cstdio>
#include <cstdint>

#define GAS __attribute__((address_space(1)))
#define GAS_K __attribute__((address_space(4)))
#define LAS __attribute__((address_space(3)))
typedef unsigned short bf16;
typedef short bf16x8 __attribute__((ext_vector_type(8)));
typedef float f32x4 __attribute__((ext_vector_type(4)));
typedef float f32x2 __attribute__((ext_vector_type(2)));
typedef unsigned u32x4 __attribute__((ext_vector_type(4)));
typedef unsigned u32x2 __attribute__((ext_vector_type(2)));

constexpr int S = 16384, DM = 2048, DEPTH = 4, CWID = 1024, NH = 16, NG = 4, HD = 128, FF = 8192;
constexpr int INW = 12336, PW = 12544;
constexpr int C_BG = 0, C_CG = 1024, C_XA = 2048, C_Q = 3072, C_KV = 5120, C_GA = 8192, C_GB = 10240, C_GN = 12288;
constexpr float NORM_EPS = 1e-6f;
constexpr float QSCALE = 0.12751743082459868f;
constexpr int NWAVES = 8;

namespace pg8 {
typedef unsigned short bf16_t;
constexpr int BM = 256, BK = 64, HALF = 128, HTB = HALF * BK * 2, STAGE_BYTES = 8 * HTB, NXCD = 8, WGM = 8;
__host__ __device__ __forceinline__ int lds_byte(int r, int c) { const int st = (r >> 4) * 2 + (c >> 5), rr = r & 15, cc = c & 31, ob = rr * 64 + cc * 2; return st * 1024 + (ob ^ (((ob >> 9) & 1) << 5)); }
__host__ __device__ __forceinline__ void stage_rc(int b, int& R, int& C) { const int st = b / 1024, sb = b % 1024, swz = sb ^ (((sb >> 9) & 1) << 5); R = (st >> 1) * 16 + swz / 64; C = (st & 1) * 32 + (swz % 64) / 2; }
__host__ __device__ __forceinline__ int perm32(int rho) { const int n = rho >> 4, i = rho & 15; return 8 * (i >> 2) + 4 * n + (i & 3); }

struct Unit { int pm, pn; };
struct Gemm { const bf16_t* A; const bf16_t* Bt; int M, N, K, lda; };

struct StaticOrder {
    int nM, nN, nwg, G, c;
    __device__ void init(int M, int N, int G_, int c_) { nM = M / BM; nN = N / BM; nwg = nM * nN; G = G_; c = c_; if (c_ < 0 || c_ >= G_) nwg = 0; }
    __device__ bool next(int i, Unit& u) const { return map((long)i * G + c, u); }
    __device__ bool map(const long L, Unit& u) const {
        if (L >= nwg) return false;
        int wgid = (int)L; { const int q = nwg / NXCD, r = nwg % NXCD, xcd = wgid % NXCD, off = wgid / NXCD; wgid = (xcd < r ? xcd * (q + 1) : r * (q + 1) + (xcd - r) * q) + off; }
        const int nig = WGM * nN, gid = wgid / nig, fm = gid * WGM, gsz = (nM - fm) < WGM ? (nM - fm) : WGM;
        u.pm = fm + ((wgid % nig) % gsz); u.pn = (wgid % nig) / gsz; return true;
    }
    __device__ __forceinline__ void a_ready(const Unit&) const {}
    __device__ __forceinline__ void done(const Unit&) const {}
};

typedef float f32x2_t_ __attribute__((ext_vector_type(2))); typedef __bf16 bf16x2_t_ __attribute__((ext_vector_type(2)));
__device__ __forceinline__ unsigned cvt_pk_bf16(float lo, float hi) { const f32x2_t_ v = {lo, hi}; const bf16x2_t_ b = __builtin_convertvector(v, bf16x2_t_); return __builtin_bit_cast(unsigned, b); }
__device__ __forceinline__ float bflo(unsigned w) { return __uint_as_float(w << 16); }
__device__ __forceinline__ float bfhi(unsigned w) { return __uint_as_float(w & 0xffff0000u); }
__device__ __forceinline__ float sigmoidf_(float x) { return __builtin_amdgcn_rcpf(1.0f + __builtin_amdgcn_exp2f(-1.4426950408889634f * x)); }

struct YaOrder {
    StaticOrder base; int bx;
    __device__ bool next(int i, Unit& u) const {
        if (bx < 32) return false;
        if (i < 2) return base.next(i, u);
        if (i == 2 && bx < 96) { const int idx = bx - 32; return base.map(idx < 32 ? (long)idx : (long)(idx - 32) + base.G, u); }
        return false;
    }
    __device__ __forceinline__ void a_ready(const Unit&) const {}
    __device__ __forceinline__ void done(const Unit&) const {}
};
struct CmpOrder {
    int c;
    __device__ bool next(int i, Unit& u) const { if (i != 0 || c < 0 || c >= 32) return false; u.pm = c; u.pn = c >> 4; return true; }
    __device__ __forceinline__ void a_ready(const Unit&) const {}
    __device__ __forceinline__ void done(const Unit&) const {}
};
struct EpiF32 {
    static constexpr bool PERM = false, AFTER_DRAIN = false;
    float* C; int ldc;
    __device__ __forceinline__ void operator()(const f32x4 (&acc)[2][2][4][2], const Unit& u, int wr, int wc, int fr, int fq) const {
        const int row0 = u.pm * BM + wr * 64 + fr, col0 = u.pn * BM + wc * 32 + 4 * fq;
#pragma unroll
        for (int ai = 0; ai < 2; ++ai)
#pragma unroll
            for (int m = 0; m < 4; ++m) { float* rowp = C + (size_t)(row0 + ai * HALF + m * 16) * ldc + col0;
#pragma unroll
                for (int bj = 0; bj < 2; ++bj)
#pragma unroll
                    for (int n = 0; n < 2; ++n) *(f32x4*)(rowp + bj * HALF + n * 16) = acc[ai][bj][m][n]; }
    }
};
template <int MODE, bool COLWRAP = false> struct EpiB {
    static constexpr bool PERM = true, AFTER_DRAIN = false;
    bf16_t* O; int ldc; const float* bias; const bf16_t* G; int ldg; const bf16_t* ADD; int ldadd;
    __device__ __forceinline__ void operator()(const f32x4 (&acc)[2][2][4][2], const Unit& u, int wr, int wc, int fr, int fq) const {
        const int row0 = u.pm * BM + wr * 64 + fr, col0 = u.pn * BM + wc * 32 + 8 * fq;
#pragma unroll
        for (int ai = 0; ai < 2; ++ai)
#pragma unroll
            for (int m = 0; m < 4; ++m) { const int row = row0 + ai * HALF + m * 16;
#pragma unroll
                for (int bj = 0; bj < 2; ++bj) { const int col = col0 + bj * HALF;
                    float v[8];
#pragma unroll
                    for (int e = 0; e < 4; ++e) { v[e] = acc[ai][bj][m][0][e]; v[4 + e] = acc[ai][bj][m][1][e]; }
                    if (MODE == 1) {
#pragma unroll
                        for (int e = 0; e < 8; ++e) { const float t = fmaxf(v[e], 0.f); v[e] = t * t; }
                    }
                    if (MODE == 2) { const f32x4 b0 = *(const f32x4*)(bias + col), b1 = *(const f32x4*)(bias + col + 4);
#pragma unroll
                        for (int e = 0; e < 8; ++e) { const float x = v[e] + (e < 4 ? b0[e] : b1[e - 4]); v[e] = x * sigmoidf_(1.5957691216057308f * (x + 0.044715f * x * x * x)); }
                    }
                    if (MODE == 3 || MODE == 4) { const u32x4 gw = *(const u32x4*)(G + (size_t)row * ldg + col);
#pragma unroll
                        for (int e = 0; e < 4; ++e) { v[2 * e] *= sigmoidf_(bflo(gw[e])); v[2 * e + 1] *= sigmoidf_(bfhi(gw[e])); }
                    }
                    if (MODE == 4) { const u32x4 aw = *(const u32x4*)(ADD + (size_t)row * ldadd + col);
#pragma unroll
                        for (int e = 0; e < 4; ++e) { v[2 * e] += bflo(aw[e]); v[2 * e + 1] += bfhi(aw[e]); }
                    }
                    u32x4 w; w.x = cvt_pk_bf16(v[0], v[1]); w.y = cvt_pk_bf16(v[2], v[3]); w.z = cvt_pk_bf16(v[4], v[5]); w.w = cvt_pk_bf16(v[6], v[7]);
                    *(u32x4*)(O + (size_t)row * ldc + (COLWRAP ? (col & 255) : col)) = w; } }
    }
};

template <class Epi, class Sched, bool ALIGN_EPI = false, bool SP2 = false>
__device__ __forceinline__ void gemm_phase(LAS unsigned char* lds, const Gemm g, const Sched& S, const Epi& E, const int tid) {
    const int wid = __builtin_amdgcn_readfirstlane(tid >> 6), lane = tid & 63, wr = wid >> 2, wc = wid & 3, fr = lane & 15, fq = lane >> 4;
    const int K = g.K, nt = K / BK;
    unsigned voffA[2], voffB[2];
#pragma unroll
    for (int i = 0; i < 2; ++i) { int R, C; stage_rc(tid * 16 + i * 8192, R, C); const int Rb = Epi::PERM ? ((R & ~31) + perm32(R & 31)) : R;
        voffA[i] = (unsigned)(R * g.lda + C) * 2u; voffB[i] = (unsigned)(Rb * K + C) * 2u; }
    const size_t kstep = (size_t)(BK * 2);
    const size_t hstepA = (size_t)HALF * g.lda * 2, hstepB = (size_t)HALF * K * 2;
    const size_t tstepA = 2 * hstepA, tstepB = 2 * hstepB;
    const unsigned ldsw = (unsigned)wid * 1024u;
    const int aoff = lds_byte(wr * 64 + fr, fq * 8), boff = lds_byte(wc * 32 + fr, fq * 8);
#define PG8_SA(b, h) (((b) * 2 + (h)) * HTB)
#define PG8_SB(b, h) ((4 + (b) * 2 + (h)) * HTB)
#define PG8_STAGE(bufoff, gbase, voff) do { _Pragma("unroll") for (int _i = 0; _i < 2; ++_i) \
        __builtin_amdgcn_global_load_lds((const unsigned*)((const char*)(gbase) + (voff)[_i]), (LAS unsigned*)(lds + (bufoff) + ldsw + _i * 8192), 16, 0, 0); } while (0)
#define PG8_LDA(dst, b, h) do { _Pragma("unroll") for (int m = 0; m < 4; ++m) _Pragma("unroll") for (int k = 0; k < 2; ++k) dst[m][k] = *(const LAS bf16x8*)(lds + PG8_SA(b, h) + aoff + m * 2048 + k * 1024); } while (0)
#define PG8_LDB(dst, b, h) do { _Pragma("unroll") for (int n = 0; n < 2; ++n) _Pragma("unroll") for (int k = 0; k < 2; ++k) dst[n][k] = *(const LAS bf16x8*)(lds + PG8_SB(b, h) + boff + n * 2048 + k * 1024); } while (0)
#define PG8_MMA(ai, bj, At, Bt) do { __builtin_amdgcn_s_setprio(1); _Pragma("unroll") for (int m = 0; m < 4; ++m) _Pragma("unroll") for (int n = 0; n < 2; ++n) _Pragma("unroll") for (int k = 0; k < 2; ++k) \
        acc[ai][bj][m][n] = __builtin_amdgcn_mfma_f32_16x16x32_bf16(Bt[n][k], At[m][k], acc[ai][bj][m][n], 0, 0, 0); __builtin_amdgcn_s_setprio(0); } while (0)
#define PG8_WAIT_V(n) asm volatile("s_waitcnt vmcnt(" #n ")" ::: "memory")
#define PG8_WAIT_L(n) asm volatile("s_waitcnt lgkmcnt(" #n ")" ::: "memory")
#define PG8_BAR __builtin_amdgcn_s_barrier()
#define PG8_SCHED __builtin_amdgcn_sched_barrier(0)
    Unit cur, nxt; int ui = 0;
    if (!S.next(0, cur)) return;
    f32x4 acc[2][2][4][2];
#pragma unroll
    for (int a = 0; a < 2; ++a)
#pragma unroll
        for (int b = 0; b < 2; ++b)
#pragma unroll
            for (int m = 0; m < 4; ++m)
#pragma unroll
                for (int n = 0; n < 2; ++n) acc[a][b][m][n] = (f32x4){0.f, 0.f, 0.f, 0.f};
    bf16x8 At[4][2], B0[2][2], B1[2][2];
    const char* cA = (const char*)g.A + (size_t)cur.pm * tstepA; const char* cB = (const char*)g.Bt + (size_t)cur.pn * tstepB;
    S.a_ready(cur);
    if constexpr (SP2) {
        PG8_STAGE(PG8_SB(0, 0), cB, voffB); PG8_STAGE(PG8_SB(0, 1), cB + hstepB, voffB); PG8_STAGE(PG8_SA(0, 0), cA, voffA); PG8_STAGE(PG8_SA(0, 1), cA + hstepA, voffA);
        if (wr == 1) PG8_BAR;
        PG8_WAIT_V(2); PG8_BAR;
        PG8_STAGE(PG8_SB(1, 0), cB + kstep, voffB); PG8_STAGE(PG8_SA(1, 0), cA + kstep, voffA); PG8_STAGE(PG8_SB(1, 1), cB + hstepB + kstep, voffB);
        PG8_WAIT_V(6); PG8_BAR;
    } else {
        PG8_STAGE(PG8_SB(0, 0), cB, voffB); PG8_STAGE(PG8_SA(0, 0), cA, voffA); PG8_STAGE(PG8_SB(0, 1), cB + hstepB, voffB); PG8_STAGE(PG8_SA(0, 1), cA + hstepA, voffA);
        if (wr == 1) PG8_BAR;
        PG8_WAIT_V(4); PG8_BAR;
        PG8_STAGE(PG8_SB(1, 0), cB + kstep, voffB); PG8_STAGE(PG8_SA(1, 0), cA + kstep, voffA); PG8_STAGE(PG8_SB(1, 1), cB + hstepB + kstep, voffB);
        PG8_WAIT_V(6); PG8_BAR;
    }
    for (;;) {
        const bool has_next = S.next(ui + 1, nxt);
        const char* nA = has_next ? (const char*)g.A + (size_t)nxt.pm * tstepA : cA; const char* nB = has_next ? (const char*)g.Bt + (size_t)nxt.pn * tstepB : cB;
        for (int t = 0; t < nt; t += 2) {
            const bool last = (t == nt - 2);
            const char* a1 = cA + (size_t)(t + 1) * kstep;
            const char* a2 = last ? nA : cA + (size_t)(t + 2) * kstep; const char* b2 = last ? nB : cB + (size_t)(t + 2) * kstep;
            const char* a3 = a2 + kstep; const char* b3 = b2 + kstep;
            if (last && has_next) S.a_ready(nxt);
            if constexpr (SP2) {
            PG8_LDB(B0, 0, 0); PG8_LDB(B1, 0, 1); PG8_SCHED; PG8_LDA(At, 0, 0); PG8_STAGE(PG8_SA(1, 1), a1 + hstepA, voffA);
            PG8_WAIT_V(8); PG8_WAIT_L(0); PG8_BAR; PG8_MMA(0, 0, At, B0); PG8_MMA(0, 1, At, B1); PG8_BAR; PG8_SCHED;
            PG8_LDA(At, 0, 1); PG8_STAGE(PG8_SB(0, 0), b2, voffB); PG8_STAGE(PG8_SB(0, 1), b2 + hstepB, voffB); PG8_STAGE(PG8_SA(0, 0), a2, voffA);
            PG8_WAIT_V(8); PG8_WAIT_L(0); PG8_BAR; PG8_MMA(1, 0, At, B0); PG8_MMA(1, 1, At, B1); PG8_BAR; PG8_SCHED;
            PG8_LDB(B0, 1, 0); PG8_LDB(B1, 1, 1); PG8_SCHED; PG8_LDA(At, 1, 0); PG8_STAGE(PG8_SA(0, 1), a2 + hstepA, voffA);
            PG8_WAIT_V(8); PG8_WAIT_L(0); PG8_BAR; PG8_MMA(0, 0, At, B0); PG8_MMA(0, 1, At, B1); PG8_BAR; PG8_SCHED;
            PG8_LDA(At, 1, 1); PG8_STAGE(PG8_SB(1, 0), b3, voffB); PG8_STAGE(PG8_SB(1, 1), b3 + hstepB, voffB); PG8_STAGE(PG8_SA(1, 0), a3, voffA);
            PG8_WAIT_V(8); PG8_WAIT_L(0); PG8_BAR; PG8_MMA(1, 0, At, B0); PG8_MMA(1, 1, At, B1); PG8_BAR; PG8_SCHED;
            } else {
            PG8_LDB(B0, 0, 0); PG8_SCHED; PG8_LDA(At, 0, 0); PG8_STAGE(PG8_SA(1, 1), a1 + hstepA, voffA);
            PG8_WAIT_L(8); PG8_BAR; PG8_WAIT_L(0); PG8_MMA(0, 0, At, B0); PG8_BAR; PG8_SCHED;
            PG8_LDB(B1, 0, 1); PG8_STAGE(PG8_SB(0, 0), b2, voffB);
            PG8_BAR; PG8_WAIT_L(0); PG8_MMA(0, 1, At, B1); PG8_BAR;
            PG8_LDA(At, 0, 1); PG8_STAGE(PG8_SA(0, 0), a2, voffA);
            PG8_BAR; PG8_WAIT_L(0); PG8_MMA(1, 0, At, B0); PG8_BAR; PG8_SCHED;
            PG8_STAGE(PG8_SB(0, 1), b2 + hstepB, voffB);
            PG8_WAIT_V(6); PG8_BAR; PG8_MMA(1, 1, At, B1); PG8_BAR;
            PG8_LDB(B0, 1, 0); PG8_SCHED; PG8_LDA(At, 1, 0); PG8_STAGE(PG8_SA(0, 1), a2 + hstepA, voffA);
            PG8_WAIT_L(8); PG8_BAR; PG8_WAIT_L(0); PG8_MMA(0, 0, At, B0); PG8_BAR; PG8_SCHED;
            PG8_LDB(B1, 1, 1); PG8_STAGE(PG8_SB(1, 0), b3, voffB);
            PG8_BAR; PG8_WAIT_L(0); PG8_MMA(0, 1, At, B1); PG8_BAR;
            PG8_LDA(At, 1, 1); PG8_STAGE(PG8_SA(1, 0), a3, voffA);
            PG8_BAR; PG8_WAIT_L(0); PG8_MMA(1, 0, At, B0); PG8_BAR; PG8_SCHED;
            PG8_STAGE(PG8_SB(1, 1), b3 + hstepB, voffB);
            PG8_WAIT_V(6); PG8_BAR; PG8_MMA(1, 1, At, B1); PG8_BAR;
            }
        }
        if constexpr (ALIGN_EPI) { if (wr == 0) PG8_BAR; }
        E(acc, cur, wr, wc, fr, fq); S.done(cur);
        if (!has_next) break;
#pragma unroll
        for (int a = 0; a < 2; ++a)
#pragma unroll
            for (int b = 0; b < 2; ++b)
#pragma unroll
                for (int m = 0; m < 4; ++m)
#pragma unroll
                    for (int n = 0; n < 2; ++n) acc[a][b][m][n] = (f32x4){0.f, 0.f, 0.f, 0.f};
        cur = nxt; cA = nA; cB = nB; ++ui;
        if constexpr (ALIGN_EPI) { if (wr == 1) PG8_BAR; }
    }
    PG8_WAIT_V(0);
    if constexpr (!ALIGN_EPI) { if (wr == 0) PG8_BAR; }
    PG8_BAR;
#undef PG8_SA
#undef PG8_SB
#undef PG8_STAGE
#undef PG8_LDA
#undef PG8_LDB
#undef PG8_MMA
#undef PG8_WAIT_V
#undef PG8_WAIT_L
#undef PG8_BAR
#undef PG8_SCHED
}
}

constexpr size_t al4k(size_t x) { return (x + 4095) & ~(size_t)4095; }
constexpr size_t WS_CTL = 0, CTL_ZERO_BYTES = 1u << 20;
constexpr size_t WS_MODP = CTL_ZERO_BYTES;
constexpr size_t WS_B1PART = al4k(WS_MODP + (size_t)DEPTH * 8 * 6 * DM * 4);
constexpr size_t WS_B1P = al4k(WS_B1PART + (size_t)DEPTH * 2 * 32 * 256 * 4);
constexpr size_t WS_COS = al4k(WS_B1P + 2 * 256 * 4);
constexpr size_t WS_SIN = al4k(WS_COS + (size_t)S * 16 * 4);
constexpr size_t WS_GT = al4k(WS_SIN + (size_t)S * 16 * 4);
constexpr size_t WS_W2T = al4k(WS_GT + (size_t)S * 48 * 4);
constexpr size_t WS_KCI = al4k(WS_W2T + (size_t)DEPTH * 2 * 128 * 256 * 2);
constexpr size_t WS_VCI = al4k(WS_KCI + (size_t)NG * 16 * 16384);
constexpr size_t WS_HC = al4k(WS_VCI + (size_t)NG * 16 * 16384);
constexpr size_t WS_WL = al4k(WS_HC + (size_t)2 * 4096 * 256 * 2);
constexpr size_t WL_WIN = 0;
constexpr size_t WL_WCONV = WL_WIN + (size_t)PW * DM * 2;
constexpr size_t WL_W1T = WL_WCONV + (size_t)DM * CWID * 2;
constexpr size_t WL_WNSA = WL_W1T + (size_t)2 * 256 * 4096 * 2;
constexpr size_t WL_WOUT = WL_WNSA + (size_t)DM * DM * 2;
constexpr size_t WL_WUP = WL_WOUT + (size_t)DM * DM * 2;
constexpr size_t WL_WDOWN = WL_WUP + (size_t)FF * DM * 2;
constexpr size_t WL_BYTES = al4k(WL_WDOWN + (size_t)DM * FF * 2);
constexpr size_t WS_P = al4k(WS_WL + DEPTH * WL_BYTES);
constexpr size_t WS_U = WS_P;
constexpr size_t WS_Y = WS_P + (size_t)S * FF * 2;
constexpr size_t P_REGION = (size_t)S * PW * 2;
static_assert((size_t)S * FF * 2 + (size_t)S * DM * 4 <= P_REGION, "U + Y fit in P's region");
constexpr size_t WS_H = al4k(WS_P + P_REGION);
constexpr size_t WS_QP = al4k(WS_H + (size_t)S * DM * 2);
constexpr size_t WS_MG = WS_QP;
constexpr size_t WS_KSI = al4k(WS_QP + (size_t)S * DM * 2);
constexpr size_t WS_VSI = WS_KSI + (size_t)NG * 256 * 16384;
constexpr size_t WS_KWI = WS_VSI + (size_t)NG * 256 * 16384;
constexpr size_t WS_VWI = WS_KWI + (size_t)NG * 256 * 16384;
constexpr size_t WS_KCR = WS_VWI + (size_t)NG * 256 * 16384;
constexpr size_t WS_VCR = WS_KCR + (size_t)NG * S * HD * 2;
constexpr size_t WS_CV = al4k(WS_VCR + (size_t)NG * S * HD * 2 + 65536);
constexpr size_t WS_AO = al4k(WS_CV + (size_t)S * CWID * 2);
constexpr size_t WS_YA = al4k(WS_AO + (size_t)S * DM * 2);
constexpr size_t WS_FS = al4k(WS_YA + (size_t)S * DM * 2);
constexpr size_t WS_XB = al4k(WS_FS + (size_t)256 * 8 * 32768);
constexpr size_t WS_END = al4k(WS_XB + (size_t)S * DM * 2);

constexpr int CW_BAR = 4096;

constexpr int RING_BYTES = 131072;
constexpr int AT_KV = 0, AT_IMP = 65536, IMP_STRIDE = 257, AT_SELW = AT_IMP + 64 * IMP_STRIDE * 4;
constexpr int MISC_OFF = AT_SELW + NWAVES * 256 * 4;
constexpr int LDS_BYTES = 147456;
static_assert(MISC_OFF + 512 <= LDS_BYTES && MISC_OFF >= RING_BYTES, "LDS map");

typedef GAS unsigned gu32;
#define RLX_AGENT __ATOMIC_RELAXED, __HIP_MEMORY_SCOPE_AGENT
#define LDS_WAIT() asm volatile("s_waitcnt lgkmcnt(0)" ::: "memory")
#define VM_WAIT() asm volatile("s_waitcnt vmcnt(0)" ::: "memory")

#define XB_TMO      128
#define XB_XCNT(j)  (256  + 64 * (j))
#define XB_XSUB(j)  (1280 + 64 * (j))
#define XB_XGEN(j)  (2304 + 64 * (j))
#define XB_TOP      3328
#define XB_TOPGEN   3392
#define XCD_BAR_WORDS 3456
#define XB_SPIN_CAP (1u << 22)

__device__ __forceinline__ unsigned xb_ld(unsigned* p)              { return __hip_atomic_load(p, __ATOMIC_RELAXED, __HIP_MEMORY_SCOPE_AGENT); }
__device__ __forceinline__ unsigned xb_add(unsigned* p, unsigned v) { return __hip_atomic_fetch_add(p, v, __ATOMIC_RELAXED, __HIP_MEMORY_SCOPE_AGENT); }
__device__ __forceinline__ unsigned xb_xcc_id() { return (unsigned)__builtin_amdgcn_s_getreg((3 << 11) | 20) & 0xFu; }
#define XB_SPIN(cond, bar) do { unsigned _sp = 0; while (cond) { __builtin_amdgcn_s_sleep(1); \
    if ((++_sp & 255u) == 0u) { if (xb_ld(&(bar)[XB_TMO])) break; if (_sp > XB_SPIN_CAP) { atomicAdd(&(bar)[XB_TMO], 1u); break; } } } } while (0)

struct XcdBarrier { unsigned* bar; unsigned x; volatile LAS unsigned* st; };

__device__ __forceinline__ XcdBarrier xcd_barrier_post(unsigned* bar, volatile LAS unsigned* st) {
    XcdBarrier b; b.bar = bar; b.x = xb_xcc_id(); b.st = st;
    if (threadIdx.x == 0) (void)xb_add(&bar[XB_XCNT(b.x)], 1u);
    return b;
}
__device__ __forceinline__ void xcd_barrier_complete(unsigned* bar, unsigned x, unsigned& nloc, unsigned& nx) {
    const unsigned G = gridDim.x * gridDim.y * gridDim.z;
    unsigned sum, cnt, mine, sp = 0u;
    for (;;) {
        sum = 0u; cnt = 0u; mine = 0u;
#pragma unroll
        for (unsigned j = 0; j < 16; ++j) { const unsigned c = xb_ld(&bar[XB_XCNT(j)]); sum += c; cnt += (c > 0u) ? 1u : 0u; mine = (j == x) ? c : mine; }
        if (sum == G) break;
        __builtin_amdgcn_s_sleep(1);
        if ((++sp & 255u) == 0u) { if (xb_ld(&bar[XB_TMO])) break; if (sp > XB_SPIN_CAP) { atomicAdd(&bar[XB_TMO], 1u); break; } }
    }
    nloc = mine > 0u ? mine : 1u; nx = cnt > 0u ? cnt : 1u;
}
__device__ __forceinline__ void xcd_barrier(const XcdBarrier& b) {
    asm volatile("s_waitcnt vmcnt(0)" ::: "memory");
    __syncthreads();
    if (threadIdx.x == 0) {
        unsigned* bar = b.bar;
        __builtin_amdgcn_s_waitcnt(0);
        unsigned nloc = b.st[0], nx = b.st[1];
        if (nloc == 0u) { xcd_barrier_complete(bar, b.x, nloc, nx); b.st[0] = nloc; b.st[1] = nx; }
        const unsigned old = xb_add(&bar[XB_XSUB(b.x)], 1u);
        const unsigned gen = old / nloc;
        if (old + 1u == (gen + 1u) * nloc) {
            __builtin_amdgcn_fence(__ATOMIC_RELEASE, "agent");
            asm volatile("s_waitcnt vmcnt(0)" ::: "memory");
            const unsigned og = xb_add(&bar[XB_TOP], 1u);
            const unsigned tg = og / nx;
            if (og + 1u == (tg + 1u) * nx) xb_add(&bar[XB_TOPGEN], 1u);
            else XB_SPIN(xb_ld(&bar[XB_TOPGEN]) == tg, bar);
            __builtin_amdgcn_fence(__ATOMIC_ACQUIRE, "agent");
            xb_add(&bar[XB_XGEN(b.x)], 1u);
            asm volatile("s_waitcnt vmcnt(0)" ::: "memory");
        } else {
            XB_SPIN(xb_ld(&bar[XB_XGEN(b.x)]) == gen, bar);
            __builtin_amdgcn_fence(__ATOMIC_ACQUIRE, "agent");
            asm volatile("s_waitcnt vmcnt(0)" ::: "memory");
        }
    }
    __syncthreads();
}

__device__ __forceinline__ unsigned f2bf(float f) { unsigned u = __builtin_bit_cast(unsigned, f); return (u + 0x7fffu + ((u >> 16) & 1u)) >> 16; }
__device__ __forceinline__ unsigned pk2(float lo, float hi) { return f2bf(lo) | (f2bf(hi) << 16); }
__device__ __forceinline__ float bf_lo(unsigned w) { return __uint_as_float(w << 16); }
__device__ __forceinline__ float bf_hi(unsigned w) { return __uint_as_float(w & 0xffff0000u); }
__device__ __forceinline__ float wave_sum(float v) {
#pragma unroll
    for (int o = 1; o < 64; o <<= 1) v += __shfl_xor(v, o);
    return v;
}
__device__ __forceinline__ float sigm(float x) { return __builtin_amdgcn_rcpf(1.0f + __builtin_amdgcn_exp2f(-1.4426950408889634f * x)); }
__device__ __forceinline__ void unpack8(const u32x4 w, float (&v)[8]) {
    v[0] = bf_lo(w.x); v[1] = bf_hi(w.x); v[2] = bf_lo(w.y); v[3] = bf_hi(w.y); v[4] = bf_lo(w.z); v[5] = bf_hi(w.z); v[6] = bf_lo(w.w); v[7] = bf_hi(w.w);
}
__device__ __forceinline__ u32x4 pack8(const float (&v)[8]) { u32x4 w; w.x = pk2(v[0], v[1]); w.y = pk2(v[2], v[3]); w.z = pk2(v[4], v[5]); w.w = pk2(v[6], v[7]); return w; }

__device__ __forceinline__ int k_rho(int kappa) { const int a = kappa >> 5, q = (kappa >> 3) & 3, h = (kappa >> 2) & 1, i = kappa & 3; return 16 * (2 * a + h) + 4 * q + i; }
__device__ __forceinline__ int kimg_off(int kappa, int ch  ) { const int rho = k_rho(kappa); return rho * 256 + ((ch ^ (rho & 15)) << 4); }
__device__ __forceinline__ int vimg_off(int d, int kc  ) { return d * 128 + ((kc ^ ((d >> 1) & 7)) << 4); }

struct Ptrs {
    const float *x, *c, *ada_w, *ada_b, *gains, *w_in, *conv_w, *w_conv_out, *cmp_pe, *cmp_w1, *cmp_b1, *cmp_w2, *cmp_b2, *w_nsa, *w_out, *w_up, *w_down;
    const int* pos;
    float* out; unsigned char* ws;
};
struct Args { const void* in[18]; float* out; unsigned char* ws; int ph_lo, ph_hi; };
static_assert(sizeof(Args) == 18 * 8 + 8 + 8 + 8, "Args has no padding");

__device__ __forceinline__ void transpose_item(const float* W, int ldw, int csrc0, int nvalid, int K, bf16* WT, int drow0, int k0, LAS float* scr, int lane) {
    const int col = lane & 31;
#pragma unroll 8
    for (int i = 0; i < 32; ++i) { const int kk = 2 * i + (lane >> 5); scr[kk * 33 + col] = (col < nvalid) ? W[(size_t)(k0 + kk) * ldw + csrc0 + col] : 0.f; }
    LDS_WAIT(); asm volatile("" ::: "memory");
    const int c = lane & 7;
#pragma unroll
    for (int j = 0; j < 4; ++j) { const int n = (lane >> 3) + 8 * j; const LAS float* s = scr + (8 * c) * 33 + n;
        u32x4 o; o.x = pk2(s[0 * 33], s[1 * 33]); o.y = pk2(s[2 * 33], s[3 * 33]); o.z = pk2(s[4 * 33], s[5 * 33]); o.w = pk2(s[6 * 33], s[7 * 33]);
        *(GAS u32x4*)(WT + (size_t)(drow0 + n) * K + k0 + 8 * c) = o; }
    LDS_WAIT(); asm volatile("" ::: "memory");
}
__device__ __forceinline__ void seg_item(const float* W, int ldw, int c0, int ncols, int K, bf16* WT, int r0, int item, LAS float* scr, int lane) {
    const int nblk = (ncols + 31) / 32, kb = item / nblk, nb = item % nblk;
    const int nv = ncols - 32 * nb;
    transpose_item(W, ldw, c0 + 32 * nb, nv < 32 ? nv : 32, K, WT, r0 + 32 * nb, 64 * kb, scr, lane);
}

__constant__ double ROPE_INVF[16] = {1.0, 0.44036660267178046, 0.19392274474868576, 0.08539710028576561, 0.03760603093086393, 0.016560440080994446, 0.007292664737217109,
    0.003211445994752591, 0.001414213562373095, 0.000622772421914596, 0.0002742481756762073, 0.00012076973741146504, 5.318295896944988e-05, 2.341999896140934e-05,
    1.031338537721246e-05, 4.5416704806078695e-06};

__device__ __forceinline__ void sincos_f64(double x, float& sn, float& cs) {
    const double k = __builtin_rint(x * 0.6366197723675814);
    double r = __builtin_fma(-k, 1.5707963267948966, x); r = __builtin_fma(-k, 6.123233995736766e-17, r);
    const double r2 = r * r;
    double ps = -1.0 / 1307674368000.0; ps = ps * r2 + 1.0 / 6227020800.0; ps = ps * r2 - 1.0 / 39916800.0; ps = ps * r2 + 1.0 / 362880.0; ps = ps * r2 - 1.0 / 5040.0; ps = ps * r2 + 1.0 / 120.0; ps = ps * r2 - 1.0 / 6.0; ps = ps * r2 + 1.0;
    const double s = ps * r;
    double pc = 1.0 / 20922789888000.0; pc = pc * r2 - 1.0 / 87178291200.0; pc = pc * r2 + 1.0 / 479001600.0; pc = pc * r2 - 1.0 / 3628800.0; pc = pc * r2 + 1.0 / 40320.0; pc = pc * r2 - 1.0 / 720.0; pc = pc * r2 + 1.0 / 24.0; pc = pc * r2 - 0.5; pc = pc * r2 + 1.0;
    const int n = ((int)(long long)k) & 3;
    const double so = (n == 0) ? s : (n == 1) ? pc : (n == 2) ? -s : -pc;
    const double co = (n == 0) ? pc : (n == 1) ? -s : (n == 2) ? -pc : s;
    sn = (float)so; cs = (float)co;
}

constexpr int SEG_ITEMS[11] = {32 * 256, 32 * 64, 32 * 64, 32 * 2, 16 * 64, 64 * 8, 64 * 8, 32 * 64, 32 * 64, 32 * 256, 128 * 64};
constexpr int ITEMS_PER_LAYER = 8192 + 2048 + 2048 + 64 + 1024 + 512 + 512 + 2048 + 2048 + 8192 + 8192;
constexpr int W2T_ITEMS = 4 * 4;

__device__ __forceinline__ void p0_prologue(const Ptrs& P, LAS unsigned char* lds, int vcu, int G, int wave, int lane, int tid) {
    LAS float* scr = (LAS float*)(lds + wave * 16384);
    const int gw = vcu * NWAVES + wave, NGW = G * NWAVES;
    for (int it = gw; it < DEPTH * ITEMS_PER_LAYER; it += NGW) {
        const int l = it / ITEMS_PER_LAYER; int r = it % ITEMS_PER_LAYER;
        unsigned char* wl = P.ws + WS_WL + (size_t)l * WL_BYTES;
        const float* win = P.w_in + (size_t)l * DM * INW;
        if (r < SEG_ITEMS[0]) { seg_item(win, INW, 0, 8192, DM, (bf16*)(wl + WL_WIN), 0, r, scr, lane); continue; } r -= SEG_ITEMS[0];
        if (r < SEG_ITEMS[1]) { seg_item(win, INW, 8240, 2048, DM, (bf16*)(wl + WL_WIN), C_GA, r, scr, lane); continue; } r -= SEG_ITEMS[1];
        if (r < SEG_ITEMS[2]) { seg_item(win, INW, 10288, 2048, DM, (bf16*)(wl + WL_WIN), C_GB, r, scr, lane); continue; } r -= SEG_ITEMS[2];
        if (r < SEG_ITEMS[3]) { seg_item(win, INW, 8192, 48, DM, (bf16*)(wl + WL_WIN), C_GN, r, scr, lane); continue; } r -= SEG_ITEMS[3];
        if (r < SEG_ITEMS[4]) { seg_item(P.w_conv_out + (size_t)l * CWID * DM, DM, 0, DM, CWID, (bf16*)(wl + WL_WCONV), 0, r, scr, lane); continue; } r -= SEG_ITEMS[4];
        if (r < SEG_ITEMS[5]) { seg_item(P.cmp_w1 + (size_t)(l * 2 + 0) * 4096 * 256, 256, 0, 256, 4096, (bf16*)(wl + WL_W1T), 0, r, scr, lane); continue; } r -= SEG_ITEMS[5];
        if (r < SEG_ITEMS[6]) { seg_item(P.cmp_w1 + (size_t)(l * 2 + 1) * 4096 * 256, 256, 0, 256, 4096, (bf16*)(wl + WL_W1T) + (size_t)256 * 4096, 0, r, scr, lane); continue; } r -= SEG_ITEMS[6];
        if (r < SEG_ITEMS[7]) { seg_item(P.w_nsa + (size_t)l * DM * DM, DM, 0, DM, DM, (bf16*)(wl + WL_WNSA), 0, r, scr, lane); continue; } r -= SEG_ITEMS[7];
        if (r < SEG_ITEMS[8]) { seg_item(P.w_out + (size_t)l * DM * DM, DM, 0, DM, DM, (bf16*)(wl + WL_WOUT), 0, r, scr, lane); continue; } r -= SEG_ITEMS[8];
        if (r < SEG_ITEMS[9]) { seg_item(P.w_up + (size_t)l * DM * FF, FF, 0, FF, DM, (bf16*)(wl + WL_WUP), 0, r, scr, lane); continue; } r -= SEG_ITEMS[9];
        seg_item(P.w_down + (size_t)l * FF * DM, DM, 0, DM, FF, (bf16*)(wl + WL_WDOWN), 0, r, scr, lane);
    }
    for (int it = gw; it < DEPTH * 2 * W2T_ITEMS; it += NGW) {
        const int m = it / W2T_ITEMS, r = it % W2T_ITEMS;
        seg_item(P.cmp_w2 + (size_t)m * 256 * 128, 128, 0, 128, 256, (bf16*)(P.ws + WS_W2T) + (size_t)m * 128 * 256, 0, r, scr, lane);
    }
    __syncthreads();
    {
        float* cosT = (float*)(P.ws + WS_COS); float* sinT = (float*)(P.ws + WS_SIN);
        for (int e = vcu * 512 + tid; e < S * 16; e += G * 512) {
            const int t = e >> 4, i = e & 15; float sn, cs; sincos_f64((double)P.pos[t] * ROPE_INVF[i], sn, cs); cosT[e] = cs; sinT[e] = sn;
        }
    }
    {
        LAS float* cact = (LAS float*)lds;
        for (int k = tid; k < DM; k += 512) { const float cv = P.c[k]; cact[k] = cv * sigm(cv); }
        __syncthreads();
        float* modp = (float*)(P.ws + WS_MODP);
        for (int e = vcu * 512 + tid; e < DEPTH * 8 * (6 * DM / 4); e += G * 512) {
            const int l = e / (8 * 3072), rem = e % (8 * 3072), kc = rem / 3072, c4 = rem % 3072;
            const float* w = P.ada_w + ((size_t)l * DM + kc * 256) * (6 * DM) + c4 * 4;
            f32x4 acc = {0.f, 0.f, 0.f, 0.f};
#pragma unroll 8
            for (int k = 0; k < 256; ++k) { const f32x4 wv = *(const f32x4*)(w + (size_t)k * (6 * DM)); acc += wv * cact[kc * 256 + k]; }
            *(f32x4*)(modp + ((size_t)(l * 8 + kc) * (6 * DM)) + c4 * 4) = acc;
        }
        __syncthreads();
    }
    for (int w = vcu; w < DEPTH * 2 * 32; w += G) {
        const int m = w >> 5, ch = w & 31;
        if (tid < 256) {
            const float* pe = P.cmp_pe + (size_t)m * 4096 + ch * 128; const float* w1 = P.cmp_w1 + ((size_t)m * 4096 + ch * 128) * 256 + tid;
            float acc = 0.f;
#pragma unroll 8
            for (int k = 0; k < 128; ++k) acc += pe[k] * w1[(size_t)k * 256];
            ((float*)(P.ws + WS_B1PART))[(size_t)w * 256 + tid] = acc;
        }
    }
}

__device__ __forceinline__ f32x4 modvec4(const Ptrs& P, int l, int off) {
    f32x4 v = *(const f32x4*)(P.ada_b + (size_t)l * 6 * DM + off);
    const float* mp = (const float*)(P.ws + WS_MODP) + (size_t)l * 8 * 6 * DM + off;
#pragma unroll
    for (int kc = 0; kc < 8; ++kc) v += *(const f32x4*)(mp + (size_t)kc * 6 * DM);
    return v;
}

template <bool HAS_Y>
__device__ __forceinline__ void resid_phase(const Ptrs& P, LAS unsigned char* lds, const void* xsrc_, const bool src_bf, void* xdst_, const bool dst_bf, const bf16* Y, bf16* H, const bool make_h,
                                            int lg, int gate_k, int gainA, int lh, int sc_k, int sh_k, int gainB, int vcu, int G, int wave, int lane, int tid) {
    LAS f32x4* vga = (LAS f32x4*)lds; LAS f32x4* vhb = vga + 512; LAS f32x4* vhc = vhb + 512;
    {
        const int c = 4 * tid;
        if (HAS_Y) vga[tid] = modvec4(P, lg, gate_k * DM + c) * *(const f32x4*)(P.gains + (size_t)(lg * 4 + gainA) * DM + c);
        if (make_h) { vhb[tid] = *(const f32x4*)(P.gains + (size_t)(lh * 4 + gainB) * DM + c) * (modvec4(P, lh, sc_k * DM + c) + 1.0f); vhc[tid] = modvec4(P, lh, sh_k * DM + c); }
    }
    __syncthreads();
    const int gw = vcu * NWAVES + wave, NGW = G * NWAVES;
    for (int m = gw; m < S; m += NGW) {
        f32x4 xv[8];
        if (src_bf) { const u32x2* xr = (const u32x2*)((const bf16*)xsrc_ + (size_t)m * DM) + lane;
#pragma unroll
            for (int j = 0; j < 8; ++j) { const u32x2 w = xr[64 * j]; xv[j] = (f32x4){bf_lo(w.x), bf_hi(w.x), bf_lo(w.y), bf_hi(w.y)}; }
        } else { const f32x4* xr = (const f32x4*)((const float*)xsrc_ + (size_t)m * DM) + lane;
#pragma unroll
            for (int j = 0; j < 8; ++j) xv[j] = xr[64 * j]; }
        if (HAS_Y) {
            f32x4 yv[8]; float s = 0.f;
            const u32x2* yr = (const u32x2*)(Y + (size_t)m * DM) + lane;
#pragma unroll
            for (int j = 0; j < 8; ++j) { const u32x2 w = yr[64 * j]; yv[j] = (f32x4){bf_lo(w.x), bf_hi(w.x), bf_lo(w.y), bf_hi(w.y)}; s += (yv[j].x * yv[j].x + yv[j].y * yv[j].y) + (yv[j].z * yv[j].z + yv[j].w * yv[j].w); }
            const float r = 1.0f / sqrtf(wave_sum(s) * (1.0f / DM) + NORM_EPS);
#pragma unroll
            for (int j = 0; j < 8; ++j) xv[j] += vga[lane + 64 * j] * (yv[j] * r);
            if (dst_bf) { u32x2* xo = (u32x2*)((bf16*)xdst_ + (size_t)m * DM) + lane;
#pragma unroll
                for (int j = 0; j < 8; ++j) { u32x2 w; w.x = pk2(xv[j].x, xv[j].y); w.y = pk2(xv[j].z, xv[j].w); xo[64 * j] = w;
                    xv[j] = (f32x4){bf_lo(w.x), bf_hi(w.x), bf_lo(w.y), bf_hi(w.y)}; }
            } else { f32x4* xo = (f32x4*)((float*)xdst_ + (size_t)m * DM) + lane;
#pragma unroll
                for (int j = 0; j < 8; ++j) xo[64 * j] = xv[j]; }
        }
        if (make_h) {
            float s = 0.f;
#pragma unroll
            for (int j = 0; j < 8; ++j) s += (xv[j].x * xv[j].x + xv[j].y * xv[j].y) + (xv[j].z * xv[j].z + xv[j].w * xv[j].w);
            const float r = 1.0f / sqrtf(wave_sum(s) * (1.0f / DM) + NORM_EPS);
            u32x2* ho = (u32x2*)(H + (size_t)m * DM) + lane;
#pragma unroll
            for (int j = 0; j < 8; ++j) { const f32x4 h = (xv[j] * r) * vhb[lane + 64 * j] + vhc[lane + 64 * j]; u32x2 w; w.x = pk2(h.x, h.y); w.y = pk2(h.z, h.w); ho[64 * j] = w; }
        }
    }
    __syncthreads();
}

__device__ __forceinline__ void rope8(float (&v)[8], const float (&p)[8], const float* cs, const float* sn, int ch  ) {
#pragma unroll
    for (int j = 0; j < 8; ++j) { const float c = cs[8 * (ch & 1) + j], s = sn[8 * (ch & 1) + j];
        v[j] = (ch < 2) ? (v[j] * c - p[j] * s) : (v[j] * c + p[j] * s); }
}
__device__ __forceinline__ void relayout_phase(const Ptrs& P, int l, LAS unsigned char* lds, int vcu, int G, int tid) {
    const bf16* Pm = (const bf16*)(P.ws + WS_P);
    const float* cosT = (const float*)(P.ws + WS_COS); const float* sinT = (const float*)(P.ws + WS_SIN);
    if (vcu == 0) {
        const float* part = (const float*)(P.ws + WS_B1PART) + (size_t)l * 2 * 32 * 256;
        const int kv = tid >> 8, col = tid & 255; float a = P.cmp_b1[(size_t)(l * 2 + kv) * 256 + col];
        for (int ch = 0; ch < 32; ++ch) a += part[(size_t)(kv * 32 + ch) * 256 + col];
        ((float*)(P.ws + WS_B1P))[tid] = a;
    }
    for (int b = vcu; b < S / 64; b += G) {
        const int t0 = b * 64;
        {
            const float* cw = P.conv_w + (size_t)l * 3 * CWID; bf16* CV = (bf16*)(P.ws + WS_CV);
            for (int e = tid; e < 64 * 128; e += 512) {
                const int tl = e >> 7, c8 = (e & 127) * 8, t = t0 + tl;
                float z[8] = {0.f, 0.f, 0.f, 0.f, 0.f, 0.f, 0.f, 0.f};
#pragma unroll
                for (int k = 0; k < 3; ++k) { const int tt = t - 2 + k;
                    if (tt >= 0) { float cg[8], xa[8]; unpack8(*(const u32x4*)(Pm + (size_t)tt * PW + C_CG + c8), cg); unpack8(*(const u32x4*)(Pm + (size_t)tt * PW + C_XA + c8), xa);
                        const f32x4 w0 = *(const f32x4*)(cw + k * CWID + c8), w1 = *(const f32x4*)(cw + k * CWID + c8 + 4);
#pragma unroll
                        for (int j = 0; j < 8; ++j) z[j] += (j < 4 ? w0[j] : w1[j - 4]) * (cg[j] * xa[j]); } }
                float bg[8]; unpack8(*(const u32x4*)(Pm + (size_t)t * PW + C_BG + c8), bg);
#pragma unroll
                for (int j = 0; j < 8; ++j) z[j] *= bg[j];
                *(u32x4*)(CV + (size_t)t * CWID + c8) = pack8(z);
            }
        }
        {
            bf16* QP = (bf16*)(P.ws + WS_QP);
            for (int e = tid; e < 64 * 256; e += 512) {
                const int tl = e >> 8, hh = (e >> 4) & 15, ch = e & 15, t = t0 + tl;
                const bf16* src = Pm + (size_t)t * PW + C_Q + hh * HD;
                float v[8]; unpack8(*(const u32x4*)(src + 8 * ch), v);
                if (ch < 4) { float p[8]; unpack8(*(const u32x4*)(src + 8 * (ch ^ 2)), p); rope8(v, p, cosT + (size_t)t * 16, sinT + (size_t)t * 16, ch); }
#pragma unroll
                for (int j = 0; j < 8; ++j) v[j] *= QSCALE;
                *(u32x4*)(QP + (size_t)t * DM + hh * HD + 8 * ch) = pack8(v);
            }
        }
        for (int e = tid; e < 4 * 4 * 64 * 16; e += 512) {
            const int pi = e >> 12, g = (e >> 10) & 3, kap = (e >> 4) & 63, ch = e & 15, t = t0 + kap;
            const int part = (pi == 0) ? 0 : (pi == 1) ? 2 : (pi == 2) ? 4 : 1;
            const bf16* src = Pm + (size_t)t * PW + C_KV + part * 512 + g * HD;
            float v[8]; unpack8(*(const u32x4*)(src + 8 * ch), v);
            if (part != 1 && ch < 4) { float p[8]; unpack8(*(const u32x4*)(src + 8 * (ch ^ 2)), p); rope8(v, p, cosT + (size_t)t * 16, sinT + (size_t)t * 16, ch); }
            const u32x4 w = pack8(v);
            if (part == 0) *(u32x4*)((bf16*)(P.ws + WS_KCR) + ((size_t)g * S + t) * HD + 8 * ch) = w;
            else if (part == 1) *(u32x4*)((bf16*)(P.ws + WS_VCR) + ((size_t)g * S + t) * HD + 8 * ch) = w;
            else { unsigned char* img = P.ws + (part == 2 ? WS_KSI : WS_KWI) + ((size_t)g * 256 + b) * 16384; *(u32x4*)(img + kimg_off(kap, ch)) = w; }
        }
        for (int vp = 0; vp < 2; ++vp) {
            const int part = 3 + 2 * vp;
            LAS unsigned short* tile = (LAS unsigned short*)lds;
            for (int e = tid; e < 4 * 64 * 16; e += 512) {
                const int g = e >> 10, kap = (e >> 4) & 63, ch = e & 15;
                const u32x4 w = *(const u32x4*)(Pm + (size_t)(t0 + kap) * PW + C_KV + part * 512 + g * HD + 8 * ch);
                *(LAS u32x4*)(tile + (g * 64 + kap) * 136 + 8 * ch) = w;
            }
            __syncthreads();
            for (int e = tid; e < 4 * 128 * 8; e += 512) {
                const int g = e >> 10, d = (e >> 3) & 127, kc = e & 7;
                const LAS unsigned short* s = tile + (g * 64 + 8 * kc) * 136 + d;
                u32x4 w; w.x = (unsigned)s[0] | ((unsigned)s[136] << 16); w.y = (unsigned)s[2 * 136] | ((unsigned)s[3 * 136] << 16);
                w.z = (unsigned)s[4 * 136] | ((unsigned)s[5 * 136] << 16); w.w = (unsigned)s[6 * 136] | ((unsigned)s[7 * 136] << 16);
                unsigned char* img = P.ws + (part == 3 ? WS_VSI : WS_VWI) + ((size_t)g * 256 + b) * 16384;
                *(u32x4*)(img + vimg_off(d, kc)) = w;
            }
            __syncthreads();
        }
        {
            float* GT = (float*)(P.ws + WS_GT);
            const bf16* Hb = (const bf16*)(P.ws + WS_H); const bf16* Wg = (const bf16*)(P.ws + WS_WL + (size_t)l * WL_BYTES + WL_WIN) + (size_t)C_GN * DM;
            const int wv = tid >> 6, ln = tid & 63, r16 = ln & 15, q4 = ln >> 4, rt = wv & 3, ct0 = (wv < 4) ? 0 : 2, nct = (wv < 4) ? 2 : 1;
            f32x4 acc[2] = {(f32x4){0.f, 0.f, 0.f, 0.f}, (f32x4){0.f, 0.f, 0.f, 0.f}};
            const bf16* ap = Hb + (size_t)(t0 + rt * 16 + r16) * DM + 8 * q4;
            const bf16* bp0 = Wg + (size_t)(ct0 * 16 + r16) * DM + 8 * q4; const bf16* bp1 = bp0 + (size_t)16 * DM;
#pragma unroll 4
            for (int ks = 0; ks < DM / 32; ++ks) {
                const bf16x8 af = *(const bf16x8*)(ap + 32 * ks);
                acc[0] = __builtin_amdgcn_mfma_f32_16x16x32_bf16(af, *(const bf16x8*)(bp0 + 32 * ks), acc[0], 0, 0, 0);
                if (nct == 2) acc[1] = __builtin_amdgcn_mfma_f32_16x16x32_bf16(af, *(const bf16x8*)(bp1 + 32 * ks), acc[1], 0, 0, 0);
            }
#pragma unroll
            for (int c = 0; c < 2; ++c) if (c < nct) {
#pragma unroll
                for (int i = 0; i < 4; ++i) GT[(size_t)(t0 + rt * 16 + 4 * q4 + i) * 48 + (ct0 + c) * 16 + r16] = sigm(acc[c][i]); }
        }
    }
}

__device__ __forceinline__ void cmp2_phase(const Ptrs& P, int l, int vcu, int G, int wave, int lane) {
    const int r16 = lane & 15, q = lane >> 4;
    for (int e = vcu; e < 128; e += G) {
        const int kv = e >> 6, g = (e >> 4) & 3, blk = e & 15;
        const bf16* HC = (const bf16*)(P.ws + WS_HC) + ((size_t)kv * 4096 + g * 1024 + blk * 64) * 256;
        const bf16* W2T = (const bf16*)(P.ws + WS_W2T) + (size_t)(l * 2 + kv) * 128 * 256;
        const float* b2 = P.cmp_b2 + (size_t)(l * 2 + kv) * 128;
        const int rt = wave & 3, ch = wave >> 2;
        bf16x8 af[8];
#pragma unroll
        for (int ks = 0; ks < 8; ++ks) af[ks] = *(const bf16x8*)(HC + (size_t)(rt * 16 + r16) * 256 + 32 * ks + 8 * q);
        unsigned char* img = P.ws + (kv == 0 ? WS_KCI : WS_VCI) + ((size_t)g * 16 + blk) * 16384;
#pragma unroll
        for (int ct = 0; ct < 4; ++ct) {
            const int n = ch * 64 + ct * 16 + r16;
            f32x4 acc = {0.f, 0.f, 0.f, 0.f};
#pragma unroll
            for (int ks = 0; ks < 8; ++ks) { const bf16x8 bfr = *(const bf16x8*)(W2T + (size_t)n * 256 + 32 * ks + 8 * q);
                acc = __builtin_amdgcn_mfma_f32_16x16x32_bf16(af[ks], bfr, acc, 0, 0, 0); }
            const float bb = b2[n];
            if (kv == 0) {
#pragma unroll
                for (int i = 0; i < 4; ++i) { const int kap = rt * 16 + 4 * q + i; *(bf16*)(img + kimg_off(kap, n >> 3) + (n & 7) * 2) = (bf16)f2bf(acc[i] + bb); }
            } else {
                const int kap0 = rt * 16 + 4 * q; u32x2 w; w.x = pk2(acc[0] + bb, acc[1] + bb); w.y = pk2(acc[2] + bb, acc[3] + bb);
                *(u32x2*)(img + vimg_off(n, kap0 >> 3) + (kap0 & 7) * 2) = w;
            }
        }
    }
}

#ifndef DBG_REP_SEL
#define DBG_REP_SEL 1
#endif
#ifndef DBG_BR
#define DBG_BR 7
#endif
#ifndef DBG_SANITIZE
#define DBG_SANITIZE 0
#endif
#ifndef DBG_DENSE_SEL
#define DBG_DENSE_SEL 0
#endif
struct AttnLane { unsigned kb, vb; int kx, vx; int q; };
#define AL_KOFF(L_, s_) ((L_).kb + 64u * (unsigned)((s_) ^ (L_).kx))
#define AL_VOFF(L_, a_) ((L_).vb + 64u * (unsigned)((a_) ^ (L_).vx))

__device__ __forceinline__ bf16x8 pack_p(const f32x4 a, const f32x4 b) {
    u32x4 w; w.x = pg8::cvt_pk_bf16(a[0], a[1]); w.y = pg8::cvt_pk_bf16(a[2], a[3]); w.z = pg8::cvt_pk_bf16(b[0], b[1]); w.w = pg8::cvt_pk_bf16(b[2], b[3]);
    return __builtin_bit_cast(bf16x8, w);
}
__device__ __forceinline__ void lds_fadd(LAS float* p, float v) { (void)__hip_atomic_fetch_add(p, v, __ATOMIC_RELAXED, __HIP_MEMORY_SCOPE_WORKGROUP); }
template <int CTRL> __device__ __forceinline__ unsigned dpp_u_(unsigned v) { return (unsigned)__builtin_amdgcn_update_dpp(0, (int)v, CTRL, 0xF, 0xF, false); }
__device__ __forceinline__ unsigned wave_umax(unsigned v) {
    v = max(v, dpp_u_<0xB1>(v)); v = max(v, dpp_u_<0x4E>(v)); v = max(v, dpp_u_<0x141>(v)); v = max(v, dpp_u_<0x140>(v));
    auto r16 = __builtin_amdgcn_permlane16_swap(v, v, false, false); v = max(r16[0], r16[1]);
    auto r32 = __builtin_amdgcn_permlane32_swap(v, v, false, false); return max(r32[0], r32[1]);
}
__device__ __forceinline__ unsigned wave_umin(unsigned v) {
    v = min(v, dpp_u_<0xB1>(v)); v = min(v, dpp_u_<0x4E>(v)); v = min(v, dpp_u_<0x141>(v)); v = min(v, dpp_u_<0x140>(v));
    auto r16 = __builtin_amdgcn_permlane16_swap(v, v, false, false); v = min(r16[0], r16[1]);
    auto r32 = __builtin_amdgcn_permlane32_swap(v, v, false, false); return min(r32[0], r32[1]);
}
__device__ __forceinline__ float quad_sum(float v) {
    v += __builtin_bit_cast(float, __builtin_amdgcn_update_dpp(0, __builtin_bit_cast(int, v), 0xB1, 0xF, 0xF, false));
    v += __builtin_bit_cast(float, __builtin_amdgcn_update_dpp(0, __builtin_bit_cast(int, v), 0x4E, 0xF, 0xF, false));
    return v;
}
__device__ __forceinline__ void ldsr128(bf16x8& d, unsigned addr) { asm volatile("ds_read_b128 %0, %1" : "=v"(d) : "v"(addr)); }
__device__ __forceinline__ void ldsr128o(bf16x8& d, unsigned addr, const int off) { asm volatile("ds_read_b128 %0, %1 offset:%2" : "=v"(d) : "v"(addr), "i"(off)); }
#define LDS_WAIT4(n, a, b, c, d) asm volatile("s_waitcnt lgkmcnt(" #n ")" : "+v"(a), "+v"(b), "+v"(c), "+v"(d))
template <bool T0, bool T1, int MODE>
__device__ __forceinline__ void block_step(LAS const unsigned char* Kb, LAS const unsigned char* Vb, const AttnLane& L, const bf16x8 (&qf)[2][4],
                                           f32x4 (&O)[2][8], float (&m)[2], float (&l)[2], const int (&limq)[2], const unsigned W,
                                           const float (&invl)[2], LAS float* const (&improw)[2], const int j0, const bool hzero, const bool MASKB) {
    AttnLane Lq = L; asm volatile("" : "+v"(Lq.kb), "+v"(Lq.vb));
    f32x4 st[2][4];
    const f32x4 z = {0.f, 0.f, 0.f, 0.f};
    {
        __builtin_amdgcn_s_setprio(1);
        const unsigned kbase = (unsigned)(uintptr_t)Kb;
        unsigned ka[4];
#pragma unroll
        for (int s = 0; s < 4; ++s) ka[s] = kbase + AL_KOFF(Lq, s);
        bf16x8 fa[4], fb[4];
#pragma unroll
        for (int s = 0; s < 4; ++s) ldsr128(fa[s], ka[s]);
#pragma unroll
        for (int kt = 0; kt < 4; ++kt) {
            if (kt < 3) {
#pragma unroll
                for (int s = 0; s < 4; ++s) { if ((kt & 1) == 0) ldsr128o(fb[s], ka[s], (kt + 1) * 4096); else ldsr128o(fa[s], ka[s], (kt + 1) * 4096); }
            }
            if ((kt & 1) == 0) { if (kt < 3) LDS_WAIT4(4, fa[0], fa[1], fa[2], fa[3]); else LDS_WAIT4(0, fa[0], fa[1], fa[2], fa[3]); }
            else               { if (kt < 3) LDS_WAIT4(4, fb[0], fb[1], fb[2], fb[3]); else LDS_WAIT4(0, fb[0], fb[1], fb[2], fb[3]); }
#pragma unroll
            for (int s = 0; s < 4; ++s) { const bf16x8 a = ((kt & 1) == 0) ? fa[s] : fb[s];
                if (T0) st[0][kt] = __builtin_amdgcn_mfma_f32_16x16x32_bf16(a, qf[0][s], s == 0 ? z : st[0][kt], 0, 0, 0);
                if (T1) st[1][kt] = __builtin_amdgcn_mfma_f32_16x16x32_bf16(a, qf[1][s], s == 0 ? z : st[1][kt], 0, 0, 0); }
        }
    }
    __builtin_amdgcn_s_setprio(0);
    bf16x8 pf[2][2];
#pragma unroll
    for (int ts = 0; ts < 2; ++ts) {
        if (!(ts == 0 ? T0 : T1)) continue;
        const float NEG = -__builtin_inff();
        if (MASKB) {
#pragma unroll
        for (int kt = 0; kt < 4; ++kt)
#pragma unroll
            for (int i = 0; i < 4; ++i) { const int kc = 32 * (kt >> 1) + 4 * (kt & 1) + i; if ((unsigned)(limq[ts] - kc) >= W) st[ts][kt][i] = NEG; }
        }
        if (MODE != 1) {
            float mx = fmaxf(fmaxf(st[ts][0][0], st[ts][0][1]), fmaxf(st[ts][0][2], st[ts][0][3]));
#pragma unroll
            for (int kt = 1; kt < 4; ++kt) mx = fmaxf(mx, fmaxf(fmaxf(st[ts][kt][0], st[ts][kt][1]), fmaxf(st[ts][kt][2], st[ts][kt][3])));
            { auto r16 = __builtin_amdgcn_permlane16_swap(__float_as_uint(mx), __float_as_uint(mx), false, false); mx = fmaxf(__uint_as_float(r16[0]), __uint_as_float(r16[1]));
              auto r32 = __builtin_amdgcn_permlane32_swap(__float_as_uint(mx), __float_as_uint(mx), false, false); mx = fmaxf(__uint_as_float(r32[0]), __uint_as_float(r32[1])); }
            const float mn = fmaxf(m[ts], mx), alpha = __builtin_amdgcn_exp2f(m[ts] - mn); m[ts] = mn;
            float sum = 0.f;
#pragma unroll
            for (int kt = 0; kt < 4; ++kt)
#pragma unroll
                for (int i = 0; i < 4; ++i) { const float pv = __builtin_amdgcn_exp2f(st[ts][kt][i] - mn); st[ts][kt][i] = pv; sum += pv; }
            l[ts] = l[ts] * alpha + sum;
            if (MODE == 2) {
#pragma unroll
                for (int dt = 0; dt < 8; ++dt) O[ts][dt] *= alpha;
            }
        } else {
#pragma unroll
            for (int kt = 0; kt < 4; ++kt)
#pragma unroll
                for (int i = 0; i < 4; ++i) st[ts][kt][i] = __builtin_amdgcn_exp2f(st[ts][kt][i] - m[ts]) * invl[ts];
            float A[4], B[4];
#pragma unroll
            for (int kt = 0; kt < 4; ++kt) { B[kt] = 0.5f * st[ts][kt][3]; A[kt] = quad_sum((st[ts][kt][0] + st[ts][kt][1]) + (st[ts][kt][2] + B[kt])); B[kt] = quad_sum(B[kt]); }
            if (hzero) { LAS float* ir = improw[ts] + j0;
                lds_fadd(ir + 0, A[0]); lds_fadd(ir + 1, B[0] + A[1]); lds_fadd(ir + 2, B[1]); lds_fadd(ir + 8, A[2]); lds_fadd(ir + 9, B[2] + A[3]); lds_fadd(ir + 10, B[3]); }
        }
        if (MODE != 0) { pf[ts][0] = pack_p(st[ts][0], st[ts][1]); pf[ts][1] = pack_p(st[ts][2], st[ts][3]); }
    }
    if (MODE != 0) {
        __builtin_amdgcn_s_setprio(1);
        const unsigned vbase = (unsigned)(uintptr_t)Vb;
        unsigned va[2];
#pragma unroll
        for (int a = 0; a < 2; ++a) va[a] = vbase + AL_VOFF(Lq, a);
        bf16x8 fa[4], fb[4];
#pragma unroll
        for (int j = 0; j < 4; ++j) ldsr128o(fa[j], va[j & 1], (j >> 1) * 2048);
#pragma unroll
        for (int dp = 0; dp < 4; ++dp) {
            if (dp < 3) {
#pragma unroll
                for (int j = 0; j < 4; ++j) { if ((dp & 1) == 0) ldsr128o(fb[j], va[j & 1], (2 * (dp + 1) + (j >> 1)) * 2048); else ldsr128o(fa[j], va[j & 1], (2 * (dp + 1) + (j >> 1)) * 2048); }
            }
            if ((dp & 1) == 0) { if (dp < 3) LDS_WAIT4(4, fa[0], fa[1], fa[2], fa[3]); else LDS_WAIT4(0, fa[0], fa[1], fa[2], fa[3]); }
            else               { if (dp < 3) LDS_WAIT4(4, fb[0], fb[1], fb[2], fb[3]); else LDS_WAIT4(0, fb[0], fb[1], fb[2], fb[3]); }
#pragma unroll
            for (int j = 0; j < 4; ++j) { const bf16x8 v = ((dp & 1) == 0) ? fa[j] : fb[j]; const int dt = 2 * dp + (j >> 1), a = j & 1;
                if (T0) O[0][dt] = __builtin_amdgcn_mfma_f32_16x16x32_bf16(v, pf[0][a], O[0][dt], 0, 0, 0);
                if (T1) O[1][dt] = __builtin_amdgcn_mfma_f32_16x16x32_bf16(v, pf[1][a], O[1][dt], 0, 0, 0); }
        }
        __builtin_amdgcn_s_setprio(0);
    }
}


constexpr float ATT_THR = 8.0f;
__device__ __forceinline__ float max3f_(float a, float b, float c) { return fmaxf(fmaxf(a, b), c); }
template <bool T0, bool T1>
__device__ __forceinline__ void step_online(LAS const unsigned char* Kb, LAS const unsigned char* Vb, const AttnLane& L, const bf16x8 (&qf)[2][4],
                                            f32x4 (&O)[2][8], float (&mref)[2], float (&l)[2], const int (&limq)[2], const unsigned W, const bool MASK, const bool START) {
    AttnLane Lq = L; asm volatile("" : "+v"(Lq.kb), "+v"(Lq.vb));
    f32x4 st[2][4];
    const float NEG = -__builtin_inff();
#pragma unroll
    for (int ts = 0; ts < 2; ++ts) { const float c0 = START ? 0.f : (limq[ts] > -500 ? -mref[ts] : NEG);
#pragma unroll
        for (int kt = 0; kt < 4; ++kt) st[ts][kt] = (f32x4){c0, c0, c0, c0}; }
    {
        __builtin_amdgcn_s_setprio(1);
        const unsigned kbase = (unsigned)(uintptr_t)Kb;
        unsigned ka[4];
#pragma unroll
        for (int s = 0; s < 4; ++s) ka[s] = kbase + AL_KOFF(Lq, s);
        bf16x8 fa[4], fb[4];
#pragma unroll
        for (int s = 0; s < 4; ++s) ldsr128(fa[s], ka[s]);
#pragma unroll
        for (int kt = 0; kt < 4; ++kt) {
            if (kt < 3) {
#pragma unroll
                for (int s = 0; s < 4; ++s) { if ((kt & 1) == 0) ldsr128o(fb[s], ka[s], (kt + 1) * 4096); else ldsr128o(fa[s], ka[s], (kt + 1) * 4096); }
            }
            if ((kt & 1) == 0) { if (kt < 3) LDS_WAIT4(4, fa[0], fa[1], fa[2], fa[3]); else LDS_WAIT4(0, fa[0], fa[1], fa[2], fa[3]); }
            else               { if (kt < 3) LDS_WAIT4(4, fb[0], fb[1], fb[2], fb[3]); else LDS_WAIT4(0, fb[0], fb[1], fb[2], fb[3]); }
#pragma unroll
            for (int s = 0; s < 4; ++s) { const bf16x8 a = ((kt & 1) == 0) ? fa[s] : fb[s];
                if (T0) st[0][kt] = __builtin_amdgcn_mfma_f32_16x16x32_bf16(a, qf[0][s], st[0][kt], 0, 0, 0);
                if (T1) st[1][kt] = __builtin_amdgcn_mfma_f32_16x16x32_bf16(a, qf[1][s], st[1][kt], 0, 0, 0); }
        }
    }
    __builtin_amdgcn_s_setprio(0);
    __builtin_amdgcn_sched_barrier(0);
    bf16x8 pf[2][2];
#pragma unroll
    for (int ts = 0; ts < 2; ++ts) {
        if (!(ts == 0 ? T0 : T1)) continue;
        if (MASK || START) {
#pragma unroll
            for (int kt = 0; kt < 4; ++kt)
#pragma unroll
                for (int i = 0; i < 4; ++i) { const int kc = 32 * (kt >> 1) + 4 * (kt & 1) + i; if ((unsigned)(limq[ts] - kc) >= W) st[ts][kt][i] = NEG; }
        }
        float mx = max3f_(st[ts][0][0], st[ts][0][1], st[ts][0][2]);
        mx = max3f_(mx, st[ts][0][3], st[ts][1][0]); mx = max3f_(mx, st[ts][1][1], st[ts][1][2]); mx = max3f_(mx, st[ts][1][3], st[ts][2][0]);
        mx = max3f_(mx, st[ts][2][1], st[ts][2][2]); mx = max3f_(mx, st[ts][2][3], st[ts][3][0]); mx = max3f_(mx, st[ts][3][1], st[ts][3][2]); mx = fmaxf(mx, st[ts][3][3]);
#define XLANE_MAX_(v_) do { auto r16 = __builtin_amdgcn_permlane16_swap(__float_as_uint(v_), __float_as_uint(v_), false, false); v_ = fmaxf(__uint_as_float(r16[0]), __uint_as_float(r16[1])); \
          auto r32 = __builtin_amdgcn_permlane32_swap(__float_as_uint(v_), __float_as_uint(v_), false, false); v_ = fmaxf(__uint_as_float(r32[0]), __uint_as_float(r32[1])); } while (0)
        if (START) {
            XLANE_MAX_(mx);
            const float m0 = fmaxf(mx, -1.0e4f); mref[ts] = m0;
#pragma unroll
            for (int kt = 0; kt < 4; ++kt) st[ts][kt] -= m0;
        } else if (__builtin_expect(__any(mx > ATT_THR), 0)) {
            XLANE_MAX_(mx);
            const float dl = fmaxf(mx, 0.f), f = __builtin_amdgcn_exp2f(-dl); mref[ts] += dl; l[ts] *= f;
#pragma unroll
            for (int kt = 0; kt < 4; ++kt) st[ts][kt] -= dl;
#pragma unroll
            for (int dt = 0; dt < 8; ++dt) O[ts][dt] *= f;
        }
        float sum = 0.f;
#pragma unroll
        for (int kt = 0; kt < 4; ++kt)
#pragma unroll
            for (int i = 0; i < 4; ++i) { const float pv = __builtin_amdgcn_exp2f(st[ts][kt][i]); st[ts][kt][i] = pv; sum += pv; }
        l[ts] += sum;
        pf[ts][0] = pack_p(st[ts][0], st[ts][1]); pf[ts][1] = pack_p(st[ts][2], st[ts][3]);
        __builtin_amdgcn_sched_barrier(0);
    }
    {
        __builtin_amdgcn_s_setprio(1);
        const unsigned vbase = (unsigned)(uintptr_t)Vb;
        unsigned va[2];
#pragma unroll
        for (int a = 0; a < 2; ++a) va[a] = vbase + AL_VOFF(Lq, a);
        bf16x8 fa[4], fb[4];
#pragma unroll
        for (int j = 0; j < 4; ++j) ldsr128o(fa[j], va[j & 1], (j >> 1) * 2048);
#pragma unroll
        for (int dp = 0; dp < 4; ++dp) {
            if (dp < 3) {
#pragma unroll
                for (int j = 0; j < 4; ++j) { if ((dp & 1) == 0) ldsr128o(fb[j], va[j & 1], (2 * (dp + 1) + (j >> 1)) * 2048); else ldsr128o(fa[j], va[j & 1], (2 * (dp + 1) + (j >> 1)) * 2048); }
            }
            if ((dp & 1) == 0) { if (dp < 3) LDS_WAIT4(4, fa[0], fa[1], fa[2], fa[3]); else LDS_WAIT4(0, fa[0], fa[1], fa[2], fa[3]); }
            else               { if (dp < 3) LDS_WAIT4(4, fb[0], fb[1], fb[2], fb[3]); else LDS_WAIT4(0, fb[0], fb[1], fb[2], fb[3]); }
#pragma unroll
            for (int j = 0; j < 4; ++j) { const bf16x8 v = ((dp & 1) == 0) ? fa[j] : fb[j]; const int dt = 2 * dp + (j >> 1), a = j & 1;
                if (T0) O[0][dt] = __builtin_amdgcn_mfma_f32_16x16x32_bf16(v, pf[0][a], O[0][dt], 0, 0, 0);
                if (T1) O[1][dt] = __builtin_amdgcn_mfma_f32_16x16x32_bf16(v, pf[1][a], O[1][dt], 0, 0, 0); }
        }
        __builtin_amdgcn_s_setprio(0);
    }
    __builtin_amdgcn_sched_barrier(0);
}
__device__ __forceinline__ void glds16(const void* gsrc, unsigned lds_dst) { unsigned keep;
    asm volatile("s_mov_b32 %0, m0\n\ts_mov_b32 m0, %2\n\ts_nop 0\n\tglobal_load_lds_dwordx4 %1, off\n\ts_mov_b32 m0, %0" : "=&s"(keep) : "v"(gsrc), "s"(lds_dst) : "memory"); }

__device__ __forceinline__ void glds16s(const void* sbase, unsigned voff, unsigned lds_dst) { unsigned keep;
    asm volatile("s_mov_b32 %0, m0\n\ts_mov_b32 m0, %3\n\ts_nop 0\n\tglobal_load_lds_dwordx4 %1, %2\n\ts_mov_b32 m0, %0" : "=&s"(keep) : "v"(voff), "s"(sbase), "s"(lds_dst) : "memory"); }

#define AT_BAR() do { asm volatile("s_waitcnt lgkmcnt(0)" ::: "memory"); __builtin_amdgcn_s_barrier(); asm volatile("" ::: "memory"); } while (0)
#define AT_STAGE(gsrc, ldsoff) do { unsigned _lo = (unsigned)lane * 16u; asm volatile("" : "+v"(_lo)); _Pragma("unroll") for (int _p = 0; _p < 2; ++_p) \
    glds16s((gsrc) + (_p * 8 + wave) * 1024, _lo, (unsigned)__builtin_amdgcn_readfirstlane((int)(ldsb + (unsigned)(ldsoff) + (unsigned)(_p * 8 + wave) * 1024u))); } while (0)
#define AT_WAITV(n) asm volatile("s_waitcnt vmcnt(" #n ")" ::: "memory")

__device__ __forceinline__ void attn_phase(const Ptrs& P, LAS unsigned char* lds, int vcu, int G, int wave, int lane) {
    const unsigned ldsb = (unsigned)(uintptr_t)lds;
    const bf16* QP = (const bf16*)(P.ws + WS_QP);
    const float* GT = (const float*)(P.ws + WS_GT);
    bf16* AO = (bf16*)(P.ws + WS_AO);
    LAS float* impw = (LAS float*)(lds + AT_IMP) + 8 * wave * IMP_STRIDE;
    LAS unsigned* selw = (LAS unsigned*)(lds + AT_SELW) + wave * 256;
#define AT_REGION() int ln_ = lane; asm volatile("" : "+v"(ln_)); const int c16 = ln_ & 15, q = ln_ >> 4, hh = c16 & 3, tq = c16 >> 2; AttnLane L; L.q = q; \
    L.kb = (unsigned)(c16 * 256 + (((q ^ c16) & 3) << 4)); L.kx = (c16 >> 2) & 3; L.vb = (unsigned)(c16 * 128 + (((q ^ (c16 >> 1)) & 3) << 4)); L.vx = (c16 >> 3) & 1; \
    const bool hzero = (hh == 0); const int tok0 = t0 + 8 * wave + tq; (void)hzero; (void)tok0; (void)L
#define tok_(ts_) (tok0 + 4 * (ts_))
#define GATE(ts_, br_) (GT[(size_t)tok_(ts_) * 48 + (4 * g + hh) * 3 + (br_)])
#define FSAT(k_) (*(f32x4*)(FSb + (fo_ + (unsigned)(k_) * 1024u)))
#define FS_OFF() unsigned fo_ = (unsigned)ln_ * 16u

    for (int e = vcu; e < 1024; e += G) {
        const int k4 = e >> 8, v = e & 255, xcd = v >> 5, g = xcd & 3, hi2 = xcd >> 2, j = v & 31;
        const int stepk = hi2 ? ((k4 == 0) ? 6 : (k4 == 1) ? 5 : (k4 == 2) ? 2 : 1) : ((k4 == 0) ? 7 : (k4 == 1) ? 4 : (k4 == 2) ? 3 : 0);
        const int tile = 32 * stepk + ((k4 & 1) ? 31 - j : j);
        const int t0 = tile * 64;
        unsigned char* FSb = P.ws + WS_FS + ((size_t)((vcu & 255) * 8 + wave)) * 32768;
        bf16x8 qf[2][4];
        f32x4 O[2][8];
        float l[2] = {0.f, 0.f};
        int limq[2];
        {
            AT_REGION();
#pragma unroll
            for (int ts = 0; ts < 2; ++ts) {
#pragma unroll
                for (int s = 0; s < 4; ++s) qf[ts][s] = *(const bf16x8*)(QP + (size_t)tok_(ts) * DM + (4 * g + hh) * HD + 32 * s + 8 * q);
            }
            for (int i = ln_; i < 8 * IMP_STRIDE; i += 64) impw[i] = 0.f;
            for (int i = ln_; i < 256; i += 64) selw[i] = 0u;
#pragma unroll
            for (int ts = 0; ts < 2; ++ts)
#pragma unroll
                for (int dt = 0; dt < 8; ++dt) O[ts][dt] = (f32x4){0.f, 0.f, 0.f, 0.f};
            float m[2] = {-1e30f, -1e30f}, invl[2] = {0.f, 0.f};
            LAS float* improw[2]; improw[0] = impw + tq * IMP_STRIDE; improw[1] = impw + (4 + tq) * IMP_STRIDE;
            VM_WAIT(); LDS_WAIT();
            const int nbc = (DBG_BR & 1) ? ((4 * tile + 2) >> 6) + 1 : 0;
            const unsigned char* kci = P.ws + WS_KCI + (size_t)g * 16 * 16384; const unsigned char* vci = P.ws + WS_VCI + (size_t)g * 16 * 16384;
            if (DBG_BR & 1) AT_STAGE(kci, AT_KV);
            for (int b = 0; b < nbc; ++b) {
                const int buf = (b & 1) * 32768;
                if (b + 1 < nbc) { AT_STAGE(kci + (size_t)(b + 1) * 16384, AT_KV + (buf ^ 32768)); AT_WAITV(2); }
                else AT_WAITV(0);
                AT_BAR();
#pragma unroll
                for (int ts = 0; ts < 2; ++ts) limq[ts] = ((tok_(ts) - 31) >> 4) - 64 * b - 8 * q;
                block_step<true, true, 0>(lds + AT_KV + buf, lds + AT_KV + buf + 16384, L, qf, O, m, l, limq, 0x80000000u, invl, improw, 0, hzero, b + 2 >= nbc);
                AT_BAR();
            }
#pragma unroll
            for (int ts = 0; ts < 2; ++ts) { float lt = l[ts]; lt += __shfl_xor(lt, 16); lt += __shfl_xor(lt, 32); invl[ts] = lt > 0.f ? 1.0f / lt : 0.f; }
            if (DBG_BR & 1) { AT_STAGE(kci, AT_KV); AT_STAGE(vci, AT_KV + 16384); }
            for (int b = 0; b < nbc; ++b) {
                const int buf = (b & 1) * 32768;
                if (b + 1 < nbc) { AT_STAGE(kci + (size_t)(b + 1) * 16384, AT_KV + (buf ^ 32768)); AT_STAGE(vci + (size_t)(b + 1) * 16384, AT_KV + (buf ^ 32768) + 16384); AT_WAITV(4); }
                else AT_WAITV(0);
                AT_BAR();
#pragma unroll
                for (int ts = 0; ts < 2; ++ts) limq[ts] = ((tok_(ts) - 31) >> 4) - 64 * b - 8 * q;
                block_step<true, true, 1>(lds + AT_KV + buf, lds + AT_KV + buf + 16384, L, qf, O, m, l, limq, 0x80000000u, invl, improw, 16 * b + 2 * q, hzero, b + 2 >= nbc);
                AT_BAR();
            }
            FS_OFF();
#pragma unroll
            for (int ts = 0; ts < 2; ++ts)
#pragma unroll
                for (int dt = 0; dt < 8; ++dt) FSAT(ts * 8 + dt) = O[ts][dt] * GATE(ts, 0);
        }
        LDS_WAIT();
        {
            const int Ksel = (!(DBG_BR & 2) || DBG_DENSE_SEL >= 2) ? 0 : (tile - 1) < 14 ? (tile - 1) : 14;
            int lane_k = lane; asm volatile("" : "+v"(lane_k));
            unsigned wsel[4] = {0u, 0u, 0u, 0u};
            bool cand[4];
#pragma unroll
            for (int e4 = 0; e4 < 4; ++e4) { const int jj = lane_k + 64 * e4; cand[e4] = (jj >= 1 && jj <= tile - 1); }
            if (Ksel > 0) {
                const bool all_sel = (tile - 1) <= 14;
                for (int tl = 0; tl < 8; ++tl) {
                    const LAS float* row = impw + tl * IMP_STRIDE;
                    unsigned val[4];
#pragma unroll
                    for (int e4 = 0; e4 < 4; ++e4) val[e4] = cand[e4] ? __float_as_uint(row[lane_k + 64 * e4]) : 0u;
                    bool sel[4];
                    if (all_sel) {
#pragma unroll
                        for (int e4 = 0; e4 < 4; ++e4) sel[e4] = cand[e4];
                    } else {
                        unsigned vmx = max(max(val[0], val[1]), max(val[2], val[3]));
                        unsigned vmn = min(min(cand[0] ? val[0] : 0xffffffffu, cand[1] ? val[1] : 0xffffffffu), min(cand[2] ? val[2] : 0xffffffffu, cand[3] ? val[3] : 0xffffffffu));
                        vmx = wave_umax(vmx); vmn = wave_umin(vmn);
                        const unsigned dif = (unsigned)__builtin_amdgcn_readfirstlane((int)(vmx ^ vmn));
                        const int hb = 31 - __builtin_clz(dif | 1u);
                        unsigned cur = (unsigned)__builtin_amdgcn_readfirstlane((int)vmx) & ~((2u << hb) - 1u);
                        for (int bit = (dif == 0u ? -1 : (hb > 30 ? 30 : hb)); bit >= 0; --bit) {
                            asm volatile("" : "+s"(cur), "+s"(bit));
                            const unsigned t = cur | (1u << bit); int cnt = 0;
#pragma unroll
                            for (int e4 = 0; e4 < 4; ++e4) cnt += __popcll(__builtin_amdgcn_uicmp(val[e4], t, 35  ));
                            if (cnt >= Ksel) cur = t;
                            if (cnt == Ksel) break;
                        }
                        int cgt = 0;
#pragma unroll
                        for (int e4 = 0; e4 < 4; ++e4) cgt += __popcll(__ballot(cand[e4] && val[e4] > cur));
                        const int need = Ksel - cgt; int prev = 0;
#pragma unroll
                        for (int e4 = 0; e4 < 4; ++e4) { const bool eq = cand[e4] && val[e4] == cur; const unsigned long long be = __ballot(eq);
                            const int rank = prev + (int)__builtin_amdgcn_mbcnt_hi((unsigned)(be >> 32), __builtin_amdgcn_mbcnt_lo((unsigned)be, 0u));
                            sel[e4] = (cand[e4] && val[e4] > cur) || (eq && rank < need); prev += __popcll(be); }
                    }
#pragma unroll
                    for (int e4 = 0; e4 < 4; ++e4) wsel[e4] |= sel[e4] ? (1u << tl) : 0u;
                }
            }
#pragma unroll
            for (int e4 = 0; e4 < 4; ++e4) { const int jj = lane_k + 64 * e4; if (jj == 0 || jj == tile) wsel[e4] = 0xffu; selw[jj] = wsel[e4]; }
            LDS_WAIT();
#if DBG_DENSE_SEL == 1
            for (int i = lane_k; i <= tile; i += 64) selw[i] = 0xffu;
            LDS_WAIT();
#elif DBG_DENSE_SEL == 4
            for (int i = lane_k; i <= tile; i += 64) selw[i] = (i == 0 || i >= tile - 14) ? 0xffu : 0u;
            LDS_WAIT();
#endif
        }
        float mref[2] = {0.f, 0.f};
#define AT_RING_LOOP(NB, KSRC, VSRC, PRE, ...) do { \
            const int nb_ = (NB); \
            _Pragma("unroll") for (int pb_ = 0; pb_ < 3; ++pb_) { if ((PRE) && pb_ == 2) AT_BAR(); \
                if (pb_ < nb_) { AT_STAGE((KSRC) + (size_t)pb_ * 16384, pb_ * 32768); AT_STAGE((VSRC) + (size_t)pb_ * 16384, pb_ * 32768 + 16384); } } \
            int bufo = 0, bufn = 98304; \
            for (int b = 0; b < nb_; ++b) { \
                const int ahead_ = nb_ - 1 - b; \
                if (ahead_ >= 2) AT_WAITV(8); else if (ahead_ == 1) AT_WAITV(4); else AT_WAITV(0); \
                AT_BAR(); \
                if (b + 3 < nb_) { AT_STAGE((KSRC) + (size_t)(b + 3) * 16384, bufn); AT_STAGE((VSRC) + (size_t)(b + 3) * 16384, bufn + 16384); } \
                LAS const unsigned char* Kb_ = lds + bufo; LAS const unsigned char* Vb_ = lds + bufo + 16384; \
                __VA_ARGS__ \
                bufo = (bufo == 98304) ? 0 : bufo + 32768; bufn = (bufn == 98304) ? 0 : bufn + 32768; \
            } \
            AT_BAR(); } while (0)
#define AT_DRIFT_LOOP(NB, KSRC, VSRC, ...) do { \
            const int nb_ = (NB); \
            volatile LAS unsigned* ldc_ = (volatile LAS unsigned*)(lds + MISC_OFF) + 32; \
            if (wave == 0 && ln_ < 4) ldc_[ln_] = 0u; \
            _Pragma("unroll") for (int pb_ = 0; pb_ < 2; ++pb_) if (pb_ < nb_) { AT_STAGE((KSRC) + (size_t)pb_ * 16384, pb_ * 32768); AT_STAGE((VSRC) + (size_t)pb_ * 16384, pb_ * 32768 + 16384); } \
            AT_BAR();                                                     \
            if (nb_ >= 2) AT_WAITV(4); else AT_WAITV(0); \
            if (ln_ == 0) (void)__hip_atomic_fetch_add((LAS unsigned*)ldc_, 1u, __ATOMIC_RELAXED, __HIP_MEMORY_SCOPE_WORKGROUP); \
            unsigned swn_ = (unsigned)__builtin_amdgcn_readfirstlane((int)selw[0]); \
            _Pragma("clang loop unroll(disable)") for (int b = 0; b < nb_; ++b) { \
                volatile LAS unsigned* lp_ = ldc_ + (b & 3); \
                const unsigned pr0_ = *lp_;                                                             \
                const unsigned swv_ = *(volatile LAS unsigned*)(selw + (b + 1 < 256 ? b + 1 : 255)); \
                if (b + 1 < nb_) { AT_WAITV(0); if (ln_ == 0) (void)__hip_atomic_fetch_add((LAS unsigned*)ldc_ + ((b + 1) & 3), 1u, __ATOMIC_RELAXED, __HIP_MEMORY_SCOPE_WORKGROUP); } \
                { const unsigned need_ = 8u * (unsigned)((b >> 2) + 1); unsigned pr_ = (unsigned)__builtin_amdgcn_readfirstlane((int)pr0_); \
                  while (pr_ < need_) { __builtin_amdgcn_s_sleep(1); pr_ = (unsigned)__builtin_amdgcn_readfirstlane((int)*lp_); } } \
                const unsigned sw = swn_; swn_ = (unsigned)__builtin_amdgcn_readfirstlane((int)swv_); \
                asm volatile("" ::: "memory"); \
                if (b + 2 < nb_) { const int sl_ = ((b + 2) & 3) * 32768; AT_STAGE((KSRC) + (size_t)(b + 2) * 16384, sl_); AT_STAGE((VSRC) + (size_t)(b + 2) * 16384, sl_ + 16384); } \
                LAS const unsigned char* Kb_ = lds + (b & 3) * 32768; LAS const unsigned char* Vb_ = Kb_ + 16384; \
                __VA_ARGS__ \
            } \
            AT_BAR(); } while (0)
        {
            AT_REGION();
            for (int rp_ = 0; rp_ < DBG_REP_SEL; ++rp_) {
#pragma unroll
            for (int ts = 0; ts < 2; ++ts) { l[ts] = 0.f; mref[ts] = 0.f;
#pragma unroll
                for (int dt = 0; dt < 8; ++dt) O[ts][dt] = (f32x4){0.f, 0.f, 0.f, 0.f}; }
            if (DBG_BR & 2) {
                const unsigned char* ksi = P.ws + WS_KSI + (size_t)g * 256 * 16384; const unsigned char* vsi = P.ws + WS_VSI + (size_t)g * 256 * 16384;
                VM_WAIT();
                AT_DRIFT_LOOP(tile + 1, ksi, vsi, {
                    _Pragma("unroll") for (int ts = 0; ts < 2; ++ts) limq[ts] = ((sw >> (4 * ts + tq)) & 1u) ? (tok_(ts) - 64 * b - 8 * q) : -1000;
                    const bool a0 = (sw & 0x0fu) != 0u, a1 = (sw & 0xf0u) != 0u;
                    const bool msk = (b == 0) || (b == tile);
                    if (a0) step_online<true, false>(Kb_, Vb_, L, qf, O, mref, l, limq, 0x80000000u, msk, b == 0);
                    if (a1) step_online<false, true>(Kb_, Vb_, L, qf, O, mref, l, limq, 0x80000000u, msk, b == 0);
                });
            }
            }
            FS_OFF();
#pragma unroll
            for (int ts = 0; ts < 2; ++ts) { float lt = l[ts]; lt += __shfl_xor(lt, 16); lt += __shfl_xor(lt, 32); const float sc = (DBG_BR & 2) ? GATE(ts, 1) / lt : 0.f;
#pragma unroll
                for (int dt = 0; dt < 8; ++dt) FSAT(16 + ts * 8 + dt) = O[ts][dt] * sc; }
            VM_WAIT();
        }
        {
            AT_REGION();
#pragma unroll
            for (int ts = 0; ts < 2; ++ts) { l[ts] = 0.f;
#pragma unroll
                for (int dt = 0; dt < 8; ++dt) O[ts][dt] = (f32x4){0.f, 0.f, 0.f, 0.f}; }
            if (DBG_BR & 4) {
                const int b0 = tile >= 8 ? tile - 8 : 0;
                const unsigned char* kwi = P.ws + WS_KWI + ((size_t)g * 256 + b0) * 16384; const unsigned char* vwi = P.ws + WS_VWI + ((size_t)g * 256 + b0) * 16384;
                AT_RING_LOOP(tile - b0 + 1, kwi, vwi, false, {
                    _Pragma("unroll") for (int ts = 0; ts < 2; ++ts) limq[ts] = tok_(ts) - 64 * (b0 + b) - 8 * q;
                    step_online<true, true>(Kb_, Vb_, L, qf, O, mref, l, limq, 512u, (b == 0) || (b0 + b == tile), b == 0);
                });
            }
            FS_OFF();
#pragma unroll
            for (int ts = 0; ts < 2; ++ts) { float lt = l[ts]; lt += __shfl_xor(lt, 16); lt += __shfl_xor(lt, 32); const float sc = (DBG_BR & 4) ? GATE(ts, 2) / lt : 0.f;
                bf16* orow = AO + (size_t)tok_(ts) * DM + (4 * g + hh) * HD + 4 * q;
#pragma unroll
                for (int dt = 0; dt < 8; ++dt) { const f32x4 o = (FSAT(ts * 8 + dt) + FSAT(16 + ts * 8 + dt)) + O[ts][dt] * sc;
                    u32x2 w; w.x = pk2(o[0], o[1]); w.y = pk2(o[2], o[3]); *(u32x2*)(orow + 16 * dt) = w; if ((dt & 3) == 3) asm volatile("" ::: "memory"); } }
        }
    }
#undef AT_REGION
#undef AT_RING_LOOP
#undef AT_DRIFT_LOOP
}

#ifndef DBG_CHECK
#define DBG_CHECK 0
#endif
#if DBG_CHECK
__device__ __forceinline__ float p_bf(const bf16* Pm, int t, int col) { return __uint_as_float((unsigned)Pm[(size_t)t * PW + col] << 16); }
__device__ __forceinline__ float roped(const bf16* Pm, const float* cosT, const float* sinT, int t, int colbase, int d) {
    const float x = p_bf(Pm, t, colbase + d);
    if (d >= 32) return x;
    const int i = d & 15; const float c = cosT[(size_t)t * 16 + i], sn = sinT[(size_t)t * 16 + i];
    return (d < 16) ? x * c - p_bf(Pm, t, colbase + d + 16) * sn : x * c + p_bf(Pm, t, colbase + d - 16) * sn;
}
__constant__ int TSAMP[28] = {0, 1, 5, 30, 31, 32, 47, 63, 64, 65, 100, 127, 128, 191, 200, 255, 300, 511, 512, 575, 1023, 1024, 1025, 2047, 4096, 8191, 12345, 16383};
__device__ __forceinline__ void attn_check(const Ptrs& P, int l, LAS unsigned char* lds, int vcu, int G, int tid, unsigned* flagword) {
    const int NS = 28;
    const bf16* Pm = (const bf16*)(P.ws + WS_P); const bf16* AO = (const bf16*)(P.ws + WS_AO);
    const float* cosT = (const float*)(P.ws + WS_COS); const float* sinT = (const float*)(P.ws + WS_SIN);
    LAS float* q = (LAS float*)lds;
    LAS float* blk = q + 512;
    LAS float* hh_ = blk + 4096;
    LAS float* kc = hh_ + 256;
    LAS float* vc = kc + 2048;
    LAS float* sc = vc + 2048;
    LAS float* fin = sc + 4096;
    LAS float* imp = fin + 512;
    LAS int* selb = (LAS int*)(imp + 256);
    LAS unsigned* red = (LAS unsigned*)(selb + 16);
    for (int item = vcu; item < NS * 4; item += G) {
        const int s = item >> 2, g = item & 3, t = TSAMP[s];
        const int cur = t >> 6;
        { const int r = tid >> 7, d = tid & 127; q[tid] = __uint_as_float((unsigned)((const bf16*)(P.ws + WS_QP))[(size_t)t * DM + (4 * g + r) * HD + d] << 16) * 0.6931471805599453f; fin[tid] = 0.f; }
        if (tid < 2) red[tid] = 0u;
        if (tid < 256) imp[tid] = 0.f;
        __syncthreads();
        const int nmax = (t - 31) >> 4;
        const bool small = t < 256;
        const unsigned char* kci = P.ws + WS_KCI + (size_t)g * 16 * 16384; const unsigned char* vci = P.ws + WS_VCI + (size_t)g * 16 * 16384;
        if (small) {
        for (int kv = 0; kv < 2; ++kv)
            for (int n = 0; n <= nmax; ++n) {
                for (int e = tid; e < 4096; e += 512) { const int l_ = e >> 7, d = e & 127, tok = 16 * n + l_;
                    const float x = (kv == 0) ? roped(Pm, cosT, sinT, tok, C_KV + 0 * 512 + g * HD, d) : p_bf(Pm, tok, C_KV + 1 * 512 + g * HD + d);
                    blk[e] = x + P.cmp_pe[((size_t)(l * 2 + kv) * 32 + l_) * 128 + d]; }
                __syncthreads();
                if (tid < 256) { const float* w1 = P.cmp_w1 + (size_t)(l * 2 + kv) * 4096 * 256 + tid; float a = P.cmp_b1[(size_t)(l * 2 + kv) * 256 + tid];
                    for (int e = 0; e < 4096; ++e) a += blk[e] * w1[(size_t)e * 256];
                    hh_[tid] = 0.5f * a * (1.0f + tanhf(0.7978845608028654f * (a + 0.044715f * a * a * a))); }
                __syncthreads();
                if (tid < 128) { const float* w2 = P.cmp_w2 + (size_t)(l * 2 + kv) * 256 * 128 + tid; float a = P.cmp_b2[(size_t)(l * 2 + kv) * 128 + tid];
                    for (int c = 0; c < 256; ++c) a += hh_[c] * w2[(size_t)c * 128];
                    (kv == 0 ? kc : vc)[n * 128 + tid] = a; }
                __syncthreads();
            }
        }
#define KC_AT(n, d) (small ? kc[(n) * 128 + (d)] : __uint_as_float((unsigned)*(const bf16*)(kci + (size_t)((n) >> 6) * 16384 + kimg_off((n) & 63, (d) >> 3) + ((d) & 7) * 2) << 16))
#define VC_AT(n, d) (small ? vc[(n) * 128 + (d)] : __uint_as_float((unsigned)*(const bf16*)(vci + (size_t)((n) >> 6) * 16384 + vimg_off((d), ((n) & 63) >> 3) + ((n) & 7) * 2) << 16))
        if (nmax >= 0) {
            for (int e = tid; e < 4 * 1024; e += 512) { const int r = e >> 10, n = e & 1023; float a = -1e30f;
                if (n <= nmax) { a = 0.f; for (int d = 0; d < 128; ++d) a += q[r * 128 + d] * KC_AT(n, d); } sc[e] = a; }
            __syncthreads();
            float mx = -1e30f, den = 0.f;
            { const int r = tid >> 7, d = tid & 127; for (int n = 0; n <= nmax; ++n) mx = fmaxf(mx, sc[r * 1024 + n]);
              float num = 0.f; for (int n = 0; n <= nmax; ++n) { const float p = expf(sc[r * 1024 + n] - mx); den += p; num += p * VC_AT(n, d); }
              if (DBG_BR & 1) fin[tid] += sigm(p_bf(Pm, t, C_GN + (4 * g + r) * 3 + 0)) * num / den; }
            __syncthreads();
            { const int r = tid >> 7; for (int n = (tid & 127); n <= nmax; n += 128) sc[r * 1024 + n] = expf(sc[r * 1024 + n] - mx) / den; }
            __syncthreads();
            if (tid <= cur) { const int j = tid; float a = 0.f;
                for (int r = 0; r < 4; ++r) for (int u = -1; u <= 3; ++u) { const int n = 4 * j + u; if (n >= 0 && n <= nmax) a += sc[r * 1024 + n] * ((u == -1 || u == 3) ? 0.5f : 1.0f); }
                imp[j] = a; }
            __syncthreads();
        }
        if (tid == 0) { int ns = 0; selb[ns++] = 0; if (cur > 0) selb[ns++] = cur;
            for (int rnd = 0; rnd < 14; ++rnd) { int bj = -1; float bv = -1.f;
                for (int j = 1; j < cur; ++j) { bool taken = false; for (int k = 0; k < ns; ++k) taken |= (selb[k] == j); if (!taken && imp[j] > bv) { bv = imp[j]; bj = j; } }
                if (bj < 0) break; selb[ns++] = bj; }
            for (; ns < 16; ++ns) selb[ns] = -1; }
        __syncthreads();
        if (DBG_BR & 2) {
            const int kcol = C_KV + 2 * 512 + g * HD, vcol = C_KV + 3 * 512 + g * HD;
            for (int e = tid; e < 4 * 1024; e += 512) { const int r = e >> 10, k = e & 1023, bsel = selb[k >> 6], kp = bsel * 64 + (k & 63); float a = -1e30f;
                if (bsel >= 0 && kp <= t) { a = 0.f; for (int d = 0; d < 128; ++d) a += q[r * 128 + d] * roped(Pm, cosT, sinT, kp, kcol, d); }
                sc[e] = a; }
            __syncthreads();
            { const int r = tid >> 7, d = tid & 127; float mx = -1e30f; for (int k = 0; k < 1024; ++k) mx = fmaxf(mx, sc[r * 1024 + k]);
              float den = 0.f, num = 0.f; for (int k = 0; k < 1024; ++k) { const float sv = sc[r * 1024 + k]; if (sv > -1e29f) { const float p = expf(sv - mx); den += p; num += p * p_bf(Pm, selb[k >> 6] * 64 + (k & 63), vcol + d); } }
              fin[tid] += sigm(p_bf(Pm, t, C_GN + (4 * g + r) * 3 + 1)) * num / den; }
            __syncthreads();
        }
        if (DBG_BR & 4) {
            const int kcol = C_KV + 4 * 512 + g * HD, vcol = C_KV + 5 * 512 + g * HD;
            for (int e = tid; e < 4 * 512; e += 512) { const int r = e >> 9, kp = t - (e & 511); float a = -1e30f;
                if (kp >= 0) { a = 0.f; for (int d = 0; d < 128; ++d) a += q[r * 128 + d] * roped(Pm, cosT, sinT, kp, kcol, d); }
                sc[r * 1024 + (e & 511)] = a; }
            __syncthreads();
            { const int r = tid >> 7, d = tid & 127; float mx = -1e30f; for (int k = 0; k < 512; ++k) mx = fmaxf(mx, sc[r * 1024 + k]);
              float den = 0.f, num = 0.f; for (int k = 0; k < 512; ++k) { const float sv = sc[r * 1024 + k]; if (sv > -1e29f) { const float p = expf(sv - mx); den += p; num += p * p_bf(Pm, t - k, vcol + d); } }
              fin[tid] += sigm(p_bf(Pm, t, C_GN + (4 * g + r) * 3 + 2)) * num / den; }
            __syncthreads();
        }
        { const int r = tid >> 7, d = tid & 127; const float ao = __uint_as_float((unsigned)AO[(size_t)t * DM + (4 * g + r) * HD + d] << 16);
          const float err = fabsf(fin[tid] - ao), mag = fabsf(fin[tid]);
          atomicMax((unsigned*)&red[0], __float_as_uint(err)); atomicMax((unsigned*)&red[1], __float_as_uint(mag)); }
        __syncthreads();
        if (tid == 0) { const float err = __uint_as_float(red[0]), mag = __uint_as_float(red[1]); if (!(err <= 0.03f * mag + 2e-3f)) atomicOr(flagword, 1u << s); }
        __syncthreads();
    }
#undef KC_AT
#undef VC_AT
}
#endif


#if DBG_CHECK
__constant__ int RSAMP[8] = {0, 1, 63, 64, 255, 256, 4097, 16383};
__device__ __forceinline__ int csamp(int ci, int N) { return ci == 63 ? N - 1 : (int)(((unsigned)ci * (unsigned)(N / 64) + ((unsigned)ci * 7u) % 61u) % (unsigned)N); }
__device__ __forceinline__ float bfv(const bf16* p, size_t i) { return __uint_as_float((unsigned)p[i] << 16); }
__device__ __forceinline__ float mod_naive(const Ptrs& P, int l, int k, int c) {
    float a = P.ada_b[(size_t)l * 6 * DM + k * DM + c];
    for (int j = 0; j < DM; ++j) { const float cv = P.c[j]; a += cv / (1.0f + expf(-cv)) * P.ada_w[((size_t)l * DM + j) * 6 * DM + k * DM + c]; }
    return a;
}
__device__ __forceinline__ void flag_if(bool bad, unsigned* flagword, int bit) { if (bad) { atomicOr(flagword, 1u << bit); if (bit == 4) { atomicMax(flagword + 1, 0xffffffffu - (unsigned)threadIdx.x); atomicAdd(flagword + 2, 1u); } } }
__device__ __forceinline__ bool mism(float got, float exp_) { return !(fabsf(got - exp_) <= 0.02f * fabsf(exp_) + 0.02f); }
__device__ __forceinline__ void main_check(const Ptrs& P, int which, int tid, unsigned* flagword) {
    const int l = 0, row = RSAMP[tid >> 6], ci = tid & 63;
    const bf16* Pm = (const bf16*)(P.ws + WS_P); const bf16* H = (const bf16*)(P.ws + WS_H); const float* Y = (const float*)(P.ws + WS_Y);
    if (which == 1 || which == 7) {
        const int c = csamp(ci, DM);
        const float* xr = (which == 1 ? P.x : P.out) + (size_t)row * DM;
        if (which == 7) {
            float ss = 0.f; for (int j = 0; j < DM; ++j) { const float y = Y[(size_t)row * DM + j]; ss += y * y; }
            const float e = P.x[(size_t)row * DM + c] + mod_naive(P, l, 2, c) * P.gains[(size_t)(l * 4 + 1) * DM + c] * Y[(size_t)row * DM + c] / sqrtf(ss / DM + NORM_EPS);
            flag_if(mism(xr[c], e), flagword, 16 + which);
        }
        float ss = 0.f; for (int j = 0; j < DM; ++j) ss += xr[j] * xr[j];
        const int gi = which == 1 ? 0 : 2, sck = which == 1 ? 1 : 4, shk = which == 1 ? 0 : 3;
        const float e = xr[c] / sqrtf(ss / DM + NORM_EPS) * P.gains[(size_t)(l * 4 + gi) * DM + c] * (1.0f + mod_naive(P, l, sck, c)) + mod_naive(P, l, shk, c);
        flag_if(mism(bfv(H, (size_t)row * DM + c), e), flagword, which);
    } else if (which == 2) {
        const int pc = (ci < 60) ? csamp(ci, 12288) : 12288 + (ci - 60) * 15;
        const int src = pc < 8192 ? pc : pc < 10240 ? 8240 + (pc - 8192) : pc < 12288 ? 10288 + (pc - 10240) : 8192 + (pc - 12288);
        float a = 0.f; for (int k = 0; k < DM; ++k) a += bfv(H, (size_t)row * DM + k) * P.w_in[((size_t)l * DM + k) * INW + src];
        flag_if(mism(bfv(Pm, (size_t)row * PW + pc), a), flagword, which);
    } else if (which == 3) {
        const int c = csamp(ci, CWID); float z = 0.f;
        for (int k = 0; k < 3; ++k) { const int tt = row - 2 + k; if (tt >= 0) z += P.conv_w[(size_t)l * 3 * CWID + k * CWID + c] * bfv(Pm, (size_t)tt * PW + C_CG + c) * bfv(Pm, (size_t)tt * PW + C_XA + c); }
        flag_if(mism(bfv((const bf16*)(P.ws + WS_CV), (size_t)row * CWID + c), z * bfv(Pm, (size_t)row * PW + C_BG + c)), flagword, which);
    } else if (which == 4) {
        const int c = csamp(ci, DM); const bf16* CV = (const bf16*)(P.ws + WS_CV);
        float a = 0.f; for (int k = 0; k < CWID; ++k) a += bfv(CV, (size_t)row * CWID + k) * P.w_conv_out[((size_t)l * CWID + k) * DM + c];
        flag_if(mism(bfv((const bf16*)(P.ws + WS_YA), (size_t)row * DM + c), a * sigm(bfv(Pm, (size_t)row * PW + C_GA + c))), flagword, which);
    } else if (which == 5 && row < 10000) {
        const int c = csamp(ci, DM); const bf16* AO = (const bf16*)(P.ws + WS_AO);
        float a = 0.f; for (int k = 0; k < DM; ++k) a += bfv(AO, (size_t)row * DM + k) * P.w_nsa[((size_t)l * DM + k) * DM + c];
        flag_if(mism(bfv((const bf16*)(P.ws + WS_MG), (size_t)row * DM + c), bfv((const bf16*)(P.ws + WS_YA), (size_t)row * DM + c) + a * sigm(bfv(Pm, (size_t)row * PW + C_GB + c))), flagword, which);
    } else if (which == 6) {
        const int c = csamp(ci, DM); const bf16* MG = (const bf16*)(P.ws + WS_MG);
        float a = 0.f; for (int k = 0; k < DM; ++k) a += bfv(MG, (size_t)row * DM + k) * P.w_out[((size_t)l * DM + k) * DM + c];
        flag_if(mism(Y[(size_t)row * DM + c], a), flagword, which);
    } else if (which == 8) {
        const int f = csamp(ci, FF);
        float a = 0.f; for (int k = 0; k < DM; ++k) a += bfv(H, (size_t)row * DM + k) * P.w_up[((size_t)l * DM + k) * FF + f];
        a = fmaxf(a, 0.f); flag_if(mism(bfv((const bf16*)(P.ws + WS_U), (size_t)row * FF + f), a * a), flagword, which);
    } else if (which == 9) {
        const int c = csamp(ci, DM); const bf16* U = (const bf16*)(P.ws + WS_U);
        float a = 0.f; for (int k = 0; k < FF; ++k) a += bfv(U, (size_t)row * FF + k) * P.w_down[((size_t)l * FF + k) * DM + c];
        flag_if(mism(Y[(size_t)row * DM + c], a), flagword, which);
    }
}
#define MAIN_CHECK(w) do { if (l == 0 && bx == 0) main_check(P, (w), OPQ_TID(), ctl + 64); } while (0)
#else
#define MAIN_CHECK(w) do { } while (0)
#endif
constexpr int NPH = 11;
constexpr int N_PHASES = 2 + DEPTH * NPH;
#ifndef DBG_CHECK_LAYER
#define DBG_CHECK_LAYER 0
#endif
#ifndef DBG_SKIP_ATTN
#define DBG_SKIP_ATTN 0
#endif
#ifndef DUP_MASK
#define DUP_MASK 0
#endif
#define DUPN(t) (1 + ((DUP_MASK >> (t)) & 1))
#ifndef MK_PER_PHASE
#define MK_PER_PHASE 0
#endif

__global__ void __launch_bounds__(NWAVES * 64, 2) nsa_fwd(Args args) {
    extern __shared__ __attribute__((aligned(16))) unsigned char lds_raw[];
    LAS unsigned char* lds = (LAS unsigned char*)lds_raw;
    const int tid = threadIdx.x, lane = tid & 63, wave = __builtin_amdgcn_readfirstlane(tid >> 6);
    const int G = gridDim.x; const int bx = blockIdx.x; const int vcu = (G % 8 == 0) ? (bx % 8) * (G / 8) + bx / 8 : bx;
    volatile LAS unsigned* MISC = (volatile LAS unsigned*)(lds + MISC_OFF);
    for (int u = tid; u < 128; u += NWAVES * 64) MISC[u] = 0u;
    __syncthreads();
    unsigned* ctl = (unsigned*)(args.ws + WS_CTL);
    XcdBarrier bar = xcd_barrier_post(ctl + CW_BAR, MISC + 8);
    const int lo = args.ph_lo, hi = args.ph_hi; (void)lo; (void)hi;
#ifndef ONLY_PHASE
#define ONLY_PHASE -1
#endif
#define PH_EN(t) (ONLY_PHASE < 0 || ONLY_PHASE == (t))
#if MK_PER_PHASE
#define IN(k) (lo <= (k) && (k) < hi)
#else
#define IN(k) true
#endif
#define LOADP() const Args GAS_K* ap_ = (const Args GAS_K*)__builtin_amdgcn_kernarg_segment_ptr(); asm volatile("" : "+s"(ap_)); Ptrs P; \
    P.x = (const float*)ap_->in[0]; P.c = (const float*)ap_->in[1]; P.pos = (const int*)ap_->in[2]; P.ada_w = (const float*)ap_->in[3]; P.ada_b = (const float*)ap_->in[4]; \
    P.gains = (const float*)ap_->in[5]; P.w_in = (const float*)ap_->in[6]; P.conv_w = (const float*)ap_->in[7]; P.w_conv_out = (const float*)ap_->in[8]; P.cmp_pe = (const float*)ap_->in[9]; \
    P.cmp_w1 = (const float*)ap_->in[10]; P.cmp_b1 = (const float*)ap_->in[11]; P.cmp_w2 = (const float*)ap_->in[12]; P.cmp_b2 = (const float*)ap_->in[13]; P.w_nsa = (const float*)ap_->in[14]; \
    P.w_out = (const float*)ap_->in[15]; P.w_up = (const float*)ap_->in[16]; P.w_down = (const float*)ap_->in[17]; P.out = ap_->out; P.ws = ap_->ws; \
    bf16* H = (bf16*)(P.ws + WS_H); bf16* Y = (bf16*)(P.ws + WS_Y); unsigned char* wl = P.ws + WS_WL + (size_t)l_ * WL_BYTES; const bf16* Pm = (const bf16*)(P.ws + WS_P); (void)H; (void)Y; (void)wl; (void)Pm
#define OPQ_S(x) ({ int _v = (x); asm volatile("" : "+s"(_v)); _v; })
#define OPQ_TID() ({ int _l; asm volatile("v_mbcnt_lo_u32_b32 %0, -1, 0\n\tv_mbcnt_hi_u32_b32 %0, -1, %0" : "=v"(_l)); int _t = (OPQ_S(wave) << 6) | _l; _t; })
#if MK_PER_PHASE
#define SEAM(k) do { } while (0)
#else
#define SEAM(k) do { if (IN((k) + 1) && rep_ + 1 == nrep_) xcd_barrier(bar); } while (0)
#endif

    { const int l_ = 0; (void)l_;
    if (PH_EN(0) && IN(0)) for (int rep_ = 0, nrep_ = (DUPN(0)); rep_ < nrep_; ++rep_) { LOADP(); { const int t_ = OPQ_TID(); p0_prologue(P, lds, OPQ_S(vcu), OPQ_S(G), OPQ_S(wave), t_ & 63, t_); } SEAM(0); }
    if (PH_EN(1) && IN(1)) for (int rep_ = 0, nrep_ = (1); rep_ < nrep_; ++rep_) { LOADP(); resid_phase<false>(P, lds, P.x, false, nullptr, false, nullptr, H, true, 0, 0, 0,  0,  1,  0,  0, OPQ_S(vcu), OPQ_S(G), OPQ_S(wave), OPQ_TID() & 63, OPQ_TID()); SEAM(1); }

    }
    for (int l = 0; l < DEPTH; ++l) {
        const int pb = 2 + l * NPH; const int l_ = l;
        if (PH_EN(2) && IN(pb + 0)) for (int rep_ = 0, nrep_ = (DUPN(2)); rep_ < nrep_; ++rep_) { LOADP();
            MAIN_CHECK(1);
            pg8::Gemm g{H, (const bf16*)(wl + WL_WIN), S, C_GN, DM, DM}; pg8::StaticOrder So; So.init(S, C_GN, OPQ_S(G), OPQ_S(bx));
            pg8::EpiB<0> E{(bf16*)(P.ws + WS_P), PW, nullptr, nullptr, 0, nullptr, 0};
            pg8::gemm_phase<pg8::EpiB<0>, pg8::StaticOrder, true, true>(lds, g, So, E, OPQ_TID());
            SEAM(pb + 0);
        }
        if (PH_EN(3) && IN(pb + 1)) for (int rep_ = 0, nrep_ = (DUPN(3)); rep_ < nrep_; ++rep_) { LOADP(); MAIN_CHECK(2); relayout_phase(P, l, lds, OPQ_S(vcu), OPQ_S(G), OPQ_TID()); SEAM(pb + 1); }
        if (PH_EN(4) && IN(pb + 2)) for (int rep_ = 0, nrep_ = (DUPN(4)); rep_ < nrep_; ++rep_) { LOADP();
            MAIN_CHECK(3);
            {   pg8::Gemm g{(const bf16*)(P.ws + WS_KCR), (const bf16*)(wl + WL_W1T), 8192, 512, 4096, 2048}; pg8::CmpOrder So{OPQ_S(bx)};
                pg8::EpiB<2, true> E{(bf16*)(P.ws + WS_HC), 256, (const float*)(P.ws + WS_B1P), nullptr, 0, nullptr, 0};
                pg8::gemm_phase<pg8::EpiB<2, true>, pg8::CmpOrder, false, true>(lds, g, So, E, OPQ_TID()); }
            {   pg8::Gemm g{(const bf16*)(P.ws + WS_CV), (const bf16*)(wl + WL_WCONV), S, DM, CWID, CWID}; pg8::StaticOrder So;
                So.init(S, DM, OPQ_S(G), OPQ_S(bx));
                pg8::EpiB<3> E{(bf16*)(P.ws + WS_YA), DM, nullptr, Pm + C_GA, PW, nullptr, 0};
                if (OPQ_S(G) == 256) { pg8::YaOrder Yo{So, OPQ_S(bx)}; pg8::gemm_phase<pg8::EpiB<3>, pg8::YaOrder, true, true>(lds, g, Yo, E, OPQ_TID()); }
                else pg8::gemm_phase<pg8::EpiB<3>, pg8::StaticOrder, true, true>(lds, g, So, E, OPQ_TID()); }
            SEAM(pb + 2);
        }
        if (PH_EN(5) && IN(pb + 3)) for (int rep_ = 0, nrep_ = (DUPN(5)); rep_ < nrep_; ++rep_) { LOADP(); MAIN_CHECK(4); cmp2_phase(P, l, OPQ_S(vcu), OPQ_S(G), OPQ_S(wave), OPQ_TID() & 63); SEAM(pb + 3); }
#if DBG_SKIP_ATTN
        if (PH_EN(6) && IN(pb + 4)) for (int rep_ = 0, nrep_ = (DUPN(6)); rep_ < nrep_; ++rep_) { LOADP(); u32x4* ao = (u32x4*)(P.ws + WS_AO); for (size_t i = (size_t)OPQ_S(vcu) * 512 + OPQ_TID(); i < (size_t)S * DM * 2 / 16; i += (size_t)OPQ_S(G) * 512) ao[i] = (u32x4){0u, 0u, 0u, 0u}; SEAM(pb + 4); }
#else
        if (PH_EN(6) && IN(pb + 4)) for (int rep_ = 0, nrep_ = (DUPN(6)); rep_ < nrep_; ++rep_) { LOADP(); attn_phase(P, lds, OPQ_S(vcu), OPQ_S(G), OPQ_S(wave), OPQ_TID() & 63);
            SEAM(pb + 4); }
#endif
        if (PH_EN(7) && IN(pb + 5)) for (int rep_ = 0, nrep_ = (DUPN(7)); rep_ < nrep_; ++rep_) { LOADP();
#if DBG_CHECK
            if (DBG_CHECK == 2 && l == DBG_CHECK_LAYER) { attn_check(P, l, lds, OPQ_S(vcu), OPQ_S(G), OPQ_TID(), ctl + 64); __syncthreads(); }
#endif
            pg8::Gemm g{(const bf16*)(P.ws + WS_AO), (const bf16*)(wl + WL_WNSA), S, DM, DM, DM}; pg8::StaticOrder So; So.init(S, DM, OPQ_S(G), OPQ_S(bx));
            pg8::EpiB<4> E{(bf16*)(P.ws + WS_MG), DM, nullptr, Pm + C_GB, PW, (const bf16*)(P.ws + WS_YA), DM};
            pg8::gemm_phase<pg8::EpiB<4>, pg8::StaticOrder, true, true>(lds, g, So, E, OPQ_TID());
            SEAM(pb + 5);
        }
        if (PH_EN(8) && IN(pb + 6)) for (int rep_ = 0, nrep_ = (DUPN(8)); rep_ < nrep_; ++rep_) { LOADP();
            MAIN_CHECK(5);
            pg8::Gemm g{(const bf16*)(P.ws + WS_MG), (const bf16*)(wl + WL_WOUT), S, DM, DM, DM}; pg8::StaticOrder So; So.init(S, DM, OPQ_S(G), OPQ_S(bx));
            pg8::EpiB<0> E{Y, DM, nullptr, nullptr, 0, nullptr, 0};
            pg8::gemm_phase<pg8::EpiB<0>, pg8::StaticOrder, true, true>(lds, g, So, E, OPQ_TID());
            SEAM(pb + 6);
        }
        if (PH_EN(9) && IN(pb + 7)) for (int rep_ = 0, nrep_ = (1); rep_ < nrep_; ++rep_) { LOADP(); MAIN_CHECK(6); resid_phase<true>(P, lds, l == 0 ? (const void*)P.x : (const void*)(P.ws + WS_XB), l != 0, (void*)(P.ws + WS_XB), true, Y, H, true, l, 2, 1, l, 4, 3, 2, OPQ_S(vcu), OPQ_S(G), OPQ_S(wave), OPQ_TID() & 63, OPQ_TID()); SEAM(pb + 7); }
        if (PH_EN(10) && IN(pb + 8)) for (int rep_ = 0, nrep_ = (DUPN(10)); rep_ < nrep_; ++rep_) { LOADP();
            MAIN_CHECK(7);
            pg8::Gemm g{H, (const bf16*)(wl + WL_WUP), S, FF, DM, DM}; pg8::StaticOrder So; So.init(S, FF, OPQ_S(G), OPQ_S(bx));
            pg8::EpiB<1> E{(bf16*)(P.ws + WS_U), FF, nullptr, nullptr, 0, nullptr, 0};
            pg8::gemm_phase<pg8::EpiB<1>, pg8::StaticOrder, true, true>(lds, g, So, E, OPQ_TID());
            SEAM(pb + 8);
        }
        if (PH_EN(11) && IN(pb + 9)) for (int rep_ = 0, nrep_ = (DUPN(11)); rep_ < nrep_; ++rep_) { LOADP();
            MAIN_CHECK(8);
            pg8::Gemm g{(const bf16*)(P.ws + WS_U), (const bf16*)(wl + WL_WDOWN), S, DM, FF, FF}; pg8::StaticOrder So; So.init(S, DM, OPQ_S(G), OPQ_S(bx));
            pg8::EpiB<0> E{Y, DM, nullptr, nullptr, 0, nullptr, 0};
            pg8::gemm_phase<pg8::EpiB<0>, pg8::StaticOrder, true, true>(lds, g, So, E, OPQ_TID());
            SEAM(pb + 9);
        }
        if (PH_EN(12) && IN(pb + 10)) for (int rep_ = 0, nrep_ = (1); rep_ < nrep_; ++rep_) { LOADP();
            MAIN_CHECK(9);
            resid_phase<true>(P, lds, (const void*)(P.ws + WS_XB), true, l + 1 < DEPTH ? (void*)(P.ws + WS_XB) : (void*)P.out, l + 1 < DEPTH, Y, H, l + 1 < DEPTH, l, 5, 3, (l + 1 < DEPTH) ? l + 1 : l, 1, 0, 0, OPQ_S(vcu), OPQ_S(G), OPQ_S(wave), OPQ_TID() & 63, OPQ_TID());
            if (l + 1 < DEPTH) SEAM(pb + 10);
#if DBG_CHECK
            else { __syncthreads(); if (OPQ_S(bx) == 0 && OPQ_TID() == 0) { __threadfence(); const unsigned f = __hip_atomic_load(ctl + 64, __ATOMIC_RELAXED, __HIP_MEMORY_SCOPE_AGENT);
                if (f) { const unsigned ft = (0xffffffffu - __hip_atomic_load(ctl + 65, __ATOMIC_RELAXED, __HIP_MEMORY_SCOPE_AGENT)) + 1u, cnt = 0u; (void)cnt;
                    P.out[0] = 2000.0f * ((((ft - 1u) & 63u) >> 3) + 1u); } } }
#endif
        }
    }
#undef IN
#undef SEAM
}

extern "C" void kernel_launch(void* const* d_in, const int* in_sizes, int n_in, void* d_out, int out_size, void* d_ws, size_t ws_size, hipStream_t stream) {
    static int grid = 0;
    if (grid == 0) {
        if (n_in != 18 || out_size != S * DM || ws_size < WS_END) { fprintf(stderr, "kernel_launch: unexpected problem (n_in %d, out %d, ws %zu, need %zu)\n", n_in, out_size, ws_size, (size_t)WS_END); grid = -1; return; }
        int dev = 0, cus = 0, per_cu = 0;
        if (hipGetDevice(&dev) != hipSuccess || hipDeviceGetAttribute(&cus, hipDeviceAttributeMultiprocessorCount, dev) != hipSuccess) { grid = -1; return; }
        if (hipFuncSetAttribute((const void*)nsa_fwd, hipFuncAttributeMaxDynamicSharedMemorySize, LDS_BYTES) != hipSuccess) { fprintf(stderr, "kernel_launch: hipFuncSetAttribute failed\n"); grid = -1; return; }
        if (hipOccupancyMaxActiveBlocksPerMultiprocessor(&per_cu, (const void*)nsa_fwd, NWAVES * 64, LDS_BYTES) != hipSuccess || per_cu < 1)
            fprintf(stderr, "kernel_launch: occupancy query reports %d workgroups per CU\n", per_cu);
        (void)hipGetLastError();
        grid = cus;
    }
    if (grid < 0) return;
    if (hipMemsetAsync((char*)d_ws + WS_CTL, 0, CTL_ZERO_BYTES, stream) != hipSuccess) { fprintf(stderr, "kernel_launch: memset failed\n"); return; }
    Args a{};
    for (int i = 0; i < 18; ++i) a.in[i] = d_in[i];
    a.out = (float*)d_out; a.ws = (unsigned char*)d_ws;
#if MK_PER_PHASE
    for (int ph = 0; ph < N_PHASES; ++ph) { a.ph_lo = ph; a.ph_hi = ph + 1; hipLaunchKernelGGL(nsa_fwd, dim3(grid), dim3(NWAVES * 64), LDS_BYTES, stream, a); }
#else
    a.ph_lo = 0; a.ph_hi = N_PHASES;
    hipLaunchKernelGGL(nsa_fwd, dim3(grid), dim3(NWAVES * 64), LDS_BYTES, stream, a);
#endif
    const hipError_t le = hipPeekAtLastError();
    if (le != hipSuccess) fprintf(stderr, "kernel_launch: launch failed: %s\n", hipGetErrorName(le));
}
```

```cpp
#include <hip/hip_runtime.h>
#include <cstdio>
#include <cstdint>

#define GAS __attribute__((address_space(1)))
#define GAS_K __attribute__((address_space(4)))
#define LAS __attribute__((address_space(3)))
typedef unsigned short bf16;
typedef short bf16x8 __attribute__((ext_vector_type(8)));
typedef float f32x4 __attribute__((ext_vector_type(4)));
typedef float f32x2 __attribute__((ext_vector_type(2)));
typedef unsigned u32x4 __attribute__((ext_vector_type(4)));
typedef unsigned u32x2 __attribute__((ext_vector_type(2)));

constexpr int S = 16384, DM = 2048, DEPTH = 4, CWID = 1024, NH = 16, NG = 4, HD = 128, FF = 8192;
constexpr int INW = 12336, PW = 12544;
constexpr int C_BG = 0, C_CG = 1024, C_XA = 2048, C_Q = 3072, C_KV = 5120, C_GA = 8192, C_GB = 10240, C_GN = 12288;
constexpr float NORM_EPS = 1e-6f;
constexpr float QSCALE = 0.12751743082459868f;
constexpr int NWAVES = 8;

namespace pg8 {
typedef unsigned short bf16_t;
constexpr int BM = 256, BK = 64, HALF = 128, HTB = HALF * BK * 2, STAGE_BYTES = 8 * HTB, NXCD = 8, WGM = 8;
__host__ __device__ __forceinline__ int lds_byte(int r, int c) { const int st = (r >> 4) * 2 + (c >> 5), rr = r & 15, cc = c & 31, ob = rr * 64 + cc * 2; return st * 1024 + (ob ^ (((ob >> 9) & 1) << 5)); }
__host__ __device__ __forceinline__ void stage_rc(int b, int& R, int& C) { const int st = b / 1024, sb = b % 1024, swz = sb ^ (((sb >> 9) & 1) << 5); R = (st >> 1) * 16 + swz / 64; C = (st & 1) * 32 + (swz % 64) / 2; }
__host__ __device__ __forceinline__ int perm32(int rho) { const int n = rho >> 4, i = rho & 15; return 8 * (i >> 2) + 4 * n + (i & 3); }

struct Unit { int pm, pn; };
struct Gemm { const bf16_t* A; const bf16_t* Bt; int M, N, K, lda; };

struct StaticOrder {
    int nM, nN, nwg, G, c;
    __device__ void init(int M, int N, int G_, int c_) { nM = M / BM; nN = N / BM; nwg = nM * nN; G = G_; c = c_; if (c_ < 0 || c_ >= G_) nwg = 0; }
    __device__ bool next(int i, Unit& u) const { return map((long)i * G + c, u); }
    __device__ bool map(const long L, Unit& u) const {
        if (L >= nwg) return false;
        int wgid = (int)L; { const int q = nwg / NXCD, r = nwg % NXCD, xcd = wgid % NXCD, off = wgid / NXCD; wgid = (xcd < r ? xcd * (q + 1) : r * (q + 1) + (xcd - r) * q) + off; }
        const int nig = WGM * nN, gid = wgid / nig, fm = gid * WGM, gsz = (nM - fm) < WGM ? (nM - fm) : WGM;
        u.pm = fm + ((wgid % nig) % gsz); u.pn = (wgid % nig) / gsz; return true;
    }
    __device__ __forceinline__ void a_ready(const Unit&) const {}
    __device__ __forceinline__ void done(const Unit&) const {}
};

typedef float f32x2_t_ __attribute__((ext_vector_type(2))); typedef __bf16 bf16x2_t_ __attribute__((ext_vector_type(2)));
__device__ __forceinline__ unsigned cvt_pk_bf16(float lo, float hi) { const f32x2_t_ v = {lo, hi}; const bf16x2_t_ b = __builtin_convertvector(v, bf16x2_t_); return __builtin_bit_cast(unsigned, b); }
__device__ __forceinline__ float bflo(unsigned w) { return __uint_as_float(w << 16); }
__device__ __forceinline__ float bfhi(unsigned w) { return __uint_as_float(w & 0xffff0000u); }
__device__ __forceinline__ float sigmoidf_(float x) { return __builtin_amdgcn_rcpf(1.0f + __builtin_amdgcn_exp2f(-1.4426950408889634f * x)); }

struct YaOrder {
    StaticOrder base; int bx;
    __device__ bool next(int i, Unit& u) const {
        if (bx < 32) return false;
        if (i < 2) return base.next(i, u);
        if (i == 2 && bx < 96) { const int idx = bx - 32; return base.map(idx < 32 ? (long)idx : (long)(idx - 32) + base.G, u); }
        return false;
    }
    __device__ __forceinline__ void a_ready(const Unit&) const {}
    __device__ __forceinline__ void done(const Unit&) const {}
};
struct CmpOrder {
    int c;
    __device__ bool next(int i, Unit& u) const { if (i != 0 || c < 0 || c >= 32) return false; u.pm = c; u.pn = c >> 4; return true; }
    __device__ __forceinline__ void a_ready(const Unit&) const {}
    __device__ __forceinline__ void done(const Unit&) const {}
};
struct EpiF32 {
    static constexpr bool PERM = false, AFTER_DRAIN = false;
    float* C; int ldc;
    __device__ __forceinline__ void operator()(const f32x4 (&acc)[2][2][4][2], const Unit& u, int wr, int wc, int fr, int fq) const {
        const int row0 = u.pm * BM + wr * 64 + fr, col0 = u.pn * BM + wc * 32 + 4 * fq;
#pragma unroll
        for (int ai = 0; ai < 2; ++ai)
#pragma unroll
            for (int m = 0; m < 4; ++m) { float* rowp = C + (size_t)(row0 + ai * HALF + m * 16) * ldc + col0;
#pragma unroll
                for (int bj = 0; bj < 2; ++bj)
#pragma unroll
                    for (int n = 0; n < 2; ++n) *(f32x4*)(rowp + bj * HALF + n * 16) = acc[ai][bj][m][n]; }
    }
};
template <int MODE, bool COLWRAP = false> struct EpiB {
    static constexpr bool PERM = true, AFTER_DRAIN = false;
    bf16_t* O; int ldc; const float* bias; const bf16_t* G; int ldg; const bf16_t* ADD; int ldadd;
    __device__ __forceinline__ void operator()(const f32x4 (&acc)[2][2][4][2], const Unit& u, int wr, int wc, int fr, int fq) const {
        const int row0 = u.pm * BM + wr * 64 + fr, col0 = u.pn * BM + wc * 32 + 8 * fq;
#pragma unroll
        for (int ai = 0; ai < 2; ++ai)
#pragma unroll
            for (int m = 0; m < 4; ++m) { const int row = row0 + ai * HALF + m * 16;
#pragma unroll
                for (int bj = 0; bj < 2; ++bj) { const int col = col0 + bj * HALF;
                    float v[8];
#pragma unroll
                    for (int e = 0; e < 4; ++e) { v[e] = acc[ai][bj][m][0][e]; v[4 + e] = acc[ai][bj][m][1][e]; }
                    if (MODE == 1) {
#pragma unroll
                        for (int e = 0; e < 8; ++e) { const float t = fmaxf(v[e], 0.f); v[e] = t * t; }
                    }
                    if (MODE == 2) { const f32x4 b0 = *(const f32x4*)(bias + col), b1 = *(const f32x4*)(bias + col + 4);
#pragma unroll
                        for (int e = 0; e < 8; ++e) { const float x = v[e] + (e < 4 ? b0[e] : b1[e - 4]); v[e] = x * sigmoidf_(1.5957691216057308f * (x + 0.044715f * x * x * x)); }
                    }
                    if (MODE == 3 || MODE == 4) { const u32x4 gw = *(const u32x4*)(G + (size_t)row * ldg + col);
#pragma unroll
                        for (int e = 0; e < 4; ++e) { v[2 * e] *= sigmoidf_(bflo(gw[e])); v[2 * e + 1] *= sigmoidf_(bfhi(gw[e])); }
                    }
                    if (MODE == 4) { const u32x4 aw = *(const u32x4*)(ADD + (size_t)row * ldadd + col);
#pragma unroll
                        for (int e = 0; e < 4; ++e) { v[2 * e] += bflo(aw[e]); v[2 * e + 1] += bfhi(aw[e]); }
                    }
                    u32x4 w; w.x = cvt_pk_bf16(v[0], v[1]); w.y = cvt_pk_bf16(v[2], v[3]); w.z = cvt_pk_bf16(v[4], v[5]); w.w = cvt_pk_bf16(v[6], v[7]);
                    *(u32x4*)(O + (size_t)row * ldc + (COLWRAP ? (col & 255) : col)) = w; } }
    }
};

template <class Epi, class Sched, bool ALIGN_EPI = false, bool SP2 = false>
__device__ __forceinline__ void gemm_phase(LAS unsigned char* lds, const Gemm g, const Sched& S, const Epi& E, const int tid) {
    const int wid = __builtin_amdgcn_readfirstlane(tid >> 6), lane = tid & 63, wr = wid >> 2, wc = wid & 3, fr = lane & 15, fq = lane >> 4;
    const int K = g.K, nt = K / BK;
    unsigned voffA[2], voffB[2];
#pragma unroll
    for (int i = 0; i < 2; ++i) { int R, C; stage_rc(tid * 16 + i * 8192, R, C); const int Rb = Epi::PERM ? ((R & ~31) + perm32(R & 31)) : R;
        voffA[i] = (unsigned)(R * g.lda + C) * 2u; voffB[i] = (unsigned)(Rb * K + C) * 2u; }
    const size_t kstep = (size_t)(BK * 2);
    const size_t hstepA = (size_t)HALF * g.lda * 2, hstepB = (size_t)HALF * K * 2;
    const size_t tstepA = 2 * hstepA, tstepB = 2 * hstepB;
    const unsigned ldsw = (unsigned)wid * 1024u;
    const int aoff = lds_byte(wr * 64 + fr, fq * 8), boff = lds_byte(wc * 32 + fr, fq * 8);
#define PG8_SA(b, h) (((b) * 2 + (h)) * HTB)
#define PG8_SB(b, h) ((4 + (b) * 2 + (h)) * HTB)
#define PG8_STAGE(bufoff, gbase, voff) do { _Pragma("unroll") for (int _i = 0; _i < 2; ++_i) \
        __builtin_amdgcn_global_load_lds((const unsigned*)((const char*)(gbase) + (voff)[_i]), (LAS unsigned*)(lds + (bufoff) + ldsw + _i * 8192), 16, 0, 0); } while (0)
#define PG8_LDA(dst, b, h) do { _Pragma("unroll") for (int m = 0; m < 4; ++m) _Pragma("unroll") for (int k = 0; k < 2; ++k) dst[m][k] = *(const LAS bf16x8*)(lds + PG8_SA(b, h) + aoff + m * 2048 + k * 1024); } while (0)
#define PG8_LDB(dst, b, h) do { _Pragma("unroll") for (int n = 0; n < 2; ++n) _Pragma("unroll") for (int k = 0; k < 2; ++k) dst[n][k] = *(const LAS bf16x8*)(lds + PG8_SB(b, h) + boff + n * 2048 + k * 1024); } while (0)
#define PG8_MMA(ai, bj, At, Bt) do { __builtin_amdgcn_s_setprio(1); _Pragma("unroll") for (int m = 0; m < 4; ++m) _Pragma("unroll") for (int n = 0; n < 2; ++n) _Pragma("unroll") for (int k = 0; k < 2; ++k) \
        acc[ai][bj][m][n] = __builtin_amdgcn_mfma_f32_16x16x32_bf16(Bt[n][k], At[m][k], acc[ai][bj][m][n], 0, 0, 0); __builtin_amdgcn_s_setprio(0); } while (0)
#define PG8_WAIT_V(n) asm volatile("s_waitcnt vmcnt(" #n ")" ::: "memory")
#define PG8_WAIT_L(n) asm volatile("s_waitcnt lgkmcnt(" #n ")" ::: "memory")
#define PG8_BAR __builtin_amdgcn_s_barrier()
#define PG8_SCHED __builtin_amdgcn_sched_barrier(0)
    Unit cur, nxt; int ui = 0;
    if (!S.next(0, cur)) return;
    f32x4 acc[2][2][4][2];
#pragma unroll
    for (int a = 0; a < 2; ++a)
#pragma unroll
        for (int b = 0; b < 2; ++b)
#pragma unroll
            for (int m = 0; m < 4; ++m)
#pragma unroll
                for (int n = 0; n < 2; ++n) acc[a][b][m][n] = (f32x4){0.f, 0.f, 0.f, 0.f};
    bf16x8 At[4][2], B0[2][2], B1[2][2];
    const char* cA = (const char*)g.A + (size_t)cur.pm * tstepA; const char* cB = (const char*)g.Bt + (size_t)cur.pn * tstepB;
    S.a_ready(cur);
    if constexpr (SP2) {
        PG8_STAGE(PG8_SB(0, 0), cB, voffB); PG8_STAGE(PG8_SB(0, 1), cB + hstepB, voffB); PG8_STAGE(PG8_SA(0, 0), cA, voffA); PG8_STAGE(PG8_SA(0, 1), cA + hstepA, voffA);
        if (wr == 1) PG8_BAR;
        PG8_WAIT_V(2); PG8_BAR;
        PG8_STAGE(PG8_SB(1, 0), cB + kstep, voffB); PG8_STAGE(PG8_SA(1, 0), cA + kstep, voffA); PG8_STAGE(PG8_SB(1, 1), cB + hstepB + kstep, voffB);
        PG8_WAIT_V(6); PG8_BAR;
    } else {
        PG8_STAGE(PG8_SB(0, 0), cB, voffB); PG8_STAGE(PG8_SA(0, 0), cA, voffA); PG8_STAGE(PG8_SB(0, 1), cB + hstepB, voffB); PG8_STAGE(PG8_SA(0, 1), cA + hstepA, voffA);
        if (wr == 1) PG8_BAR;
        PG8_WAIT_V(4); PG8_BAR;
        PG8_STAGE(PG8_SB(1, 0), cB + kstep, voffB); PG8_STAGE(PG8_SA(1, 0), cA + kstep, voffA); PG8_STAGE(PG8_SB(1, 1), cB + hstepB + kstep, voffB);
        PG8_WAIT_V(6); PG8_BAR;
    }
    for (;;) {
        const bool has_next = S.next(ui + 1, nxt);
        const char* nA = has_next ? (const char*)g.A + (size_t)nxt.pm * tstepA : cA; const char* nB = has_next ? (const char*)g.Bt + (size_t)nxt.pn * tstepB : cB;
        for (int t = 0; t < nt; t += 2) {
            const bool last = (t == nt - 2);
            const char* a1 = cA + (size_t)(t + 1) * kstep;
            const char* a2 = last ? nA : cA + (size_t)(t + 2) * kstep; const char* b2 = last ? nB : cB + (size_t)(t + 2) * kstep;
            const char* a3 = a2 + kstep; const char* b3 = b2 + kstep;
            if (last && has_next) S.a_ready(nxt);
            if constexpr (SP2) {
            PG8_LDB(B0, 0, 0); PG8_LDB(B1, 0, 1); PG8_SCHED; PG8_LDA(At, 0, 0); PG8_STAGE(PG8_SA(1, 1), a1 + hstepA, voffA);
            PG8_WAIT_V(8); PG8_WAIT_L(0); PG8_BAR; PG8_MMA(0, 0, At, B0); PG8_MMA(0, 1, At, B1); PG8_BAR; PG8_SCHED;
            PG8_LDA(At, 0, 1); PG8_STAGE(PG8_SB(0, 0), b2, voffB); PG8_STAGE(PG8_SB(0, 1), b2 + hstepB, voffB); PG8_STAGE(PG8_SA(0, 0), a2, voffA);
            PG8_WAIT_V(8); PG8_WAIT_L(0); PG8_BAR; PG8_MMA(1, 0, At, B0); PG8_MMA(1, 1, At, B1); PG8_BAR; PG8_SCHED;
            PG8_LDB(B0, 1, 0); PG8_LDB(B1, 1, 1); PG8_SCHED; PG8_LDA(At, 1, 0); PG8_STAGE(PG8_SA(0, 1), a2 + hstepA, voffA);
            PG8_WAIT_V(8); PG8_WAIT_L(0); PG8_BAR; PG8_MMA(0, 0, At, B0); PG8_MMA(0, 1, At, B1); PG8_BAR; PG8_SCHED;
            PG8_LDA(At, 1, 1); PG8_STAGE(PG8_SB(1, 0), b3, voffB); PG8_STAGE(PG8_SB(1, 1), b3 + hstepB, voffB); PG8_STAGE(PG8_SA(1, 0), a3, voffA);
            PG8_WAIT_V(8); PG8_WAIT_L(0); PG8_BAR; PG8_MMA(1, 0, At, B0); PG8_MMA(1, 1, At, B1); PG8_BAR; PG8_SCHED;
            } else {
            PG8_LDB(B0, 0, 0); PG8_SCHED; PG8_LDA(At, 0, 0); PG8_STAGE(PG8_SA(1, 1), a1 + hstepA, voffA);
            PG8_WAIT_L(8); PG8_BAR; PG8_WAIT_L(0); PG8_MMA(0, 0, At, B0); PG8_BAR; PG8_SCHED;
            PG8_LDB(B1, 0, 1); PG8_STAGE(PG8_SB(0, 0), b2, voffB);
            PG8_BAR; PG8_WAIT_L(0); PG8_MMA(0, 1, At, B1); PG8_BAR;
            PG8_LDA(At, 0, 1); PG8_STAGE(PG8_SA(0, 0), a2, voffA);
            PG8_BAR; PG8_WAIT_L(0); PG8_MMA(1, 0, At, B0); PG8_BAR; PG8_SCHED;
            PG8_STAGE(PG8_SB(0, 1), b2 + hstepB, voffB);
            PG8_WAIT_V(6); PG8_BAR; PG8_MMA(1, 1, At, B1); PG8_BAR;
            PG8_LDB(B0, 1, 0); PG8_SCHED; PG8_LDA(At, 1, 0); PG8_STAGE(PG8_SA(0, 1), a2 + hstepA, voffA);
            PG8_WAIT_L(8); PG8_BAR; PG8_WAIT_L(0); PG8_MMA(0, 0, At, B0); PG8_BAR; PG8_SCHED;
            PG8_LDB(B1, 1, 1); PG8_STAGE(PG8_SB(1, 0), b3, voffB);
            PG8_BAR; PG8_WAIT_L(0); PG8_MMA(0, 1, At, B1); PG8_BAR;
            PG8_LDA(At, 1, 1); PG8_STAGE(PG8_SA(1, 0), a3, voffA);
            PG8_BAR; PG8_WAIT_L(0); PG8_MMA(1, 0, At, B0); PG8_BAR; PG8_SCHED;
            PG8_STAGE(PG8_SB(1, 1), b3 + hstepB, voffB);
            PG8_WAIT_V(6); PG8_BAR; PG8_MMA(1, 1, At, B1); PG8_BAR;
            }
        }
        if constexpr (ALIGN_EPI) { if (wr == 0) PG8_BAR; }
        E(acc, cur, wr, wc, fr, fq); S.done(cur);
        if (!has_next) break;
#pragma unroll
        for (int a = 0; a < 2; ++a)
#pragma unroll
            for (int b = 0; b < 2; ++b)
#pragma unroll
                for (int m = 0; m < 4; ++m)
#pragma unroll
                    for (int n = 0; n < 2; ++n) acc[a][b][m][n] = (f32x4){0.f, 0.f, 0.f, 0.f};
        cur = nxt; cA = nA; cB = nB; ++ui;
        if constexpr (ALIGN_EPI) { if (wr == 1) PG8_BAR; }
    }
    PG8_WAIT_V(0);
    if constexpr (!ALIGN_EPI) { if (wr == 0) PG8_BAR; }
    PG8_BAR;
#undef PG8_SA
#undef PG8_SB
#undef PG8_STAGE
#undef PG8_LDA
#undef PG8_LDB
#undef PG8_MMA
#undef PG8_WAIT_V
#undef PG8_WAIT_L
#undef PG8_BAR
#undef PG8_SCHED
}
}

constexpr size_t al4k(size_t x) { return (x + 4095) & ~(size_t)4095; }
constexpr size_t WS_CTL = 0, CTL_ZERO_BYTES = 1u << 20;
constexpr size_t WS_MODP = CTL_ZERO_BYTES;
constexpr size_t WS_B1PART = al4k(WS_MODP + (size_t)DEPTH * 8 * 6 * DM * 4);
constexpr size_t WS_B1P = al4k(WS_B1PART + (size_t)DEPTH * 2 * 32 * 256 * 4);
constexpr size_t WS_COS = al4k(WS_B1P + 2 * 256 * 4);
constexpr size_t WS_SIN = al4k(WS_COS + (size_t)S * 16 * 4);
constexpr size_t WS_GT = al4k(WS_SIN + (size_t)S * 16 * 4);
constexpr size_t WS_W2T = al4k(WS_GT + (size_t)S * 48 * 4);
constexpr size_t WS_KCI = al4k(WS_W2T + (size_t)DEPTH * 2 * 128 * 256 * 2);
constexpr size_t WS_VCI = al4k(WS_KCI + (size_t)NG * 16 * 16384);
constexpr size_t WS_HC = al4k(WS_VCI + (size_t)NG * 16 * 16384);
constexpr size_t WS_WL = al4k(WS_HC + (size_t)2 * 4096 * 256 * 2);
constexpr size_t WL_WIN = 0;
constexpr size_t WL_WCONV = WL_WIN + (size_t)PW * DM * 2;
constexpr size_t WL_W1T = WL_WCONV + (size_t)DM * CWID * 2;
constexpr size_t WL_WNSA = WL_W1T + (size_t)2 * 256 * 4096 * 2;
constexpr size_t WL_WOUT = WL_WNSA + (size_t)DM * DM * 2;
constexpr size_t WL_WUP = WL_WOUT + (size_t)DM * DM * 2;
constexpr size_t WL_WDOWN = WL_WUP + (size_t)FF * DM * 2;
constexpr size_t WL_BYTES = al4k(WL_WDOWN + (size_t)DM * FF * 2);
constexpr size_t WS_P = al4k(WS_WL + DEPTH * WL_BYTES);
constexpr size_t WS_U = WS_P;
constexpr size_t WS_Y = WS_P + (size_t)S * FF * 2;
constexpr size_t P_REGION = (size_t)S * PW * 2;
static_assert((size_t)S * FF * 2 + (size_t)S * DM * 4 <= P_REGION, "U + Y fit in P's region");
constexpr size_t WS_H = al4k(WS_P + P_REGION);
constexpr size_t WS_QP = al4k(WS_H + (size_t)S * DM * 2);
constexpr size_t WS_MG = WS_QP;
constexpr size_t WS_KSI = al4k(WS_QP + (size_t)S * DM * 2);
constexpr size_t WS_VSI = WS_KSI + (size_t)NG * 256 * 16384;
constexpr size_t WS_KWI = WS_VSI + (size_t)NG * 256 * 16384;
constexpr size_t WS_VWI = WS_KWI + (size_t)NG * 256 * 16384;
constexpr size_t WS_KCR = WS_VWI + (size_t)NG * 256 * 16384;
constexpr size_t WS_VCR = WS_KCR + (size_t)NG * S * HD * 2;
constexpr size_t WS_CV = al4k(WS_VCR + (size_t)NG * S * HD * 2 + 65536);
constexpr size_t WS_AO = al4k(WS_CV + (size_t)S * CWID * 2);
constexpr size_t WS_YA = al4k(WS_AO + (size_t)S * DM * 2);
constexpr size_t WS_FS = al4k(WS_YA + (size_t)S * DM * 2);
constexpr size_t WS_XB = al4k(WS_FS + (size_t)256 * 8 * 16384);
constexpr size_t WS_END = al4k(WS_XB + (size_t)S * DM * 2);

constexpr int CW_BAR = 4096;
constexpr int CW_ATT = 8192;

constexpr int RING_BYTES = 131072;
constexpr int AT_KV = 0, AT_IMP = 65536, IMP_STRIDE = 257, AT_SELW = AT_IMP + 64 * IMP_STRIDE * 4;
constexpr int MISC_OFF = AT_SELW + NWAVES * 256 * 4;
constexpr int LDS_BYTES = 147456;
static_assert(MISC_OFF + 512 <= LDS_BYTES && MISC_OFF >= RING_BYTES, "LDS map");

typedef GAS unsigned gu32;
#define RLX_AGENT __ATOMIC_RELAXED, __HIP_MEMORY_SCOPE_AGENT
#define LDS_WAIT() asm volatile("s_waitcnt lgkmcnt(0)" ::: "memory")
#define VM_WAIT() asm volatile("s_waitcnt vmcnt(0)" ::: "memory")

#define XB_TMO      128
#define XB_XCNT(j)  (256  + 64 * (j))
#define XB_XSUB(j)  (1280 + 64 * (j))
#define XB_XGEN(j)  (2304 + 64 * (j))
#define XB_TOP      3328
#define XB_TOPGEN   3392
#define XCD_BAR_WORDS 3456
#define XB_SPIN_CAP (1u << 22)

__device__ __forceinline__ unsigned xb_ld(unsigned* p)              { return __hip_atomic_load(p, __ATOMIC_RELAXED, __HIP_MEMORY_SCOPE_AGENT); }
__device__ __forceinline__ unsigned xb_add(unsigned* p, unsigned v) { return __hip_atomic_fetch_add(p, v, __ATOMIC_RELAXED, __HIP_MEMORY_SCOPE_AGENT); }
__device__ __forceinline__ unsigned xb_xcc_id() { return (unsigned)__builtin_amdgcn_s_getreg((3 << 11) | 20) & 0xFu; }
#define XB_SPIN(cond, bar) do { unsigned _sp = 0; while (cond) { __builtin_amdgcn_s_sleep(1); \
    if ((++_sp & 255u) == 0u) { if (xb_ld(&(bar)[XB_TMO])) break; if (_sp > XB_SPIN_CAP) { atomicAdd(&(bar)[XB_TMO], 1u); break; } } } } while (0)

struct XcdBarrier { unsigned* bar; unsigned x; volatile LAS unsigned* st; };

__device__ __forceinline__ XcdBarrier xcd_barrier_post(unsigned* bar, volatile LAS unsigned* st) {
    XcdBarrier b; b.bar = bar; b.x = xb_xcc_id(); b.st = st;
    if (threadIdx.x == 0) (void)xb_add(&bar[XB_XCNT(b.x)], 1u);
    return b;
}
__device__ __forceinline__ void xcd_barrier_complete(unsigned* bar, unsigned x, unsigned& nloc, unsigned& nx) {
    const unsigned G = gridDim.x * gridDim.y * gridDim.z;
    unsigned sum, cnt, mine, sp = 0u;
    for (;;) {
        sum = 0u; cnt = 0u; mine = 0u;
#pragma unroll
        for (unsigned j = 0; j < 16; ++j) { const unsigned c = xb_ld(&bar[XB_XCNT(j)]); sum += c; cnt += (c > 0u) ? 1u : 0u; mine = (j == x) ? c : mine; }
        if (sum == G) break;
        __builtin_amdgcn_s_sleep(1);
        if ((++sp & 255u) == 0u) { if (xb_ld(&bar[XB_TMO])) break; if (sp > XB_SPIN_CAP) { atomicAdd(&bar[XB_TMO], 1u); break; } }
    }
    nloc = mine > 0u ? mine : 1u; nx = cnt > 0u ? cnt : 1u;
}
__device__ __forceinline__ void xcd_barrier(const XcdBarrier& b) {
    asm volatile("s_waitcnt vmcnt(0)" ::: "memory");
    __syncthreads();
    if (threadIdx.x == 0) {
        unsigned* bar = b.bar;
        __builtin_amdgcn_s_waitcnt(0);
        unsigned nloc = b.st[0], nx = b.st[1];
        if (nloc == 0u) { xcd_barrier_complete(bar, b.x, nloc, nx); b.st[0] = nloc; b.st[1] = nx; }
        const unsigned old = xb_add(&bar[XB_XSUB(b.x)], 1u);
        const unsigned gen = old / nloc;
        if (old + 1u == (gen + 1u) * nloc) {
            __builtin_amdgcn_fence(__ATOMIC_RELEASE, "agent");
            asm volatile("s_waitcnt vmcnt(0)" ::: "memory");
            const unsigned og = xb_add(&bar[XB_TOP], 1u);
            const unsigned tg = og / nx;
            if (og + 1u == (tg + 1u) * nx) xb_add(&bar[XB_TOPGEN], 1u);
            else XB_SPIN(xb_ld(&bar[XB_TOPGEN]) == tg, bar);
            __builtin_amdgcn_fence(__ATOMIC_ACQUIRE, "agent");
            xb_add(&bar[XB_XGEN(b.x)], 1u);
            asm volatile("s_waitcnt vmcnt(0)" ::: "memory");
        } else {
            XB_SPIN(xb_ld(&bar[XB_XGEN(b.x)]) == gen, bar);
            __builtin_amdgcn_fence(__ATOMIC_ACQUIRE, "agent");
            asm volatile("s_waitcnt vmcnt(0)" ::: "memory");
        }
    }
    __syncthreads();
}

__device__ __forceinline__ unsigned f2bf(float f) { unsigned u = __builtin_bit_cast(unsigned, f); return (u + 0x7fffu + ((u >> 16) & 1u)) >> 16; }
__device__ __forceinline__ unsigned pk2(float lo, float hi) { return f2bf(lo) | (f2bf(hi) << 16); }
__device__ __forceinline__ float bf_lo(unsigned w) { return __uint_as_float(w << 16); }
__device__ __forceinline__ float bf_hi(unsigned w) { return __uint_as_float(w & 0xffff0000u); }
__device__ __forceinline__ float wave_sum(float v) {
#pragma unroll
    for (int o = 1; o < 64; o <<= 1) v += __shfl_xor(v, o);
    return v;
}
__device__ __forceinline__ float sigm(float x) { return __builtin_amdgcn_rcpf(1.0f + __builtin_amdgcn_exp2f(-1.4426950408889634f * x)); }
__device__ __forceinline__ void unpack8(const u32x4 w, float (&v)[8]) {
    v[0] = bf_lo(w.x); v[1] = bf_hi(w.x); v[2] = bf_lo(w.y); v[3] = bf_hi(w.y); v[4] = bf_lo(w.z); v[5] = bf_hi(w.z); v[6] = bf_lo(w.w); v[7] = bf_hi(w.w);
}
__device__ __forceinline__ u32x4 pack8(const float (&v)[8]) { u32x4 w; w.x = pk2(v[0], v[1]); w.y = pk2(v[2], v[3]); w.z = pk2(v[4], v[5]); w.w = pk2(v[6], v[7]); return w; }

__device__ __forceinline__ int k_rho(int kappa) { const int a = kappa >> 5, q = (kappa >> 3) & 3, h = (kappa >> 2) & 1, i = kappa & 3; return 16 * (2 * a + h) + 4 * q + i; }
__device__ __forceinline__ int kimg_off(int kappa, int ch  ) { const int rho = k_rho(kappa); return rho * 256 + ((ch ^ (rho & 15)) << 4); }
__device__ __forceinline__ int vimg_off(int d, int kc  ) { return d * 128 + ((kc ^ ((d >> 1) & 7)) << 4); }

struct Ptrs {
    const float *x, *c, *ada_w, *ada_b, *gains, *w_in, *conv_w, *w_conv_out, *cmp_pe, *cmp_w1, *cmp_b1, *cmp_w2, *cmp_b2, *w_nsa, *w_out, *w_up, *w_down;
    const int* pos;
    float* out; unsigned char* ws;
};
struct Args { const void* in[18]; float* out; unsigned char* ws; int ph_lo, ph_hi; };
static_assert(sizeof(Args) == 18 * 8 + 8 + 8 + 8, "Args has no padding");

__device__ __forceinline__ void transpose_item(const float* W, int ldw, int csrc0, int nvalid, int K, bf16* WT, int drow0, int k0, LAS float* scr, int lane) {
    const int col = lane & 31;
#pragma unroll 8
    for (int i = 0; i < 32; ++i) { const int kk = 2 * i + (lane >> 5); scr[kk * 33 + col] = (col < nvalid) ? W[(size_t)(k0 + kk) * ldw + csrc0 + col] : 0.f; }
    LDS_WAIT(); asm volatile("" ::: "memory");
    const int c = lane & 7;
#pragma unroll
    for (int j = 0; j < 4; ++j) { const int n = (lane >> 3) + 8 * j; const LAS float* s = scr + (8 * c) * 33 + n;
        u32x4 o; o.x = pk2(s[0 * 33], s[1 * 33]); o.y = pk2(s[2 * 33], s[3 * 33]); o.z = pk2(s[4 * 33], s[5 * 33]); o.w = pk2(s[6 * 33], s[7 * 33]);
        *(GAS u32x4*)(WT + (size_t)(drow0 + n) * K + k0 + 8 * c) = o; }
    LDS_WAIT(); asm volatile("" ::: "memory");
}
__device__ __forceinline__ void seg_item(const float* W, int ldw, int c0, int ncols, int K, bf16* WT, int r0, int item, LAS float* scr, int lane) {
    const int nblk = (ncols + 31) / 32, kb = item / nblk, nb = item % nblk;
    const int nv = ncols - 32 * nb;
    transpose_item(W, ldw, c0 + 32 * nb, nv < 32 ? nv : 32, K, WT, r0 + 32 * nb, 64 * kb, scr, lane);
}

__constant__ double ROPE_INVF[16] = {1.0, 0.44036660267178046, 0.19392274474868576, 0.08539710028576561, 0.03760603093086393, 0.016560440080994446, 0.007292664737217109,
    0.003211445994752591, 0.001414213562373095, 0.000622772421914596, 0.0002742481756762073, 0.00012076973741146504, 5.318295896944988e-05, 2.341999896140934e-05,
    1.031338537721246e-05, 4.5416704806078695e-06};

__device__ __forceinline__ void sincos_f64(double x, float& sn, float& cs) {
    const double k = __builtin_rint(x * 0.6366197723675814);
    double r = __builtin_fma(-k, 1.5707963267948966, x); r = __builtin_fma(-k, 6.123233995736766e-17, r);
    const double r2 = r * r;
    double ps = -1.0 / 1307674368000.0; ps = ps * r2 + 1.0 / 6227020800.0; ps = ps * r2 - 1.0 / 39916800.0; ps = ps * r2 + 1.0 / 362880.0; ps = ps * r2 - 1.0 / 5040.0; ps = ps * r2 + 1.0 / 120.0; ps = ps * r2 - 1.0 / 6.0; ps = ps * r2 + 1.0;
    const double s = ps * r;
    double pc = 1.0 / 20922789888000.0; pc = pc * r2 - 1.0 / 87178291200.0; pc = pc * r2 + 1.0 / 479001600.0; pc = pc * r2 - 1.0 / 3628800.0; pc = pc * r2 + 1.0 / 40320.0; pc = pc * r2 - 1.0 / 720.0; pc = pc * r2 + 1.0 / 24.0; pc = pc * r2 - 0.5; pc = pc * r2 + 1.0;
    const int n = ((int)(long long)k) & 3;
    const double so = (n == 0) ? s : (n == 1) ? pc : (n == 2) ? -s : -pc;
    const double co = (n == 0) ? pc : (n == 1) ? -s : (n == 2) ? -pc : s;
    sn = (float)so; cs = (float)co;
}

constexpr int SEG_ITEMS[11] = {32 * 256, 32 * 64, 32 * 64, 32 * 2, 16 * 64, 64 * 8, 64 * 8, 32 * 64, 32 * 64, 32 * 256, 128 * 64};
constexpr int ITEMS_PER_LAYER = 8192 + 2048 + 2048 + 64 + 1024 + 512 + 512 + 2048 + 2048 + 8192 + 8192;
constexpr int W2T_ITEMS = 4 * 4;

__device__ __forceinline__ void p0_prologue(const Ptrs& P, LAS unsigned char* lds, int vcu, int G, int wave, int lane, int tid) {
    LAS float* scr = (LAS float*)(lds + wave * 16384);
    const int gw = vcu * NWAVES + wave, NGW = G * NWAVES;
    for (int it = gw; it < DEPTH * ITEMS_PER_LAYER; it += NGW) {
        const int l = it / ITEMS_PER_LAYER; int r = it % ITEMS_PER_LAYER;
        unsigned char* wl = P.ws + WS_WL + (size_t)l * WL_BYTES;
        const float* win = P.w_in + (size_t)l * DM * INW;
        if (r < SEG_ITEMS[0]) { seg_item(win, INW, 0, 8192, DM, (bf16*)(wl + WL_WIN), 0, r, scr, lane); continue; } r -= SEG_ITEMS[0];
        if (r < SEG_ITEMS[1]) { seg_item(win, INW, 8240, 2048, DM, (bf16*)(wl + WL_WIN), C_GA, r, scr, lane); continue; } r -= SEG_ITEMS[1];
        if (r < SEG_ITEMS[2]) { seg_item(win, INW, 10288, 2048, DM, (bf16*)(wl + WL_WIN), C_GB, r, scr, lane); continue; } r -= SEG_ITEMS[2];
        if (r < SEG_ITEMS[3]) { seg_item(win, INW, 8192, 48, DM, (bf16*)(wl + WL_WIN), C_GN, r, scr, lane); continue; } r -= SEG_ITEMS[3];
        if (r < SEG_ITEMS[4]) { seg_item(P.w_conv_out + (size_t)l * CWID * DM, DM, 0, DM, CWID, (bf16*)(wl + WL_WCONV), 0, r, scr, lane); continue; } r -= SEG_ITEMS[4];
        if (r < SEG_ITEMS[5]) { seg_item(P.cmp_w1 + (size_t)(l * 2 + 0) * 4096 * 256, 256, 0, 256, 4096, (bf16*)(wl + WL_W1T), 0, r, scr, lane); continue; } r -= SEG_ITEMS[5];
        if (r < SEG_ITEMS[6]) { seg_item(P.cmp_w1 + (size_t)(l * 2 + 1) * 4096 * 256, 256, 0, 256, 4096, (bf16*)(wl + WL_W1T) + (size_t)256 * 4096, 0, r, scr, lane); continue; } r -= SEG_ITEMS[6];
        if (r < SEG_ITEMS[7]) { seg_item(P.w_nsa + (size_t)l * DM * DM, DM, 0, DM, DM, (bf16*)(wl + WL_WNSA), 0, r, scr, lane); continue; } r -= SEG_ITEMS[7];
        if (r < SEG_ITEMS[8]) { seg_item(P.w_out + (size_t)l * DM * DM, DM, 0, DM, DM, (bf16*)(wl + WL_WOUT), 0, r, scr, lane); continue; } r -= SEG_ITEMS[8];
        if (r < SEG_ITEMS[9]) { seg_item(P.w_up + (size_t)l * DM * FF, FF, 0, FF, DM, (bf16*)(wl + WL_WUP), 0, r, scr, lane); continue; } r -= SEG_ITEMS[9];
        seg_item(P.w_down + (size_t)l * FF * DM, DM, 0, DM, FF, (bf16*)(wl + WL_WDOWN), 0, r, scr, lane);
    }
    for (int it = gw; it < DEPTH * 2 * W2T_ITEMS; it += NGW) {
        const int m = it / W2T_ITEMS, r = it % W2T_ITEMS;
        seg_item(P.cmp_w2 + (size_t)m * 256 * 128, 128, 0, 128, 256, (bf16*)(P.ws + WS_W2T) + (size_t)m * 128 * 256, 0, r, scr, lane);
    }
    __syncthreads();
    {
        float* cosT = (float*)(P.ws + WS_COS); float* sinT = (float*)(P.ws + WS_SIN);
        for (int e = vcu * 512 + tid; e < S * 16; e += G * 512) {
            const int t = e >> 4, i = e & 15; float sn, cs; sincos_f64((double)P.pos[t] * ROPE_INVF[i], sn, cs); cosT[e] = cs; sinT[e] = sn;
        }
    }
    {
        LAS float* cact = (LAS float*)lds;
        for (int k = tid; k < DM; k += 512) { const float cv = P.c[k]; cact[k] = cv * sigm(cv); }
        __syncthreads();
        float* modp = (float*)(P.ws + WS_MODP);
        for (int e = vcu * 512 + tid; e < DEPTH * 8 * (6 * DM / 4); e += G * 512) {
            const int l = e / (8 * 3072), rem = e % (8 * 3072), kc = rem / 3072, c4 = rem % 3072;
            const float* w = P.ada_w + ((size_t)l * DM + kc * 256) * (6 * DM) + c4 * 4;
            f32x4 acc = {0.f, 0.f, 0.f, 0.f};
#pragma unroll 8
            for (int k = 0; k < 256; ++k) { const f32x4 wv = *(const f32x4*)(w + (size_t)k * (6 * DM)); acc += wv * cact[kc * 256 + k]; }
            *(f32x4*)(modp + ((size_t)(l * 8 + kc) * (6 * DM)) + c4 * 4) = acc;
        }
        __syncthreads();
    }
    for (int w = vcu; w < DEPTH * 2 * 32; w += G) {
        const int m = w >> 5, ch = w & 31;
        if (tid < 256) {
            const float* pe = P.cmp_pe + (size_t)m * 4096 + ch * 128; const float* w1 = P.cmp_w1 + ((size_t)m * 4096 + ch * 128) * 256 + tid;
            float acc = 0.f;
#pragma unroll 8
            for (int k = 0; k < 128; ++k) acc += pe[k] * w1[(size_t)k * 256];
            ((float*)(P.ws + WS_B1PART))[(size_t)w * 256 + tid] = acc;
        }
    }
}

__device__ __forceinline__ f32x4 modvec4(const Ptrs& P, int l, int off) {
    f32x4 v = *(const f32x4*)(P.ada_b + (size_t)l * 6 * DM + off);
    const float* mp = (const float*)(P.ws + WS_MODP) + (size_t)l * 8 * 6 * DM + off;
#pragma unroll
    for (int kc = 0; kc < 8; ++kc) v += *(const f32x4*)(mp + (size_t)kc * 6 * DM);
    return v;
}

template <bool HAS_Y>
__device__ __forceinline__ void resid_phase(const Ptrs& P, LAS unsigned char* lds, const void* xsrc_, const bool src_bf, void* xdst_, const bool dst_bf, const bf16* Y, bf16* H, const bool make_h,
                                            int lg, int gate_k, int gainA, int lh, int sc_k, int sh_k, int gainB, int vcu, int G, int wave, int lane, int tid) {
    LAS f32x4* vga = (LAS f32x4*)lds; LAS f32x4* vhb = vga + 512; LAS f32x4* vhc = vhb + 512;
    {
        const int c = 4 * tid;
        if (HAS_Y) vga[tid] = modvec4(P, lg, gate_k * DM + c) * *(const f32x4*)(P.gains + (size_t)(lg * 4 + gainA) * DM + c);
        if (make_h) { vhb[tid] = *(const f32x4*)(P.gains + (size_t)(lh * 4 + gainB) * DM + c) * (modvec4(P, lh, sc_k * DM + c) + 1.0f); vhc[tid] = modvec4(P, lh, sh_k * DM + c); }
    }
    __syncthreads();
    const int gw = vcu * NWAVES + wave, NGW = G * NWAVES;
    for (int m = gw; m < S; m += NGW) {
        f32x4 xv[8];
        if (src_bf) { const u32x2* xr = (const u32x2*)((const bf16*)xsrc_ + (size_t)m * DM) + lane;
#pragma unroll
            for (int j = 0; j < 8; ++j) { const u32x2 w = xr[64 * j]; xv[j] = (f32x4){bf_lo(w.x), bf_hi(w.x), bf_lo(w.y), bf_hi(w.y)}; }
        } else { const f32x4* xr = (const f32x4*)((const float*)xsrc_ + (size_t)m * DM) + lane;
#pragma unroll
            for (int j = 0; j < 8; ++j) xv[j] = xr[64 * j]; }
        if (HAS_Y) {
            f32x4 yv[8]; float s = 0.f;
            const u32x2* yr = (const u32x2*)(Y + (size_t)m * DM) + lane;
#pragma unroll
            for (int j = 0; j < 8; ++j) { const u32x2 w = yr[64 * j]; yv[j] = (f32x4){bf_lo(w.x), bf_hi(w.x), bf_lo(w.y), bf_hi(w.y)}; s += (yv[j].x * yv[j].x + yv[j].y * yv[j].y) + (yv[j].z * yv[j].z + yv[j].w * yv[j].w); }
            const float r = 1.0f / sqrtf(wave_sum(s) * (1.0f / DM) + NORM_EPS);
#pragma unroll
            for (int j = 0; j < 8; ++j) xv[j] += vga[lane + 64 * j] * (yv[j] * r);
            if (dst_bf) { u32x2* xo = (u32x2*)((bf16*)xdst_ + (size_t)m * DM) + lane;
#pragma unroll
                for (int j = 0; j < 8; ++j) { u32x2 w; w.x = pk2(xv[j].x, xv[j].y); w.y = pk2(xv[j].z, xv[j].w); xo[64 * j] = w;
                    xv[j] = (f32x4){bf_lo(w.x), bf_hi(w.x), bf_lo(w.y), bf_hi(w.y)}; }
            } else { f32x4* xo = (f32x4*)((float*)xdst_ + (size_t)m * DM) + lane;
#pragma unroll
                for (int j = 0; j < 8; ++j) xo[64 * j] = xv[j]; }
        }
        if (make_h) {
            float s = 0.f;
#pragma unroll
            for (int j = 0; j < 8; ++j) s += (xv[j].x * xv[j].x + xv[j].y * xv[j].y) + (xv[j].z * xv[j].z + xv[j].w * xv[j].w);
            const float r = 1.0f / sqrtf(wave_sum(s) * (1.0f / DM) + NORM_EPS);
            u32x2* ho = (u32x2*)(H + (size_t)m * DM) + lane;
#pragma unroll
            for (int j = 0; j < 8; ++j) { const f32x4 h = (xv[j] * r) * vhb[lane + 64 * j] + vhc[lane + 64 * j]; u32x2 w; w.x = pk2(h.x, h.y); w.y = pk2(h.z, h.w); ho[64 * j] = w; }
        }
    }
    __syncthreads();
}

__device__ __forceinline__ void rope8(float (&v)[8], const float (&p)[8], const float* cs, const float* sn, int ch  ) {
#pragma unroll
    for (int j = 0; j < 8; ++j) { const float c = cs[8 * (ch & 1) + j], s = sn[8 * (ch & 1) + j];
        v[j] = (ch < 2) ? (v[j] * c - p[j] * s) : (v[j] * c + p[j] * s); }
}
__device__ __forceinline__ void relayout_phase(const Ptrs& P, int l, LAS unsigned char* lds, int vcu, int G, int tid) {
    const bf16* Pm = (const bf16*)(P.ws + WS_P);
    const float* cosT = (const float*)(P.ws + WS_COS); const float* sinT = (const float*)(P.ws + WS_SIN);
    if (vcu == 0) {
        const float* part = (const float*)(P.ws + WS_B1PART) + (size_t)l * 2 * 32 * 256;
        const int kv = tid >> 8, col = tid & 255; float a = P.cmp_b1[(size_t)(l * 2 + kv) * 256 + col];
        for (int ch = 0; ch < 32; ++ch) a += part[(size_t)(kv * 32 + ch) * 256 + col];
        ((float*)(P.ws + WS_B1P))[tid] = a;
    }
    for (int b = vcu; b < S / 64; b += G) {
        const int t0 = b * 64;
        {
            const float* cw = P.conv_w + (size_t)l * 3 * CWID; bf16* CV = (bf16*)(P.ws + WS_CV);
            for (int e = tid; e < 64 * 128; e += 512) {
                const int tl = e >> 7, c8 = (e & 127) * 8, t = t0 + tl;
                float z[8] = {0.f, 0.f, 0.f, 0.f, 0.f, 0.f, 0.f, 0.f};
#pragma unroll
                for (int k = 0; k < 3; ++k) { const int tt = t - 2 + k;
                    if (tt >= 0) { float cg[8], xa[8]; unpack8(*(const u32x4*)(Pm + (size_t)tt * PW + C_CG + c8), cg); unpack8(*(const u32x4*)(Pm + (size_t)tt * PW + C_XA + c8), xa);
                        const f32x4 w0 = *(const f32x4*)(cw + k * CWID + c8), w1 = *(const f32x4*)(cw + k * CWID + c8 + 4);
#pragma unroll
                        for (int j = 0; j < 8; ++j) z[j] += (j < 4 ? w0[j] : w1[j - 4]) * (cg[j] * xa[j]); } }
                float bg[8]; unpack8(*(const u32x4*)(Pm + (size_t)t * PW + C_BG + c8), bg);
#pragma unroll
                for (int j = 0; j < 8; ++j) z[j] *= bg[j];
                *(u32x4*)(CV + (size_t)t * CWID + c8) = pack8(z);
            }
        }
        {
            bf16* QP = (bf16*)(P.ws + WS_QP);
            for (int e = tid; e < 64 * 256; e += 512) {
                const int tl = e >> 8, hh = (e >> 4) & 15, ch = e & 15, t = t0 + tl;
                const bf16* src = Pm + (size_t)t * PW + C_Q + hh * HD;
                float v[8]; unpack8(*(const u32x4*)(src + 8 * ch), v);
                if (ch < 4) { float p[8]; unpack8(*(const u32x4*)(src + 8 * (ch ^ 2)), p); rope8(v, p, cosT + (size_t)t * 16, sinT + (size_t)t * 16, ch); }
#pragma unroll
                for (int j = 0; j < 8; ++j) v[j] *= QSCALE;
                *(u32x4*)(QP + (size_t)t * DM + hh * HD + 8 * ch) = pack8(v);
            }
        }
        for (int e = tid; e < 4 * 4 * 64 * 16; e += 512) {
            const int pi = e >> 12, g = (e >> 10) & 3, kap = (e >> 4) & 63, ch = e & 15, t = t0 + kap;
            const int part = (pi == 0) ? 0 : (pi == 1) ? 2 : (pi == 2) ? 4 : 1;
            const bf16* src = Pm + (size_t)t * PW + C_KV + part * 512 + g * HD;
            float v[8]; unpack8(*(const u32x4*)(src + 8 * ch), v);
            if (part != 1 && ch < 4) { float p[8]; unpack8(*(const u32x4*)(src + 8 * (ch ^ 2)), p); rope8(v, p, cosT + (size_t)t * 16, sinT + (size_t)t * 16, ch); }
            const u32x4 w = pack8(v);
            if (part == 0) *(u32x4*)((bf16*)(P.ws + WS_KCR) + ((size_t)g * S + t) * HD + 8 * ch) = w;
            else if (part == 1) *(u32x4*)((bf16*)(P.ws + WS_VCR) + ((size_t)g * S + t) * HD + 8 * ch) = w;
            else { unsigned char* img = P.ws + (part == 2 ? WS_KSI : WS_KWI) + ((size_t)g * 256 + b) * 16384; *(u32x4*)(img + kimg_off(kap, ch)) = w; }
        }
        for (int vp = 0; vp < 2; ++vp) {
            const int part = 3 + 2 * vp;
            LAS unsigned short* tile = (LAS unsigned short*)lds;
            for (int e = tid; e < 4 * 64 * 16; e += 512) {
                const int g = e >> 10, kap = (e >> 4) & 63, ch = e & 15;
                const u32x4 w = *(const u32x4*)(Pm + (size_t)(t0 + kap) * PW + C_KV + part * 512 + g * HD + 8 * ch);
                *(LAS u32x4*)(tile + (g * 64 + kap) * 136 + 8 * ch) = w;
            }
            __syncthreads();
            for (int e = tid; e < 4 * 128 * 8; e += 512) {
                const int g = e >> 10, d = (e >> 3) & 127, kc = e & 7;
                const LAS unsigned short* s = tile + (g * 64 + 8 * kc) * 136 + d;
                u32x4 w; w.x = (unsigned)s[0] | ((unsigned)s[136] << 16); w.y = (unsigned)s[2 * 136] | ((unsigned)s[3 * 136] << 16);
                w.z = (unsigned)s[4 * 136] | ((unsigned)s[5 * 136] << 16); w.w = (unsigned)s[6 * 136] | ((unsigned)s[7 * 136] << 16);
                unsigned char* img = P.ws + (part == 3 ? WS_VSI : WS_VWI) + ((size_t)g * 256 + b) * 16384;
                *(u32x4*)(img + vimg_off(d, kc)) = w;
            }
            __syncthreads();
        }
        {
            float* GT = (float*)(P.ws + WS_GT);
            const bf16* Hb = (const bf16*)(P.ws + WS_H); const bf16* Wg = (const bf16*)(P.ws + WS_WL + (size_t)l * WL_BYTES + WL_WIN) + (size_t)C_GN * DM;
            const int wv = tid >> 6, ln = tid & 63, r16 = ln & 15, q4 = ln >> 4, rt = wv & 3, ct0 = (wv < 4) ? 0 : 2, nct = (wv < 4) ? 2 : 1;
            f32x4 acc[2] = {(f32x4){0.f, 0.f, 0.f, 0.f}, (f32x4){0.f, 0.f, 0.f, 0.f}};
            const bf16* ap = Hb + (size_t)(t0 + rt * 16 + r16) * DM + 8 * q4;
            const bf16* bp0 = Wg + (size_t)(ct0 * 16 + r16) * DM + 8 * q4; const bf16* bp1 = bp0 + (size_t)16 * DM;
#pragma unroll 4
            for (int ks = 0; ks < DM / 32; ++ks) {
                const bf16x8 af = *(const bf16x8*)(ap + 32 * ks);
                acc[0] = __builtin_amdgcn_mfma_f32_16x16x32_bf16(af, *(const bf16x8*)(bp0 + 32 * ks), acc[0], 0, 0, 0);
                if (nct == 2) acc[1] = __builtin_amdgcn_mfma_f32_16x16x32_bf16(af, *(const bf16x8*)(bp1 + 32 * ks), acc[1], 0, 0, 0);
            }
#pragma unroll
            for (int c = 0; c < 2; ++c) if (c < nct) {
#pragma unroll
                for (int i = 0; i < 4; ++i) GT[(size_t)(t0 + rt * 16 + 4 * q4 + i) * 48 + (ct0 + c) * 16 + r16] = sigm(acc[c][i]); }
        }
    }
}

__device__ __forceinline__ void cmp2_phase(const Ptrs& P, int l, int vcu, int G, int wave, int lane) {
    const int r16 = lane & 15, q = lane >> 4;
    for (int e = vcu; e < 128; e += G) {
        const int kv = e >> 6, g = (e >> 4) & 3, blk = e & 15;
        const bf16* HC = (const bf16*)(P.ws + WS_HC) + ((size_t)kv * 4096 + g * 1024 + blk * 64) * 256;
        const bf16* W2T = (const bf16*)(P.ws + WS_W2T) + (size_t)(l * 2 + kv) * 128 * 256;
        const float* b2 = P.cmp_b2 + (size_t)(l * 2 + kv) * 128;
        const int rt = wave & 3, ch = wave >> 2;
        bf16x8 af[8];
#pragma unroll
        for (int ks = 0; ks < 8; ++ks) af[ks] = *(const bf16x8*)(HC + (size_t)(rt * 16 + r16) * 256 + 32 * ks + 8 * q);
        unsigned char* img = P.ws + (kv == 0 ? WS_KCI : WS_VCI) + ((size_t)g * 16 + blk) * 16384;
#pragma unroll
        for (int ct = 0; ct < 4; ++ct) {
            const int n = ch * 64 + ct * 16 + r16;
            f32x4 acc = {0.f, 0.f, 0.f, 0.f};
#pragma unroll
            for (int ks = 0; ks < 8; ++ks) { const bf16x8 bfr = *(const bf16x8*)(W2T + (size_t)n * 256 + 32 * ks + 8 * q);
                acc = __builtin_amdgcn_mfma_f32_16x16x32_bf16(af[ks], bfr, acc, 0, 0, 0); }
            const float bb = b2[n];
            if (kv == 0) {
#pragma unroll
                for (int i = 0; i < 4; ++i) { const int kap = rt * 16 + 4 * q + i; *(bf16*)(img + kimg_off(kap, n >> 3) + (n & 7) * 2) = (bf16)f2bf(acc[i] + bb); }
            } else {
                const int kap0 = rt * 16 + 4 * q; u32x2 w; w.x = pk2(acc[0] + bb, acc[1] + bb); w.y = pk2(acc[2] + bb, acc[3] + bb);
                *(u32x2*)(img + vimg_off(n, kap0 >> 3) + (kap0 & 7) * 2) = w;
            }
        }
    }
}

#ifndef DBG_REP_SEL
#define DBG_REP_SEL 1
#endif
#ifndef DBG_BR
#define DBG_BR 7
#endif
#ifndef DBG_SANITIZE
#define DBG_SANITIZE 0
#endif
#ifndef DBG_DENSE_SEL
#define DBG_DENSE_SEL 0
#endif
struct AttnLane { unsigned kb, vb; int kx, vx; int q; };
#define AL_KOFF(L_, s_) ((L_).kb + 64u * (unsigned)((s_) ^ (L_).kx))
#define AL_VOFF(L_, a_) ((L_).vb + 64u * (unsigned)((a_) ^ (L_).vx))

__device__ __forceinline__ bf16x8 pack_p(const f32x4 a, const f32x4 b) {
    u32x4 w; w.x = pg8::cvt_pk_bf16(a[0], a[1]); w.y = pg8::cvt_pk_bf16(a[2], a[3]); w.z = pg8::cvt_pk_bf16(b[0], b[1]); w.w = pg8::cvt_pk_bf16(b[2], b[3]);
    return __builtin_bit_cast(bf16x8, w);
}
__device__ __forceinline__ void lds_fadd(LAS float* p, float v) { (void)__hip_atomic_fetch_add(p, v, __ATOMIC_RELAXED, __HIP_MEMORY_SCOPE_WORKGROUP); }
template <int CTRL> __device__ __forceinline__ unsigned dpp_u_(unsigned v) { return (unsigned)__builtin_amdgcn_update_dpp(0, (int)v, CTRL, 0xF, 0xF, false); }
__device__ __forceinline__ unsigned wave_umax(unsigned v) {
    v = max(v, dpp_u_<0xB1>(v)); v = max(v, dpp_u_<0x4E>(v)); v = max(v, dpp_u_<0x141>(v)); v = max(v, dpp_u_<0x140>(v));
    auto r16 = __builtin_amdgcn_permlane16_swap(v, v, false, false); v = max(r16[0], r16[1]);
    auto r32 = __builtin_amdgcn_permlane32_swap(v, v, false, false); return max(r32[0], r32[1]);
}
__device__ __forceinline__ unsigned wave_umin(unsigned v) {
    v = min(v, dpp_u_<0xB1>(v)); v = min(v, dpp_u_<0x4E>(v)); v = min(v, dpp_u_<0x141>(v)); v = min(v, dpp_u_<0x140>(v));
    auto r16 = __builtin_amdgcn_permlane16_swap(v, v, false, false); v = min(r16[0], r16[1]);
    auto r32 = __builtin_amdgcn_permlane32_swap(v, v, false, false); return min(r32[0], r32[1]);
}
__device__ __forceinline__ float quad_sum(float v) {
    v += __builtin_bit_cast(float, __builtin_amdgcn_update_dpp(0, __builtin_bit_cast(int, v), 0xB1, 0xF, 0xF, false));
    v += __builtin_bit_cast(float, __builtin_amdgcn_update_dpp(0, __builtin_bit_cast(int, v), 0x4E, 0xF, 0xF, false));
    return v;
}
__device__ __forceinline__ void ldsr128(bf16x8& d, unsigned addr) { asm volatile("ds_read_b128 %0, %1" : "=v"(d) : "v"(addr)); }
__device__ __forceinline__ void ldsr128o(bf16x8& d, unsigned addr, const int off) { asm volatile("ds_read_b128 %0, %1 offset:%2" : "=v"(d) : "v"(addr), "i"(off)); }
#define LDS_WAIT4(n, a, b, c, d) asm volatile("s_waitcnt lgkmcnt(" #n ")" : "+v"(a), "+v"(b), "+v"(c), "+v"(d))
template <bool T0, bool T1, int MODE>
__device__ __forceinline__ void block_step(LAS const unsigned char* Kb, LAS const unsigned char* Vb, const AttnLane& L, const bf16x8 (&qf)[2][4],
                                           f32x4 (&O)[2][8], float (&m)[2], float (&l)[2], const int (&limq)[2], const unsigned W,
                                           const float (&invl)[2], LAS float* const (&improw)[2], const int j0, const bool hzero, const bool MASKB) {
    AttnLane Lq = L; asm volatile("" : "+v"(Lq.kb), "+v"(Lq.vb));
    f32x4 st[2][4];
    const f32x4 z = {0.f, 0.f, 0.f, 0.f};
    {
        __builtin_amdgcn_s_setprio(1);
        const unsigned kbase = (unsigned)(uintptr_t)Kb;
        unsigned ka[4];
#pragma unroll
        for (int s = 0; s < 4; ++s) ka[s] = kbase + AL_KOFF(Lq, s);
        bf16x8 fa[4], fb[4];
#pragma unroll
        for (int s = 0; s < 4; ++s) ldsr128(fa[s], ka[s]);
#pragma unroll
        for (int kt = 0; kt < 4; ++kt) {
            if (kt < 3) {
#pragma unroll
                for (int s = 0; s < 4; ++s) { if ((kt & 1) == 0) ldsr128o(fb[s], ka[s], (kt + 1) * 4096); else ldsr128o(fa[s], ka[s], (kt + 1) * 4096); }
            }
            if ((kt & 1) == 0) { if (kt < 3) LDS_WAIT4(4, fa[0], fa[1], fa[2], fa[3]); else LDS_WAIT4(0, fa[0], fa[1], fa[2], fa[3]); }
            else               { if (kt < 3) LDS_WAIT4(4, fb[0], fb[1], fb[2], fb[3]); else LDS_WAIT4(0, fb[0], fb[1], fb[2], fb[3]); }
#pragma unroll
            for (int s = 0; s < 4; ++s) { const bf16x8 a = ((kt & 1) == 0) ? fa[s] : fb[s];
                if (T0) st[0][kt] = __builtin_amdgcn_mfma_f32_16x16x32_bf16(a, qf[0][s], s == 0 ? z : st[0][kt], 0, 0, 0);
                if (T1) st[1][kt] = __builtin_amdgcn_mfma_f32_16x16x32_bf16(a, qf[1][s], s == 0 ? z : st[1][kt], 0, 0, 0); }
        }
    }
    __builtin_amdgcn_s_setprio(0);
    bf16x8 pf[2][2];
#pragma unroll
    for (int ts = 0; ts < 2; ++ts) {
        if (!(ts == 0 ? T0 : T1)) continue;
        const float NEG = -__builtin_inff();
        if (MASKB) {
#pragma unroll
        for (int kt = 0; kt < 4; ++kt)
#pragma unroll
            for (int i = 0; i < 4; ++i) { const int kc = 32 * (kt >> 1) + 4 * (kt & 1) + i; if ((unsigned)(limq[ts] - kc) >= W) st[ts][kt][i] = NEG; }
        }
        if (MODE != 1) {
            float mx = fmaxf(fmaxf(st[ts][0][0], st[ts][0][1]), fmaxf(st[ts][0][2], st[ts][0][3]));
#pragma unroll
            for (int kt = 1; kt < 4; ++kt) mx = fmaxf(mx, fmaxf(fmaxf(st[ts][kt][0], st[ts][kt][1]), fmaxf(st[ts][kt][2], st[ts][kt][3])));
            { auto r16 = __builtin_amdgcn_permlane16_swap(__float_as_uint(mx), __float_as_uint(mx), false, false); mx = fmaxf(__uint_as_float(r16[0]), __uint_as_float(r16[1]));
              auto r32 = __builtin_amdgcn_permlane32_swap(__float_as_uint(mx), __float_as_uint(mx), false, false); mx = fmaxf(__uint_as_float(r32[0]), __uint_as_float(r32[1])); }
            const float mn = fmaxf(m[ts], mx), alpha = __builtin_amdgcn_exp2f(m[ts] - mn); m[ts] = mn;
            float sum = 0.f;
#pragma unroll
            for (int kt = 0; kt < 4; ++kt)
#pragma unroll
                for (int i = 0; i < 4; ++i) { const float pv = __builtin_amdgcn_exp2f(st[ts][kt][i] - mn); st[ts][kt][i] = pv; sum += pv; }
            l[ts] = l[ts] * alpha + sum;
            if (MODE == 2) {
#pragma unroll
                for (int dt = 0; dt < 8; ++dt) O[ts][dt] *= alpha;
            }
        } else {
#pragma unroll
            for (int kt = 0; kt < 4; ++kt)
#pragma unroll
                for (int i = 0; i < 4; ++i) st[ts][kt][i] = __builtin_amdgcn_exp2f(st[ts][kt][i] - m[ts]) * invl[ts];
            float A[4], B[4];
#pragma unroll
            for (int kt = 0; kt < 4; ++kt) { B[kt] = 0.5f * st[ts][kt][3]; A[kt] = quad_sum((st[ts][kt][0] + st[ts][kt][1]) + (st[ts][kt][2] + B[kt])); B[kt] = quad_sum(B[kt]); }
            if (hzero) { LAS float* ir = improw[ts] + j0;
                lds_fadd(ir + 0, A[0]); lds_fadd(ir + 1, B[0] + A[1]); lds_fadd(ir + 2, B[1]); lds_fadd(ir + 8, A[2]); lds_fadd(ir + 9, B[2] + A[3]); lds_fadd(ir + 10, B[3]); }
        }
        if (MODE != 0) { pf[ts][0] = pack_p(st[ts][0], st[ts][1]); pf[ts][1] = pack_p(st[ts][2], st[ts][3]); }
    }
    if (MODE != 0) {
        __builtin_amdgcn_s_setprio(1);
        const unsigned vbase = (unsigned)(uintptr_t)Vb;
        unsigned va[2];
#pragma unroll
        for (int a = 0; a < 2; ++a) va[a] = vbase + AL_VOFF(Lq, a);
        bf16x8 fa[4], fb[4];
#pragma unroll
        for (int j = 0; j < 4; ++j) ldsr128o(fa[j], va[j & 1], (j >> 1) * 2048);
#pragma unroll
        for (int dp = 0; dp < 4; ++dp) {
            if (dp < 3) {
#pragma unroll
                for (int j = 0; j < 4; ++j) { if ((dp & 1) == 0) ldsr128o(fb[j], va[j & 1], (2 * (dp + 1) + (j >> 1)) * 2048); else ldsr128o(fa[j], va[j & 1], (2 * (dp + 1) + (j >> 1)) * 2048); }
            }
            if ((dp & 1) == 0) { if (dp < 3) LDS_WAIT4(4, fa[0], fa[1], fa[2], fa[3]); else LDS_WAIT4(0, fa[0], fa[1], fa[2], fa[3]); }
            else               { if (dp < 3) LDS_WAIT4(4, fb[0], fb[1], fb[2], fb[3]); else LDS_WAIT4(0, fb[0], fb[1], fb[2], fb[3]); }
#pragma unroll
            for (int j = 0; j < 4; ++j) { const bf16x8 v = ((dp & 1) == 0) ? fa[j] : fb[j]; const int dt = 2 * dp + (j >> 1), a = j & 1;
                if (T0) O[0][dt] = __builtin_amdgcn_mfma_f32_16x16x32_bf16(v, pf[0][a], O[0][dt], 0, 0, 0);
                if (T1) O[1][dt] = __builtin_amdgcn_mfma_f32_16x16x32_bf16(v, pf[1][a], O[1][dt], 0, 0, 0); }
        }
        __builtin_amdgcn_s_setprio(0);
    }
}


constexpr float ATT_THR = 8.0f;
__device__ __forceinline__ float max3f_(float a, float b, float c) { return fmaxf(fmaxf(a, b), c); }
template <bool T0, bool T1>
__device__ __forceinline__ void step_online(LAS const unsigned char* Kb, LAS const unsigned char* Vb, const AttnLane& L, const bf16x8 (&qf)[2][4],
                                            f32x4 (&O)[2][8], float (&mref)[2], float (&l)[2], const int (&limq)[2], const unsigned W, const bool MASK, const bool START) {
    AttnLane Lq = L; asm volatile("" : "+v"(Lq.kb), "+v"(Lq.vb));
    f32x4 st[2][4];
    const float NEG = -__builtin_inff();
#pragma unroll
    for (int ts = 0; ts < 2; ++ts) { const float c0 = START ? 0.f : (limq[ts] > -500 ? -mref[ts] : NEG);
#pragma unroll
        for (int kt = 0; kt < 4; ++kt) st[ts][kt] = (f32x4){c0, c0, c0, c0}; }
    {
        __builtin_amdgcn_s_setprio(1);
        const unsigned kbase = (unsigned)(uintptr_t)Kb;
        unsigned ka[4];
#pragma unroll
        for (int s = 0; s < 4; ++s) ka[s] = kbase + AL_KOFF(Lq, s);
        bf16x8 fa[4], fb[4];
#pragma unroll
        for (int s = 0; s < 4; ++s) ldsr128(fa[s], ka[s]);
#pragma unroll
        for (int kt = 0; kt < 4; ++kt) {
            if (kt < 3) {
#pragma unroll
                for (int s = 0; s < 4; ++s) { if ((kt & 1) == 0) ldsr128o(fb[s], ka[s], (kt + 1) * 4096); else ldsr128o(fa[s], ka[s], (kt + 1) * 4096); }
            }
            if ((kt & 1) == 0) { if (kt < 3) LDS_WAIT4(4, fa[0], fa[1], fa[2], fa[3]); else LDS_WAIT4(0, fa[0], fa[1], fa[2], fa[3]); }
            else               { if (kt < 3) LDS_WAIT4(4, fb[0], fb[1], fb[2], fb[3]); else LDS_WAIT4(0, fb[0], fb[1], fb[2], fb[3]); }
#pragma unroll
            for (int s = 0; s < 4; ++s) { const bf16x8 a = ((kt & 1) == 0) ? fa[s] : fb[s];
                if (T0) st[0][kt] = __builtin_amdgcn_mfma_f32_16x16x32_bf16(a, qf[0][s], st[0][kt], 0, 0, 0);
                if (T1) st[1][kt] = __builtin_amdgcn_mfma_f32_16x16x32_bf16(a, qf[1][s], st[1][kt], 0, 0, 0); }
        }
    }
    __builtin_amdgcn_s_setprio(0);
    __builtin_amdgcn_sched_barrier(0);
    bf16x8 pf[2][2];
#pragma unroll
    for (int ts = 0; ts < 2; ++ts) {
        if (!(ts == 0 ? T0 : T1)) continue;
        if (MASK || START) {
#pragma unroll
            for (int kt = 0; kt < 4; ++kt)
#pragma unroll
                for (int i = 0; i < 4; ++i) { const int kc = 32 * (kt >> 1) + 4 * (kt & 1) + i; if ((unsigned)(limq[ts] - kc) >= W) st[ts][kt][i] = NEG; }
        }
        float mx = max3f_(st[ts][0][0], st[ts][0][1], st[ts][0][2]);
        mx = max3f_(mx, st[ts][0][3], st[ts][1][0]); mx = max3f_(mx, st[ts][1][1], st[ts][1][2]); mx = max3f_(mx, st[ts][1][3], st[ts][2][0]);
        mx = max3f_(mx, st[ts][2][1], st[ts][2][2]); mx = max3f_(mx, st[ts][2][3], st[ts][3][0]); mx = max3f_(mx, st[ts][3][1], st[ts][3][2]); mx = fmaxf(mx, st[ts][3][3]);
#define XLANE_MAX_(v_) do { auto r16 = __builtin_amdgcn_permlane16_swap(__float_as_uint(v_), __float_as_uint(v_), false, false); v_ = fmaxf(__uint_as_float(r16[0]), __uint_as_float(r16[1])); \
          auto r32 = __builtin_amdgcn_permlane32_swap(__float_as_uint(v_), __float_as_uint(v_), false, false); v_ = fmaxf(__uint_as_float(r32[0]), __uint_as_float(r32[1])); } while (0)
        if (START) {
            XLANE_MAX_(mx);
            const float m0 = fmaxf(mx, -1.0e4f); mref[ts] = m0;
#pragma unroll
            for (int kt = 0; kt < 4; ++kt) st[ts][kt] -= m0;
        } else if (__builtin_expect(__any(mx > ATT_THR), 0)) {
            XLANE_MAX_(mx);
            const float dl = fmaxf(mx, 0.f), f = __builtin_amdgcn_exp2f(-dl); mref[ts] += dl; l[ts] *= f;
#pragma unroll
            for (int kt = 0; kt < 4; ++kt) st[ts][kt] -= dl;
#pragma unroll
            for (int dt = 0; dt < 8; ++dt) O[ts][dt] *= f;
        }
        float sum = 0.f;
#pragma unroll
        for (int kt = 0; kt < 4; ++kt)
#pragma unroll
            for (int i = 0; i < 4; ++i) { const float pv = __builtin_amdgcn_exp2f(st[ts][kt][i]); st[ts][kt][i] = pv; sum += pv; }
        l[ts] += sum;
        pf[ts][0] = pack_p(st[ts][0], st[ts][1]); pf[ts][1] = pack_p(st[ts][2], st[ts][3]);
        __builtin_amdgcn_sched_barrier(0);
    }
    {
        __builtin_amdgcn_s_setprio(1);
        const unsigned vbase = (unsigned)(uintptr_t)Vb;
        unsigned va[2];
#pragma unroll
        for (int a = 0; a < 2; ++a) va[a] = vbase + AL_VOFF(Lq, a);
        bf16x8 fa[4], fb[4];
#pragma unroll
        for (int j = 0; j < 4; ++j) ldsr128o(fa[j], va[j & 1], (j >> 1) * 2048);
#pragma unroll
        for (int dp = 0; dp < 4; ++dp) {
            if (dp < 3) {
#pragma unroll
                for (int j = 0; j < 4; ++j) { if ((dp & 1) == 0) ldsr128o(fb[j], va[j & 1], (2 * (dp + 1) + (j >> 1)) * 2048); else ldsr128o(fa[j], va[j & 1], (2 * (dp + 1) + (j >> 1)) * 2048); }
            }
            if ((dp & 1) == 0) { if (dp < 3) LDS_WAIT4(4, fa[0], fa[1], fa[2], fa[3]); else LDS_WAIT4(0, fa[0], fa[1], fa[2], fa[3]); }
            else               { if (dp < 3) LDS_WAIT4(4, fb[0], fb[1], fb[2], fb[3]); else LDS_WAIT4(0, fb[0], fb[1], fb[2], fb[3]); }
#pragma unroll
            for (int j = 0; j < 4; ++j) { const bf16x8 v = ((dp & 1) == 0) ? fa[j] : fb[j]; const int dt = 2 * dp + (j >> 1), a = j & 1;
                if (T0) O[0][dt] = __builtin_amdgcn_mfma_f32_16x16x32_bf16(v, pf[0][a], O[0][dt], 0, 0, 0);
                if (T1) O[1][dt] = __builtin_amdgcn_mfma_f32_16x16x32_bf16(v, pf[1][a], O[1][dt], 0, 0, 0); }
        }
        __builtin_amdgcn_s_setprio(0);
    }
    __builtin_amdgcn_sched_barrier(0);
}
__device__ __forceinline__ void glds16(const void* gsrc, unsigned lds_dst) { unsigned keep;
    asm volatile("s_mov_b32 %0, m0\n\ts_mov_b32 m0, %2\n\ts_nop 0\n\tglobal_load_lds_dwordx4 %1, off\n\ts_mov_b32 m0, %0" : "=&s"(keep) : "v"(gsrc), "s"(lds_dst) : "memory"); }

__device__ __forceinline__ void glds16s(const void* sbase, unsigned voff, unsigned lds_dst) { unsigned keep;
    asm volatile("s_mov_b32 %0, m0\n\ts_mov_b32 m0, %3\n\ts_nop 0\n\tglobal_load_lds_dwordx4 %1, %2\n\ts_mov_b32 m0, %0" : "=&s"(keep) : "v"(voff), "s"(sbase), "s"(lds_dst) : "memory"); }

#define AT_BAR() do { asm volatile("s_waitcnt lgkmcnt(0)" ::: "memory"); __builtin_amdgcn_s_barrier(); asm volatile("" ::: "memory"); } while (0)
#define AT_STAGE(gsrc, ldsoff) do { unsigned _lo = (unsigned)lane * 16u; asm volatile("" : "+v"(_lo)); _Pragma("unroll") for (int _p = 0; _p < 2; ++_p) \
    glds16s((gsrc) + (_p * 8 + wave) * 1024, _lo, (unsigned)__builtin_amdgcn_readfirstlane((int)(ldsb + (unsigned)(ldsoff) + (unsigned)(_p * 8 + wave) * 1024u))); } while (0)
#define AT_WAITV(n) asm volatile("s_waitcnt vmcnt(" #n ")" ::: "memory")

__device__ __forceinline__ void attn_phase(const Ptrs& P, LAS unsigned char* lds, int vcu, int G, int wave, int lane, int layer) {
    const unsigned ldsb = (unsigned)(uintptr_t)lds;
    const bf16* QP = (const bf16*)(P.ws + WS_QP);
    const float* GT = (const float*)(P.ws + WS_GT);
    bf16* AO = (bf16*)(P.ws + WS_AO);
    LAS float* impw = (LAS float*)(lds + AT_IMP) + 8 * wave * IMP_STRIDE;
    LAS unsigned* selw = (LAS unsigned*)(lds + AT_SELW) + wave * 256;
#define AT_REGION() int ln_ = lane; asm volatile("" : "+v"(ln_)); const int c16 = ln_ & 15, q = ln_ >> 4, hh = c16 & 3, tq = c16 >> 2; AttnLane L; L.q = q; \
    L.kb = (unsigned)(c16 * 256 + (((q ^ c16) & 3) << 4)); L.kx = (c16 >> 2) & 3; L.vb = (unsigned)(c16 * 128 + (((q ^ (c16 >> 1)) & 3) << 4)); L.vx = (c16 >> 3) & 1; \
    const bool hzero = (hh == 0); const int tok0 = t0 + 8 * wave + tq; (void)hzero; (void)tok0; (void)L
#define tok_(ts_) (tok0 + 4 * (ts_))
#define GATE(ts_, br_) (GT[(size_t)tok_(ts_) * 48 + (4 * g + hh) * 3 + (br_)])
#define FSAT(k_) (*(f32x4*)(FSb + (fo_ + (unsigned)(k_) * 1024u)))
#define FS_OFF() unsigned fo_ = (unsigned)ln_ * 16u

    unsigned* actr_ = (unsigned*)(P.ws + WS_CTL) + CW_ATT + layer;
    volatile LAS unsigned* abc_ = (volatile LAS unsigned*)(lds + MISC_OFF) + 40;
    for (;;) {
        if (wave == 0) { int l0_; asm volatile("v_mbcnt_lo_u32_b32 %0, -1, 0\n\tv_mbcnt_hi_u32_b32 %0, -1, %0" : "=v"(l0_));
            if (l0_ == 0) *abc_ = __hip_atomic_fetch_add(actr_, 1u, __ATOMIC_RELAXED, __HIP_MEMORY_SCOPE_AGENT); }
        __syncthreads();
        const int e = __builtin_amdgcn_readfirstlane((int)*abc_);
        __syncthreads();
        if (e >= 1024) break;
        const int tile = 255 - (e >> 2), g = e & 3;
        const int t0 = tile * 64;
        unsigned char* FSb = P.ws + WS_FS + ((size_t)((vcu & 255) * 8 + wave)) * 16384;
        bf16x8 qf[2][4];
        f32x4 O[2][8];
        float l[2] = {0.f, 0.f};
        int limq[2];
        {
            AT_REGION();
#pragma unroll
            for (int ts = 0; ts < 2; ++ts) {
#pragma unroll
                for (int s = 0; s < 4; ++s) qf[ts][s] = *(const bf16x8*)(QP + (size_t)tok_(ts) * DM + (4 * g + hh) * HD + 32 * s + 8 * q);
            }
            for (int i = ln_; i < 8 * IMP_STRIDE; i += 64) impw[i] = 0.f;
            for (int i = ln_; i < 256; i += 64) selw[i] = 0u;
#pragma unroll
            for (int ts = 0; ts < 2; ++ts)
#pragma unroll
                for (int dt = 0; dt < 8; ++dt) O[ts][dt] = (f32x4){0.f, 0.f, 0.f, 0.f};
            float m[2] = {-1e30f, -1e30f}, invl[2] = {0.f, 0.f};
            LAS float* improw[2]; improw[0] = impw + tq * IMP_STRIDE; improw[1] = impw + (4 + tq) * IMP_STRIDE;
            VM_WAIT(); LDS_WAIT();
            const int nbc = (DBG_BR & 1) ? ((4 * tile + 2) >> 6) + 1 : 0;
            const unsigned char* kci = P.ws + WS_KCI + (size_t)g * 16 * 16384; const unsigned char* vci = P.ws + WS_VCI + (size_t)g * 16 * 16384;
            if (DBG_BR & 1) AT_STAGE(kci, AT_KV);
            for (int b = 0; b < nbc; ++b) {
                const int buf = (b & 1) * 32768;
                if (b + 1 < nbc) { AT_STAGE(kci + (size_t)(b + 1) * 16384, AT_KV + (buf ^ 32768)); AT_WAITV(2); }
                else AT_WAITV(0);
                AT_BAR();
#pragma unroll
                for (int ts = 0; ts < 2; ++ts) limq[ts] = ((tok_(ts) - 31) >> 4) - 64 * b - 8 * q;
                block_step<true, true, 0>(lds + AT_KV + buf, lds + AT_KV + buf + 16384, L, qf, O, m, l, limq, 0x80000000u, invl, improw, 0, hzero, b + 2 >= nbc);
                AT_BAR();
            }
#pragma unroll
            for (int ts = 0; ts < 2; ++ts) { float lt = l[ts]; lt += __shfl_xor(lt, 16); lt += __shfl_xor(lt, 32); invl[ts] = lt > 0.f ? 1.0f / lt : 0.f; }
            if (DBG_BR & 1) { AT_STAGE(kci, AT_KV); AT_STAGE(vci, AT_KV + 16384); }
            for (int b = 0; b < nbc; ++b) {
                const int buf = (b & 1) * 32768;
                if (b + 1 < nbc) { AT_STAGE(kci + (size_t)(b + 1) * 16384, AT_KV + (buf ^ 32768)); AT_STAGE(vci + (size_t)(b + 1) * 16384, AT_KV + (buf ^ 32768) + 16384); AT_WAITV(4); }
                else AT_WAITV(0);
                AT_BAR();
#pragma unroll
                for (int ts = 0; ts < 2; ++ts) limq[ts] = ((tok_(ts) - 31) >> 4) - 64 * b - 8 * q;
                block_step<true, true, 1>(lds + AT_KV + buf, lds + AT_KV + buf + 16384, L, qf, O, m, l, limq, 0x80000000u, invl, improw, 16 * b + 2 * q, hzero, b + 2 >= nbc);
                AT_BAR();
            }
            FS_OFF();
#pragma unroll
            for (int ts = 0; ts < 2; ++ts)
#pragma unroll
                for (int dt = 0; dt < 8; ++dt) FSAT(ts * 8 + dt) = O[ts][dt] * GATE(ts, 0);
        }
        LDS_WAIT();
        {
            const int Ksel = (!(DBG_BR & 2) || DBG_DENSE_SEL >= 2) ? 0 : (tile - 1) < 14 ? (tile - 1) : 14;
            int lane_k = lane; asm volatile("" : "+v"(lane_k));
            unsigned wsel[4] = {0u, 0u, 0u, 0u};
            bool cand[4];
#pragma unroll
            for (int e4 = 0; e4 < 4; ++e4) { const int jj = lane_k + 64 * e4; cand[e4] = (jj >= 1 && jj <= tile - 1); }
            if (Ksel > 0) {
                const bool all_sel = (tile - 1) <= 14;
                for (int tl = 0; tl < 8; ++tl) {
                    const LAS float* row = impw + tl * IMP_STRIDE;
                    unsigned val[4];
#pragma unroll
                    for (int e4 = 0; e4 < 4; ++e4) val[e4] = cand[e4] ? __float_as_uint(row[lane_k + 64 * e4]) : 0u;
                    bool sel[4];
                    if (all_sel) {
#pragma unroll
                        for (int e4 = 0; e4 < 4; ++e4) sel[e4] = cand[e4];
                    } else {
                        unsigned vmx = max(max(val[0], val[1]), max(val[2], val[3]));
                        unsigned vmn = min(min(cand[0] ? val[0] : 0xffffffffu, cand[1] ? val[1] : 0xffffffffu), min(cand[2] ? val[2] : 0xffffffffu, cand[3] ? val[3] : 0xffffffffu));
                        vmx = wave_umax(vmx); vmn = wave_umin(vmn);
                        const unsigned dif = (unsigned)__builtin_amdgcn_readfirstlane((int)(vmx ^ vmn));
                        const int hb = 31 - __builtin_clz(dif | 1u);
                        unsigned cur = (unsigned)__builtin_amdgcn_readfirstlane((int)vmx) & ~((2u << hb) - 1u);
                        for (int bit = (dif == 0u ? -1 : (hb > 30 ? 30 : hb)); bit >= 0; --bit) {
                            asm volatile("" : "+s"(cur), "+s"(bit));
                            const unsigned t = cur | (1u << bit); int cnt = 0;
#pragma unroll
                            for (int e4 = 0; e4 < 4; ++e4) cnt += __popcll(__builtin_amdgcn_uicmp(val[e4], t, 35  ));
                            if (cnt >= Ksel) cur = t;
                            if (cnt == Ksel) break;
                        }
                        int cgt = 0;
#pragma unroll
                        for (int e4 = 0; e4 < 4; ++e4) cgt += __popcll(__ballot(cand[e4] && val[e4] > cur));
                        const int need = Ksel - cgt; int prev = 0;
#pragma unroll
                        for (int e4 = 0; e4 < 4; ++e4) { const bool eq = cand[e4] && val[e4] == cur; const unsigned long long be = __ballot(eq);
                            const int rank = prev + (int)__builtin_amdgcn_mbcnt_hi((unsigned)(be >> 32), __builtin_amdgcn_mbcnt_lo((unsigned)be, 0u));
                            sel[e4] = (cand[e4] && val[e4] > cur) || (eq && rank < need); prev += __popcll(be); }
                    }
#pragma unroll
                    for (int e4 = 0; e4 < 4; ++e4) wsel[e4] |= sel[e4] ? (1u << tl) : 0u;
                }
            }
#pragma unroll
            for (int e4 = 0; e4 < 4; ++e4) { const int jj = lane_k + 64 * e4; if (jj == 0 || jj == tile) wsel[e4] = 0xffu; selw[jj] = wsel[e4]; }
            LDS_WAIT();
#if DBG_DENSE_SEL == 1
            for (int i = lane_k; i <= tile; i += 64) selw[i] = 0xffu;
            LDS_WAIT();
#elif DBG_DENSE_SEL == 4
            for (int i = lane_k; i <= tile; i += 64) selw[i] = (i == 0 || i >= tile - 14) ? 0xffu : 0u;
            LDS_WAIT();
#endif
        }
        float mref[2] = {0.f, 0.f};
#define AT_RING_LOOP(NB, KSRC, VSRC, PRE, ...) do { \
            const int nb_ = (NB); \
            _Pragma("unroll") for (int pb_ = 0; pb_ < 3; ++pb_) { if ((PRE) && pb_ == 2) AT_BAR(); \
                if (pb_ < nb_) { AT_STAGE((KSRC) + (size_t)pb_ * 16384, pb_ * 32768); AT_STAGE((VSRC) + (size_t)pb_ * 16384, pb_ * 32768 + 16384); } } \
            int bufo = 0, bufn = 98304; \
            for (int b = 0; b < nb_; ++b) { \
                const int ahead_ = nb_ - 1 - b; \
                if (ahead_ >= 2) AT_WAITV(8); else if (ahead_ == 1) AT_WAITV(4); else AT_WAITV(0); \
                AT_BAR(); \
                if (b + 3 < nb_) { AT_STAGE((KSRC) + (size_t)(b + 3) * 16384, bufn); AT_STAGE((VSRC) + (size_t)(b + 3) * 16384, bufn + 16384); } \
                LAS const unsigned char* Kb_ = lds + bufo; LAS const unsigned char* Vb_ = lds + bufo + 16384; \
                __VA_ARGS__ \
                bufo = (bufo == 98304) ? 0 : bufo + 32768; bufn = (bufn == 98304) ? 0 : bufn + 32768; \
            } \
            AT_BAR(); } while (0)
#define AT_DRIFT_LOOP(NB, KSRC, VSRC, ...) do { \
            const int nb_ = (NB); \
            volatile LAS unsigned* ldc_ = (volatile LAS unsigned*)(lds + MISC_OFF) + 32; \
            if (wave == 0 && ln_ < 4) ldc_[ln_] = 0u; \
            _Pragma("unroll") for (int pb_ = 0; pb_ < 2; ++pb_) if (pb_ < nb_) { AT_STAGE((KSRC) + (size_t)pb_ * 16384, pb_ * 32768); AT_STAGE((VSRC) + (size_t)pb_ * 16384, pb_ * 32768 + 16384); } \
            AT_BAR();                                                     \
            if (nb_ >= 2) AT_WAITV(4); else AT_WAITV(0); \
            if (ln_ == 0) (void)__hip_atomic_fetch_add((LAS unsigned*)ldc_, 1u, __ATOMIC_RELAXED, __HIP_MEMORY_SCOPE_WORKGROUP); \
            unsigned swn_ = (unsigned)__builtin_amdgcn_readfirstlane((int)selw[0]); \
            _Pragma("clang loop unroll(disable)") for (int b = 0; b < nb_; ++b) { \
                volatile LAS unsigned* lp_ = ldc_ + (b & 3); \
                const unsigned pr0_ = *lp_;                                                             \
                const unsigned swv_ = *(volatile LAS unsigned*)(selw + (b + 1 < 256 ? b + 1 : 255)); \
                if (b + 1 < nb_) { AT_WAITV(0); if (ln_ == 0) (void)__hip_atomic_fetch_add((LAS unsigned*)ldc_ + ((b + 1) & 3), 1u, __ATOMIC_RELAXED, __HIP_MEMORY_SCOPE_WORKGROUP); } \
                { const unsigned need_ = 8u * (unsigned)((b >> 2) + 1); unsigned pr_ = (unsigned)__builtin_amdgcn_readfirstlane((int)pr0_); \
                  while (pr_ < need_) { __builtin_amdgcn_s_sleep(1); pr_ = (unsigned)__builtin_amdgcn_readfirstlane((int)*lp_); } } \
                const unsigned sw = swn_; swn_ = (unsigned)__builtin_amdgcn_readfirstlane((int)swv_); \
                asm volatile("" ::: "memory"); \
                if (b + 2 < nb_) { const int sl_ = ((b + 2) & 3) * 32768; AT_STAGE((KSRC) + (size_t)(b + 2) * 16384, sl_); AT_STAGE((VSRC) + (size_t)(b + 2) * 16384, sl_ + 16384); } \
                LAS const unsigned char* Kb_ = lds + (b & 3) * 32768; LAS const unsigned char* Vb_ = Kb_ + 16384; \
                __VA_ARGS__ \
            } \
            AT_BAR(); } while (0)
        {
            AT_REGION();
            for (int rp_ = 0; rp_ < DBG_REP_SEL; ++rp_) {
#pragma unroll
            for (int ts = 0; ts < 2; ++ts) { l[ts] = 0.f; mref[ts] = 0.f;
#pragma unroll
                for (int dt = 0; dt < 8; ++dt) O[ts][dt] = (f32x4){0.f, 0.f, 0.f, 0.f}; }
            if (DBG_BR & 2) {
                const unsigned char* ksi = P.ws + WS_KSI + (size_t)g * 256 * 16384; const unsigned char* vsi = P.ws + WS_VSI + (size_t)g * 256 * 16384;
                VM_WAIT();
                AT_DRIFT_LOOP(tile + 1, ksi, vsi, {
                    _Pragma("unroll") for (int ts = 0; ts < 2; ++ts) limq[ts] = ((sw >> (4 * ts + tq)) & 1u) ? (tok_(ts) - 64 * b - 8 * q) : -1000;
                    const bool a0 = (sw & 0x0fu) != 0u, a1 = (sw & 0xf0u) != 0u;
                    const bool msk = (b == 0) || (b == tile);
                    if (a0) step_online<true, false>(Kb_, Vb_, L, qf, O, mref, l, limq, 0x80000000u, msk, b == 0);
                    if (a1) step_online<false, true>(Kb_, Vb_, L, qf, O, mref, l, limq, 0x80000000u, msk, b == 0);
                });
            }
            }
            FS_OFF();
#pragma unroll
            for (int ts = 0; ts < 2; ++ts) { float lt = l[ts]; lt += __shfl_xor(lt, 16); lt += __shfl_xor(lt, 32); const float sc = (DBG_BR & 2) ? GATE(ts, 1) / lt : 0.f;
#pragma unroll
                for (int dt = 0; dt < 8; ++dt) { FSAT(ts * 8 + dt) += O[ts][dt] * sc; if ((dt & 3) == 3) asm volatile("" ::: "memory"); } }
            VM_WAIT();
        }
        {
            AT_REGION();
#pragma unroll
            for (int ts = 0; ts < 2; ++ts) { l[ts] = 0.f;
#pragma unroll
                for (int dt = 0; dt < 8; ++dt) O[ts][dt] = (f32x4){0.f, 0.f, 0.f, 0.f}; }
            if (DBG_BR & 4) {
                const int b0 = tile >= 8 ? tile - 8 : 0;
                const unsigned char* kwi = P.ws + WS_KWI + ((size_t)g * 256 + b0) * 16384; const unsigned char* vwi = P.ws + WS_VWI + ((size_t)g * 256 + b0) * 16384;
                AT_RING_LOOP(tile - b0 + 1, kwi, vwi, false, {
                    _Pragma("unroll") for (int ts = 0; ts < 2; ++ts) limq[ts] = tok_(ts) - 64 * (b0 + b) - 8 * q;
                    step_online<true, true>(Kb_, Vb_, L, qf, O, mref, l, limq, 512u, (b == 0) || (b0 + b == tile), b == 0);
                });
            }
            FS_OFF();
#pragma unroll
            for (int ts = 0; ts < 2; ++ts) { float lt = l[ts]; lt += __shfl_xor(lt, 16); lt += __shfl_xor(lt, 32); const float sc = (DBG_BR & 4) ? GATE(ts, 2) / lt : 0.f;
                bf16* orow = AO + (size_t)tok_(ts) * DM + (4 * g + hh) * HD + 4 * q;
#pragma unroll
                for (int dt = 0; dt < 8; ++dt) { const f32x4 o = FSAT(ts * 8 + dt) + O[ts][dt] * sc;
                    u32x2 w; w.x = pk2(o[0], o[1]); w.y = pk2(o[2], o[3]); *(u32x2*)(orow + 16 * dt) = w; if ((dt & 3) == 3) asm volatile("" ::: "memory"); } }
        }
    }
#undef AT_REGION
#undef AT_RING_LOOP
#undef AT_DRIFT_LOOP
}

#ifndef DBG_CHECK
#define DBG_CHECK 0
#endif
#if DBG_CHECK
__device__ __forceinline__ float p_bf(const bf16* Pm, int t, int col) { return __uint_as_float((unsigned)Pm[(size_t)t * PW + col] << 16); }
__device__ __forceinline__ float roped(const bf16* Pm, const float* cosT, const float* sinT, int t, int colbase, int d) {
    const float x = p_bf(Pm, t, colbase + d);
    if (d >= 32) return x;
    const int i = d & 15; const float c = cosT[(size_t)t * 16 + i], sn = sinT[(size_t)t * 16 + i];
    return (d < 16) ? x * c - p_bf(Pm, t, colbase + d + 16) * sn : x * c + p_bf(Pm, t, colbase + d - 16) * sn;
}
__constant__ int TSAMP[28] = {0, 1, 5, 30, 31, 32, 47, 63, 64, 65, 100, 127, 128, 191, 200, 255, 300, 511, 512, 575, 1023, 1024, 1025, 2047, 4096, 8191, 12345, 16383};
__device__ __forceinline__ void attn_check(const Ptrs& P, int l, LAS unsigned char* lds, int vcu, int G, int tid, unsigned* flagword) {
    const int NS = 28;
    const bf16* Pm = (const bf16*)(P.ws + WS_P); const bf16* AO = (const bf16*)(P.ws + WS_AO);
    const float* cosT = (const float*)(P.ws + WS_COS); const float* sinT = (const float*)(P.ws + WS_SIN);
    LAS float* q = (LAS float*)lds;
    LAS float* blk = q + 512;
    LAS float* hh_ = blk + 4096;
    LAS float* kc = hh_ + 256;
    LAS float* vc = kc + 2048;
    LAS float* sc = vc + 2048;
    LAS float* fin = sc + 4096;
    LAS float* imp = fin + 512;
    LAS int* selb = (LAS int*)(imp + 256);
    LAS unsigned* red = (LAS unsigned*)(selb + 16);
    for (int item = vcu; item < NS * 4; item += G) {
        const int s = item >> 2, g = item & 3, t = TSAMP[s];
        const int cur = t >> 6;
        { const int r = tid >> 7, d = tid & 127; q[tid] = __uint_as_float((unsigned)((const bf16*)(P.ws + WS_QP))[(size_t)t * DM + (4 * g + r) * HD + d] << 16) * 0.6931471805599453f; fin[tid] = 0.f; }
        if (tid < 2) red[tid] = 0u;
        if (tid < 256) imp[tid] = 0.f;
        __syncthreads();
        const int nmax = (t - 31) >> 4;
        const bool small = t < 256;
        const unsigned char* kci = P.ws + WS_KCI + (size_t)g * 16 * 16384; const unsigned char* vci = P.ws + WS_VCI + (size_t)g * 16 * 16384;
        if (small) {
        for (int kv = 0; kv < 2; ++kv)
            for (int n = 0; n <= nmax; ++n) {
                for (int e = tid; e < 4096; e += 512) { const int l_ = e >> 7, d = e & 127, tok = 16 * n + l_;
                    const float x = (kv == 0) ? roped(Pm, cosT, sinT, tok, C_KV + 0 * 512 + g * HD, d) : p_bf(Pm, tok, C_KV + 1 * 512 + g * HD + d);
                    blk[e] = x + P.cmp_pe[((size_t)(l * 2 + kv) * 32 + l_) * 128 + d]; }
                __syncthreads();
                if (tid < 256) { const float* w1 = P.cmp_w1 + (size_t)(l * 2 + kv) * 4096 * 256 + tid; float a = P.cmp_b1[(size_t)(l * 2 + kv) * 256 + tid];
                    for (int e = 0; e < 4096; ++e) a += blk[e] * w1[(size_t)e * 256];
                    hh_[tid] = 0.5f * a * (1.0f + tanhf(0.7978845608028654f * (a + 0.044715f * a * a * a))); }
                __syncthreads();
                if (tid < 128) { const float* w2 = P.cmp_w2 + (size_t)(l * 2 + kv) * 256 * 128 + tid; float a = P.cmp_b2[(size_t)(l * 2 + kv) * 128 + tid];
                    for (int c = 0; c < 256; ++c) a += hh_[c] * w2[(size_t)c * 128];
                    (kv == 0 ? kc : vc)[n * 128 + tid] = a; }
                __syncthreads();
            }
        }
#define KC_AT(n, d) (small ? kc[(n) * 128 + (d)] : __uint_as_float((unsigned)*(const bf16*)(kci + (size_t)((n) >> 6) * 16384 + kimg_off((n) & 63, (d) >> 3) + ((d) & 7) * 2) << 16))
#define VC_AT(n, d) (small ? vc[(n) * 128 + (d)] : __uint_as_float((unsigned)*(const bf16*)(vci + (size_t)((n) >> 6) * 16384 + vimg_off((d), ((n) & 63) >> 3) + ((n) & 7) * 2) << 16))
        if (nmax >= 0) {
            for (int e = tid; e < 4 * 1024; e += 512) { const int r = e >> 10, n = e & 1023; float a = -1e30f;
                if (n <= nmax) { a = 0.f; for (int d = 0; d < 128; ++d) a += q[r * 128 + d] * KC_AT(n, d); } sc[e] = a; }
            __syncthreads();
            float mx = -1e30f, den = 0.f;
            { const int r = tid >> 7, d = tid & 127; for (int n = 0; n <= nmax; ++n) mx = fmaxf(mx, sc[r * 1024 + n]);
              float num = 0.f; for (int n = 0; n <= nmax; ++n) { const float p = expf(sc[r * 1024 + n] - mx); den += p; num += p * VC_AT(n, d); }
              if (DBG_BR & 1) fin[tid] += sigm(p_bf(Pm, t, C_GN + (4 * g + r) * 3 + 0)) * num / den; }
            __syncthreads();
            { const int r = tid >> 7; for (int n = (tid & 127); n <= nmax; n += 128) sc[r * 1024 + n] = expf(sc[r * 1024 + n] - mx) / den; }
            __syncthreads();
            if (tid <= cur) { const int j = tid; float a = 0.f;
                for (int r = 0; r < 4; ++r) for (int u = -1; u <= 3; ++u) { const int n = 4 * j + u; if (n >= 0 && n <= nmax) a += sc[r * 1024 + n] * ((u == -1 || u == 3) ? 0.5f : 1.0f); }
                imp[j] = a; }
            __syncthreads();
        }
        if (tid == 0) { int ns = 0; selb[ns++] = 0; if (cur > 0) selb[ns++] = cur;
            for (int rnd = 0; rnd < 14; ++rnd) { int bj = -1; float bv = -1.f;
                for (int j = 1; j < cur; ++j) { bool taken = false; for (int k = 0; k < ns; ++k) taken |= (selb[k] == j); if (!taken && imp[j] > bv) { bv = imp[j]; bj = j; } }
                if (bj < 0) break; selb[ns++] = bj; }
            for (; ns < 16; ++ns) selb[ns] = -1; }
        __syncthreads();
        if (DBG_BR & 2) {
            const int kcol = C_KV + 2 * 512 + g * HD, vcol = C_KV + 3 * 512 + g * HD;
            for (int e = tid; e < 4 * 1024; e += 512) { const int r = e >> 10, k = e & 1023, bsel = selb[k >> 6], kp = bsel * 64 + (k & 63); float a = -1e30f;
                if (bsel >= 0 && kp <= t) { a = 0.f; for (int d = 0; d < 128; ++d) a += q[r * 128 + d] * roped(Pm, cosT, sinT, kp, kcol, d); }
                sc[e] = a; }
            __syncthreads();
            { const int r = tid >> 7, d = tid & 127; float mx = -1e30f; for (int k = 0; k < 1024; ++k) mx = fmaxf(mx, sc[r * 1024 + k]);
              float den = 0.f, num = 0.f; for (int k = 0; k < 1024; ++k) { const float sv = sc[r * 1024 + k]; if (sv > -1e29f) { const float p = expf(sv - mx); den += p; num += p * p_bf(Pm, selb[k >> 6] * 64 + (k & 63), vcol + d); } }
              fin[tid] += sigm(p_bf(Pm, t, C_GN + (4 * g + r) * 3 + 1)) * num / den; }
            __syncthreads();
        }
        if (DBG_BR & 4) {
            const int kcol = C_KV + 4 * 512 + g * HD, vcol = C_KV + 5 * 512 + g * HD;
            for (int e = tid; e < 4 * 512; e += 512) { const int r = e >> 9, kp = t - (e & 511); float a = -1e30f;
                if (kp >= 0) { a = 0.f; for (int d = 0; d < 128; ++d) a += q[r * 128 + d] * roped(Pm, cosT, sinT, kp, kcol, d); }
                sc[r * 1024 + (e & 511)] = a; }
            __syncthreads();
            { const int r = tid >> 7, d = tid & 127; float mx = -1e30f; for (int k = 0; k < 512; ++k) mx = fmaxf(mx, sc[r * 1024 + k]);
              float den = 0.f, num = 0.f; for (int k = 0; k < 512; ++k) { const float sv = sc[r * 1024 + k]; if (sv > -1e29f) { const float p = expf(sv - mx); den += p; num += p * p_bf(Pm, t - k, vcol + d); } }
              fin[tid] += sigm(p_bf(Pm, t, C_GN + (4 * g + r) * 3 + 2)) * num / den; }
            __syncthreads();
        }
        { const int r = tid >> 7, d = tid & 127; const float ao = __uint_as_float((unsigned)AO[(size_t)t * DM + (4 * g + r) * HD + d] << 16);
          const float err = fabsf(fin[tid] - ao), mag = fabsf(fin[tid]);
          atomicMax((unsigned*)&red[0], __float_as_uint(err)); atomicMax((unsigned*)&red[1], __float_as_uint(mag)); }
        __syncthreads();
        if (tid == 0) { const float err = __uint_as_float(red[0]), mag = __uint_as_float(red[1]); if (!(err <= 0.03f * mag + 2e-3f)) atomicOr(flagword, 1u << s); }
        __syncthreads();
    }
#undef KC_AT
#undef VC_AT
}
#endif


#if DBG_CHECK
__constant__ int RSAMP[8] = {0, 1, 63, 64, 255, 256, 4097, 16383};
__device__ __forceinline__ int csamp(int ci, int N) { return ci == 63 ? N - 1 : (int)(((unsigned)ci * (unsigned)(N / 64) + ((unsigned)ci * 7u) % 61u) % (unsigned)N); }
__device__ __forceinline__ float bfv(const bf16* p, size_t i) { return __uint_as_float((unsigned)p[i] << 16); }
__device__ __forceinline__ float mod_naive(const Ptrs& P, int l, int k, int c) {
    float a = P.ada_b[(size_t)l * 6 * DM + k * DM + c];
    for (int j = 0; j < DM; ++j) { const float cv = P.c[j]; a += cv / (1.0f + expf(-cv)) * P.ada_w[((size_t)l * DM + j) * 6 * DM + k * DM + c]; }
    return a;
}
__device__ __forceinline__ void flag_if(bool bad, unsigned* flagword, int bit) { if (bad) { atomicOr(flagword, 1u << bit); if (bit == 4) { atomicMax(flagword + 1, 0xffffffffu - (unsigned)threadIdx.x); atomicAdd(flagword + 2, 1u); } } }
__device__ __forceinline__ bool mism(float got, float exp_) { return !(fabsf(got - exp_) <= 0.02f * fabsf(exp_) + 0.02f); }
__device__ __forceinline__ void main_check(const Ptrs& P, int which, int tid, unsigned* flagword) {
    const int l = 0, row = RSAMP[tid >> 6], ci = tid & 63;
    const bf16* Pm = (const bf16*)(P.ws + WS_P); const bf16* H = (const bf16*)(P.ws + WS_H); const float* Y = (const float*)(P.ws + WS_Y);
    if (which == 1 || which == 7) {
        const int c = csamp(ci, DM);
        const float* xr = (which == 1 ? P.x : P.out) + (size_t)row * DM;
        if (which == 7) {
            float ss = 0.f; for (int j = 0; j < DM; ++j) { const float y = Y[(size_t)row * DM + j]; ss += y * y; }
            const float e = P.x[(size_t)row * DM + c] + mod_naive(P, l, 2, c) * P.gains[(size_t)(l * 4 + 1) * DM + c] * Y[(size_t)row * DM + c] / sqrtf(ss / DM + NORM_EPS);
            flag_if(mism(xr[c], e), flagword, 16 + which);
        }
        float ss = 0.f; for (int j = 0; j < DM; ++j) ss += xr[j] * xr[j];
        const int gi = which == 1 ? 0 : 2, sck = which == 1 ? 1 : 4, shk = which == 1 ? 0 : 3;
        const float e = xr[c] / sqrtf(ss / DM + NORM_EPS) * P.gains[(size_t)(l * 4 + gi) * DM + c] * (1.0f + mod_naive(P, l, sck, c)) + mod_naive(P, l, shk, c);
        flag_if(mism(bfv(H, (size_t)row * DM + c), e), flagword, which);
    } else if (which == 2) {
        const int pc = (ci < 60) ? csamp(ci, 12288) : 12288 + (ci - 60) * 15;
        const int src = pc < 8192 ? pc : pc < 10240 ? 8240 + (pc - 8192) : pc < 12288 ? 10288 + (pc - 10240) : 8192 + (pc - 12288);
        float a = 0.f; for (int k = 0; k < DM; ++k) a += bfv(H, (size_t)row * DM + k) * P.w_in[((size_t)l * DM + k) * INW + src];
        flag_if(mism(bfv(Pm, (size_t)row * PW + pc), a), flagword, which);
    } else if (which == 3) {
        const int c = csamp(ci, CWID); float z = 0.f;
        for (int k = 0; k < 3; ++k) { const int tt = row - 2 + k; if (tt >= 0) z += P.conv_w[(size_t)l * 3 * CWID + k * CWID + c] * bfv(Pm, (size_t)tt * PW + C_CG + c) * bfv(Pm, (size_t)tt * PW + C_XA + c); }
        flag_if(mism(bfv((const bf16*)(P.ws + WS_CV), (size_t)row * CWID + c), z * bfv(Pm, (size_t)row * PW + C_BG + c)), flagword, which);
    } else if (which == 4) {
        const int c = csamp(ci, DM); const bf16* CV = (const bf16*)(P.ws + WS_CV);
        float a = 0.f; for (int k = 0; k < CWID; ++k) a += bfv(CV, (size_t)row * CWID + k) * P.w_conv_out[((size_t)l * CWID + k) * DM + c];
        flag_if(mism(bfv((const bf16*)(P.ws + WS_YA), (size_t)row * DM + c), a * sigm(bfv(Pm, (size_t)row * PW + C_GA + c))), flagword, which);
    } else if (which == 5 && row < 10000) {
        const int c = csamp(ci, DM); const bf16* AO = (const bf16*)(P.ws + WS_AO);
        float a = 0.f; for (int k = 0; k < DM; ++k) a += bfv(AO, (size_t)row * DM + k) * P.w_nsa[((size_t)l * DM + k) * DM + c];
        flag_if(mism(bfv((const bf16*)(P.ws + WS_MG), (size_t)row * DM + c), bfv((const bf16*)(P.ws + WS_YA), (size_t)row * DM + c) + a * sigm(bfv(Pm, (size_t)row * PW + C_GB + c))), flagword, which);
    } else if (which == 6) {
        const int c = csamp(ci, DM); const bf16* MG = (const bf16*)(P.ws + WS_MG);
        float a = 0.f; for (int k = 0; k < DM; ++k) a += bfv(MG, (size_t)row * DM + k) * P.w_out[((size_t)l * DM + k) * DM + c];
        flag_if(mism(Y[(size_t)row * DM + c], a), flagword, which);
    } else if (which == 8) {
        const int f = csamp(ci, FF);
        float a = 0.f; for (int k = 0; k < DM; ++k) a += bfv(H, (size_t)row * DM + k) * P.w_up[((size_t)l * DM + k) * FF + f];
        a = fmaxf(a, 0.f); flag_if(mism(bfv((const bf16*)(P.ws + WS_U), (size_t)row * FF + f), a * a), flagword, which);
    } else if (which == 9) {
        const int c = csamp(ci, DM); const bf16* U = (const bf16*)(P.ws + WS_U);
        float a = 0.f; for (int k = 0; k < FF; ++k) a += bfv(U, (size_t)row * FF + k) * P.w_down[((size_t)l * FF + k) * DM + c];
        flag_if(mism(Y[(size_t)row * DM + c], a), flagword, which);
    }
}
#define MAIN_CHECK(w) do { if (l == 0 && bx == 0) main_check(P, (w), OPQ_TID(), ctl + 64); } while (0)
#else
#define MAIN_CHECK(w) do { } while (0)
#endif
constexpr int NPH = 11;
constexpr int N_PHASES = 2 + DEPTH * NPH;
#ifndef DBG_CHECK_LAYER
#define DBG_CHECK_LAYER 0
#endif
#ifndef DBG_SKIP_ATTN
#define DBG_SKIP_ATTN 0
#endif
#ifndef DUP_MASK
#define DUP_MASK 0
#endif
#define DUPN(t) (1 + ((DUP_MASK >> (t)) & 1))
#ifndef MK_PER_PHASE
#define MK_PER_PHASE 0
#endif

__global__ void __launch_bounds__(NWAVES * 64, 2) nsa_fwd(Args args) {
    extern __shared__ __attribute__((aligned(16))) unsigned char lds_raw[];
    LAS unsigned char* lds = (LAS unsigned char*)lds_raw;
    const int tid = threadIdx.x, lane = tid & 63, wave = __builtin_amdgcn_readfirstlane(tid >> 6);
    const int G = gridDim.x; const int bx = blockIdx.x; const int vcu = (G % 8 == 0) ? (bx % 8) * (G / 8) + bx / 8 : bx;
    volatile LAS unsigned* MISC = (volatile LAS unsigned*)(lds + MISC_OFF);
    for (int u = tid; u < 128; u += NWAVES * 64) MISC[u] = 0u;
    __syncthreads();
    unsigned* ctl = (unsigned*)(args.ws + WS_CTL);
    XcdBarrier bar = xcd_barrier_post(ctl + CW_BAR, MISC + 8);
    const int lo = args.ph_lo, hi = args.ph_hi; (void)lo; (void)hi;
#ifndef ONLY_PHASE
#define ONLY_PHASE -1
#endif
#define PH_EN(t) (ONLY_PHASE < 0 || ONLY_PHASE == (t))
#if MK_PER_PHASE
#define IN(k) (lo <= (k) && (k) < hi)
#else
#define IN(k) true
#endif
#define LOADP() const Args GAS_K* ap_ = (const Args GAS_K*)__builtin_amdgcn_kernarg_segment_ptr(); asm volatile("" : "+s"(ap_)); Ptrs P; \
    P.x = (const float*)ap_->in[0]; P.c = (const float*)ap_->in[1]; P.pos = (const int*)ap_->in[2]; P.ada_w = (const float*)ap_->in[3]; P.ada_b = (const float*)ap_->in[4]; \
    P.gains = (const float*)ap_->in[5]; P.w_in = (const float*)ap_->in[6]; P.conv_w = (const float*)ap_->in[7]; P.w_conv_out = (const float*)ap_->in[8]; P.cmp_pe = (const float*)ap_->in[9]; \
    P.cmp_w1 = (const float*)ap_->in[10]; P.cmp_b1 = (const float*)ap_->in[11]; P.cmp_w2 = (const float*)ap_->in[12]; P.cmp_b2 = (const float*)ap_->in[13]; P.w_nsa = (const float*)ap_->in[14]; \
    P.w_out = (const float*)ap_->in[15]; P.w_up = (const float*)ap_->in[16]; P.w_down = (const float*)ap_->in[17]; P.out = ap_->out; P.ws = ap_->ws; \
    bf16* H = (bf16*)(P.ws + WS_H); bf16* Y = (bf16*)(P.ws + WS_Y); unsigned char* wl = P.ws + WS_WL + (size_t)l_ * WL_BYTES; const bf16* Pm = (const bf16*)(P.ws + WS_P); (void)H; (void)Y; (void)wl; (void)Pm
#define OPQ_S(x) ({ int _v = (x); asm volatile("" : "+s"(_v)); _v; })
#define OPQ_TID() ({ int _l; asm volatile("v_mbcnt_lo_u32_b32 %0, -1, 0\n\tv_mbcnt_hi_u32_b32 %0, -1, %0" : "=v"(_l)); int _t = (OPQ_S(wave) << 6) | _l; _t; })
#if MK_PER_PHASE
#define SEAM(k) do { } while (0)
#else
#define SEAM(k) do { if (IN((k) + 1) && rep_ + 1 == nrep_) xcd_barrier(bar); } while (0)
#endif

    { const int l_ = 0; (void)l_;
    if (PH_EN(0) && IN(0)) for (int rep_ = 0, nrep_ = (DUPN(0)); rep_ < nrep_; ++rep_) { LOADP(); { const int t_ = OPQ_TID(); p0_prologue(P, lds, OPQ_S(vcu), OPQ_S(G), OPQ_S(wave), t_ & 63, t_); } SEAM(0); }
    if (PH_EN(1) && IN(1)) for (int rep_ = 0, nrep_ = (1); rep_ < nrep_; ++rep_) { LOADP(); resid_phase<false>(P, lds, P.x, false, nullptr, false, nullptr, H, true, 0, 0, 0,  0,  1,  0,  0, OPQ_S(vcu), OPQ_S(G), OPQ_S(wave), OPQ_TID() & 63, OPQ_TID()); SEAM(1); }

    }
    for (int l = 0; l < DEPTH; ++l) {
        const int pb = 2 + l * NPH; const int l_ = l;
        if (PH_EN(2) && IN(pb + 0)) for (int rep_ = 0, nrep_ = (DUPN(2)); rep_ < nrep_; ++rep_) { LOADP();
            MAIN_CHECK(1);
            pg8::Gemm g{H, (const bf16*)(wl + WL_WIN), S, C_GN, DM, DM}; pg8::StaticOrder So; So.init(S, C_GN, OPQ_S(G), OPQ_S(bx));
            pg8::EpiB<0> E{(bf16*)(P.ws + WS_P), PW, nullptr, nullptr, 0, nullptr, 0};
            pg8::gemm_phase<pg8::EpiB<0>, pg8::StaticOrder, true, true>(lds, g, So, E, OPQ_TID());
            SEAM(pb + 0);
        }
        if (PH_EN(3) && IN(pb + 1)) for (int rep_ = 0, nrep_ = (DUPN(3)); rep_ < nrep_; ++rep_) { LOADP(); MAIN_CHECK(2); relayout_phase(P, l, lds, OPQ_S(vcu), OPQ_S(G), OPQ_TID()); SEAM(pb + 1); }
        if (PH_EN(4) && IN(pb + 2)) for (int rep_ = 0, nrep_ = (DUPN(4)); rep_ < nrep_; ++rep_) { LOADP();
            MAIN_CHECK(3);
            {   pg8::Gemm g{(const bf16*)(P.ws + WS_KCR), (const bf16*)(wl + WL_W1T), 8192, 512, 4096, 2048}; pg8::CmpOrder So{OPQ_S(bx)};
                pg8::EpiB<2, true> E{(bf16*)(P.ws + WS_HC), 256, (const float*)(P.ws + WS_B1P), nullptr, 0, nullptr, 0};
                pg8::gemm_phase<pg8::EpiB<2, true>, pg8::CmpOrder, false, true>(lds, g, So, E, OPQ_TID()); }
            {   pg8::Gemm g{(const bf16*)(P.ws + WS_CV), (const bf16*)(wl + WL_WCONV), S, DM, CWID, CWID}; pg8::StaticOrder So;
                So.init(S, DM, OPQ_S(G), OPQ_S(bx));
                pg8::EpiB<3> E{(bf16*)(P.ws + WS_YA), DM, nullptr, Pm + C_GA, PW, nullptr, 0};
                if (OPQ_S(G) == 256) { pg8::YaOrder Yo{So, OPQ_S(bx)}; pg8::gemm_phase<pg8::EpiB<3>, pg8::YaOrder, true, true>(lds, g, Yo, E, OPQ_TID()); }
                else pg8::gemm_phase<pg8::EpiB<3>, pg8::StaticOrder, true, true>(lds, g, So, E, OPQ_TID()); }
            SEAM(pb + 2);
        }
        if (PH_EN(5) && IN(pb + 3)) for (int rep_ = 0, nrep_ = (DUPN(5)); rep_ < nrep_; ++rep_) { LOADP(); MAIN_CHECK(4); cmp2_phase(P, l, OPQ_S(vcu), OPQ_S(G), OPQ_S(wave), OPQ_TID() & 63); SEAM(pb + 3); }
#if DBG_SKIP_ATTN
        if (PH_EN(6) && IN(pb + 4)) for (int rep_ = 0, nrep_ = (DUPN(6)); rep_ < nrep_; ++rep_) { LOADP(); u32x4* ao = (u32x4*)(P.ws + WS_AO); for (size_t i = (size_t)OPQ_S(vcu) * 512 + OPQ_TID(); i < (size_t)S * DM * 2 / 16; i += (size_t)OPQ_S(G) * 512) ao[i] = (u32x4){0u, 0u, 0u, 0u}; SEAM(pb + 4); }
#else
        if (PH_EN(6) && IN(pb + 4)) for (int rep_ = 0, nrep_ = (DUPN(6)); rep_ < nrep_; ++rep_) { LOADP(); attn_phase(P, lds, OPQ_S(vcu), OPQ_S(G), OPQ_S(wave), OPQ_TID() & 63, l);
            SEAM(pb + 4); }
#endif
        if (PH_EN(7) && IN(pb + 5)) for (int rep_ = 0, nrep_ = (DUPN(7)); rep_ < nrep_; ++rep_) { LOADP();
#if DBG_CHECK
            if (DBG_CHECK == 2 && l == DBG_CHECK_LAYER) { attn_check(P, l, lds, OPQ_S(vcu), OPQ_S(G), OPQ_TID(), ctl + 64); __syncthreads(); }
#endif
            pg8::Gemm g{(const bf16*)(P.ws + WS_AO), (const bf16*)(wl + WL_WNSA), S, DM, DM, DM}; pg8::StaticOrder So; So.init(S, DM, OPQ_S(G), OPQ_S(bx));
            pg8::EpiB<4> E{(bf16*)(P.ws + WS_MG), DM, nullptr, Pm + C_GB, PW, (const bf16*)(P.ws + WS_YA), DM};
            pg8::gemm_phase<pg8::EpiB<4>, pg8::StaticOrder, true, true>(lds, g, So, E, OPQ_TID());
            SEAM(pb + 5);
        }
        if (PH_EN(8) && IN(pb + 6)) for (int rep_ = 0, nrep_ = (DUPN(8)); rep_ < nrep_; ++rep_) { LOADP();
            MAIN_CHECK(5);
            pg8::Gemm g{(const bf16*)(P.ws + WS_MG), (const bf16*)(wl + WL_WOUT), S, DM, DM, DM}; pg8::StaticOrder So; So.init(S, DM, OPQ_S(G), OPQ_S(bx));
            pg8::EpiB<0> E{Y, DM, nullptr, nullptr, 0, nullptr, 0};
            pg8::gemm_phase<pg8::EpiB<0>, pg8::StaticOrder, true, true>(lds, g, So, E, OPQ_TID());
            SEAM(pb + 6);
        }
        if (PH_EN(9) && IN(pb + 7)) for (int rep_ = 0, nrep_ = (1); rep_ < nrep_; ++rep_) { LOADP(); MAIN_CHECK(6); resid_phase<true>(P, lds, l == 0 ? (const void*)P.x : (const void*)(P.ws + WS_XB), l != 0, (void*)(P.ws + WS_XB), true, Y, H, true, l, 2, 1, l, 4, 3, 2, OPQ_S(vcu), OPQ_S(G), OPQ_S(wave), OPQ_TID() & 63, OPQ_TID()); SEAM(pb + 7); }
        if (PH_EN(10) && IN(pb + 8)) for (int rep_ = 0, nrep_ = (DUPN(10)); rep_ < nrep_; ++rep_) { LOADP();
            MAIN_CHECK(7);
            pg8::Gemm g{H, (const bf16*)(wl + WL_WUP), S, FF, DM, DM}; pg8::StaticOrder So; So.init(S, FF, OPQ_S(G), OPQ_S(bx));
            pg8::EpiB<1> E{(bf16*)(P.ws + WS_U), FF, nullptr, nullptr, 0, nullptr, 0};
            pg8::gemm_phase<pg8::EpiB<1>, pg8::StaticOrder, true, true>(lds, g, So, E, OPQ_TID());
            SEAM(pb + 8);
        }
        if (PH_EN(11) && IN(pb + 9)) for (int rep_ = 0, nrep_ = (DUPN(11)); rep_ < nrep_; ++rep_) { LOADP();
            MAIN_CHECK(8);
            pg8::Gemm g{(const bf16*)(P.ws + WS_U), (const bf16*)(wl + WL_WDOWN), S, DM, FF, FF}; pg8::StaticOrder So; So.init(S, DM, OPQ_S(G), OPQ_S(bx));
            pg8::EpiB<0> E{Y, DM, nullptr, nullptr, 0, nullptr, 0};
            pg8::gemm_phase<pg8::EpiB<0>, pg8::StaticOrder, true, true>(lds, g, So, E, OPQ_TID());
            SEAM(pb + 9);
        }
        if (PH_EN(12) && IN(pb + 10)) for (int rep_ = 0, nrep_ = (1); rep_ < nrep_; ++rep_) { LOADP();
            MAIN_CHECK(9);
            resid_phase<true>(P, lds, (const void*)(P.ws + WS_XB), true, l + 1 < DEPTH ? (void*)(P.ws + WS_XB) : (void*)P.out, l + 1 < DEPTH, Y, H, l + 1 < DEPTH, l, 5, 3, (l + 1 < DEPTH) ? l + 1 : l, 1, 0, 0, OPQ_S(vcu), OPQ_S(G), OPQ_S(wave), OPQ_TID() & 63, OPQ_TID());
            if (l + 1 < DEPTH) SEAM(pb + 10);
#if DBG_CHECK
            else { __syncthreads(); if (OPQ_S(bx) == 0 && OPQ_TID() == 0) { __threadfence(); const unsigned f = __hip_atomic_load(ctl + 64, __ATOMIC_RELAXED, __HIP_MEMORY_SCOPE_AGENT);
                if (f) { const unsigned ft = (0xffffffffu - __hip_atomic_load(ctl + 65, __ATOMIC_RELAXED, __HIP_MEMORY_SCOPE_AGENT)) + 1u, cnt = 0u; (void)cnt;
                    P.out[0] = 2000.0f * ((((ft - 1u) & 63u) >> 3) + 1u); } } }
#endif
        }
    }
#undef IN
#undef SEAM
}

extern "C" void kernel_launch(void* const* d_in, const int* in_sizes, int n_in, void* d_out, int out_size, void* d_ws, size_t ws_size, hipStream_t stream) {
    static int grid = 0;
    if (grid == 0) {
        if (n_in != 18 || out_size != S * DM || ws_size < WS_END) { fprintf(stderr, "kernel_launch: unexpected problem (n_in %d, out %d, ws %zu, need %zu)\n", n_in, out_size, ws_size, (size_t)WS_END); grid = -1; return; }
        int dev = 0, cus = 0, per_cu = 0;
        if (hipGetDevice(&dev) != hipSuccess || hipDeviceGetAttribute(&cus, hipDeviceAttributeMultiprocessorCount, dev) != hipSuccess) { grid = -1; return; }
        if (hipFuncSetAttribute((const void*)nsa_fwd, hipFuncAttributeMaxDynamicSharedMemorySize, LDS_BYTES) != hipSuccess) { fprintf(stderr, "kernel_launch: hipFuncSetAttribute failed\n"); grid = -1; return; }
        if (hipOccupancyMaxActiveBlocksPerMultiprocessor(&per_cu, (const void*)nsa_fwd, NWAVES * 64, LDS_BYTES) != hipSuccess || per_cu < 1)
            fprintf(stderr, "kernel_launch: occupancy query reports %d workgroups per CU\n", per_cu);
        (void)hipGetLastError();
        grid = cus;
    }
    if (grid < 0) return;
    if (hipMemsetAsync((char*)d_ws + WS_CTL, 0, CTL_ZERO_BYTES, stream) != hipSuccess) { fprintf(stderr, "kernel_launch: memset failed\n"); return; }
    Args a{};
    for (int i = 0; i < 18; ++i) a.in[i] = d_in[i];
    a.out = (float*)d_out; a.ws = (unsigned char*)d_ws;
#if MK_PER_PHASE
    for (int ph = 0; ph < N_PHASES; ++ph) { a.ph_lo = ph; a.ph_hi = ph + 1; hipLaunchKernelGGL(nsa_fwd, dim3(grid), dim3(NWAVES * 64), LDS_BYTES, stream, a); }
#else
    a.ph_lo = 0; a.ph_hi = N_PHASES;
    hipLaunchKernelGGL(nsa_fwd, dim3(grid), dim3(NWAVES * 64), LDS_BYTES, stream, a);
#endif
    const hipError_t le = hipPeekAtLastError();
    if (le != hipSuccess) fprintf(stderr, "kernel_launch: launch failed: %s\n", hipGetErrorName(le));
}
```

```cpp
#include <hip/hip_runtime.h>
#include <cstdio>
#include <cstdint>

#define GAS __attribute__((address_space(1)))
#define GAS_K __attribute__((address_space(4)))
#define LAS __attribute__((address_space(3)))
typedef unsigned short bf16;
typedef short bf16x8 __attribute__((ext_vector_type(8)));
typedef float f32x4 __attribute__((ext_vector_type(4)));
typedef float f32x2 __attribute__((ext_vector_type(2)));
typedef unsigned u32x4 __attribute__((ext_vector_type(4)));
typedef unsigned u32x2 __attribute__((ext_vector_type(2)));

constexpr int S = 16384, DM = 2048, DEPTH = 4, CWID = 1024, NH = 16, NG = 4, HD = 128, FF = 8192;
constexpr int INW = 12336, PW = 12544;
constexpr int C_BG = 0, C_CG = 1024, C_XA = 2048, C_Q = 3072, C_KV = 5120, C_GA = 8192, C_GB = 10240, C_GN = 12288;
constexpr float NORM_EPS = 1e-6f;
constexpr float QSCALE = 0.12751743082459868f;
constexpr int NWAVES = 8;

namespace pg8 {
typedef unsigned short bf16_t;
constexpr int BM = 256, BK = 64, HALF = 128, HTB = HALF * BK * 2, STAGE_BYTES = 8 * HTB, NXCD = 8, WGM = 8;
__host__ __device__ __forceinline__ int lds_byte(int r, int c) { const int st = (r >> 4) * 2 + (c >> 5), rr = r & 15, cc = c & 31, ob = rr * 64 + cc * 2; return st * 1024 + (ob ^ (((ob >> 9) & 1) << 5)); }
__host__ __device__ __forceinline__ void stage_rc(int b, int& R, int& C) { const int st = b / 1024, sb = b % 1024, swz = sb ^ (((sb >> 9) & 1) << 5); R = (st >> 1) * 16 + swz / 64; C = (st & 1) * 32 + (swz % 64) / 2; }
__host__ __device__ __forceinline__ int perm32(int rho) { const int n = rho >> 4, i = rho & 15; return 8 * (i >> 2) + 4 * n + (i & 3); }

struct Unit { int pm, pn; };
struct Gemm { const bf16_t* A; const bf16_t* Bt; int M, N, K, lda; };

struct StaticOrder {
    int nM, nN, nwg, G, c;
    __device__ void init(int M, int N, int G_, int c_) { nM = M / BM; nN = N / BM; nwg = nM * nN; G = G_; c = c_; if (c_ < 0 || c_ >= G_) nwg = 0; }
    __device__ bool next(int i, Unit& u) const { return map((long)i * G + c, u); }
    __device__ bool map(const long L, Unit& u) const {
        if (L >= nwg) return false;
        int wgid = (int)L; { const int q = nwg / NXCD, r = nwg % NXCD, xcd = wgid % NXCD, off = wgid / NXCD; wgid = (xcd < r ? xcd * (q + 1) : r * (q + 1) + (xcd - r) * q) + off; }
        const int nig = WGM * nN, gid = wgid / nig, fm = gid * WGM, gsz = (nM - fm) < WGM ? (nM - fm) : WGM;
        u.pm = fm + ((wgid % nig) % gsz); u.pn = (wgid % nig) / gsz; return true;
    }
    __device__ __forceinline__ void a_ready(const Unit&) const {}
    __device__ __forceinline__ void done(const Unit&) const {}
};

typedef float f32x2_t_ __attribute__((ext_vector_type(2))); typedef __bf16 bf16x2_t_ __attribute__((ext_vector_type(2)));
__device__ __forceinline__ unsigned cvt_pk_bf16(float lo, float hi) { const f32x2_t_ v = {lo, hi}; const bf16x2_t_ b = __builtin_convertvector(v, bf16x2_t_); return __builtin_bit_cast(unsigned, b); }
__device__ __forceinline__ float bflo(unsigned w) { return __uint_as_float(w << 16); }
__device__ __forceinline__ float bfhi(unsigned w) { return __uint_as_float(w & 0xffff0000u); }
__device__ __forceinline__ float sigmoidf_(float x) { return __builtin_amdgcn_rcpf(1.0f + __builtin_amdgcn_exp2f(-1.4426950408889634f * x)); }

struct YaOrder {
    StaticOrder base; int bx;
    __device__ bool next(int i, Unit& u) const {
        if (bx < 32) return false;
        if (i < 2) return base.next(i, u);
        if (i == 2 && bx < 96) { const int idx = bx - 32; return base.map(idx < 32 ? (long)idx : (long)(idx - 32) + base.G, u); }
        return false;
    }
    __device__ __forceinline__ void a_ready(const Unit&) const {}
    __device__ __forceinline__ void done(const Unit&) const {}
};
struct CmpOrder {
    int c;
    __device__ bool next(int i, Unit& u) const { if (i != 0 || c < 0 || c >= 32) return false; u.pm = c; u.pn = c >> 4; return true; }
    __device__ __forceinline__ void a_ready(const Unit&) const {}
    __device__ __forceinline__ void done(const Unit&) const {}
};
struct EpiF32 {
    static constexpr bool PERM = false, AFTER_DRAIN = false;
    float* C; int ldc;
    __device__ __forceinline__ void operator()(const f32x4 (&acc)[2][2][4][2], const Unit& u, int wr, int wc, int fr, int fq) const {
        const int row0 = u.pm * BM + wr * 64 + fr, col0 = u.pn * BM + wc * 32 + 4 * fq;
#pragma unroll
        for (int ai = 0; ai < 2; ++ai)
#pragma unroll
            for (int m = 0; m < 4; ++m) { float* rowp = C + (size_t)(row0 + ai * HALF + m * 16) * ldc + col0;
#pragma unroll
                for (int bj = 0; bj < 2; ++bj)
#pragma unroll
                    for (int n = 0; n < 2; ++n) *(f32x4*)(rowp + bj * HALF + n * 16) = acc[ai][bj][m][n]; }
    }
};
template <int MODE, bool COLWRAP = false> struct EpiB {
    static constexpr bool PERM = true, AFTER_DRAIN = false;
    bf16_t* O; int ldc; const float* bias; const bf16_t* G; int ldg; const bf16_t* ADD; int ldadd;
    __device__ __forceinline__ void operator()(const f32x4 (&acc)[2][2][4][2], const Unit& u, int wr, int wc, int fr, int fq) const {
        const int row0 = u.pm * BM + wr * 64 + fr, col0 = u.pn * BM + wc * 32 + 8 * fq;
#pragma unroll
        for (int ai = 0; ai < 2; ++ai)
#pragma unroll
            for (int m = 0; m < 4; ++m) { const int row = row0 + ai * HALF + m * 16;
#pragma unroll
                for (int bj = 0; bj < 2; ++bj) { const int col = col0 + bj * HALF;
                    float v[8];
#pragma unroll
                    for (int e = 0; e < 4; ++e) { v[e] = acc[ai][bj][m][0][e]; v[4 + e] = acc[ai][bj][m][1][e]; }
                    if (MODE == 1) {
#pragma unroll
                        for (int e = 0; e < 8; ++e) { const float t = fmaxf(v[e], 0.f); v[e] = t * t; }
                    }
                    if (MODE == 2) { const f32x4 b0 = *(const f32x4*)(bias + col), b1 = *(const f32x4*)(bias + col + 4);
#pragma unroll
                        for (int e = 0; e < 8; ++e) { const float x = v[e] + (e < 4 ? b0[e] : b1[e - 4]); v[e] = x * sigmoidf_(1.5957691216057308f * (x + 0.044715f * x * x * x)); }
                    }
                    if (MODE == 3 || MODE == 4) { const u32x4 gw = *(const u32x4*)(G + (size_t)row * ldg + col);
#pragma unroll
                        for (int e = 0; e < 4; ++e) { v[2 * e] *= sigmoidf_(bflo(gw[e])); v[2 * e + 1] *= sigmoidf_(bfhi(gw[e])); }
                    }
                    if (MODE == 4) { const u32x4 aw = *(const u32x4*)(ADD + (size_t)row * ldadd + col);
#pragma unroll
                        for (int e = 0; e < 4; ++e) { v[2 * e] += bflo(aw[e]); v[2 * e + 1] += bfhi(aw[e]); }
                    }
                    u32x4 w; w.x = cvt_pk_bf16(v[0], v[1]); w.y = cvt_pk_bf16(v[2], v[3]); w.z = cvt_pk_bf16(v[4], v[5]); w.w = cvt_pk_bf16(v[6], v[7]);
                    *(u32x4*)(O + (size_t)row * ldc + (COLWRAP ? (col & 255) : col)) = w; } }
    }
};

template <class Epi, class Sched, bool ALIGN_EPI = false, bool SP2 = false>
__device__ __forceinline__ void gemm_phase(LAS unsigned char* lds, const Gemm g, const Sched& S, const Epi& E, const int tid) {
    const int wid = __builtin_amdgcn_readfirstlane(tid >> 6), lane = tid & 63, wr = wid >> 2, wc = wid & 3, fr = lane & 15, fq = lane >> 4;
    const int K = g.K, nt = K / BK;
    unsigned voffA[2], voffB[2];
#pragma unroll
    for (int i = 0; i < 2; ++i) { int R, C; stage_rc(tid * 16 + i * 8192, R, C); const int Rb = Epi::PERM ? ((R & ~31) + perm32(R & 31)) : R;
        voffA[i] = (unsigned)(R * g.lda + C) * 2u; voffB[i] = (unsigned)(Rb * K + C) * 2u; }
    const size_t kstep = (size_t)(BK * 2);
    const size_t hstepA = (size_t)HALF * g.lda * 2, hstepB = (size_t)HALF * K * 2;
    const size_t tstepA = 2 * hstepA, tstepB = 2 * hstepB;
    const unsigned ldsw = (unsigned)wid * 1024u;
    const int aoff = lds_byte(wr * 64 + fr, fq * 8), boff = lds_byte(wc * 32 + fr, fq * 8);
#define PG8_SA(b, h) (((b) * 2 + (h)) * HTB)
#define PG8_SB(b, h) ((4 + (b) * 2 + (h)) * HTB)
#define PG8_STAGE(bufoff, gbase, voff) do { _Pragma("unroll") for (int _i = 0; _i < 2; ++_i) \
        __builtin_amdgcn_global_load_lds((const unsigned*)((const char*)(gbase) + (voff)[_i]), (LAS unsigned*)(lds + (bufoff) + ldsw + _i * 8192), 16, 0, 0); } while (0)
#define PG8_LDA(dst, b, h) do { _Pragma("unroll") for (int m = 0; m < 4; ++m) _Pragma("unroll") for (int k = 0; k < 2; ++k) dst[m][k] = *(const LAS bf16x8*)(lds + PG8_SA(b, h) + aoff + m * 2048 + k * 1024); } while (0)
#define PG8_LDB(dst, b, h) do { _Pragma("unroll") for (int n = 0; n < 2; ++n) _Pragma("unroll") for (int k = 0; k < 2; ++k) dst[n][k] = *(const LAS bf16x8*)(lds + PG8_SB(b, h) + boff + n * 2048 + k * 1024); } while (0)
#define PG8_MMA(ai, bj, At, Bt) do { __builtin_amdgcn_s_setprio(1); _Pragma("unroll") for (int m = 0; m < 4; ++m) _Pragma("unroll") for (int n = 0; n < 2; ++n) _Pragma("unroll") for (int k = 0; k < 2; ++k) \
        acc[ai][bj][m][n] = __builtin_amdgcn_mfma_f32_16x16x32_bf16(Bt[n][k], At[m][k], acc[ai][bj][m][n], 0, 0, 0); __builtin_amdgcn_s_setprio(0); } while (0)
#define PG8_WAIT_V(n) asm volatile("s_waitcnt vmcnt(" #n ")" ::: "memory")
#define PG8_WAIT_L(n) asm volatile("s_waitcnt lgkmcnt(" #n ")" ::: "memory")
#define PG8_BAR __builtin_amdgcn_s_barrier()
#define PG8_SCHED __builtin_amdgcn_sched_barrier(0)
    Unit cur, nxt; int ui = 0;
    if (!S.next(0, cur)) return;
    f32x4 acc[2][2][4][2];
#pragma unroll
    for (int a = 0; a < 2; ++a)
#pragma unroll
        for (int b = 0; b < 2; ++b)
#pragma unroll
            for (int m = 0; m < 4; ++m)
#pragma unroll
                for (int n = 0; n < 2; ++n) acc[a][b][m][n] = (f32x4){0.f, 0.f, 0.f, 0.f};
    bf16x8 At[4][2], B0[2][2], B1[2][2];
    const char* cA = (const char*)g.A + (size_t)cur.pm * tstepA; const char* cB = (const char*)g.Bt + (size_t)cur.pn * tstepB;
    S.a_ready(cur);
    if constexpr (SP2) {
        PG8_STAGE(PG8_SB(0, 0), cB, voffB); PG8_STAGE(PG8_SB(0, 1), cB + hstepB, voffB); PG8_STAGE(PG8_SA(0, 0), cA, voffA); PG8_STAGE(PG8_SA(0, 1), cA + hstepA, voffA);
        if (wr == 1) PG8_BAR;
        PG8_WAIT_V(2); PG8_BAR;
        PG8_STAGE(PG8_SB(1, 0), cB + kstep, voffB); PG8_STAGE(PG8_SA(1, 0), cA + kstep, voffA); PG8_STAGE(PG8_SB(1, 1), cB + hstepB + kstep, voffB);
        PG8_WAIT_V(6); PG8_BAR;
    } else {
        PG8_STAGE(PG8_SB(0, 0), cB, voffB); PG8_STAGE(PG8_SA(0, 0), cA, voffA); PG8_STAGE(PG8_SB(0, 1), cB + hstepB, voffB); PG8_STAGE(PG8_SA(0, 1), cA + hstepA, voffA);
        if (wr == 1) PG8_BAR;
        PG8_WAIT_V(4); PG8_BAR;
        PG8_STAGE(PG8_SB(1, 0), cB + kstep, voffB); PG8_STAGE(PG8_SA(1, 0), cA + kstep, voffA); PG8_STAGE(PG8_SB(1, 1), cB + hstepB + kstep, voffB);
        PG8_WAIT_V(6); PG8_BAR;
    }
    for (;;) {
        const bool has_next = S.next(ui + 1, nxt);
        const char* nA = has_next ? (const char*)g.A + (size_t)nxt.pm * tstepA : cA; const char* nB = has_next ? (const char*)g.Bt + (size_t)nxt.pn * tstepB : cB;
        for (int t = 0; t < nt; t += 2) {
            const bool last = (t == nt - 2);
            const char* a1 = cA + (size_t)(t + 1) * kstep;
            const char* a2 = last ? nA : cA + (size_t)(t + 2) * kstep; const char* b2 = last ? nB : cB + (size_t)(t + 2) * kstep;
            const char* a3 = a2 + kstep; const char* b3 = b2 + kstep;
            if (last && has_next) S.a_ready(nxt);
            if constexpr (SP2) {
            PG8_LDB(B0, 0, 0); PG8_LDB(B1, 0, 1); PG8_SCHED; PG8_LDA(At, 0, 0); PG8_STAGE(PG8_SA(1, 1), a1 + hstepA, voffA);
            PG8_WAIT_V(8); PG8_WAIT_L(0); PG8_BAR; PG8_MMA(0, 0, At, B0); PG8_MMA(0, 1, At, B1); PG8_BAR; PG8_SCHED;
            PG8_LDA(At, 0, 1); PG8_STAGE(PG8_SB(0, 0), b2, voffB); PG8_STAGE(PG8_SB(0, 1), b2 + hstepB, voffB); PG8_STAGE(PG8_SA(0, 0), a2, voffA);
            PG8_WAIT_V(8); PG8_WAIT_L(0); PG8_BAR; PG8_MMA(1, 0, At, B0); PG8_MMA(1, 1, At, B1); PG8_BAR; PG8_SCHED;
            PG8_LDB(B0, 1, 0); PG8_LDB(B1, 1, 1); PG8_SCHED; PG8_LDA(At, 1, 0); PG8_STAGE(PG8_SA(0, 1), a2 + hstepA, voffA);
            PG8_WAIT_V(8); PG8_WAIT_L(0); PG8_BAR; PG8_MMA(0, 0, At, B0); PG8_MMA(0, 1, At, B1); PG8_BAR; PG8_SCHED;
            PG8_LDA(At, 1, 1); PG8_STAGE(PG8_SB(1, 0), b3, voffB); PG8_STAGE(PG8_SB(1, 1), b3 + hstepB, voffB); PG8_STAGE(PG8_SA(1, 0), a3, voffA);
            PG8_WAIT_V(8); PG8_WAIT_L(0); PG8_BAR; PG8_MMA(1, 0, At, B0); PG8_MMA(1, 1, At, B1); PG8_BAR; PG8_SCHED;
            } else {
            PG8_LDB(B0, 0, 0); PG8_SCHED; PG8_LDA(At, 0, 0); PG8_STAGE(PG8_SA(1, 1), a1 + hstepA, voffA);
            PG8_WAIT_L(8); PG8_BAR; PG8_WAIT_L(0); PG8_MMA(0, 0, At, B0); PG8_BAR; PG8_SCHED;
            PG8_LDB(B1, 0, 1); PG8_STAGE(PG8_SB(0, 0), b2, voffB);
            PG8_BAR; PG8_WAIT_L(0); PG8_MMA(0, 1, At, B1); PG8_BAR;
            PG8_LDA(At, 0, 1); PG8_STAGE(PG8_SA(0, 0), a2, voffA);
            PG8_BAR; PG8_WAIT_L(0); PG8_MMA(1, 0, At, B0); PG8_BAR; PG8_SCHED;
            PG8_STAGE(PG8_SB(0, 1), b2 + hstepB, voffB);
            PG8_WAIT_V(6); PG8_BAR; PG8_MMA(1, 1, At, B1); PG8_BAR;
            PG8_LDB(B0, 1, 0); PG8_SCHED; PG8_LDA(At, 1, 0); PG8_STAGE(PG8_SA(0, 1), a2 + hstepA, voffA);
            PG8_WAIT_L(8); PG8_BAR; PG8_WAIT_L(0); PG8_MMA(0, 0, At, B0); PG8_BAR; PG8_SCHED;
            PG8_LDB(B1, 1, 1); PG8_STAGE(PG8_SB(1, 0), b3, voffB);
            PG8_BAR; PG8_WAIT_L(0); PG8_MMA(0, 1, At, B1); PG8_BAR;
            PG8_LDA(At, 1, 1); PG8_STAGE(PG8_SA(1, 0), a3, voffA);
            PG8_BAR; PG8_WAIT_L(0); PG8_MMA(1, 0, At, B0); PG8_BAR; PG8_SCHED;
            PG8_STAGE(PG8_SB(1, 1), b3 + hstepB, voffB);
            PG8_WAIT_V(6); PG8_BAR; PG8_MMA(1, 1, At, B1); PG8_BAR;
            }
        }
        if constexpr (ALIGN_EPI) { if (wr == 0) PG8_BAR; }
        E(acc, cur, wr, wc, fr, fq); S.done(cur);
        if (!has_next) break;
#pragma unroll
        for (int a = 0; a < 2; ++a)
#pragma unroll
            for (int b = 0; b < 2; ++b)
#pragma unroll
                for (int m = 0; m < 4; ++m)
#pragma unroll
                    for (int n = 0; n < 2; ++n) acc[a][b][m][n] = (f32x4){0.f, 0.f, 0.f, 0.f};
        cur = nxt; cA = nA; cB = nB; ++ui;
        if constexpr (ALIGN_EPI) { if (wr == 1) PG8_BAR; }
    }
    PG8_WAIT_V(0);
    if constexpr (!ALIGN_EPI) { if (wr == 0) PG8_BAR; }
    PG8_BAR;
#undef PG8_SA
#undef PG8_SB
#undef PG8_STAGE
#undef PG8_LDA
#undef PG8_LDB
#undef PG8_MMA
#undef PG8_WAIT_V
#undef PG8_WAIT_L
#undef PG8_BAR
#undef PG8_SCHED
}
}

constexpr size_t al4k(size_t x) { return (x + 4095) & ~(size_t)4095; }
constexpr size_t WS_CTL = 0, CTL_ZERO_BYTES = 1u << 20;
constexpr size_t WS_MODP = CTL_ZERO_BYTES;
constexpr size_t WS_B1PART = al4k(WS_MODP + (size_t)DEPTH * 8 * 6 * DM * 4);
constexpr size_t WS_B1P = al4k(WS_B1PART + (size_t)DEPTH * 2 * 32 * 256 * 4);
constexpr size_t WS_COS = al4k(WS_B1P + 2 * 256 * 4);
constexpr size_t WS_SIN = al4k(WS_COS + (size_t)S * 16 * 4);
constexpr size_t WS_GT = al4k(WS_SIN + (size_t)S * 16 * 4);
constexpr size_t WS_W2T = al4k(WS_GT + (size_t)S * 48 * 4);
constexpr size_t WS_KCI = al4k(WS_W2T + (size_t)DEPTH * 2 * 128 * 256 * 2);
constexpr size_t WS_VCI = al4k(WS_KCI + (size_t)NG * 16 * 16384);
constexpr size_t WS_HC = al4k(WS_VCI + (size_t)NG * 16 * 16384);
constexpr size_t WS_WL = al4k(WS_HC + (size_t)2 * 4096 * 256 * 2);
constexpr size_t WL_WIN = 0;
constexpr size_t WL_WCONV = WL_WIN + (size_t)PW * DM * 2;
constexpr size_t WL_W1T = WL_WCONV + (size_t)DM * CWID * 2;
constexpr size_t WL_WNSA = WL_W1T + (size_t)2 * 256 * 4096 * 2;
constexpr size_t WL_WOUT = WL_WNSA + (size_t)DM * DM * 2;
constexpr size_t WL_WUP = WL_WOUT + (size_t)DM * DM * 2;
constexpr size_t WL_WDOWN = WL_WUP + (size_t)FF * DM * 2;
constexpr size_t WL_BYTES = al4k(WL_WDOWN + (size_t)DM * FF * 2);
constexpr size_t WS_P = al4k(WS_WL + DEPTH * WL_BYTES);
constexpr size_t WS_U = WS_P;
constexpr size_t WS_Y = WS_P + (size_t)S * FF * 2;
constexpr size_t P_REGION = (size_t)S * PW * 2;
static_assert((size_t)S * FF * 2 + (size_t)S * DM * 4 <= P_REGION, "U + Y fit in P's region");
constexpr size_t WS_H = al4k(WS_P + P_REGION);
constexpr size_t WS_QP = al4k(WS_H + (size_t)S * DM * 2);
constexpr size_t WS_MG = WS_QP;
constexpr size_t WS_KSI = al4k(WS_QP + (size_t)S * DM * 2);
constexpr size_t WS_VSI = WS_KSI + (size_t)NG * 256 * 16384;
constexpr size_t WS_KWI = WS_VSI + (size_t)NG * 256 * 16384;
constexpr size_t WS_VWI = WS_KWI + (size_t)NG * 256 * 16384;
constexpr size_t WS_KCR = WS_VWI + (size_t)NG * 256 * 16384;
constexpr size_t WS_VCR = WS_KCR + (size_t)NG * S * HD * 2;
constexpr size_t WS_CV = al4k(WS_VCR + (size_t)NG * S * HD * 2 + 65536);
constexpr size_t WS_AO = al4k(WS_CV + (size_t)S * CWID * 2);
constexpr size_t WS_YA = al4k(WS_AO + (size_t)S * DM * 2);
constexpr size_t WS_FS = al4k(WS_YA + (size_t)S * DM * 2);
constexpr size_t WS_XB = al4k(WS_FS + (size_t)256 * 8 * 16384);
constexpr size_t WS_END = al4k(WS_XB + (size_t)S * DM * 2);

constexpr int CW_BAR = 4096;

constexpr int RING_BYTES = 131072;
constexpr int AT_KV = 0, AT_IMP = 65536, IMP_STRIDE = 257, AT_SELW = AT_IMP + 64 * IMP_STRIDE * 4;
constexpr int MISC_OFF = AT_SELW + NWAVES * 256 * 4;
constexpr int LDS_BYTES = 147456;
static_assert(MISC_OFF + 512 <= LDS_BYTES && MISC_OFF >= RING_BYTES, "LDS map");

typedef GAS unsigned gu32;
#define RLX_AGENT __ATOMIC_RELAXED, __HIP_MEMORY_SCOPE_AGENT
#define LDS_WAIT() asm volatile("s_waitcnt lgkmcnt(0)" ::: "memory")
#define VM_WAIT() asm volatile("s_waitcnt vmcnt(0)" ::: "memory")

#define XB_TMO      128
#define XB_XCNT(j)  (256  + 64 * (j))
#define XB_XSUB(j)  (1280 + 64 * (j))
#define XB_XGEN(j)  (2304 + 64 * (j))
#define XB_TOP      3328
#define XB_TOPGEN   3392
#define XCD_BAR_WORDS 3456
#define XB_SPIN_CAP (1u << 22)

__device__ __forceinline__ unsigned xb_ld(unsigned* p)              { return __hip_atomic_load(p, __ATOMIC_RELAXED, __HIP_MEMORY_SCOPE_AGENT); }
__device__ __forceinline__ unsigned xb_add(unsigned* p, unsigned v) { return __hip_atomic_fetch_add(p, v, __ATOMIC_RELAXED, __HIP_MEMORY_SCOPE_AGENT); }
__device__ __forceinline__ unsigned xb_xcc_id() { return (unsigned)__builtin_amdgcn_s_getreg((3 << 11) | 20) & 0xFu; }
#define XB_SPIN(cond, bar) do { unsigned _sp = 0; while (cond) { __builtin_amdgcn_s_sleep(1); \
    if ((++_sp & 255u) == 0u) { if (xb_ld(&(bar)[XB_TMO])) break; if (_sp > XB_SPIN_CAP) { atomicAdd(&(bar)[XB_TMO], 1u); break; } } } } while (0)

struct XcdBarrier { unsigned* bar; unsigned x; volatile LAS unsigned* st; };

__device__ __forceinline__ XcdBarrier xcd_barrier_post(unsigned* bar, volatile LAS unsigned* st) {
    XcdBarrier b; b.bar = bar; b.x = xb_xcc_id(); b.st = st;
    if (threadIdx.x == 0) (void)xb_add(&bar[XB_XCNT(b.x)], 1u);
    return b;
}
__device__ __forceinline__ void xcd_barrier_complete(unsigned* bar, unsigned x, unsigned& nloc, unsigned& nx) {
    const unsigned G = gridDim.x * gridDim.y * gridDim.z;
    unsigned sum, cnt, mine, sp = 0u;
    for (;;) {
        sum = 0u; cnt = 0u; mine = 0u;
#pragma unroll
        for (unsigned j = 0; j < 16; ++j) { const unsigned c = xb_ld(&bar[XB_XCNT(j)]); sum += c; cnt += (c > 0u) ? 1u : 0u; mine = (j == x) ? c : mine; }
        if (sum == G) break;
        __builtin_amdgcn_s_sleep(1);
        if ((++sp & 255u) == 0u) { if (xb_ld(&bar[XB_TMO])) break; if (sp > XB_SPIN_CAP) { atomicAdd(&bar[XB_TMO], 1u); break; } }
    }
    nloc = mine > 0u ? mine : 1u; nx = cnt > 0u ? cnt : 1u;
}
__device__ __forceinline__ void xcd_barrier(const XcdBarrier& b) {
    asm volatile("s_waitcnt vmcnt(0)" ::: "memory");
    __syncthreads();
    if (threadIdx.x == 0) {
        unsigned* bar = b.bar;
        __builtin_amdgcn_s_waitcnt(0);
        unsigned nloc = b.st[0], nx = b.st[1];
        if (nloc == 0u) { xcd_barrier_complete(bar, b.x, nloc, nx); b.st[0] = nloc; b.st[1] = nx; }
        const unsigned old = xb_add(&bar[XB_XSUB(b.x)], 1u);
        const unsigned gen = old / nloc;
        if (old + 1u == (gen + 1u) * nloc) {
            __builtin_amdgcn_fence(__ATOMIC_RELEASE, "agent");
            asm volatile("s_waitcnt vmcnt(0)" ::: "memory");
            const unsigned og = xb_add(&bar[XB_TOP], 1u);
            const unsigned tg = og / nx;
            if (og + 1u == (tg + 1u) * nx) xb_add(&bar[XB_TOPGEN], 1u);
            else XB_SPIN(xb_ld(&bar[XB_TOPGEN]) == tg, bar);
            __builtin_amdgcn_fence(__ATOMIC_ACQUIRE, "agent");
            xb_add(&bar[XB_XGEN(b.x)], 1u);
            asm volatile("s_waitcnt vmcnt(0)" ::: "memory");
        } else {
            XB_SPIN(xb_ld(&bar[XB_XGEN(b.x)]) == gen, bar);
            __builtin_amdgcn_fence(__ATOMIC_ACQUIRE, "agent");
            asm volatile("s_waitcnt vmcnt(0)" ::: "memory");
        }
    }
    __syncthreads();
}

__device__ __forceinline__ unsigned f2bf(float f) { unsigned u = __builtin_bit_cast(unsigned, f); return (u + 0x7fffu + ((u >> 16) & 1u)) >> 16; }
__device__ __forceinline__ unsigned pk2(float lo, float hi) { return f2bf(lo) | (f2bf(hi) << 16); }
__device__ __forceinline__ float bf_lo(unsigned w) { return __uint_as_float(w << 16); }
__device__ __forceinline__ float bf_hi(unsigned w) { return __uint_as_float(w & 0xffff0000u); }
__device__ __forceinline__ float wave_sum(float v) {
#pragma unroll
    for (int o = 1; o < 64; o <<= 1) v += __shfl_xor(v, o);
    return v;
}
__device__ __forceinline__ float sigm(float x) { return __builtin_amdgcn_rcpf(1.0f + __builtin_amdgcn_exp2f(-1.4426950408889634f * x)); }
__device__ __forceinline__ void unpack8(const u32x4 w, float (&v)[8]) {
    v[0] = bf_lo(w.x); v[1] = bf_hi(w.x); v[2] = bf_lo(w.y); v[3] = bf_hi(w.y); v[4] = bf_lo(w.z); v[5] = bf_hi(w.z); v[6] = bf_lo(w.w); v[7] = bf_hi(w.w);
}
__device__ __forceinline__ u32x4 pack8(const float (&v)[8]) { u32x4 w; w.x = pk2(v[0], v[1]); w.y = pk2(v[2], v[3]); w.z = pk2(v[4], v[5]); w.w = pk2(v[6], v[7]); return w; }

__device__ __forceinline__ int k_rho(int kappa) { const int a = kappa >> 5, q = (kappa >> 3) & 3, h = (kappa >> 2) & 1, i = kappa & 3; return 16 * (2 * a + h) + 4 * q + i; }
__device__ __forceinline__ int kimg_off(int kappa, int ch  ) { const int rho = k_rho(kappa); return rho * 256 + ((ch ^ (rho & 15)) << 4); }
__device__ __forceinline__ int vimg_off(int d, int kc  ) { return d * 128 + ((kc ^ ((d >> 1) & 7)) << 4); }

struct Ptrs {
    const float *x, *c, *ada_w, *ada_b, *gains, *w_in, *conv_w, *w_conv_out, *cmp_pe, *cmp_w1, *cmp_b1, *cmp_w2, *cmp_b2, *w_nsa, *w_out, *w_up, *w_down;
    const int* pos;
    float* out; unsigned char* ws;
};
struct Args { const void* in[18]; float* out; unsigned char* ws; int ph_lo, ph_hi; };
static_assert(sizeof(Args) == 18 * 8 + 8 + 8 + 8, "Args has no padding");

__device__ __forceinline__ void transpose_item(const float* W, int ldw, int csrc0, int nvalid, int K, bf16* WT, int drow0, int k0, LAS float* scr, int lane) {
    const int col = lane & 31;
#pragma unroll 8
    for (int i = 0; i < 32; ++i) { const int kk = 2 * i + (lane >> 5); scr[kk * 33 + col] = (col < nvalid) ? W[(size_t)(k0 + kk) * ldw + csrc0 + col] : 0.f; }
    LDS_WAIT(); asm volatile("" ::: "memory");
    const int c = lane & 7;
#pragma unroll
    for (int j = 0; j < 4; ++j) { const int n = (lane >> 3) + 8 * j; const LAS float* s = scr + (8 * c) * 33 + n;
        u32x4 o; o.x = pk2(s[0 * 33], s[1 * 33]); o.y = pk2(s[2 * 33], s[3 * 33]); o.z = pk2(s[4 * 33], s[5 * 33]); o.w = pk2(s[6 * 33], s[7 * 33]);
        *(GAS u32x4*)(WT + (size_t)(drow0 + n) * K + k0 + 8 * c) = o; }
    LDS_WAIT(); asm volatile("" ::: "memory");
}
__device__ __forceinline__ void seg_item(const float* W, int ldw, int c0, int ncols, int K, bf16* WT, int r0, int item, LAS float* scr, int lane) {
    const int nblk = (ncols + 31) / 32, kb = item / nblk, nb = item % nblk;
    const int nv = ncols - 32 * nb;
    transpose_item(W, ldw, c0 + 32 * nb, nv < 32 ? nv : 32, K, WT, r0 + 32 * nb, 64 * kb, scr, lane);
}

__constant__ double ROPE_INVF[16] = {1.0, 0.44036660267178046, 0.19392274474868576, 0.08539710028576561, 0.03760603093086393, 0.016560440080994446, 0.007292664737217109,
    0.003211445994752591, 0.001414213562373095, 0.000622772421914596, 0.0002742481756762073, 0.00012076973741146504, 5.318295896944988e-05, 2.341999896140934e-05,
    1.031338537721246e-05, 4.5416704806078695e-06};

__device__ __forceinline__ void sincos_f64(double x, float& sn, float& cs) {
    const double k = __builtin_rint(x * 0.6366197723675814);
    double r = __builtin_fma(-k, 1.5707963267948966, x); r = __builtin_fma(-k, 6.123233995736766e-17, r);
    const double r2 = r * r;
    double ps = -1.0 / 1307674368000.0; ps = ps * r2 + 1.0 / 6227020800.0; ps = ps * r2 - 1.0 / 39916800.0; ps = ps * r2 + 1.0 / 362880.0; ps = ps * r2 - 1.0 / 5040.0; ps = ps * r2 + 1.0 / 120.0; ps = ps * r2 - 1.0 / 6.0; ps = ps * r2 + 1.0;
    const double s = ps * r;
    double pc = 1.0 / 20922789888000.0; pc = pc * r2 - 1.0 / 87178291200.0; pc = pc * r2 + 1.0 / 479001600.0; pc = pc * r2 - 1.0 / 3628800.0; pc = pc * r2 + 1.0 / 40320.0; pc = pc * r2 - 1.0 / 720.0; pc = pc * r2 + 1.0 / 24.0; pc = pc * r2 - 0.5; pc = pc * r2 + 1.0;
    const int n = ((int)(long long)k) & 3;
    const double so = (n == 0) ? s : (n == 1) ? pc : (n == 2) ? -s : -pc;
    const double co = (n == 0) ? pc : (n == 1) ? -s : (n == 2) ? -pc : s;
    sn = (float)so; cs = (float)co;
}

constexpr int SEG_ITEMS[11] = {32 * 256, 32 * 64, 32 * 64, 32 * 2, 16 * 64, 64 * 8, 64 * 8, 32 * 64, 32 * 64, 32 * 256, 128 * 64};
constexpr int ITEMS_PER_LAYER = 8192 + 2048 + 2048 + 64 + 1024 + 512 + 512 + 2048 + 2048 + 8192 + 8192;
constexpr int W2T_ITEMS = 4 * 4;

__device__ __forceinline__ void p0_prologue(const Ptrs& P, LAS unsigned char* lds, int vcu, int G, int wave, int lane, int tid) {
    LAS float* scr = (LAS float*)(lds + wave * 16384);
    const int gw = vcu * NWAVES + wave, NGW = G * NWAVES;
    for (int it = gw; it < DEPTH * ITEMS_PER_LAYER; it += NGW) {
        const int l = it / ITEMS_PER_LAYER; int r = it % ITEMS_PER_LAYER;
        unsigned char* wl = P.ws + WS_WL + (size_t)l * WL_BYTES;
        const float* win = P.w_in + (size_t)l * DM * INW;
        if (r < SEG_ITEMS[0]) { seg_item(win, INW, 0, 8192, DM, (bf16*)(wl + WL_WIN), 0, r, scr, lane); continue; } r -= SEG_ITEMS[0];
        if (r < SEG_ITEMS[1]) { seg_item(win, INW, 8240, 2048, DM, (bf16*)(wl + WL_WIN), C_GA, r, scr, lane); continue; } r -= SEG_ITEMS[1];
        if (r < SEG_ITEMS[2]) { seg_item(win, INW, 10288, 2048, DM, (bf16*)(wl + WL_WIN), C_GB, r, scr, lane); continue; } r -= SEG_ITEMS[2];
        if (r < SEG_ITEMS[3]) { seg_item(win, INW, 8192, 48, DM, (bf16*)(wl + WL_WIN), C_GN, r, scr, lane); continue; } r -= SEG_ITEMS[3];
        if (r < SEG_ITEMS[4]) { seg_item(P.w_conv_out + (size_t)l * CWID * DM, DM, 0, DM, CWID, (bf16*)(wl + WL_WCONV), 0, r, scr, lane); continue; } r -= SEG_ITEMS[4];
        if (r < SEG_ITEMS[5]) { seg_item(P.cmp_w1 + (size_t)(l * 2 + 0) * 4096 * 256, 256, 0, 256, 4096, (bf16*)(wl + WL_W1T), 0, r, scr, lane); continue; } r -= SEG_ITEMS[5];
        if (r < SEG_ITEMS[6]) { seg_item(P.cmp_w1 + (size_t)(l * 2 + 1) * 4096 * 256, 256, 0, 256, 4096, (bf16*)(wl + WL_W1T) + (size_t)256 * 4096, 0, r, scr, lane); continue; } r -= SEG_ITEMS[6];
        if (r < SEG_ITEMS[7]) { seg_item(P.w_nsa + (size_t)l * DM * DM, DM, 0, DM, DM, (bf16*)(wl + WL_WNSA), 0, r, scr, lane); continue; } r -= SEG_ITEMS[7];
        if (r < SEG_ITEMS[8]) { seg_item(P.w_out + (size_t)l * DM * DM, DM, 0, DM, DM, (bf16*)(wl + WL_WOUT), 0, r, scr, lane); continue; } r -= SEG_ITEMS[8];
        if (r < SEG_ITEMS[9]) { seg_item(P.w_up + (size_t)l * DM * FF, FF, 0, FF, DM, (bf16*)(wl + WL_WUP), 0, r, scr, lane); continue; } r -= SEG_ITEMS[9];
        seg_item(P.w_down + (size_t)l * FF * DM, DM, 0, DM, FF, (bf16*)(wl + WL_WDOWN), 0, r, scr, lane);
    }
    for (int it = gw; it < DEPTH * 2 * W2T_ITEMS; it += NGW) {
        const int m = it / W2T_ITEMS, r = it % W2T_ITEMS;
        seg_item(P.cmp_w2 + (size_t)m * 256 * 128, 128, 0, 128, 256, (bf16*)(P.ws + WS_W2T) + (size_t)m * 128 * 256, 0, r, scr, lane);
    }
    __syncthreads();
    {
        float* cosT = (float*)(P.ws + WS_COS); float* sinT = (float*)(P.ws + WS_SIN);
        for (int e = vcu * 512 + tid; e < S * 16; e += G * 512) {
            const int t = e >> 4, i = e & 15; float sn, cs; sincos_f64((double)P.pos[t] * ROPE_INVF[i], sn, cs); cosT[e] = cs; sinT[e] = sn;
        }
    }
    {
        LAS float* cact = (LAS float*)lds;
        for (int k = tid; k < DM; k += 512) { const float cv = P.c[k]; cact[k] = cv * sigm(cv); }
        __syncthreads();
        float* modp = (float*)(P.ws + WS_MODP);
        for (int e = vcu * 512 + tid; e < DEPTH * 8 * (6 * DM / 4); e += G * 512) {
            const int l = e / (8 * 3072), rem = e % (8 * 3072), kc = rem / 3072, c4 = rem % 3072;
            const float* w = P.ada_w + ((size_t)l * DM + kc * 256) * (6 * DM) + c4 * 4;
            f32x4 acc = {0.f, 0.f, 0.f, 0.f};
#pragma unroll 8
            for (int k = 0; k < 256; ++k) { const f32x4 wv = *(const f32x4*)(w + (size_t)k * (6 * DM)); acc += wv * cact[kc * 256 + k]; }
            *(f32x4*)(modp + ((size_t)(l * 8 + kc) * (6 * DM)) + c4 * 4) = acc;
        }
        __syncthreads();
    }
    for (int w = vcu; w < DEPTH * 2 * 32; w += G) {
        const int m = w >> 5, ch = w & 31;
        if (tid < 256) {
            const float* pe = P.cmp_pe + (size_t)m * 4096 + ch * 128; const float* w1 = P.cmp_w1 + ((size_t)m * 4096 + ch * 128) * 256 + tid;
            float acc = 0.f;
#pragma unroll 8
            for (int k = 0; k < 128; ++k) acc += pe[k] * w1[(size_t)k * 256];
            ((float*)(P.ws + WS_B1PART))[(size_t)w * 256 + tid] = acc;
        }
    }
}

__device__ __forceinline__ f32x4 modvec4(const Ptrs& P, int l, int off) {
    f32x4 v = *(const f32x4*)(P.ada_b + (size_t)l * 6 * DM + off);
    const float* mp = (const float*)(P.ws + WS_MODP) + (size_t)l * 8 * 6 * DM + off;
#pragma unroll
    for (int kc = 0; kc < 8; ++kc) v += *(const f32x4*)(mp + (size_t)kc * 6 * DM);
    return v;
}

template <bool HAS_Y>
__device__ __forceinline__ void resid_phase(const Ptrs& P, LAS unsigned char* lds, const void* xsrc_, const bool src_bf, void* xdst_, const bool dst_bf, const bf16* Y, bf16* H, const bool make_h,
                                            int lg, int gate_k, int gainA, int lh, int sc_k, int sh_k, int gainB, int vcu, int G, int wave, int lane, int tid) {
    LAS f32x4* vga = (LAS f32x4*)lds; LAS f32x4* vhb = vga + 512; LAS f32x4* vhc = vhb + 512;
    {
        const int c = 4 * tid;
        if (HAS_Y) vga[tid] = modvec4(P, lg, gate_k * DM + c) * *(const f32x4*)(P.gains + (size_t)(lg * 4 + gainA) * DM + c);
        if (make_h) { vhb[tid] = *(const f32x4*)(P.gains + (size_t)(lh * 4 + gainB) * DM + c) * (modvec4(P, lh, sc_k * DM + c) + 1.0f); vhc[tid] = modvec4(P, lh, sh_k * DM + c); }
    }
    __syncthreads();
    const int gw = vcu * NWAVES + wave, NGW = G * NWAVES;
    for (int m = gw; m < S; m += NGW) {
        f32x4 xv[8];
        if (src_bf) { const u32x2* xr = (const u32x2*)((const bf16*)xsrc_ + (size_t)m * DM) + lane;
#pragma unroll
            for (int j = 0; j < 8; ++j) { const u32x2 w = xr[64 * j]; xv[j] = (f32x4){bf_lo(w.x), bf_hi(w.x), bf_lo(w.y), bf_hi(w.y)}; }
        } else { const f32x4* xr = (const f32x4*)((const float*)xsrc_ + (size_t)m * DM) + lane;
#pragma unroll
            for (int j = 0; j < 8; ++j) xv[j] = xr[64 * j]; }
        if (HAS_Y) {
            f32x4 yv[8]; float s = 0.f;
            const u32x2* yr = (const u32x2*)(Y + (size_t)m * DM) + lane;
#pragma unroll
            for (int j = 0; j < 8; ++j) { const u32x2 w = yr[64 * j]; yv[j] = (f32x4){bf_lo(w.x), bf_hi(w.x), bf_lo(w.y), bf_hi(w.y)}; s += (yv[j].x * yv[j].x + yv[j].y * yv[j].y) + (yv[j].z * yv[j].z + yv[j].w * yv[j].w); }
            const float r = 1.0f / sqrtf(wave_sum(s) * (1.0f / DM) + NORM_EPS);
#pragma unroll
            for (int j = 0; j < 8; ++j) xv[j] += vga[lane + 64 * j] * (yv[j] * r);
            if (dst_bf) { u32x2* xo = (u32x2*)((bf16*)xdst_ + (size_t)m * DM) + lane;
#pragma unroll
                for (int j = 0; j < 8; ++j) { u32x2 w; w.x = pk2(xv[j].x, xv[j].y); w.y = pk2(xv[j].z, xv[j].w); xo[64 * j] = w;
                    xv[j] = (f32x4){bf_lo(w.x), bf_hi(w.x), bf_lo(w.y), bf_hi(w.y)}; }
            } else { f32x4* xo = (f32x4*)((float*)xdst_ + (size_t)m * DM) + lane;
#pragma unroll
                for (int j = 0; j < 8; ++j) xo[64 * j] = xv[j]; }
        }
        if (make_h) {
            float s = 0.f;
#pragma unroll
            for (int j = 0; j < 8; ++j) s += (xv[j].x * xv[j].x + xv[j].y * xv[j].y) + (xv[j].z * xv[j].z + xv[j].w * xv[j].w);
            const float r = 1.0f / sqrtf(wave_sum(s) * (1.0f / DM) + NORM_EPS);
            u32x2* ho = (u32x2*)(H + (size_t)m * DM) + lane;
#pragma unroll
            for (int j = 0; j < 8; ++j) { const f32x4 h = (xv[j] * r) * vhb[lane + 64 * j] + vhc[lane + 64 * j]; u32x2 w; w.x = pk2(h.x, h.y); w.y = pk2(h.z, h.w); ho[64 * j] = w; }
        }
    }
    __syncthreads();
}

__device__ __forceinline__ void rope8(float (&v)[8], const float (&p)[8], const float* cs, const float* sn, int ch  ) {
#pragma unroll
    for (int j = 0; j < 8; ++j) { const float c = cs[8 * (ch & 1) + j], s = sn[8 * (ch & 1) + j];
        v[j] = (ch < 2) ? (v[j] * c - p[j] * s) : (v[j] * c + p[j] * s); }
}
__device__ __forceinline__ void relayout_phase(const Ptrs& P, int l, LAS unsigned char* lds, int vcu, int G, int tid) {
    const bf16* Pm = (const bf16*)(P.ws + WS_P);
    const float* cosT = (const float*)(P.ws + WS_COS); const float* sinT = (const float*)(P.ws + WS_SIN);
    if (vcu == 0) {
        const float* part = (const float*)(P.ws + WS_B1PART) + (size_t)l * 2 * 32 * 256;
        const int kv = tid >> 8, col = tid & 255; float a = P.cmp_b1[(size_t)(l * 2 + kv) * 256 + col];
        for (int ch = 0; ch < 32; ++ch) a += part[(size_t)(kv * 32 + ch) * 256 + col];
        ((float*)(P.ws + WS_B1P))[tid] = a;
    }
    for (int b = vcu; b < S / 64; b += G) {
        const int t0 = b * 64;
        {
            const float* cw = P.conv_w + (size_t)l * 3 * CWID; bf16* CV = (bf16*)(P.ws + WS_CV);
            for (int e = tid; e < 64 * 128; e += 512) {
                const int tl = e >> 7, c8 = (e & 127) * 8, t = t0 + tl;
                float z[8] = {0.f, 0.f, 0.f, 0.f, 0.f, 0.f, 0.f, 0.f};
#pragma unroll
                for (int k = 0; k < 3; ++k) { const int tt = t - 2 + k;
                    if (tt >= 0) { float cg[8], xa[8]; unpack8(*(const u32x4*)(Pm + (size_t)tt * PW + C_CG + c8), cg); unpack8(*(const u32x4*)(Pm + (size_t)tt * PW + C_XA + c8), xa);
                        const f32x4 w0 = *(const f32x4*)(cw + k * CWID + c8), w1 = *(const f32x4*)(cw + k * CWID + c8 + 4);
#pragma unroll
                        for (int j = 0; j < 8; ++j) z[j] += (j < 4 ? w0[j] : w1[j - 4]) * (cg[j] * xa[j]); } }
                float bg[8]; unpack8(*(const u32x4*)(Pm + (size_t)t * PW + C_BG + c8), bg);
#pragma unroll
                for (int j = 0; j < 8; ++j) z[j] *= bg[j];
                *(u32x4*)(CV + (size_t)t * CWID + c8) = pack8(z);
            }
        }
        {
            bf16* QP = (bf16*)(P.ws + WS_QP);
            for (int e = tid; e < 64 * 256; e += 512) {
                const int tl = e >> 8, hh = (e >> 4) & 15, ch = e & 15, t = t0 + tl;
                const bf16* src = Pm + (size_t)t * PW + C_Q + hh * HD;
                float v[8]; unpack8(*(const u32x4*)(src + 8 * ch), v);
                if (ch < 4) { float p[8]; unpack8(*(const u32x4*)(src + 8 * (ch ^ 2)), p); rope8(v, p, cosT + (size_t)t * 16, sinT + (size_t)t * 16, ch); }
#pragma unroll
                for (int j = 0; j < 8; ++j) v[j] *= QSCALE;
                *(u32x4*)(QP + (size_t)t * DM + hh * HD + 8 * ch) = pack8(v);
            }
        }
        for (int e = tid; e < 4 * 4 * 64 * 16; e += 512) {
            const int pi = e >> 12, g = (e >> 10) & 3, kap = (e >> 4) & 63, ch = e & 15, t = t0 + kap;
            const int part = (pi == 0) ? 0 : (pi == 1) ? 2 : (pi == 2) ? 4 : 1;
            const bf16* src = Pm + (size_t)t * PW + C_KV + part * 512 + g * HD;
            float v[8]; unpack8(*(const u32x4*)(src + 8 * ch), v);
            if (part != 1 && ch < 4) { float p[8]; unpack8(*(const u32x4*)(src + 8 * (ch ^ 2)), p); rope8(v, p, cosT + (size_t)t * 16, sinT + (size_t)t * 16, ch); }
            const u32x4 w = pack8(v);
            if (part == 0) *(u32x4*)((bf16*)(P.ws + WS_KCR) + ((size_t)g * S + t) * HD + 8 * ch) = w;
            else if (part == 1) *(u32x4*)((bf16*)(P.ws + WS_VCR) + ((size_t)g * S + t) * HD + 8 * ch) = w;
            else { unsigned char* img = P.ws + (part == 2 ? WS_KSI : WS_KWI) + ((size_t)g * 256 + b) * 16384; *(u32x4*)(img + kimg_off(kap, ch)) = w; }
        }
        for (int vp = 0; vp < 2; ++vp) {
            const int part = 3 + 2 * vp;
            LAS unsigned short* tile = (LAS unsigned short*)lds;
            for (int e = tid; e < 4 * 64 * 16; e += 512) {
                const int g = e >> 10, kap = (e >> 4) & 63, ch = e & 15;
                const u32x4 w = *(const u32x4*)(Pm + (size_t)(t0 + kap) * PW + C_KV + part * 512 + g * HD + 8 * ch);
                *(LAS u32x4*)(tile + (g * 64 + kap) * 136 + 8 * ch) = w;
            }
            __syncthreads();
            for (int e = tid; e < 4 * 128 * 8; e += 512) {
                const int g = e >> 10, d = (e >> 3) & 127, kc = e & 7;
                const LAS unsigned short* s = tile + (g * 64 + 8 * kc) * 136 + d;
                u32x4 w; w.x = (unsigned)s[0] | ((unsigned)s[136] << 16); w.y = (unsigned)s[2 * 136] | ((unsigned)s[3 * 136] << 16);
                w.z = (unsigned)s[4 * 136] | ((unsigned)s[5 * 136] << 16); w.w = (unsigned)s[6 * 136] | ((unsigned)s[7 * 136] << 16);
                unsigned char* img = P.ws + (part == 3 ? WS_VSI : WS_VWI) + ((size_t)g * 256 + b) * 16384;
                *(u32x4*)(img + vimg_off(d, kc)) = w;
            }
            __syncthreads();
        }
        {
            float* GT = (float*)(P.ws + WS_GT);
            const bf16* Hb = (const bf16*)(P.ws + WS_H); const bf16* Wg = (const bf16*)(P.ws + WS_WL + (size_t)l * WL_BYTES + WL_WIN) + (size_t)C_GN * DM;
            const int wv = tid >> 6, ln = tid & 63, r16 = ln & 15, q4 = ln >> 4, rt = wv & 3, ct0 = (wv < 4) ? 0 : 2, nct = (wv < 4) ? 2 : 1;
            f32x4 acc[2] = {(f32x4){0.f, 0.f, 0.f, 0.f}, (f32x4){0.f, 0.f, 0.f, 0.f}};
            const bf16* ap = Hb + (size_t)(t0 + rt * 16 + r16) * DM + 8 * q4;
            const bf16* bp0 = Wg + (size_t)(ct0 * 16 + r16) * DM + 8 * q4; const bf16* bp1 = bp0 + (size_t)16 * DM;
#pragma unroll 4
            for (int ks = 0; ks < DM / 32; ++ks) {
                const bf16x8 af = *(const bf16x8*)(ap + 32 * ks);
                acc[0] = __builtin_amdgcn_mfma_f32_16x16x32_bf16(af, *(const bf16x8*)(bp0 + 32 * ks), acc[0], 0, 0, 0);
                if (nct == 2) acc[1] = __builtin_amdgcn_mfma_f32_16x16x32_bf16(af, *(const bf16x8*)(bp1 + 32 * ks), acc[1], 0, 0, 0);
            }
#pragma unroll
            for (int c = 0; c < 2; ++c) if (c < nct) {
#pragma unroll
                for (int i = 0; i < 4; ++i) GT[(size_t)(t0 + rt * 16 + 4 * q4 + i) * 48 + (ct0 + c) * 16 + r16] = sigm(acc[c][i]); }
        }
    }
}

__device__ __forceinline__ void cmp2_phase(const Ptrs& P, int l, int vcu, int G, int wave, int lane) {
    const int r16 = lane & 15, q = lane >> 4;
    for (int e = vcu; e < 128; e += G) {
        const int kv = e >> 6, g = (e >> 4) & 3, blk = e & 15;
        const bf16* HC = (const bf16*)(P.ws + WS_HC) + ((size_t)kv * 4096 + g * 1024 + blk * 64) * 256;
        const bf16* W2T = (const bf16*)(P.ws + WS_W2T) + (size_t)(l * 2 + kv) * 128 * 256;
        const float* b2 = P.cmp_b2 + (size_t)(l * 2 + kv) * 128;
        const int rt = wave & 3, ch = wave >> 2;
        bf16x8 af[8];
#pragma unroll
        for (int ks = 0; ks < 8; ++ks) af[ks] = *(const bf16x8*)(HC + (size_t)(rt * 16 + r16) * 256 + 32 * ks + 8 * q);
        unsigned char* img = P.ws + (kv == 0 ? WS_KCI : WS_VCI) + ((size_t)g * 16 + blk) * 16384;
#pragma unroll
        for (int ct = 0; ct < 4; ++ct) {
            const int n = ch * 64 + ct * 16 + r16;
            f32x4 acc = {0.f, 0.f, 0.f, 0.f};
#pragma unroll
            for (int ks = 0; ks < 8; ++ks) { const bf16x8 bfr = *(const bf16x8*)(W2T + (size_t)n * 256 + 32 * ks + 8 * q);
                acc = __builtin_amdgcn_mfma_f32_16x16x32_bf16(af[ks], bfr, acc, 0, 0, 0); }
            const float bb = b2[n];
            if (kv == 0) {
#pragma unroll
                for (int i = 0; i < 4; ++i) { const int kap = rt * 16 + 4 * q + i; *(bf16*)(img + kimg_off(kap, n >> 3) + (n & 7) * 2) = (bf16)f2bf(acc[i] + bb); }
            } else {
                const int kap0 = rt * 16 + 4 * q; u32x2 w; w.x = pk2(acc[0] + bb, acc[1] + bb); w.y = pk2(acc[2] + bb, acc[3] + bb);
                *(u32x2*)(img + vimg_off(n, kap0 >> 3) + (kap0 & 7) * 2) = w;
            }
        }
    }
}

#ifndef DBG_REP_SEL
#define DBG_REP_SEL 1
#endif
#ifndef DBG_BR
#define DBG_BR 7
#endif
#ifndef DBG_SANITIZE
#define DBG_SANITIZE 0
#endif
#ifndef DBG_DENSE_SEL
#define DBG_DENSE_SEL 0
#endif
struct AttnLane { unsigned kb, vb; int kx, vx; int q; };
#define AL_KOFF(L_, s_) ((L_).kb + 64u * (unsigned)((s_) ^ (L_).kx))
#define AL_VOFF(L_, a_) ((L_).vb + 64u * (unsigned)((a_) ^ (L_).vx))

__device__ __forceinline__ bf16x8 pack_p(const f32x4 a, const f32x4 b) {
    u32x4 w; w.x = pg8::cvt_pk_bf16(a[0], a[1]); w.y = pg8::cvt_pk_bf16(a[2], a[3]); w.z = pg8::cvt_pk_bf16(b[0], b[1]); w.w = pg8::cvt_pk_bf16(b[2], b[3]);
    return __builtin_bit_cast(bf16x8, w);
}
__device__ __forceinline__ void lds_fadd(LAS float* p, float v) { (void)__hip_atomic_fetch_add(p, v, __ATOMIC_RELAXED, __HIP_MEMORY_SCOPE_WORKGROUP); }
template <int CTRL> __device__ __forceinline__ unsigned dpp_u_(unsigned v) { return (unsigned)__builtin_amdgcn_update_dpp(0, (int)v, CTRL, 0xF, 0xF, false); }
__device__ __forceinline__ unsigned wave_umax(unsigned v) {
    v = max(v, dpp_u_<0xB1>(v)); v = max(v, dpp_u_<0x4E>(v)); v = max(v, dpp_u_<0x141>(v)); v = max(v, dpp_u_<0x140>(v));
    auto r16 = __builtin_amdgcn_permlane16_swap(v, v, false, false); v = max(r16[0], r16[1]);
    auto r32 = __builtin_amdgcn_permlane32_swap(v, v, false, false); return max(r32[0], r32[1]);
}
__device__ __forceinline__ unsigned wave_umin(unsigned v) {
    v = min(v, dpp_u_<0xB1>(v)); v = min(v, dpp_u_<0x4E>(v)); v = min(v, dpp_u_<0x141>(v)); v = min(v, dpp_u_<0x140>(v));
    auto r16 = __builtin_amdgcn_permlane16_swap(v, v, false, false); v = min(r16[0], r16[1]);
    auto r32 = __builtin_amdgcn_permlane32_swap(v, v, false, false); return min(r32[0], r32[1]);
}
__device__ __forceinline__ float quad_sum(float v) {
    v += __builtin_bit_cast(float, __builtin_amdgcn_update_dpp(0, __builtin_bit_cast(int, v), 0xB1, 0xF, 0xF, false));
    v += __builtin_bit_cast(float, __builtin_amdgcn_update_dpp(0, __builtin_bit_cast(int, v), 0x4E, 0xF, 0xF, false));
    return v;
}
__device__ __forceinline__ void ldsr128(bf16x8& d, unsigned addr) { asm volatile("ds_read_b128 %0, %1" : "=v"(d) : "v"(addr)); }
__device__ __forceinline__ void ldsr128o(bf16x8& d, unsigned addr, const int off) { asm volatile("ds_read_b128 %0, %1 offset:%2" : "=v"(d) : "v"(addr), "i"(off)); }
#define LDS_WAIT4(n, a, b, c, d) asm volatile("s_waitcnt lgkmcnt(" #n ")" : "+v"(a), "+v"(b), "+v"(c), "+v"(d))
template <bool T0, bool T1, int MODE>
__device__ __forceinline__ void block_step(LAS const unsigned char* Kb, LAS const unsigned char* Vb, const AttnLane& L, const bf16x8 (&qf)[2][4],
                                           f32x4 (&O)[2][8], float (&m)[2], float (&l)[2], const int (&limq)[2], const unsigned W,
                                           const float (&invl)[2], LAS float* const (&improw)[2], const int j0, const bool hzero, const bool MASKB) {
    AttnLane Lq = L; asm volatile("" : "+v"(Lq.kb), "+v"(Lq.vb));
    f32x4 st[2][4];
    const f32x4 z = {0.f, 0.f, 0.f, 0.f};
    {
        __builtin_amdgcn_s_setprio(1);
        const unsigned kbase = (unsigned)(uintptr_t)Kb;
        unsigned ka[4];
#pragma unroll
        for (int s = 0; s < 4; ++s) ka[s] = kbase + AL_KOFF(Lq, s);
        bf16x8 fa[4], fb[4];
#pragma unroll
        for (int s = 0; s < 4; ++s) ldsr128(fa[s], ka[s]);
#pragma unroll
        for (int kt = 0; kt < 4; ++kt) {
            if (kt < 3) {
#pragma unroll
                for (int s = 0; s < 4; ++s) { if ((kt & 1) == 0) ldsr128o(fb[s], ka[s], (kt + 1) * 4096); else ldsr128o(fa[s], ka[s], (kt + 1) * 4096); }
            }
            if ((kt & 1) == 0) { if (kt < 3) LDS_WAIT4(4, fa[0], fa[1], fa[2], fa[3]); else LDS_WAIT4(0, fa[0], fa[1], fa[2], fa[3]); }
            else               { if (kt < 3) LDS_WAIT4(4, fb[0], fb[1], fb[2], fb[3]); else LDS_WAIT4(0, fb[0], fb[1], fb[2], fb[3]); }
#pragma unroll
            for (int s = 0; s < 4; ++s) { const bf16x8 a = ((kt & 1) == 0) ? fa[s] : fb[s];
                if (T0) st[0][kt] = __builtin_amdgcn_mfma_f32_16x16x32_bf16(a, qf[0][s], s == 0 ? z : st[0][kt], 0, 0, 0);
                if (T1) st[1][kt] = __builtin_amdgcn_mfma_f32_16x16x32_bf16(a, qf[1][s], s == 0 ? z : st[1][kt], 0, 0, 0); }
        }
    }
    __builtin_amdgcn_s_setprio(0);
    bf16x8 pf[2][2];
#pragma unroll
    for (int ts = 0; ts < 2; ++ts) {
        if (!(ts == 0 ? T0 : T1)) continue;
        const float NEG = -__builtin_inff();
        if (MASKB) {
#pragma unroll
        for (int kt = 0; kt < 4; ++kt)
#pragma unroll
            for (int i = 0; i < 4; ++i) { const int kc = 32 * (kt >> 1) + 4 * (kt & 1) + i; if ((unsigned)(limq[ts] - kc) >= W) st[ts][kt][i] = NEG; }
        }
        if (MODE != 1) {
            float mx = fmaxf(fmaxf(st[ts][0][0], st[ts][0][1]), fmaxf(st[ts][0][2], st[ts][0][3]));
#pragma unroll
            for (int kt = 1; kt < 4; ++kt) mx = fmaxf(mx, fmaxf(fmaxf(st[ts][kt][0], st[ts][kt][1]), fmaxf(st[ts][kt][2], st[ts][kt][3])));
            { auto r16 = __builtin_amdgcn_permlane16_swap(__float_as_uint(mx), __float_as_uint(mx), false, false); mx = fmaxf(__uint_as_float(r16[0]), __uint_as_float(r16[1]));
              auto r32 = __builtin_amdgcn_permlane32_swap(__float_as_uint(mx), __float_as_uint(mx), false, false); mx = fmaxf(__uint_as_float(r32[0]), __uint_as_float(r32[1])); }
            const float mn = fmaxf(m[ts], mx), alpha = __builtin_amdgcn_exp2f(m[ts] - mn); m[ts] = mn;
            float sum = 0.f;
#pragma unroll
            for (int kt = 0; kt < 4; ++kt)
#pragma unroll
                for (int i = 0; i < 4; ++i) { const float pv = __builtin_amdgcn_exp2f(st[ts][kt][i] - mn); st[ts][kt][i] = pv; sum += pv; }
            l[ts] = l[ts] * alpha + sum;
            if (MODE == 2) {
#pragma unroll
                for (int dt = 0; dt < 8; ++dt) O[ts][dt] *= alpha;
            }
        } else {
#pragma unroll
            for (int kt = 0; kt < 4; ++kt)
#pragma unroll
                for (int i = 0; i < 4; ++i) st[ts][kt][i] = __builtin_amdgcn_exp2f(st[ts][kt][i] - m[ts]) * invl[ts];
            float A[4], B[4];
#pragma unroll
            for (int kt = 0; kt < 4; ++kt) { B[kt] = 0.5f * st[ts][kt][3]; A[kt] = quad_sum((st[ts][kt][0] + st[ts][kt][1]) + (st[ts][kt][2] + B[kt])); B[kt] = quad_sum(B[kt]); }
            if (hzero) { LAS float* ir = improw[ts] + j0;
                lds_fadd(ir + 0, A[0]); lds_fadd(ir + 1, B[0] + A[1]); lds_fadd(ir + 2, B[1]); lds_fadd(ir + 8, A[2]); lds_fadd(ir + 9, B[2] + A[3]); lds_fadd(ir + 10, B[3]); }
        }
        if (MODE != 0) { pf[ts][0] = pack_p(st[ts][0], st[ts][1]); pf[ts][1] = pack_p(st[ts][2], st[ts][3]); }
    }
    if (MODE != 0) {
        __builtin_amdgcn_s_setprio(1);
        const unsigned vbase = (unsigned)(uintptr_t)Vb;
        unsigned va[2];
#pragma unroll
        for (int a = 0; a < 2; ++a) va[a] = vbase + AL_VOFF(Lq, a);
        bf16x8 fa[4], fb[4];
#pragma unroll
        for (int j = 0; j < 4; ++j) ldsr128o(fa[j], va[j & 1], (j >> 1) * 2048);
#pragma unroll
        for (int dp = 0; dp < 4; ++dp) {
            if (dp < 3) {
#pragma unroll
                for (int j = 0; j < 4; ++j) { if ((dp & 1) == 0) ldsr128o(fb[j], va[j & 1], (2 * (dp + 1) + (j >> 1)) * 2048); else ldsr128o(fa[j], va[j & 1], (2 * (dp + 1) + (j >> 1)) * 2048); }
            }
            if ((dp & 1) == 0) { if (dp < 3) LDS_WAIT4(4, fa[0], fa[1], fa[2], fa[3]); else LDS_WAIT4(0, fa[0], fa[1], fa[2], fa[3]); }
            else               { if (dp < 3) LDS_WAIT4(4, fb[0], fb[1], fb[2], fb[3]); else LDS_WAIT4(0, fb[0], fb[1], fb[2], fb[3]); }
#pragma unroll
            for (int j = 0; j < 4; ++j) { const bf16x8 v = ((dp & 1) == 0) ? fa[j] : fb[j]; const int dt = 2 * dp + (j >> 1), a = j & 1;
                if (T0) O[0][dt] = __builtin_amdgcn_mfma_f32_16x16x32_bf16(v, pf[0][a], O[0][dt], 0, 0, 0);
                if (T1) O[1][dt] = __builtin_amdgcn_mfma_f32_16x16x32_bf16(v, pf[1][a], O[1][dt], 0, 0, 0); }
        }
        __builtin_amdgcn_s_setprio(0);
    }
}


constexpr float ATT_THR = 8.0f;
__device__ __forceinline__ float max3f_(float a, float b, float c) { return fmaxf(fmaxf(a, b), c); }
template <bool T0, bool T1>
__device__ __forceinline__ void step_online(LAS const unsigned char* Kb, LAS const unsigned char* Vb, const AttnLane& L, const bf16x8 (&qf)[2][4],
                                            f32x4 (&O)[2][8], float (&mref)[2], float (&l)[2], const int (&limq)[2], const unsigned W, const bool MASK, const bool START) {
    AttnLane Lq = L; asm volatile("" : "+v"(Lq.kb), "+v"(Lq.vb));
    f32x4 st[2][4];
    const float NEG = -__builtin_inff();
#pragma unroll
    for (int ts = 0; ts < 2; ++ts) { const float c0 = START ? 0.f : (limq[ts] > -500 ? -mref[ts] : NEG);
#pragma unroll
        for (int kt = 0; kt < 4; ++kt) st[ts][kt] = (f32x4){c0, c0, c0, c0}; }
    {
        __builtin_amdgcn_s_setprio(1);
        const unsigned kbase = (unsigned)(uintptr_t)Kb;
        unsigned ka[4];
#pragma unroll
        for (int s = 0; s < 4; ++s) ka[s] = kbase + AL_KOFF(Lq, s);
        bf16x8 fa[4], fb[4];
#pragma unroll
        for (int s = 0; s < 4; ++s) ldsr128(fa[s], ka[s]);
#pragma unroll
        for (int kt = 0; kt < 4; ++kt) {
            if (kt < 3) {
#pragma unroll
                for (int s = 0; s < 4; ++s) { if ((kt & 1) == 0) ldsr128o(fb[s], ka[s], (kt + 1) * 4096); else ldsr128o(fa[s], ka[s], (kt + 1) * 4096); }
            }
            if ((kt & 1) == 0) { if (kt < 3) LDS_WAIT4(4, fa[0], fa[1], fa[2], fa[3]); else LDS_WAIT4(0, fa[0], fa[1], fa[2], fa[3]); }
            else               { if (kt < 3) LDS_WAIT4(4, fb[0], fb[1], fb[2], fb[3]); else LDS_WAIT4(0, fb[0], fb[1], fb[2], fb[3]); }
#pragma unroll
            for (int s = 0; s < 4; ++s) { const bf16x8 a = ((kt & 1) == 0) ? fa[s] : fb[s];
                if (T0) st[0][kt] = __builtin_amdgcn_mfma_f32_16x16x32_bf16(a, qf[0][s], st[0][kt], 0, 0, 0);
                if (T1) st[1][kt] = __builtin_amdgcn_mfma_f32_16x16x32_bf16(a, qf[1][s], st[1][kt], 0, 0, 0); }
        }
    }
    __builtin_amdgcn_s_setprio(0);
    __builtin_amdgcn_sched_barrier(0);
    bf16x8 pf[2][2];
#pragma unroll
    for (int ts = 0; ts < 2; ++ts) {
        if (!(ts == 0 ? T0 : T1)) continue;
        if (MASK || START) {
#pragma unroll
            for (int kt = 0; kt < 4; ++kt)
#pragma unroll
                for (int i = 0; i < 4; ++i) { const int kc = 32 * (kt >> 1) + 4 * (kt & 1) + i; if ((unsigned)(limq[ts] - kc) >= W) st[ts][kt][i] = NEG; }
        }
        float mx = max3f_(st[ts][0][0], st[ts][0][1], st[ts][0][2]);
        mx = max3f_(mx, st[ts][0][3], st[ts][1][0]); mx = max3f_(mx, st[ts][1][1], st[ts][1][2]); mx = max3f_(mx, st[ts][1][3], st[ts][2][0]);
        mx = max3f_(mx, st[ts][2][1], st[ts][2][2]); mx = max3f_(mx, st[ts][2][3], st[ts][3][0]); mx = max3f_(mx, st[ts][3][1], st[ts][3][2]); mx = fmaxf(mx, st[ts][3][3]);
#define XLANE_MAX_(v_) do { auto r16 = __builtin_amdgcn_permlane16_swap(__float_as_uint(v_), __float_as_uint(v_), false, false); v_ = fmaxf(__uint_as_float(r16[0]), __uint_as_float(r16[1])); \
          auto r32 = __builtin_amdgcn_permlane32_swap(__float_as_uint(v_), __float_as_uint(v_), false, false); v_ = fmaxf(__uint_as_float(r32[0]), __uint_as_float(r32[1])); } while (0)
        if (START) {
            XLANE_MAX_(mx);
            const float m0 = fmaxf(mx, -1.0e4f); mref[ts] = m0;
#pragma unroll
            for (int kt = 0; kt < 4; ++kt) st[ts][kt] -= m0;
        } else if (__builtin_expect(__any(mx > ATT_THR), 0)) {
            XLANE_MAX_(mx);
            const float dl = fmaxf(mx, 0.f), f = __builtin_amdgcn_exp2f(-dl); mref[ts] += dl; l[ts] *= f;
#pragma unroll
            for (int kt = 0; kt < 4; ++kt) st[ts][kt] -= dl;
#pragma unroll
            for (int dt = 0; dt < 8; ++dt) O[ts][dt] *= f;
        }
#pragma unroll
        for (int kt = 0; kt < 4; ++kt)
#pragma unroll
            for (int i = 0; i < 4; ++i) st[ts][kt][i] = __builtin_amdgcn_exp2f(st[ts][kt][i]);
        pf[ts][0] = pack_p(st[ts][0], st[ts][1]); pf[ts][1] = pack_p(st[ts][2], st[ts][3]);
        __builtin_amdgcn_sched_barrier(0);
    }
    {
        __builtin_amdgcn_s_setprio(1);
        const unsigned vbase = (unsigned)(uintptr_t)Vb;
        unsigned va[2];
#pragma unroll
        for (int a = 0; a < 2; ++a) va[a] = vbase + AL_VOFF(Lq, a);
        bf16x8 fa[4], fb[4];
#pragma unroll
        for (int j = 0; j < 4; ++j) ldsr128o(fa[j], va[j & 1], (j >> 1) * 2048);
#pragma unroll
        for (int dp = 0; dp < 4; ++dp) {
            if (dp < 3) {
#pragma unroll
                for (int j = 0; j < 4; ++j) { if ((dp & 1) == 0) ldsr128o(fb[j], va[j & 1], (2 * (dp + 1) + (j >> 1)) * 2048); else ldsr128o(fa[j], va[j & 1], (2 * (dp + 1) + (j >> 1)) * 2048); }
            }
            if ((dp & 1) == 0) { if (dp < 3) LDS_WAIT4(4, fa[0], fa[1], fa[2], fa[3]); else LDS_WAIT4(0, fa[0], fa[1], fa[2], fa[3]); }
            else               { if (dp < 3) LDS_WAIT4(4, fb[0], fb[1], fb[2], fb[3]); else LDS_WAIT4(0, fb[0], fb[1], fb[2], fb[3]); }
#pragma unroll
            for (int j = 0; j < 4; ++j) { const bf16x8 v = ((dp & 1) == 0) ? fa[j] : fb[j]; const int dt = 2 * dp + (j >> 1), a = j & 1;
                if (T0) O[0][dt] = __builtin_amdgcn_mfma_f32_16x16x32_bf16(v, pf[0][a], O[0][dt], 0, 0, 0);
                if (T1) O[1][dt] = __builtin_amdgcn_mfma_f32_16x16x32_bf16(v, pf[1][a], O[1][dt], 0, 0, 0); }
        }
        { const short one_ = (short)0x3F80; const bf16x8 ones = {one_, one_, one_, one_, one_, one_, one_, one_}; const f32x4 z4 = {0.f, 0.f, 0.f, 0.f};
          if (T0) { f32x4 bs = __builtin_amdgcn_mfma_f32_16x16x32_bf16(ones, pf[0][0], z4, 0, 0, 0); bs = __builtin_amdgcn_mfma_f32_16x16x32_bf16(ones, pf[0][1], bs, 0, 0, 0); l[0] += bs[0]; }
          if (T1) { f32x4 bs = __builtin_amdgcn_mfma_f32_16x16x32_bf16(ones, pf[1][0], z4, 0, 0, 0); bs = __builtin_amdgcn_mfma_f32_16x16x32_bf16(ones, pf[1][1], bs, 0, 0, 0); l[1] += bs[0]; } }
        __builtin_amdgcn_s_setprio(0);
    }
    __builtin_amdgcn_sched_barrier(0);
}
__device__ __forceinline__ void glds16(const void* gsrc, unsigned lds_dst) { unsigned keep;
    asm volatile("s_mov_b32 %0, m0\n\ts_mov_b32 m0, %2\n\ts_nop 0\n\tglobal_load_lds_dwordx4 %1, off\n\ts_mov_b32 m0, %0" : "=&s"(keep) : "v"(gsrc), "s"(lds_dst) : "memory"); }

__device__ __forceinline__ void glds16s(const void* sbase, unsigned voff, unsigned lds_dst) { unsigned keep;
    asm volatile("s_mov_b32 %0, m0\n\ts_mov_b32 m0, %3\n\ts_nop 0\n\tglobal_load_lds_dwordx4 %1, %2\n\ts_mov_b32 m0, %0" : "=&s"(keep) : "v"(voff), "s"(sbase), "s"(lds_dst) : "memory"); }

#define AT_BAR() do { asm volatile("s_waitcnt lgkmcnt(0)" ::: "memory"); __builtin_amdgcn_s_barrier(); asm volatile("" ::: "memory"); } while (0)
#define AT_STAGE(gsrc, ldsoff) do { unsigned _lo = (unsigned)lane * 16u; asm volatile("" : "+v"(_lo)); _Pragma("unroll") for (int _p = 0; _p < 2; ++_p) \
    glds16s((gsrc) + (_p * 8 + wave) * 1024, _lo, (unsigned)__builtin_amdgcn_readfirstlane((int)(ldsb + (unsigned)(ldsoff) + (unsigned)(_p * 8 + wave) * 1024u))); } while (0)
#define AT_WAITV(n) asm volatile("s_waitcnt vmcnt(" #n ")" ::: "memory")

__device__ __forceinline__ void attn_phase(const Ptrs& P, LAS unsigned char* lds, int vcu, int G, int wave, int lane) {
    const unsigned ldsb = (unsigned)(uintptr_t)lds;
    const bf16* QP = (const bf16*)(P.ws + WS_QP);
    const float* GT = (const float*)(P.ws + WS_GT);
    bf16* AO = (bf16*)(P.ws + WS_AO);
    LAS float* impw = (LAS float*)(lds + AT_IMP) + 8 * wave * IMP_STRIDE;
    LAS unsigned* selw = (LAS unsigned*)(lds + AT_SELW) + wave * 256;
#define AT_REGION() int ln_ = lane; asm volatile("" : "+v"(ln_)); const int c16 = ln_ & 15, q = ln_ >> 4, hh = c16 & 3, tq = c16 >> 2; AttnLane L; L.q = q; \
    L.kb = (unsigned)(c16 * 256 + (((q ^ c16) & 3) << 4)); L.kx = (c16 >> 2) & 3; L.vb = (unsigned)(c16 * 128 + (((q ^ (c16 >> 1)) & 3) << 4)); L.vx = (c16 >> 3) & 1; \
    const bool hzero = (hh == 0); const int tok0 = t0 + 8 * wave + tq; (void)hzero; (void)tok0; (void)L
#define tok_(ts_) (tok0 + 4 * (ts_))
#define GATE(ts_, br_) (GT[(size_t)tok_(ts_) * 48 + (4 * g + hh) * 3 + (br_)])
#define FSAT(k_) (*(f32x4*)(FSb + (fo_ + (unsigned)(k_) * 1024u)))
#define FS_OFF() unsigned fo_ = (unsigned)ln_ * 16u

    for (int e = vcu; e < 1024; e += G) {
        const int k4 = e >> 8, v = e & 255, xcd = v >> 5, g = xcd & 3, hi2 = xcd >> 2, j = v & 31;
        const int stepk = hi2 ? ((k4 == 0) ? 6 : (k4 == 1) ? 5 : (k4 == 2) ? 2 : 1) : ((k4 == 0) ? 7 : (k4 == 1) ? 4 : (k4 == 2) ? 3 : 0);
        const int tile = 32 * stepk + ((k4 & 1) ? 31 - j : j);
        const int t0 = tile * 64;
        unsigned char* FSb = P.ws + WS_FS + ((size_t)((vcu & 255) * 8 + wave)) * 16384;
        bf16x8 qf[2][4];
        f32x4 O[2][8];
        float l[2] = {0.f, 0.f};
        int limq[2];
        {
            AT_REGION();
#pragma unroll
            for (int ts = 0; ts < 2; ++ts) {
#pragma unroll
                for (int s = 0; s < 4; ++s) qf[ts][s] = *(const bf16x8*)(QP + (size_t)tok_(ts) * DM + (4 * g + hh) * HD + 32 * s + 8 * q);
            }
            for (int i = ln_; i < 8 * IMP_STRIDE; i += 64) impw[i] = 0.f;
            for (int i = ln_; i < 256; i += 64) selw[i] = 0u;
#pragma unroll
            for (int ts = 0; ts < 2; ++ts)
#pragma unroll
                for (int dt = 0; dt < 8; ++dt) O[ts][dt] = (f32x4){0.f, 0.f, 0.f, 0.f};
            float m[2] = {-1e30f, -1e30f}, invl[2] = {0.f, 0.f};
            LAS float* improw[2]; improw[0] = impw + tq * IMP_STRIDE; improw[1] = impw + (4 + tq) * IMP_STRIDE;
            VM_WAIT(); LDS_WAIT();
            const int nbc = (DBG_BR & 1) ? ((4 * tile + 2) >> 6) + 1 : 0;
            const unsigned char* kci = P.ws + WS_KCI + (size_t)g * 16 * 16384; const unsigned char* vci = P.ws + WS_VCI + (size_t)g * 16 * 16384;
            if (DBG_BR & 1) AT_STAGE(kci, AT_KV);
            for (int b = 0; b < nbc; ++b) {
                const int buf = (b & 1) * 32768;
                if (b + 1 < nbc) { AT_STAGE(kci + (size_t)(b + 1) * 16384, AT_KV + (buf ^ 32768)); AT_WAITV(2); }
                else AT_WAITV(0);
                AT_BAR();
#pragma unroll
                for (int ts = 0; ts < 2; ++ts) limq[ts] = ((tok_(ts) - 31) >> 4) - 64 * b - 8 * q;
                block_step<true, true, 0>(lds + AT_KV + buf, lds + AT_KV + buf + 16384, L, qf, O, m, l, limq, 0x80000000u, invl, improw, 0, hzero, b + 2 >= nbc);
                AT_BAR();
            }
#pragma unroll
            for (int ts = 0; ts < 2; ++ts) { float lt = l[ts]; lt += __shfl_xor(lt, 16); lt += __shfl_xor(lt, 32); invl[ts] = lt > 0.f ? 1.0f / lt : 0.f; }
            if (DBG_BR & 1) { AT_STAGE(kci, AT_KV); AT_STAGE(vci, AT_KV + 16384); }
            for (int b = 0; b < nbc; ++b) {
                const int buf = (b & 1) * 32768;
                if (b + 1 < nbc) { AT_STAGE(kci + (size_t)(b + 1) * 16384, AT_KV + (buf ^ 32768)); AT_STAGE(vci + (size_t)(b + 1) * 16384, AT_KV + (buf ^ 32768) + 16384); AT_WAITV(4); }
                else AT_WAITV(0);
                AT_BAR();
#pragma unroll
                for (int ts = 0; ts < 2; ++ts) limq[ts] = ((tok_(ts) - 31) >> 4) - 64 * b - 8 * q;
                block_step<true, true, 1>(lds + AT_KV + buf, lds + AT_KV + buf + 16384, L, qf, O, m, l, limq, 0x80000000u, invl, improw, 16 * b + 2 * q, hzero, b + 2 >= nbc);
                AT_BAR();
            }
            FS_OFF();
#pragma unroll
            for (int ts = 0; ts < 2; ++ts)
#pragma unroll
                for (int dt = 0; dt < 8; ++dt) FSAT(ts * 8 + dt) = O[ts][dt] * GATE(ts, 0);
        }
        LDS_WAIT();
        {
            const int Ksel = (!(DBG_BR & 2) || DBG_DENSE_SEL >= 2) ? 0 : (tile - 1) < 14 ? (tile - 1) : 14;
            int lane_k = lane; asm volatile("" : "+v"(lane_k));
            unsigned wsel[4] = {0u, 0u, 0u, 0u};
            bool cand[4];
#pragma unroll
            for (int e4 = 0; e4 < 4; ++e4) { const int jj = lane_k + 64 * e4; cand[e4] = (jj >= 1 && jj <= tile - 1); }
            if (Ksel > 0) {
                const bool all_sel = (tile - 1) <= 14;
                for (int tl = 0; tl < 8; ++tl) {
                    const LAS float* row = impw + tl * IMP_STRIDE;
                    unsigned val[4];
#pragma unroll
                    for (int e4 = 0; e4 < 4; ++e4) val[e4] = cand[e4] ? __float_as_uint(row[lane_k + 64 * e4]) : 0u;
                    bool sel[4];
                    if (all_sel) {
#pragma unroll
                        for (int e4 = 0; e4 < 4; ++e4) sel[e4] = cand[e4];
                    } else {
                        unsigned vmx = max(max(val[0], val[1]), max(val[2], val[3]));
                        unsigned vmn = min(min(cand[0] ? val[0] : 0xffffffffu, cand[1] ? val[1] : 0xffffffffu), min(cand[2] ? val[2] : 0xffffffffu, cand[3] ? val[3] : 0xffffffffu));
                        vmx = wave_umax(vmx); vmn = wave_umin(vmn);
                        const unsigned dif = (unsigned)__builtin_amdgcn_readfirstlane((int)(vmx ^ vmn));
                        const int hb = 31 - __builtin_clz(dif | 1u);
                        unsigned cur = (unsigned)__builtin_amdgcn_readfirstlane((int)vmx) & ~((2u << hb) - 1u);
                        for (int bit = (dif == 0u ? -1 : (hb > 30 ? 30 : hb)); bit >= 0; --bit) {
                            asm volatile("" : "+s"(cur), "+s"(bit));
                            const unsigned t = cur | (1u << bit); int cnt = 0;
#pragma unroll
                            for (int e4 = 0; e4 < 4; ++e4) cnt += __popcll(__builtin_amdgcn_uicmp(val[e4], t, 35  ));
                            if (cnt >= Ksel) cur = t;
                            if (cnt == Ksel) break;
                        }
                        int cgt = 0;
#pragma unroll
                        for (int e4 = 0; e4 < 4; ++e4) cgt += __popcll(__ballot(cand[e4] && val[e4] > cur));
                        const int need = Ksel - cgt; int prev = 0;
#pragma unroll
                        for (int e4 = 0; e4 < 4; ++e4) { const bool eq = cand[e4] && val[e4] == cur; const unsigned long long be = __ballot(eq);
                            const int rank = prev + (int)__builtin_amdgcn_mbcnt_hi((unsigned)(be >> 32), __builtin_amdgcn_mbcnt_lo((unsigned)be, 0u));
                            sel[e4] = (cand[e4] && val[e4] > cur) || (eq && rank < need); prev += __popcll(be); }
                    }
#pragma unroll
                    for (int e4 = 0; e4 < 4; ++e4) wsel[e4] |= sel[e4] ? (1u << tl) : 0u;
                }
            }
#pragma unroll
            for (int e4 = 0; e4 < 4; ++e4) { const int jj = lane_k + 64 * e4; if (jj == 0 || jj == tile) wsel[e4] = 0xffu; selw[jj] = wsel[e4]; }
            LDS_WAIT();
#if DBG_DENSE_SEL == 1
            for (int i = lane_k; i <= tile; i += 64) selw[i] = 0xffu;
            LDS_WAIT();
#elif DBG_DENSE_SEL == 4
            for (int i = lane_k; i <= tile; i += 64) selw[i] = (i == 0 || i >= tile - 14) ? 0xffu : 0u;
            LDS_WAIT();
#endif
        }
        float mref[2] = {0.f, 0.f};
#define AT_RING_LOOP(NB, KSRC, VSRC, PRE, ...) do { \
            const int nb_ = (NB); \
            _Pragma("unroll") for (int pb_ = 0; pb_ < 3; ++pb_) { if ((PRE) && pb_ == 2) AT_BAR(); \
                if (pb_ < nb_) { AT_STAGE((KSRC) + (size_t)pb_ * 16384, pb_ * 32768); AT_STAGE((VSRC) + (size_t)pb_ * 16384, pb_ * 32768 + 16384); } } \
            int bufo = 0, bufn = 98304; \
            for (int b = 0; b < nb_; ++b) { \
                const int ahead_ = nb_ - 1 - b; \
                if (ahead_ >= 2) AT_WAITV(8); else if (ahead_ == 1) AT_WAITV(4); else AT_WAITV(0); \
                AT_BAR(); \
                if (b + 3 < nb_) { AT_STAGE((KSRC) + (size_t)(b + 3) * 16384, bufn); AT_STAGE((VSRC) + (size_t)(b + 3) * 16384, bufn + 16384); } \
                LAS const unsigned char* Kb_ = lds + bufo; LAS const unsigned char* Vb_ = lds + bufo + 16384; \
                __VA_ARGS__ \
                bufo = (bufo == 98304) ? 0 : bufo + 32768; bufn = (bufn == 98304) ? 0 : bufn + 32768; \
            } \
            AT_BAR(); } while (0)
#define AT_DRIFT_LOOP(NB, KSRC, VSRC, ...) do { \
            const int nb_ = (NB); \
            volatile LAS unsigned* ldc_ = (volatile LAS unsigned*)(lds + MISC_OFF) + 32; \
            if (wave == 0 && ln_ < 4) ldc_[ln_] = 0u; \
            _Pragma("unroll") for (int pb_ = 0; pb_ < 2; ++pb_) if (pb_ < nb_) { AT_STAGE((KSRC) + (size_t)pb_ * 16384, pb_ * 32768); AT_STAGE((VSRC) + (size_t)pb_ * 16384, pb_ * 32768 + 16384); } \
            AT_BAR();                                                     \
            if (nb_ >= 2) AT_WAITV(4); else AT_WAITV(0); \
            if (ln_ == 0) (void)__hip_atomic_fetch_add((LAS unsigned*)ldc_, 1u, __ATOMIC_RELAXED, __HIP_MEMORY_SCOPE_WORKGROUP); \
            unsigned swn_ = (unsigned)__builtin_amdgcn_readfirstlane((int)selw[0]); \
            _Pragma("clang loop unroll(disable)") for (int b = 0; b < nb_; ++b) { \
                volatile LAS unsigned* lp_ = ldc_ + (b & 3); \
                const unsigned pr0_ = *lp_;                                                             \
                const unsigned swv_ = *(volatile LAS unsigned*)(selw + (b + 1 < 256 ? b + 1 : 255)); \
                if (b + 1 < nb_) { AT_WAITV(0); if (ln_ == 0) (void)__hip_atomic_fetch_add((LAS unsigned*)ldc_ + ((b + 1) & 3), 1u, __ATOMIC_RELAXED, __HIP_MEMORY_SCOPE_WORKGROUP); } \
                { const unsigned need_ = 8u * (unsigned)((b >> 2) + 1); unsigned pr_ = (unsigned)__builtin_amdgcn_readfirstlane((int)pr0_); \
                  while (pr_ < need_) { __builtin_amdgcn_s_sleep(1); pr_ = (unsigned)__builtin_amdgcn_readfirstlane((int)*lp_); } } \
                const unsigned sw = swn_; swn_ = (unsigned)__builtin_amdgcn_readfirstlane((int)swv_); \
                asm volatile("" ::: "memory"); \
                if (b + 2 < nb_) { const int sl_ = ((b + 2) & 3) * 32768; AT_STAGE((KSRC) + (size_t)(b + 2) * 16384, sl_); AT_STAGE((VSRC) + (size_t)(b + 2) * 16384, sl_ + 16384); } \
                LAS const unsigned char* Kb_ = lds + (b & 3) * 32768; LAS const unsigned char* Vb_ = Kb_ + 16384; \
                __VA_ARGS__ \
            } \
            AT_BAR(); } while (0)
        {
            AT_REGION();
            for (int rp_ = 0; rp_ < DBG_REP_SEL; ++rp_) {
#pragma unroll
            for (int ts = 0; ts < 2; ++ts) { l[ts] = 0.f; mref[ts] = 0.f;
#pragma unroll
                for (int dt = 0; dt < 8; ++dt) O[ts][dt] = (f32x4){0.f, 0.f, 0.f, 0.f}; }
            if (DBG_BR & 2) {
                const unsigned char* ksi = P.ws + WS_KSI + (size_t)g * 256 * 16384; const unsigned char* vsi = P.ws + WS_VSI + (size_t)g * 256 * 16384;
                VM_WAIT();
                AT_DRIFT_LOOP(tile + 1, ksi, vsi, {
                    _Pragma("unroll") for (int ts = 0; ts < 2; ++ts) limq[ts] = ((sw >> (4 * ts + tq)) & 1u) ? (tok_(ts) - 64 * b - 8 * q) : -1000;
                    const bool a0 = (sw & 0x0fu) != 0u, a1 = (sw & 0xf0u) != 0u;
                    const bool msk = (b == 0) || (b == tile);
                    if (a0) step_online<true, false>(Kb_, Vb_, L, qf, O, mref, l, limq, 0x80000000u, msk, b == 0);
                    if (a1) step_online<false, true>(Kb_, Vb_, L, qf, O, mref, l, limq, 0x80000000u, msk, b == 0);
                });
            }
            }
            FS_OFF();
#pragma unroll
            for (int ts = 0; ts < 2; ++ts) { const float lt = l[ts]; const float sc = (DBG_BR & 2) ? GATE(ts, 1) / lt : 0.f;
#pragma unroll
                for (int dt = 0; dt < 8; ++dt) { FSAT(ts * 8 + dt) += O[ts][dt] * sc; if ((dt & 3) == 3) asm volatile("" ::: "memory"); } }
            VM_WAIT();
        }
        {
            AT_REGION();
#pragma unroll
            for (int ts = 0; ts < 2; ++ts) { l[ts] = 0.f;
#pragma unroll
                for (int dt = 0; dt < 8; ++dt) O[ts][dt] = (f32x4){0.f, 0.f, 0.f, 0.f}; }
            if (DBG_BR & 4) {
                const int b0 = tile >= 8 ? tile - 8 : 0;
                const unsigned char* kwi = P.ws + WS_KWI + ((size_t)g * 256 + b0) * 16384; const unsigned char* vwi = P.ws + WS_VWI + ((size_t)g * 256 + b0) * 16384;
                AT_RING_LOOP(tile - b0 + 1, kwi, vwi, false, {
                    _Pragma("unroll") for (int ts = 0; ts < 2; ++ts) limq[ts] = tok_(ts) - 64 * (b0 + b) - 8 * q;
                    step_online<true, true>(Kb_, Vb_, L, qf, O, mref, l, limq, 512u, (b == 0) || (b0 + b == tile), b == 0);
                });
            }
            FS_OFF();
#pragma unroll
            for (int ts = 0; ts < 2; ++ts) { const float lt = l[ts]; const float sc = (DBG_BR & 4) ? GATE(ts, 2) / lt : 0.f;
                bf16* orow = AO + (size_t)tok_(ts) * DM + (4 * g + hh) * HD + 4 * q;
#pragma unroll
                for (int dt = 0; dt < 8; ++dt) { const f32x4 o = FSAT(ts * 8 + dt) + O[ts][dt] * sc;
                    u32x2 w; w.x = pk2(o[0], o[1]); w.y = pk2(o[2], o[3]); *(u32x2*)(orow + 16 * dt) = w; if ((dt & 3) == 3) asm volatile("" ::: "memory"); } }
        }
    }
#undef AT_REGION
#undef AT_RING_LOOP
#undef AT_DRIFT_LOOP
}

#ifndef DBG_CHECK
#define DBG_CHECK 0
#endif
#if DBG_CHECK
__device__ __forceinline__ float p_bf(const bf16* Pm, int t, int col) { return __uint_as_float((unsigned)Pm[(size_t)t * PW + col] << 16); }
__device__ __forceinline__ float roped(const bf16* Pm, const float* cosT, const float* sinT, int t, int colbase, int d) {
    const float x = p_bf(Pm, t, colbase + d);
    if (d >= 32) return x;
    const int i = d & 15; const float c = cosT[(size_t)t * 16 + i], sn = sinT[(size_t)t * 16 + i];
    return (d < 16) ? x * c - p_bf(Pm, t, colbase + d + 16) * sn : x * c + p_bf(Pm, t, colbase + d - 16) * sn;
}
__constant__ int TSAMP[28] = {0, 1, 5, 30, 31, 32, 47, 63, 64, 65, 100, 127, 128, 191, 200, 255, 300, 511, 512, 575, 1023, 1024, 1025, 2047, 4096, 8191, 12345, 16383};
__device__ __forceinline__ void attn_check(const Ptrs& P, int l, LAS unsigned char* lds, int vcu, int G, int tid, unsigned* flagword) {
    const int NS = 28;
    const bf16* Pm = (const bf16*)(P.ws + WS_P); const bf16* AO = (const bf16*)(P.ws + WS_AO);
    const float* cosT = (const float*)(P.ws + WS_COS); const float* sinT = (const float*)(P.ws + WS_SIN);
    LAS float* q = (LAS float*)lds;
    LAS float* blk = q + 512;
    LAS float* hh_ = blk + 4096;
    LAS float* kc = hh_ + 256;
    LAS float* vc = kc + 2048;
    LAS float* sc = vc + 2048;
    LAS float* fin = sc + 4096;
    LAS float* imp = fin + 512;
    LAS int* selb = (LAS int*)(imp + 256);
    LAS unsigned* red = (LAS unsigned*)(selb + 16);
    for (int item = vcu; item < NS * 4; item += G) {
        const int s = item >> 2, g = item & 3, t = TSAMP[s];
        const int cur = t >> 6;
        { const int r = tid >> 7, d = tid & 127; q[tid] = __uint_as_float((unsigned)((const bf16*)(P.ws + WS_QP))[(size_t)t * DM + (4 * g + r) * HD + d] << 16) * 0.6931471805599453f; fin[tid] = 0.f; }
        if (tid < 2) red[tid] = 0u;
        if (tid < 256) imp[tid] = 0.f;
        __syncthreads();
        const int nmax = (t - 31) >> 4;
        const bool small = t < 256;
        const unsigned char* kci = P.ws + WS_KCI + (size_t)g * 16 * 16384; const unsigned char* vci = P.ws + WS_VCI + (size_t)g * 16 * 16384;
        if (small) {
        for (int kv = 0; kv < 2; ++kv)
            for (int n = 0; n <= nmax; ++n) {
                for (int e = tid; e < 4096; e += 512) { const int l_ = e >> 7, d = e & 127, tok = 16 * n + l_;
                    const float x = (kv == 0) ? roped(Pm, cosT, sinT, tok, C_KV + 0 * 512 + g * HD, d) : p_bf(Pm, tok, C_KV + 1 * 512 + g * HD + d);
                    blk[e] = x + P.cmp_pe[((size_t)(l * 2 + kv) * 32 + l_) * 128 + d]; }
                __syncthreads();
                if (tid < 256) { const float* w1 = P.cmp_w1 + (size_t)(l * 2 + kv) * 4096 * 256 + tid; float a = P.cmp_b1[(size_t)(l * 2 + kv) * 256 + tid];
                    for (int e = 0; e < 4096; ++e) a += blk[e] * w1[(size_t)e * 256];
                    hh_[tid] = 0.5f * a * (1.0f + tanhf(0.7978845608028654f * (a + 0.044715f * a * a * a))); }
                __syncthreads();
                if (tid < 128) { const float* w2 = P.cmp_w2 + (size_t)(l * 2 + kv) * 256 * 128 + tid; float a = P.cmp_b2[(size_t)(l * 2 + kv) * 128 + tid];
                    for (int c = 0; c < 256; ++c) a += hh_[c] * w2[(size_t)c * 128];
                    (kv == 0 ? kc : vc)[n * 128 + tid] = a; }
                __syncthreads();
            }
        }
#define KC_AT(n, d) (small ? kc[(n) * 128 + (d)] : __uint_as_float((unsigned)*(const bf16*)(kci + (size_t)((n) >> 6) * 16384 + kimg_off((n) & 63, (d) >> 3) + ((d) & 7) * 2) << 16))
#define VC_AT(n, d) (small ? vc[(n) * 128 + (d)] : __uint_as_float((unsigned)*(const bf16*)(vci + (size_t)((n) >> 6) * 16384 + vimg_off((d), ((n) & 63) >> 3) + ((n) & 7) * 2) << 16))
        if (nmax >= 0) {
            for (int e = tid; e < 4 * 1024; e += 512) { const int r = e >> 10, n = e & 1023; float a = -1e30f;
                if (n <= nmax) { a = 0.f; for (int d = 0; d < 128; ++d) a += q[r * 128 + d] * KC_AT(n, d); } sc[e] = a; }
            __syncthreads();
            float mx = -1e30f, den = 0.f;
            { const int r = tid >> 7, d = tid & 127; for (int n = 0; n <= nmax; ++n) mx = fmaxf(mx, sc[r * 1024 + n]);
              float num = 0.f; for (int n = 0; n <= nmax; ++n) { const float p = expf(sc[r * 1024 + n] - mx); den += p; num += p * VC_AT(n, d); }
              if (DBG_BR & 1) fin[tid] += sigm(p_bf(Pm, t, C_GN + (4 * g + r) * 3 + 0)) * num / den; }
            __syncthreads();
            { const int r = tid >> 7; for (int n = (tid & 127); n <= nmax; n += 128) sc[r * 1024 + n] = expf(sc[r * 1024 + n] - mx) / den; }
            __syncthreads();
            if (tid <= cur) { const int j = tid; float a = 0.f;
                for (int r = 0; r < 4; ++r) for (int u = -1; u <= 3; ++u) { const int n = 4 * j + u; if (n >= 0 && n <= nmax) a += sc[r * 1024 + n] * ((u == -1 || u == 3) ? 0.5f : 1.0f); }
                imp[j] = a; }
            __syncthreads();
        }
        if (tid == 0) { int ns = 0; selb[ns++] = 0; if (cur > 0) selb[ns++] = cur;
            for (int rnd = 0; rnd < 14; ++rnd) { int bj = -1; float bv = -1.f;
                for (int j = 1; j < cur; ++j) { bool taken = false; for (int k = 0; k < ns; ++k) taken |= (selb[k] == j); if (!taken && imp[j] > bv) { bv = imp[j]; bj = j; } }
                if (bj < 0) break; selb[ns++] = bj; }
            for (; ns < 16; ++ns) selb[ns] = -1; }
        __syncthreads();
        if (DBG_BR & 2) {
            const int kcol = C_KV + 2 * 512 + g * HD, vcol = C_KV + 3 * 512 + g * HD;
            for (int e = tid; e < 4 * 1024; e += 512) { const int r = e >> 10, k = e & 1023, bsel = selb[k >> 6], kp = bsel * 64 + (k & 63); float a = -1e30f;
                if (bsel >= 0 && kp <= t) { a = 0.f; for (int d = 0; d < 128; ++d) a += q[r * 128 + d] * roped(Pm, cosT, sinT, kp, kcol, d); }
                sc[e] = a; }
            __syncthreads();
            { const int r = tid >> 7, d = tid & 127; float mx = -1e30f; for (int k = 0; k < 1024; ++k) mx = fmaxf(mx, sc[r * 1024 + k]);
              float den = 0.f, num = 0.f; for (int k = 0; k < 1024; ++k) { const float sv = sc[r * 1024 + k]; if (sv > -1e29f) { const float p = expf(sv - mx); den += p; num += p * p_bf(Pm, selb[k >> 6] * 64 + (k & 63), vcol + d); } }
              fin[tid] += sigm(p_bf(Pm, t, C_GN + (4 * g + r) * 3 + 1)) * num / den; }
            __syncthreads();
        }
        if (DBG_BR & 4) {
            const int kcol = C_KV + 4 * 512 + g * HD, vcol = C_KV + 5 * 512 + g * HD;
            for (int e = tid; e < 4 * 512; e += 512) { const int r = e >> 9, kp = t - (e & 511); float a = -1e30f;
                if (kp >= 0) { a = 0.f; for (int d = 0; d < 128; ++d) a += q[r * 128 + d] * roped(Pm, cosT, sinT, kp, kcol, d); }
                sc[r * 1024 + (e & 511)] = a; }
            __syncthreads();
            { const int r = tid >> 7, d = tid & 127; float mx = -1e30f; for (int k = 0; k < 512; ++k) mx = fmaxf(mx, sc[r * 1024 + k]);
              float den = 0.f, num = 0.f; for (int k = 0; k < 512; ++k) { const float sv = sc[r * 1024 + k]; if (sv > -1e29f) { const float p = expf(sv - mx); den += p; num += p * p_bf(Pm, t - k, vcol + d); } }
              fin[tid] += sigm(p_bf(Pm, t, C_GN + (4 * g + r) * 3 + 2)) * num / den; }
            __syncthreads();
        }
        { const int r = tid >> 7, d = tid & 127; const float ao = __uint_as_float((unsigned)AO[(size_t)t * DM + (4 * g + r) * HD + d] << 16);
          const float err = fabsf(fin[tid] - ao), mag = fabsf(fin[tid]);
          atomicMax((unsigned*)&red[0], __float_as_uint(err)); atomicMax((unsigned*)&red[1], __float_as_uint(mag)); }
        __syncthreads();
        if (tid == 0) { const float err = __uint_as_float(red[0]), mag = __uint_as_float(red[1]); if (!(err <= 0.03f * mag + 2e-3f)) atomicOr(flagword, 1u << s); }
        __syncthreads();
    }
#undef KC_AT
#undef VC_AT
}
#endif


#if DBG_CHECK
__constant__ int RSAMP[8] = {0, 1, 63, 64, 255, 256, 4097, 16383};
__device__ __forceinline__ int csamp(int ci, int N) { return ci == 63 ? N - 1 : (int)(((unsigned)ci * (unsigned)(N / 64) + ((unsigned)ci * 7u) % 61u) % (unsigned)N); }
__device__ __forceinline__ float bfv(const bf16* p, size_t i) { return __uint_as_float((unsigned)p[i] << 16); }
__device__ __forceinline__ float mod_naive(const Ptrs& P, int l, int k, int c) {
    float a = P.ada_b[(size_t)l * 6 * DM + k * DM + c];
    for (int j = 0; j < DM; ++j) { const float cv = P.c[j]; a += cv / (1.0f + expf(-cv)) * P.ada_w[((size_t)l * DM + j) * 6 * DM + k * DM + c]; }
    return a;
}
__device__ __forceinline__ void flag_if(bool bad, unsigned* flagword, int bit) { if (bad) { atomicOr(flagword, 1u << bit); if (bit == 4) { atomicMax(flagword + 1, 0xffffffffu - (unsigned)threadIdx.x); atomicAdd(flagword + 2, 1u); } } }
__device__ __forceinline__ bool mism(float got, float exp_) { return !(fabsf(got - exp_) <= 0.02f * fabsf(exp_) + 0.02f); }
__device__ __forceinline__ void main_check(const Ptrs& P, int which, int tid, unsigned* flagword) {
    const int l = 0, row = RSAMP[tid >> 6], ci = tid & 63;
    const bf16* Pm = (const bf16*)(P.ws + WS_P); const bf16* H = (const bf16*)(P.ws + WS_H); const float* Y = (const float*)(P.ws + WS_Y);
    if (which == 1 || which == 7) {
        const int c = csamp(ci, DM);
        const float* xr = (which == 1 ? P.x : P.out) + (size_t)row * DM;
        if (which == 7) {
            float ss = 0.f; for (int j = 0; j < DM; ++j) { const float y = Y[(size_t)row * DM + j]; ss += y * y; }
            const float e = P.x[(size_t)row * DM + c] + mod_naive(P, l, 2, c) * P.gains[(size_t)(l * 4 + 1) * DM + c] * Y[(size_t)row * DM + c] / sqrtf(ss / DM + NORM_EPS);
            flag_if(mism(xr[c], e), flagword, 16 + which);
        }
        float ss = 0.f; for (int j = 0; j < DM; ++j) ss += xr[j] * xr[j];
        const int gi = which == 1 ? 0 : 2, sck = which == 1 ? 1 : 4, shk = which == 1 ? 0 : 3;
        const float e = xr[c] / sqrtf(ss / DM + NORM_EPS) * P.gains[(size_t)(l * 4 + gi) * DM + c] * (1.0f + mod_naive(P, l, sck, c)) + mod_naive(P, l, shk, c);
        flag_if(mism(bfv(H, (size_t)row * DM + c), e), flagword, which);
    } else if (which == 2) {
        const int pc = (ci < 60) ? csamp(ci, 12288) : 12288 + (ci - 60) * 15;
        const int src = pc < 8192 ? pc : pc < 10240 ? 8240 + (pc - 8192) : pc < 12288 ? 10288 + (pc - 10240) : 8192 + (pc - 12288);
        float a = 0.f; for (int k = 0; k < DM; ++k) a += bfv(H, (size_t)row * DM + k) * P.w_in[((size_t)l * DM + k) * INW + src];
        flag_if(mism(bfv(Pm, (size_t)row * PW + pc), a), flagword, which);
    } else if (which == 3) {
        const int c = csamp(ci, CWID); float z = 0.f;
        for (int k = 0; k < 3; ++k) { const int tt = row - 2 + k; if (tt >= 0) z += P.conv_w[(size_t)l * 3 * CWID + k * CWID + c] * bfv(Pm, (size_t)tt * PW + C_CG + c) * bfv(Pm, (size_t)tt * PW + C_XA + c); }
        flag_if(mism(bfv((const bf16*)(P.ws + WS_CV), (size_t)row * CWID + c), z * bfv(Pm, (size_t)row * PW + C_BG + c)), flagword, which);
    } else if (which == 4) {
        const int c = csamp(ci, DM); const bf16* CV = (const bf16*)(P.ws + WS_CV);
        float a = 0.f; for (int k = 0; k < CWID; ++k) a += bfv(CV, (size_t)row * CWID + k) * P.w_conv_out[((size_t)l * CWID + k) * DM + c];
        flag_if(mism(bfv((const bf16*)(P.ws + WS_YA), (size_t)row * DM + c), a * sigm(bfv(Pm, (size_t)row * PW + C_GA + c))), flagword, which);
    } else if (which == 5 && row < 10000) {
        const int c = csamp(ci, DM); const bf16* AO = (const bf16*)(P.ws + WS_AO);
        float a = 0.f; for (int k = 0; k < DM; ++k) a += bfv(AO, (size_t)row * DM + k) * P.w_nsa[((size_t)l * DM + k) * DM + c];
        flag_if(mism(bfv((const bf16*)(P.ws + WS_MG), (size_t)row * DM + c), bfv((const bf16*)(P.ws + WS_YA), (size_t)row * DM + c) + a * sigm(bfv(Pm, (size_t)row * PW + C_GB + c))), flagword, which);
    } else if (which == 6) {
        const int c = csamp(ci, DM); const bf16* MG = (const bf16*)(P.ws + WS_MG);
        float a = 0.f; for (int k = 0; k < DM; ++k) a += bfv(MG, (size_t)row * DM + k) * P.w_out[((size_t)l * DM + k) * DM + c];
        flag_if(mism(Y[(size_t)row * DM + c], a), flagword, which);
    } else if (which == 8) {
        const int f = csamp(ci, FF);
        float a = 0.f; for (int k = 0; k < DM; ++k) a += bfv(H, (size_t)row * DM + k) * P.w_up[((size_t)l * DM + k) * FF + f];
        a = fmaxf(a, 0.f); flag_if(mism(bfv((const bf16*)(P.ws + WS_U), (size_t)row * FF + f), a * a), flagword, which);
    } else if (which == 9) {
        const int c = csamp(ci, DM); const bf16* U = (const bf16*)(P.ws + WS_U);
        float a = 0.f; for (int k = 0; k < FF; ++k) a += bfv(U, (size_t)row * FF + k) * P.w_down[((size_t)l * FF + k) * DM + c];
        flag_if(mism(Y[(size_t)row * DM + c], a), flagword, which);
    }
}
#define MAIN_CHECK(w) do { if (l == 0 && bx == 0) main_check(P, (w), OPQ_TID(), ctl + 64); } while (0)
#else
#define MAIN_CHECK(w) do { } while (0)
#endif
constexpr int NPH = 11;
constexpr int N_PHASES = 2 + DEPTH * NPH;
#ifndef DBG_CHECK_LAYER
#define DBG_CHECK_LAYER 0
#endif
#ifndef DBG_SKIP_ATTN
#define DBG_SKIP_ATTN 0
#endif
#ifndef DUP_MASK
#define DUP_MASK 0
#endif
#define DUPN(t) (1 + ((DUP_MASK >> (t)) & 1))
#ifndef MK_PER_PHASE
#define MK_PER_PHASE 0
#endif

__global__ void __launch_bounds__(NWAVES * 64, 2) nsa_fwd(Args args) {
    extern __shared__ __attribute__((aligned(16))) unsigned char lds_raw[];
    LAS unsigned char* lds = (LAS unsigned char*)lds_raw;
    const int tid = threadIdx.x, lane = tid & 63, wave = __builtin_amdgcn_readfirstlane(tid >> 6);
    const int G = gridDim.x; const int bx = blockIdx.x; const int vcu = (G % 8 == 0) ? (bx % 8) * (G / 8) + bx / 8 : bx;
    volatile LAS unsigned* MISC = (volatile LAS unsigned*)(lds + MISC_OFF);
    for (int u = tid; u < 128; u += NWAVES * 64) MISC[u] = 0u;
    __syncthreads();
    unsigned* ctl = (unsigned*)(args.ws + WS_CTL);
    XcdBarrier bar = xcd_barrier_post(ctl + CW_BAR, MISC + 8);
    const int lo = args.ph_lo, hi = args.ph_hi; (void)lo; (void)hi;
#ifndef ONLY_PHASE
#define ONLY_PHASE -1
#endif
#define PH_EN(t) (ONLY_PHASE < 0 || ONLY_PHASE == (t))
#if MK_PER_PHASE
#define IN(k) (lo <= (k) && (k) < hi)
#else
#define IN(k) true
#endif
#define LOADP() const Args GAS_K* ap_ = (const Args GAS_K*)__builtin_amdgcn_kernarg_segment_ptr(); asm volatile("" : "+s"(ap_)); Ptrs P; \
    P.x = (const float*)ap_->in[0]; P.c = (const float*)ap_->in[1]; P.pos = (const int*)ap_->in[2]; P.ada_w = (const float*)ap_->in[3]; P.ada_b = (const float*)ap_->in[4]; \
    P.gains = (const float*)ap_->in[5]; P.w_in = (const float*)ap_->in[6]; P.conv_w = (const float*)ap_->in[7]; P.w_conv_out = (const float*)ap_->in[8]; P.cmp_pe = (const float*)ap_->in[9]; \
    P.cmp_w1 = (const float*)ap_->in[10]; P.cmp_b1 = (const float*)ap_->in[11]; P.cmp_w2 = (const float*)ap_->in[12]; P.cmp_b2 = (const float*)ap_->in[13]; P.w_nsa = (const float*)ap_->in[14]; \
    P.w_out = (const float*)ap_->in[15]; P.w_up = (const float*)ap_->in[16]; P.w_down = (const float*)ap_->in[17]; P.out = ap_->out; P.ws = ap_->ws; \
    bf16* H = (bf16*)(P.ws + WS_H); bf16* Y = (bf16*)(P.ws + WS_Y); unsigned char* wl = P.ws + WS_WL + (size_t)l_ * WL_BYTES; const bf16* Pm = (const bf16*)(P.ws + WS_P); (void)H; (void)Y; (void)wl; (void)Pm
#define OPQ_S(x) ({ int _v = (x); asm volatile("" : "+s"(_v)); _v; })
#define OPQ_TID() ({ int _l; asm volatile("v_mbcnt_lo_u32_b32 %0, -1, 0\n\tv_mbcnt_hi_u32_b32 %0, -1, %0" : "=v"(_l)); int _t = (OPQ_S(wave) << 6) | _l; _t; })
#if MK_PER_PHASE
#define SEAM(k) do { } while (0)
#else
#define SEAM(k) do { if (IN((k) + 1) && rep_ + 1 == nrep_) xcd_barrier(bar); } while (0)
#endif

    { const int l_ = 0; (void)l_;
    if (PH_EN(0) && IN(0)) for (int rep_ = 0, nrep_ = (DUPN(0)); rep_ < nrep_; ++rep_) { LOADP(); { const int t_ = OPQ_TID(); p0_prologue(P, lds, OPQ_S(vcu), OPQ_S(G), OPQ_S(wave), t_ & 63, t_); } SEAM(0); }
    if (PH_EN(1) && IN(1)) for (int rep_ = 0, nrep_ = (1); rep_ < nrep_; ++rep_) { LOADP(); resid_phase<false>(P, lds, P.x, false, nullptr, false, nullptr, H, true, 0, 0, 0,  0,  1,  0,  0, OPQ_S(vcu), OPQ_S(G), OPQ_S(wave), OPQ_TID() & 63, OPQ_TID()); SEAM(1); }

    }
    for (int l = 0; l < DEPTH; ++l) {
        const int pb = 2 + l * NPH; const int l_ = l;
        if (PH_EN(2) && IN(pb + 0)) for (int rep_ = 0, nrep_ = (DUPN(2)); rep_ < nrep_; ++rep_) { LOADP();
            MAIN_CHECK(1);
            pg8::Gemm g{H, (const bf16*)(wl + WL_WIN), S, C_GN, DM, DM}; pg8::StaticOrder So; So.init(S, C_GN, OPQ_S(G), OPQ_S(bx));
            pg8::EpiB<0> E{(bf16*)(P.ws + WS_P), PW, nullptr, nullptr, 0, nullptr, 0};
            pg8::gemm_phase<pg8::EpiB<0>, pg8::StaticOrder, true, true>(lds, g, So, E, OPQ_TID());
            SEAM(pb + 0);
        }
        if (PH_EN(3) && IN(pb + 1)) for (int rep_ = 0, nrep_ = (DUPN(3)); rep_ < nrep_; ++rep_) { LOADP(); MAIN_CHECK(2); relayout_phase(P, l, lds, OPQ_S(vcu), OPQ_S(G), OPQ_TID()); SEAM(pb + 1); }
        if (PH_EN(4) && IN(pb + 2)) for (int rep_ = 0, nrep_ = (DUPN(4)); rep_ < nrep_; ++rep_) { LOADP();
            MAIN_CHECK(3);
            {   pg8::Gemm g{(const bf16*)(P.ws + WS_KCR), (const bf16*)(wl + WL_W1T), 8192, 512, 4096, 2048}; pg8::CmpOrder So{OPQ_S(bx)};
                pg8::EpiB<2, true> E{(bf16*)(P.ws + WS_HC), 256, (const float*)(P.ws + WS_B1P), nullptr, 0, nullptr, 0};
                pg8::gemm_phase<pg8::EpiB<2, true>, pg8::CmpOrder, false, true>(lds, g, So, E, OPQ_TID()); }
            {   pg8::Gemm g{(const bf16*)(P.ws + WS_CV), (const bf16*)(wl + WL_WCONV), S, DM, CWID, CWID}; pg8::StaticOrder So;
                So.init(S, DM, OPQ_S(G), OPQ_S(bx));
                pg8::EpiB<3> E{(bf16*)(P.ws + WS_YA), DM, nullptr, Pm + C_GA, PW, nullptr, 0};
                if (OPQ_S(G) == 256) { pg8::YaOrder Yo{So, OPQ_S(bx)}; pg8::gemm_phase<pg8::EpiB<3>, pg8::YaOrder, true, true>(lds, g, Yo, E, OPQ_TID()); }
                else pg8::gemm_phase<pg8::EpiB<3>, pg8::StaticOrder, true, true>(lds, g, So, E, OPQ_TID()); }
            SEAM(pb + 2);
        }
        if (PH_EN(5) && IN(pb + 3)) for (int rep_ = 0, nrep_ = (DUPN(5)); rep_ < nrep_; ++rep_) { LOADP(); MAIN_CHECK(4); cmp2_phase(P, l, OPQ_S(vcu), OPQ_S(G), OPQ_S(wave), OPQ_TID() & 63); SEAM(pb + 3); }
#if DBG_SKIP_ATTN
        if (PH_EN(6) && IN(pb + 4)) for (int rep_ = 0, nrep_ = (DUPN(6)); rep_ < nrep_; ++rep_) { LOADP(); u32x4* ao = (u32x4*)(P.ws + WS_AO); for (size_t i = (size_t)OPQ_S(vcu) * 512 + OPQ_TID(); i < (size_t)S * DM * 2 / 16; i += (size_t)OPQ_S(G) * 512) ao[i] = (u32x4){0u, 0u, 0u, 0u}; SEAM(pb + 4); }
#else
        if (PH_EN(6) && IN(pb + 4)) for (int rep_ = 0, nrep_ = (DUPN(6)); rep_ < nrep_; ++rep_) { LOADP(); attn_phase(P, lds, OPQ_S(vcu), OPQ_S(G), OPQ_S(wave), OPQ_TID() & 63);
            SEAM(pb + 4); }
#endif
        if (PH_EN(7) && IN(pb + 5)) for (int rep_ = 0, nrep_ = (DUPN(7)); rep_ < nrep_; ++rep_) { LOADP();
#if DBG_CHECK
            if (DBG_CHECK == 2 && l == DBG_CHECK_LAYER) { attn_check(P, l, lds, OPQ_S(vcu), OPQ_S(G), OPQ_TID(), ctl + 64); __syncthreads(); }
#endif
            pg8::Gemm g{(const bf16*)(P.ws + WS_AO), (const bf16*)(wl + WL_WNSA), S, DM, DM, DM}; pg8::StaticOrder So; So.init(S, DM, OPQ_S(G), OPQ_S(bx));
            pg8::EpiB<4> E{(bf16*)(P.ws + WS_MG), DM, nullptr, Pm + C_GB, PW, (const bf16*)(P.ws + WS_YA), DM};
            pg8::gemm_phase<pg8::EpiB<4>, pg8::StaticOrder, true, true>(lds, g, So, E, OPQ_TID());
            SEAM(pb + 5);
        }
        if (PH_EN(8) && IN(pb + 6)) for (int rep_ = 0, nrep_ = (DUPN(8)); rep_ < nrep_; ++rep_) { LOADP();
            MAIN_CHECK(5);
            pg8::Gemm g{(const bf16*)(P.ws + WS_MG), (const bf16*)(wl + WL_WOUT), S, DM, DM, DM}; pg8::StaticOrder So; So.init(S, DM, OPQ_S(G), OPQ_S(bx));
            pg8::EpiB<0> E{Y, DM, nullptr, nullptr, 0, nullptr, 0};
            pg8::gemm_phase<pg8::EpiB<0>, pg8::StaticOrder, true, true>(lds, g, So, E, OPQ_TID());
            SEAM(pb + 6);
        }
        if (PH_EN(9) && IN(pb + 7)) for (int rep_ = 0, nrep_ = (1); rep_ < nrep_; ++rep_) { LOADP(); MAIN_CHECK(6); resid_phase<true>(P, lds, l == 0 ? (const void*)P.x : (const void*)(P.ws + WS_XB), l != 0, (void*)(P.ws + WS_XB), true, Y, H, true, l, 2, 1, l, 4, 3, 2, OPQ_S(vcu), OPQ_S(G), OPQ_S(wave), OPQ_TID() & 63, OPQ_TID()); SEAM(pb + 7); }
        if (PH_EN(10) && IN(pb + 8)) for (int rep_ = 0, nrep_ = (DUPN(10)); rep_ < nrep_; ++rep_) { LOADP();
            MAIN_CHECK(7);
            pg8::Gemm g{H, (const bf16*)(wl + WL_WUP), S, FF, DM, DM}; pg8::StaticOrder So; So.init(S, FF, OPQ_S(G), OPQ_S(bx));
            pg8::EpiB<1> E{(bf16*)(P.ws + WS_U), FF, nullptr, nullptr, 0, nullptr, 0};
            pg8::gemm_phase<pg8::EpiB<1>, pg8::StaticOrder, true, true>(lds, g, So, E, OPQ_TID());
            SEAM(pb + 8);
        }
        if (PH_EN(11) && IN(pb + 9)) for (int rep_ = 0, nrep_ = (DUPN(11)); rep_ < nrep_; ++rep_) { LOADP();
            MAIN_CHECK(8);
            pg8::Gemm g{(const bf16*)(P.ws + WS_U), (const bf16*)(wl + WL_WDOWN), S, DM, FF, FF}; pg8::StaticOrder So; So.init(S, DM, OPQ_S(G), OPQ_S(bx));
            pg8::EpiB<0> E{Y, DM, nullptr, nullptr, 0, nullptr, 0};
            pg8::gemm_phase<pg8::EpiB<0>, pg8::StaticOrder, true, true>(lds, g, So, E, OPQ_TID());
            SEAM(pb + 9);
        }
        if (PH_EN(12) && IN(pb + 10)) for (int rep_ = 0, nrep_ = (1); rep_ < nrep_; ++rep_) { LOADP();
            MAIN_CHECK(9);
            resid_phase<true>(P, lds, (const void*)(P.ws + WS_XB), true, l + 1 < DEPTH ? (void*)(P.ws + WS_XB) : (void*)P.out, l + 1 < DEPTH, Y, H, l + 1 < DEPTH, l, 5, 3, (l + 1 < DEPTH) ? l + 1 : l, 1, 0, 0, OPQ_S(vcu), OPQ_S(G), OPQ_S(wave), OPQ_TID() & 63, OPQ_TID());
            if (l + 1 < DEPTH) SEAM(pb + 10);
#if DBG_CHECK
            else { __syncthreads(); if (OPQ_S(bx) == 0 && OPQ_TID() == 0) { __threadfence(); const unsigned f = __hip_atomic_load(ctl + 64, __ATOMIC_RELAXED, __HIP_MEMORY_SCOPE_AGENT);
                if (f) { const unsigned ft = (0xffffffffu - __hip_atomic_load(ctl + 65, __ATOMIC_RELAXED, __HIP_MEMORY_SCOPE_AGENT)) + 1u, cnt = 0u; (void)cnt;
                    P.out[0] = 2000.0f * ((((ft - 1u) & 63u) >> 3) + 1u); } } }
#endif
        }
    }
#undef IN
#undef SEAM
}

extern "C" void kernel_launch(void* const* d_in, const int* in_sizes, int n_in, void* d_out, int out_size, void* d_ws, size_t ws_size, hipStream_t stream) {
    static int grid = 0;
    if (grid == 0) {
        if (n_in != 18 || out_size != S * DM || ws_size < WS_END) { fprintf(stderr, "kernel_launch: unexpected problem (n_in %d, out %d, ws %zu, need %zu)\n", n_in, out_size, ws_size, (size_t)WS_END); grid = -1; return; }
        int dev = 0, cus = 0, per_cu = 0;
        if (hipGetDevice(&dev) != hipSuccess || hipDeviceGetAttribute(&cus, hipDeviceAttributeMultiprocessorCount, dev) != hipSuccess) { grid = -1; return; }
        if (hipFuncSetAttribute((const void*)nsa_fwd, hipFuncAttributeMaxDynamicSharedMemorySize, LDS_BYTES) != hipSuccess) { fprintf(stderr, "kernel_launch: hipFuncSetAttribute failed\n"); grid = -1; return; }
        if (hipOccupancyMaxActiveBlocksPerMultiprocessor(&per_cu, (const void*)nsa_fwd, NWAVES * 64, LDS_BYTES) != hipSuccess || per_cu < 1)
            fprintf(stderr, "kernel_launch: occupancy query reports %d workgroups per CU\n", per_cu);
        (void)hipGetLastError();
        grid = cus;
    }
    if (grid < 0) return;
    if (hipMemsetAsync((char*)d_ws + WS_CTL, 0, CTL_ZERO_BYTES, stream) != hipSuccess) { fprintf(stderr, "kernel_launch: memset failed\n"); return; }
    Args a{};
    for (int i = 0; i < 18; ++i) a.in[i] = d_in[i];
    a.out = (float*)d_out; a.ws = (unsigned char*)d_ws;
#if MK_PER_PHASE
    for (int ph = 0; ph < N_PHASES; ++ph) { a.ph_lo = ph; a.ph_hi = ph + 1; hipLaunchKernelGGL(nsa_fwd, dim3(grid), dim3(NWAVES * 64), LDS_BYTES, stream, a); }
#else
    a.ph_lo = 0; a.ph_hi = N_PHASES;
    hipLaunchKernelGGL(nsa_fwd, dim3(grid), dim3(NWAVES * 64), LDS_BYTES, stream, a);
#endif
    const hipError_t le = hipPeekAtLastError();
    if (le != hipSuccess) fprintf(stderr, "kernel_launch: launch failed: %s\n", hipGetErrorName(le));
}
```

```cpp
#include <hip/hip_runtime.h>
#include <cstdio>
#include <cstdint>

#define GAS __attribute__((address_space(1)))
#define GAS_K __attribute__((address_space(4)))
#define LAS __attribute__((address_space(3)))
typedef unsigned short bf16;
typedef short bf16x8 __attribute__((ext_vector_type(8)));
typedef float f32x4 __attribute__((ext_vector_type(4)));
typedef float f32x2 __attribute__((ext_vector_type(2)));
typedef unsigned u32x4 __attribute__((ext_vector_type(4)));
typedef unsigned u32x2 __attribute__((ext_vector_type(2)));

constexpr int S = 16384, DM = 2048, DEPTH = 4, CWID = 1024, NH = 16, NG = 4, HD = 128, FF = 8192;
constexpr int INW = 12336, PW = 12544;
constexpr int C_BG = 0, C_CG = 1024, C_XA = 2048, C_Q = 3072, C_KV = 5120, C_GA = 8192, C_GB = 10240, C_GN = 12288;
constexpr float NORM_EPS = 1e-6f;
constexpr float QSCALE = 0.12751743082459868f;
constexpr int NWAVES = 8;

namespace pg8 {
typedef unsigned short bf16_t;
constexpr int BM = 256, BK = 64, HALF = 128, HTB = HALF * BK * 2, STAGE_BYTES = 8 * HTB, NXCD = 8, WGM = 4;
__host__ __device__ __forceinline__ int lds_byte(int r, int c) { const int st = (r >> 4) * 2 + (c >> 5), rr = r & 15, cc = c & 31, ob = rr * 64 + cc * 2; return st * 1024 + (ob ^ (((ob >> 9) & 1) << 5)); }
__host__ __device__ __forceinline__ void stage_rc(int b, int& R, int& C) { const int st = b / 1024, sb = b % 1024, swz = sb ^ (((sb >> 9) & 1) << 5); R = (st >> 1) * 16 + swz / 64; C = (st & 1) * 32 + (swz % 64) / 2; }
__host__ __device__ __forceinline__ int perm32(int rho) { const int n = rho >> 4, i = rho & 15; return 8 * (i >> 2) + 4 * n + (i & 3); }

struct Unit { int pm, pn; };
struct Gemm { const bf16_t* A; const bf16_t* Bt; int M, N, K, lda; };

struct StaticOrder {
    int nM, nN, nwg, G, c;
    __device__ void init(int M, int N, int G_, int c_) { nM = M / BM; nN = N / BM; nwg = nM * nN; G = G_; c = c_; if (c_ < 0 || c_ >= G_) nwg = 0; }
    __device__ bool next(int i, Unit& u) const { return map((long)i * G + c, u); }
    __device__ bool map(const long L, Unit& u) const {
        if (L >= nwg) return false;
        int wgid = (int)L; { const int q = nwg / NXCD, r = nwg % NXCD, xcd = wgid % NXCD, off = wgid / NXCD; wgid = (xcd < r ? xcd * (q + 1) : r * (q + 1) + (xcd - r) * q) + off; }
        const int nig = WGM * nN, gid = wgid / nig, fm = gid * WGM, gsz = (nM - fm) < WGM ? (nM - fm) : WGM;
        u.pm = fm + ((wgid % nig) % gsz); u.pn = (wgid % nig) / gsz; return true;
    }
    __device__ __forceinline__ void a_ready(const Unit&) const {}
    __device__ __forceinline__ void done(const Unit&) const {}
};

typedef float f32x2_t_ __attribute__((ext_vector_type(2))); typedef __bf16 bf16x2_t_ __attribute__((ext_vector_type(2)));
__device__ __forceinline__ unsigned cvt_pk_bf16(float lo, float hi) { const f32x2_t_ v = {lo, hi}; const bf16x2_t_ b = __builtin_convertvector(v, bf16x2_t_); return __builtin_bit_cast(unsigned, b); }
__device__ __forceinline__ float bflo(unsigned w) { return __uint_as_float(w << 16); }
__device__ __forceinline__ float bfhi(unsigned w) { return __uint_as_float(w & 0xffff0000u); }
__device__ __forceinline__ float sigmoidf_(float x) { return __builtin_amdgcn_rcpf(1.0f + __builtin_amdgcn_exp2f(-1.4426950408889634f * x)); }

struct YaOrder {
    StaticOrder base; int bx;
    __device__ bool next(int i, Unit& u) const {
        if (bx < 32) return false;
        if (i < 2) return base.next(i, u);
        if (i == 2 && bx < 96) { const int idx = bx - 32; return base.map(idx < 32 ? (long)idx : (long)(idx - 32) + base.G, u); }
        return false;
    }
    __device__ __forceinline__ void a_ready(const Unit&) const {}
    __device__ __forceinline__ void done(const Unit&) const {}
};
struct CmpOrder {
    int c;
    __device__ bool next(int i, Unit& u) const { if (i != 0 || c < 0 || c >= 32) return false; u.pm = c; u.pn = c >> 4; return true; }
    __device__ __forceinline__ void a_ready(const Unit&) const {}
    __device__ __forceinline__ void done(const Unit&) const {}
};
struct EpiF32 {
    static constexpr bool PERM = false, AFTER_DRAIN = false;
    float* C; int ldc;
    __device__ __forceinline__ void operator()(const f32x4 (&acc)[2][2][4][2], const Unit& u, int wr, int wc, int fr, int fq) const {
        const int row0 = u.pm * BM + wr * 64 + fr, col0 = u.pn * BM + wc * 32 + 4 * fq;
#pragma unroll
        for (int ai = 0; ai < 2; ++ai)
#pragma unroll
            for (int m = 0; m < 4; ++m) { float* rowp = C + (size_t)(row0 + ai * HALF + m * 16) * ldc + col0;
#pragma unroll
                for (int bj = 0; bj < 2; ++bj)
#pragma unroll
                    for (int n = 0; n < 2; ++n) *(f32x4*)(rowp + bj * HALF + n * 16) = acc[ai][bj][m][n]; }
    }
};
template <int MODE, bool COLWRAP = false> struct EpiB {
    static constexpr bool PERM = true, AFTER_DRAIN = false;
    bf16_t* O; int ldc; const float* bias; const bf16_t* G; int ldg; const bf16_t* ADD; int ldadd;
    __device__ __forceinline__ void operator()(const f32x4 (&acc)[2][2][4][2], const Unit& u, int wr, int wc, int fr, int fq) const {
        const int row0 = u.pm * BM + wr * 64 + fr, col0 = u.pn * BM + wc * 32 + 8 * fq;
#pragma unroll
        for (int ai = 0; ai < 2; ++ai)
#pragma unroll
            for (int m = 0; m < 4; ++m) { const int row = row0 + ai * HALF + m * 16;
#pragma unroll
                for (int bj = 0; bj < 2; ++bj) { const int col = col0 + bj * HALF;
                    float v[8];
#pragma unroll
                    for (int e = 0; e < 4; ++e) { v[e] = acc[ai][bj][m][0][e]; v[4 + e] = acc[ai][bj][m][1][e]; }
                    if (MODE == 1) {
#pragma unroll
                        for (int e = 0; e < 8; ++e) { const float t = fmaxf(v[e], 0.f); v[e] = t * t; }
                    }
                    if (MODE == 2) { const f32x4 b0 = *(const f32x4*)(bias + col), b1 = *(const f32x4*)(bias + col + 4);
#pragma unroll
                        for (int e = 0; e < 8; ++e) { const float x = v[e] + (e < 4 ? b0[e] : b1[e - 4]); v[e] = x * sigmoidf_(1.5957691216057308f * (x + 0.044715f * x * x * x)); }
                    }
                    if (MODE == 3 || MODE == 4) { const u32x4 gw = *(const u32x4*)(G + (size_t)row * ldg + col);
#pragma unroll
                        for (int e = 0; e < 4; ++e) { v[2 * e] *= sigmoidf_(bflo(gw[e])); v[2 * e + 1] *= sigmoidf_(bfhi(gw[e])); }
                    }
                    if (MODE == 4) { const u32x4 aw = *(const u32x4*)(ADD + (size_t)row * ldadd + col);
#pragma unroll
                        for (int e = 0; e < 4; ++e) { v[2 * e] += bflo(aw[e]); v[2 * e + 1] += bfhi(aw[e]); }
                    }
                    u32x4 w; w.x = cvt_pk_bf16(v[0], v[1]); w.y = cvt_pk_bf16(v[2], v[3]); w.z = cvt_pk_bf16(v[4], v[5]); w.w = cvt_pk_bf16(v[6], v[7]);
                    *(u32x4*)(O + (size_t)row * ldc + (COLWRAP ? (col & 255) : col)) = w; } }
    }
};

template <class Epi, class Sched, bool ALIGN_EPI = false, bool SP2 = false>
__device__ __forceinline__ void gemm_phase(LAS unsigned char* lds, const Gemm g, const Sched& S, const Epi& E, const int tid) {
    const int wid = __builtin_amdgcn_readfirstlane(tid >> 6), lane = tid & 63, wr = wid >> 2, wc = wid & 3, fr = lane & 15, fq = lane >> 4;
    const int K = g.K, nt = K / BK;
    unsigned voffA[2], voffB[2];
#pragma unroll
    for (int i = 0; i < 2; ++i) { int R, C; stage_rc(tid * 16 + i * 8192, R, C); const int Rb = Epi::PERM ? ((R & ~31) + perm32(R & 31)) : R;
        voffA[i] = (unsigned)(R * g.lda + C) * 2u; voffB[i] = (unsigned)(Rb * K + C) * 2u; }
    const size_t kstep = (size_t)(BK * 2);
    const size_t hstepA = (size_t)HALF * g.lda * 2, hstepB = (size_t)HALF * K * 2;
    const size_t tstepA = 2 * hstepA, tstepB = 2 * hstepB;
    const unsigned ldsw = (unsigned)wid * 1024u;
    const int aoff = lds_byte(wr * 64 + fr, fq * 8), boff = lds_byte(wc * 32 + fr, fq * 8);
#define PG8_SA(b, h) (((b) * 2 + (h)) * HTB)
#define PG8_SB(b, h) ((4 + (b) * 2 + (h)) * HTB)
#define PG8_STAGE(bufoff, gbase, voff) do { _Pragma("unroll") for (int _i = 0; _i < 2; ++_i) \
        __builtin_amdgcn_global_load_lds((const unsigned*)((const char*)(gbase) + (voff)[_i]), (LAS unsigned*)(lds + (bufoff) + ldsw + _i * 8192), 16, 0, 0); } while (0)
#define PG8_LDA(dst, b, h) do { _Pragma("unroll") for (int m = 0; m < 4; ++m) _Pragma("unroll") for (int k = 0; k < 2; ++k) dst[m][k] = *(const LAS bf16x8*)(lds + PG8_SA(b, h) + aoff + m * 2048 + k * 1024); } while (0)
#define PG8_LDB(dst, b, h) do { _Pragma("unroll") for (int n = 0; n < 2; ++n) _Pragma("unroll") for (int k = 0; k < 2; ++k) dst[n][k] = *(const LAS bf16x8*)(lds + PG8_SB(b, h) + boff + n * 2048 + k * 1024); } while (0)
#define PG8_MMA(ai, bj, At, Bt) do { __builtin_amdgcn_s_setprio(1); _Pragma("unroll") for (int m = 0; m < 4; ++m) _Pragma("unroll") for (int n = 0; n < 2; ++n) _Pragma("unroll") for (int k = 0; k < 2; ++k) \
        acc[ai][bj][m][n] = __builtin_amdgcn_mfma_f32_16x16x32_bf16(Bt[n][k], At[m][k], acc[ai][bj][m][n], 0, 0, 0); __builtin_amdgcn_s_setprio(0); } while (0)
#define PG8_WAIT_V(n) asm volatile("s_waitcnt vmcnt(" #n ")" ::: "memory")
#define PG8_WAIT_L(n) asm volatile("s_waitcnt lgkmcnt(" #n ")" ::: "memory")
#define PG8_BAR __builtin_amdgcn_s_barrier()
#define PG8_SCHED __builtin_amdgcn_sched_barrier(0)
    Unit cur, nxt; int ui = 0;
    if (!S.next(0, cur)) return;
    f32x4 acc[2][2][4][2];
#pragma unroll
    for (int a = 0; a < 2; ++a)
#pragma unroll
        for (int b = 0; b < 2; ++b)
#pragma unroll
            for (int m = 0; m < 4; ++m)
#pragma unroll
                for (int n = 0; n < 2; ++n) acc[a][b][m][n] = (f32x4){0.f, 0.f, 0.f, 0.f};
    bf16x8 At[4][2], B0[2][2], B1[2][2];
    const char* cA = (const char*)g.A + (size_t)cur.pm * tstepA; const char* cB = (const char*)g.Bt + (size_t)cur.pn * tstepB;
    S.a_ready(cur);
    if constexpr (SP2) {
        PG8_STAGE(PG8_SB(0, 0), cB, voffB); PG8_STAGE(PG8_SB(0, 1), cB + hstepB, voffB); PG8_STAGE(PG8_SA(0, 0), cA, voffA); PG8_STAGE(PG8_SA(0, 1), cA + hstepA, voffA);
        if (wr == 1) PG8_BAR;
        PG8_WAIT_V(2); PG8_BAR;
        PG8_STAGE(PG8_SB(1, 0), cB + kstep, voffB); PG8_STAGE(PG8_SA(1, 0), cA + kstep, voffA); PG8_STAGE(PG8_SB(1, 1), cB + hstepB + kstep, voffB);
        PG8_WAIT_V(6); PG8_BAR;
    } else {
        PG8_STAGE(PG8_SB(0, 0), cB, voffB); PG8_STAGE(PG8_SA(0, 0), cA, voffA); PG8_STAGE(PG8_SB(0, 1), cB + hstepB, voffB); PG8_STAGE(PG8_SA(0, 1), cA + hstepA, voffA);
        if (wr == 1) PG8_BAR;
        PG8_WAIT_V(4); PG8_BAR;
        PG8_STAGE(PG8_SB(1, 0), cB + kstep, voffB); PG8_STAGE(PG8_SA(1, 0), cA + kstep, voffA); PG8_STAGE(PG8_SB(1, 1), cB + hstepB + kstep, voffB);
        PG8_WAIT_V(6); PG8_BAR;
    }
    for (;;) {
        const bool has_next = S.next(ui + 1, nxt);
        const char* nA = has_next ? (const char*)g.A + (size_t)nxt.pm * tstepA : cA; const char* nB = has_next ? (const char*)g.Bt + (size_t)nxt.pn * tstepB : cB;
        for (int t = 0; t < nt; t += 2) {
            const bool last = (t == nt - 2);
            const char* a1 = cA + (size_t)(t + 1) * kstep;
            const char* a2 = last ? nA : cA + (size_t)(t + 2) * kstep; const char* b2 = last ? nB : cB + (size_t)(t + 2) * kstep;
            const char* a3 = a2 + kstep; const char* b3 = b2 + kstep;
            if (last && has_next) S.a_ready(nxt);
            if constexpr (SP2) {
            PG8_LDB(B0, 0, 0); PG8_LDB(B1, 0, 1); PG8_SCHED; PG8_LDA(At, 0, 0); PG8_STAGE(PG8_SA(1, 1), a1 + hstepA, voffA);
            PG8_WAIT_V(8); PG8_WAIT_L(0); PG8_BAR; PG8_MMA(0, 0, At, B0); PG8_MMA(0, 1, At, B1); PG8_BAR; PG8_SCHED;
            PG8_LDA(At, 0, 1); PG8_STAGE(PG8_SB(0, 0), b2, voffB); PG8_STAGE(PG8_SB(0, 1), b2 + hstepB, voffB); PG8_STAGE(PG8_SA(0, 0), a2, voffA);
            PG8_WAIT_V(8); PG8_WAIT_L(0); PG8_BAR; PG8_MMA(1, 0, At, B0); PG8_MMA(1, 1, At, B1); PG8_BAR; PG8_SCHED;
            PG8_LDB(B0, 1, 0); PG8_LDB(B1, 1, 1); PG8_SCHED; PG8_LDA(At, 1, 0); PG8_STAGE(PG8_SA(0, 1), a2 + hstepA, voffA);
            PG8_WAIT_V(8); PG8_WAIT_L(0); PG8_BAR; PG8_MMA(0, 0, At, B0); PG8_MMA(0, 1, At, B1); PG8_BAR; PG8_SCHED;
            PG8_LDA(At, 1, 1); PG8_STAGE(PG8_SB(1, 0), b3, voffB); PG8_STAGE(PG8_SB(1, 1), b3 + hstepB, voffB); PG8_STAGE(PG8_SA(1, 0), a3, voffA);
            PG8_WAIT_V(8); PG8_WAIT_L(0); PG8_BAR; PG8_MMA(1, 0, At, B0); PG8_MMA(1, 1, At, B1); PG8_BAR; PG8_SCHED;
            } else {
            PG8_LDB(B0, 0, 0); PG8_SCHED; PG8_LDA(At, 0, 0); PG8_STAGE(PG8_SA(1, 1), a1 + hstepA, voffA);
            PG8_WAIT_L(8); PG8_BAR; PG8_WAIT_L(0); PG8_MMA(0, 0, At, B0); PG8_BAR; PG8_SCHED;
            PG8_LDB(B1, 0, 1); PG8_STAGE(PG8_SB(0, 0), b2, voffB);
            PG8_BAR; PG8_WAIT_L(0); PG8_MMA(0, 1, At, B1); PG8_BAR;
            PG8_LDA(At, 0, 1); PG8_STAGE(PG8_SA(0, 0), a2, voffA);
            PG8_BAR; PG8_WAIT_L(0); PG8_MMA(1, 0, At, B0); PG8_BAR; PG8_SCHED;
            PG8_STAGE(PG8_SB(0, 1), b2 + hstepB, voffB);
            PG8_WAIT_V(6); PG8_BAR; PG8_MMA(1, 1, At, B1); PG8_BAR;
            PG8_LDB(B0, 1, 0); PG8_SCHED; PG8_LDA(At, 1, 0); PG8_STAGE(PG8_SA(0, 1), a2 + hstepA, voffA);
            PG8_WAIT_L(8); PG8_BAR; PG8_WAIT_L(0); PG8_MMA(0, 0, At, B0); PG8_BAR; PG8_SCHED;
            PG8_LDB(B1, 1, 1); PG8_STAGE(PG8_SB(1, 0), b3, voffB);
            PG8_BAR; PG8_WAIT_L(0); PG8_MMA(0, 1, At, B1); PG8_BAR;
            PG8_LDA(At, 1, 1); PG8_STAGE(PG8_SA(1, 0), a3, voffA);
            PG8_BAR; PG8_WAIT_L(0); PG8_MMA(1, 0, At, B0); PG8_BAR; PG8_SCHED;
            PG8_STAGE(PG8_SB(1, 1), b3 + hstepB, voffB);
            PG8_WAIT_V(6); PG8_BAR; PG8_MMA(1, 1, At, B1); PG8_BAR;
            }
        }
        if constexpr (ALIGN_EPI) { if (wr == 0) PG8_BAR; }
        E(acc, cur, wr, wc, fr, fq); S.done(cur);
        if (!has_next) break;
#pragma unroll
        for (int a = 0; a < 2; ++a)
#pragma unroll
            for (int b = 0; b < 2; ++b)
#pragma unroll
                for (int m = 0; m < 4; ++m)
#pragma unroll
                    for (int n = 0; n < 2; ++n) acc[a][b][m][n] = (f32x4){0.f, 0.f, 0.f, 0.f};
        cur = nxt; cA = nA; cB = nB; ++ui;
        if constexpr (ALIGN_EPI) { if (wr == 1) PG8_BAR; }
    }
    PG8_WAIT_V(0);
    if constexpr (!ALIGN_EPI) { if (wr == 0) PG8_BAR; }
    PG8_BAR;
#undef PG8_SA
#undef PG8_SB
#undef PG8_STAGE
#undef PG8_LDA
#undef PG8_LDB
#undef PG8_MMA
#undef PG8_WAIT_V
#undef PG8_WAIT_L
#undef PG8_BAR
#undef PG8_SCHED
}
}

constexpr size_t al4k(size_t x) { return (x + 4095) & ~(size_t)4095; }
constexpr size_t WS_CTL = 0, CTL_ZERO_BYTES = 1u << 20;
constexpr size_t WS_MODP = CTL_ZERO_BYTES;
constexpr size_t WS_B1PART = al4k(WS_MODP + (size_t)DEPTH * 8 * 6 * DM * 4);
constexpr size_t WS_B1P = al4k(WS_B1PART + (size_t)DEPTH * 2 * 32 * 256 * 4);
constexpr size_t WS_COS = al4k(WS_B1P + 2 * 256 * 4);
constexpr size_t WS_SIN = al4k(WS_COS + (size_t)S * 16 * 4);
constexpr size_t WS_GT = al4k(WS_SIN + (size_t)S * 16 * 4);
constexpr size_t WS_W2T = al4k(WS_GT + (size_t)S * 48 * 4);
constexpr size_t WS_KCI = al4k(WS_W2T + (size_t)DEPTH * 2 * 128 * 256 * 2);
constexpr size_t WS_VCI = al4k(WS_KCI + (size_t)NG * 16 * 16384);
constexpr size_t WS_HC = al4k(WS_VCI + (size_t)NG * 16 * 16384);
constexpr size_t WS_WL = al4k(WS_HC + (size_t)2 * 4096 * 256 * 2);
constexpr size_t WL_WIN = 0;
constexpr size_t WL_WCONV = WL_WIN + (size_t)PW * DM * 2;
constexpr size_t WL_W1T = WL_WCONV + (size_t)DM * CWID * 2;
constexpr size_t WL_WNSA = WL_W1T + (size_t)2 * 256 * 4096 * 2;
constexpr size_t WL_WOUT = WL_WNSA + (size_t)DM * DM * 2;
constexpr size_t WL_WUP = WL_WOUT + (size_t)DM * DM * 2;
constexpr size_t WL_WDOWN = WL_WUP + (size_t)FF * DM * 2;
constexpr size_t WL_BYTES = al4k(WL_WDOWN + (size_t)DM * FF * 2);
constexpr size_t WS_P = al4k(WS_WL + DEPTH * WL_BYTES);
constexpr size_t WS_U = WS_P;
constexpr size_t WS_Y = WS_P + (size_t)S * FF * 2;
constexpr size_t P_REGION = (size_t)S * PW * 2;
static_assert((size_t)S * FF * 2 + (size_t)S * DM * 4 <= P_REGION, "U + Y fit in P's region");
constexpr size_t WS_H = al4k(WS_P + P_REGION);
constexpr size_t WS_QP = al4k(WS_H + (size_t)S * DM * 2);
constexpr size_t WS_MG = WS_QP;
constexpr size_t WS_KSI = al4k(WS_QP + (size_t)S * DM * 2);
constexpr size_t WS_VSI = WS_KSI + (size_t)NG * 256 * 16384;
constexpr size_t WS_KWI = WS_VSI + (size_t)NG * 256 * 16384;
constexpr size_t WS_VWI = WS_KWI + (size_t)NG * 256 * 16384;
constexpr size_t WS_KCR = WS_VWI + (size_t)NG * 256 * 16384;
constexpr size_t WS_VCR = WS_KCR + (size_t)NG * S * HD * 2;
constexpr size_t WS_CV = al4k(WS_VCR + (size_t)NG * S * HD * 2 + 65536);
constexpr size_t WS_AO = al4k(WS_CV + (size_t)S * CWID * 2);
constexpr size_t WS_YA = al4k(WS_AO + (size_t)S * DM * 2);
constexpr size_t WS_FS = al4k(WS_YA + (size_t)S * DM * 2);
constexpr size_t WS_XB = al4k(WS_FS + (size_t)256 * 8 * 16384);
constexpr size_t WS_END = al4k(WS_XB + (size_t)S * DM * 2);

constexpr int CW_BAR = 4096;

constexpr int RING_BYTES = 131072;
constexpr int AT_KV = 0, AT_IMP = 65536, IMP_STRIDE = 257, AT_SELW = AT_IMP + 64 * IMP_STRIDE * 4;
constexpr int MISC_OFF = AT_SELW + NWAVES * 256 * 4;
constexpr int LDS_BYTES = 147456;
static_assert(MISC_OFF + 512 <= LDS_BYTES && MISC_OFF >= RING_BYTES, "LDS map");

typedef GAS unsigned gu32;
#define RLX_AGENT __ATOMIC_RELAXED, __HIP_MEMORY_SCOPE_AGENT
#define LDS_WAIT() asm volatile("s_waitcnt lgkmcnt(0)" ::: "memory")
#define VM_WAIT() asm volatile("s_waitcnt vmcnt(0)" ::: "memory")

#define XB_TMO      128
#define XB_XCNT(j)  (256  + 64 * (j))
#define XB_XSUB(j)  (1280 + 64 * (j))
#define XB_XGEN(j)  (2304 + 64 * (j))
#define XB_TOP      3328
#define XB_TOPGEN   3392
#define XCD_BAR_WORDS 3456
#define XB_SPIN_CAP (1u << 22)

__device__ __forceinline__ unsigned xb_ld(unsigned* p)              { return __hip_atomic_load(p, __ATOMIC_RELAXED, __HIP_MEMORY_SCOPE_AGENT); }
__device__ __forceinline__ unsigned xb_add(unsigned* p, unsigned v) { return __hip_atomic_fetch_add(p, v, __ATOMIC_RELAXED, __HIP_MEMORY_SCOPE_AGENT); }
__device__ __forceinline__ unsigned xb_xcc_id() { return (unsigned)__builtin_amdgcn_s_getreg((3 << 11) | 20) & 0xFu; }
#define XB_SPIN(cond, bar) do { unsigned _sp = 0; while (cond) { __builtin_amdgcn_s_sleep(1); \
    if ((++_sp & 255u) == 0u) { if (xb_ld(&(bar)[XB_TMO])) break; if (_sp > XB_SPIN_CAP) { atomicAdd(&(bar)[XB_TMO], 1u); break; } } } } while (0)

struct XcdBarrier { unsigned* bar; unsigned x; volatile LAS unsigned* st; };

__device__ __forceinline__ XcdBarrier xcd_barrier_post(unsigned* bar, volatile LAS unsigned* st) {
    XcdBarrier b; b.bar = bar; b.x = xb_xcc_id(); b.st = st;
    if (threadIdx.x == 0) (void)xb_add(&bar[XB_XCNT(b.x)], 1u);
    return b;
}
__device__ __forceinline__ void xcd_barrier_complete(unsigned* bar, unsigned x, unsigned& nloc, unsigned& nx) {
    const unsigned G = gridDim.x * gridDim.y * gridDim.z;
    unsigned sum, cnt, mine, sp = 0u;
    for (;;) {
        sum = 0u; cnt = 0u; mine = 0u;
#pragma unroll
        for (unsigned j = 0; j < 16; ++j) { const unsigned c = xb_ld(&bar[XB_XCNT(j)]); sum += c; cnt += (c > 0u) ? 1u : 0u; mine = (j == x) ? c : mine; }
        if (sum == G) break;
        __builtin_amdgcn_s_sleep(1);
        if ((++sp & 255u) == 0u) { if (xb_ld(&bar[XB_TMO])) break; if (sp > XB_SPIN_CAP) { atomicAdd(&bar[XB_TMO], 1u); break; } }
    }
    nloc = mine > 0u ? mine : 1u; nx = cnt > 0u ? cnt : 1u;
}
__device__ __forceinline__ void xcd_barrier(const XcdBarrier& b) {
    asm volatile("s_waitcnt vmcnt(0)" ::: "memory");
    __syncthreads();
    if (threadIdx.x == 0) {
        unsigned* bar = b.bar;
        __builtin_amdgcn_s_waitcnt(0);
        unsigned nloc = b.st[0], nx = b.st[1];
        if (nloc == 0u) { xcd_barrier_complete(bar, b.x, nloc, nx); b.st[0] = nloc; b.st[1] = nx; }
        const unsigned old = xb_add(&bar[XB_XSUB(b.x)], 1u);
        const unsigned gen = old / nloc;
        if (old + 1u == (gen + 1u) * nloc) {
            __builtin_amdgcn_fence(__ATOMIC_RELEASE, "agent");
            asm volatile("s_waitcnt vmcnt(0)" ::: "memory");
            const unsigned og = xb_add(&bar[XB_TOP], 1u);
            const unsigned tg = og / nx;
            if (og + 1u == (tg + 1u) * nx) xb_add(&bar[XB_TOPGEN], 1u);
            else XB_SPIN(xb_ld(&bar[XB_TOPGEN]) == tg, bar);
            __builtin_amdgcn_fence(__ATOMIC_ACQUIRE, "agent");
            xb_add(&bar[XB_XGEN(b.x)], 1u);
            asm volatile("s_waitcnt vmcnt(0)" ::: "memory");
        } else {
            XB_SPIN(xb_ld(&bar[XB_XGEN(b.x)]) == gen, bar);
            __builtin_amdgcn_fence(__ATOMIC_ACQUIRE, "agent");
            asm volatile("s_waitcnt vmcnt(0)" ::: "memory");
        }
    }
    __syncthreads();
}

__device__ __forceinline__ unsigned f2bf(float f) { unsigned u = __builtin_bit_cast(unsigned, f); return (u + 0x7fffu + ((u >> 16) & 1u)) >> 16; }
__device__ __forceinline__ unsigned pk2(float lo, float hi) { return f2bf(lo) | (f2bf(hi) << 16); }
__device__ __forceinline__ float bf_lo(unsigned w) { return __uint_as_float(w << 16); }
__device__ __forceinline__ float bf_hi(unsigned w) { return __uint_as_float(w & 0xffff0000u); }
__device__ __forceinline__ float wave_sum(float v) {
#pragma unroll
    for (int o = 1; o < 64; o <<= 1) v += __shfl_xor(v, o);
    return v;
}
__device__ __forceinline__ float sigm(float x) { return __builtin_amdgcn_rcpf(1.0f + __builtin_amdgcn_exp2f(-1.4426950408889634f * x)); }
__device__ __forceinline__ void unpack8(const u32x4 w, float (&v)[8]) {
    v[0] = bf_lo(w.x); v[1] = bf_hi(w.x); v[2] = bf_lo(w.y); v[3] = bf_hi(w.y); v[4] = bf_lo(w.z); v[5] = bf_hi(w.z); v[6] = bf_lo(w.w); v[7] = bf_hi(w.w);
}
__device__ __forceinline__ u32x4 pack8(const float (&v)[8]) { u32x4 w; w.x = pk2(v[0], v[1]); w.y = pk2(v[2], v[3]); w.z = pk2(v[4], v[5]); w.w = pk2(v[6], v[7]); return w; }

__device__ __forceinline__ int k_rho(int kappa) { const int a = kappa >> 5, q = (kappa >> 3) & 3, h = (kappa >> 2) & 1, i = kappa & 3; return 16 * (2 * a + h) + 4 * q + i; }
__device__ __forceinline__ int kimg_off(int kappa, int ch  ) { const int rho = k_rho(kappa); return rho * 256 + ((ch ^ (rho & 15)) << 4); }
__device__ __forceinline__ int vimg_off(int d, int kc  ) { return d * 128 + ((kc ^ ((d >> 1) & 7)) << 4); }

struct Ptrs {
    const float *x, *c, *ada_w, *ada_b, *gains, *w_in, *conv_w, *w_conv_out, *cmp_pe, *cmp_w1, *cmp_b1, *cmp_w2, *cmp_b2, *w_nsa, *w_out, *w_up, *w_down;
    const int* pos;
    float* out; unsigned char* ws;
};
struct Args { const void* in[18]; float* out; unsigned char* ws; int ph_lo, ph_hi; };
static_assert(sizeof(Args) == 18 * 8 + 8 + 8 + 8, "Args has no padding");

__device__ __forceinline__ void transpose_item(const float* W, int ldw, int csrc0, int nvalid, int K, bf16* WT, int drow0, int k0, LAS float* scr, int lane) {
    const int col = lane & 31;
#pragma unroll 8
    for (int i = 0; i < 32; ++i) { const int kk = 2 * i + (lane >> 5); scr[kk * 33 + col] = (col < nvalid) ? W[(size_t)(k0 + kk) * ldw + csrc0 + col] : 0.f; }
    LDS_WAIT(); asm volatile("" ::: "memory");
    const int c = lane & 7;
#pragma unroll
    for (int j = 0; j < 4; ++j) { const int n = (lane >> 3) + 8 * j; const LAS float* s = scr + (8 * c) * 33 + n;
        u32x4 o; o.x = pk2(s[0 * 33], s[1 * 33]); o.y = pk2(s[2 * 33], s[3 * 33]); o.z = pk2(s[4 * 33], s[5 * 33]); o.w = pk2(s[6 * 33], s[7 * 33]);
        *(GAS u32x4*)(WT + (size_t)(drow0 + n) * K + k0 + 8 * c) = o; }
    LDS_WAIT(); asm volatile("" ::: "memory");
}
__device__ __forceinline__ void seg_item(const float* W, int ldw, int c0, int ncols, int K, bf16* WT, int r0, int item, LAS float* scr, int lane) {
    const int nblk = (ncols + 31) / 32, kb = item / nblk, nb = item % nblk;
    const int nv = ncols - 32 * nb;
    transpose_item(W, ldw, c0 + 32 * nb, nv < 32 ? nv : 32, K, WT, r0 + 32 * nb, 64 * kb, scr, lane);
}

__constant__ double ROPE_INVF[16] = {1.0, 0.44036660267178046, 0.19392274474868576, 0.08539710028576561, 0.03760603093086393, 0.016560440080994446, 0.007292664737217109,
    0.003211445994752591, 0.001414213562373095, 0.000622772421914596, 0.0002742481756762073, 0.00012076973741146504, 5.318295896944988e-05, 2.341999896140934e-05,
    1.031338537721246e-05, 4.5416704806078695e-06};

__device__ __forceinline__ void sincos_f64(double x, float& sn, float& cs) {
    const double k = __builtin_rint(x * 0.6366197723675814);
    double r = __builtin_fma(-k, 1.5707963267948966, x); r = __builtin_fma(-k, 6.123233995736766e-17, r);
    const double r2 = r * r;
    double ps = -1.0 / 1307674368000.0; ps = ps * r2 + 1.0 / 6227020800.0; ps = ps * r2 - 1.0 / 39916800.0; ps = ps * r2 + 1.0 / 362880.0; ps = ps * r2 - 1.0 / 5040.0; ps = ps * r2 + 1.0 / 120.0; ps = ps * r2 - 1.0 / 6.0; ps = ps * r2 + 1.0;
    const double s = ps * r;
    double pc = 1.0 / 20922789888000.0; pc = pc * r2 - 1.0 / 87178291200.0; pc = pc * r2 + 1.0 / 479001600.0; pc = pc * r2 - 1.0 / 3628800.0; pc = pc * r2 + 1.0 / 40320.0; pc = pc * r2 - 1.0 / 720.0; pc = pc * r2 + 1.0 / 24.0; pc = pc * r2 - 0.5; pc = pc * r2 + 1.0;
    const int n = ((int)(long long)k) & 3;
    const double so = (n == 0) ? s : (n == 1) ? pc : (n == 2) ? -s : -pc;
    const double co = (n == 0) ? pc : (n == 1) ? -s : (n == 2) ? -pc : s;
    sn = (float)so; cs = (float)co;
}

constexpr int SEG_ITEMS[11] = {32 * 256, 32 * 64, 32 * 64, 32 * 2, 16 * 64, 64 * 8, 64 * 8, 32 * 64, 32 * 64, 32 * 256, 128 * 64};
constexpr int ITEMS_PER_LAYER = 8192 + 2048 + 2048 + 64 + 1024 + 512 + 512 + 2048 + 2048 + 8192 + 8192;
constexpr int W2T_ITEMS = 4 * 4;

__device__ __forceinline__ void p0_prologue(const Ptrs& P, LAS unsigned char* lds, int vcu, int G, int wave, int lane, int tid) {
    LAS float* scr = (LAS float*)(lds + wave * 16384);
    const int gw = vcu * NWAVES + wave, NGW = G * NWAVES;
    for (int it = gw; it < DEPTH * ITEMS_PER_LAYER; it += NGW) {
        const int l = it / ITEMS_PER_LAYER; int r = it % ITEMS_PER_LAYER;
        unsigned char* wl = P.ws + WS_WL + (size_t)l * WL_BYTES;
        const float* win = P.w_in + (size_t)l * DM * INW;
        if (r < SEG_ITEMS[0]) { seg_item(win, INW, 0, 8192, DM, (bf16*)(wl + WL_WIN), 0, r, scr, lane); continue; } r -= SEG_ITEMS[0];
        if (r < SEG_ITEMS[1]) { seg_item(win, INW, 8240, 2048, DM, (bf16*)(wl + WL_WIN), C_GA, r, scr, lane); continue; } r -= SEG_ITEMS[1];
        if (r < SEG_ITEMS[2]) { seg_item(win, INW, 10288, 2048, DM, (bf16*)(wl + WL_WIN), C_GB, r, scr, lane); continue; } r -= SEG_ITEMS[2];
        if (r < SEG_ITEMS[3]) { seg_item(win, INW, 8192, 48, DM, (bf16*)(wl + WL_WIN), C_GN, r, scr, lane); continue; } r -= SEG_ITEMS[3];
        if (r < SEG_ITEMS[4]) { seg_item(P.w_conv_out + (size_t)l * CWID * DM, DM, 0, DM, CWID, (bf16*)(wl + WL_WCONV), 0, r, scr, lane); continue; } r -= SEG_ITEMS[4];
        if (r < SEG_ITEMS[5]) { seg_item(P.cmp_w1 + (size_t)(l * 2 + 0) * 4096 * 256, 256, 0, 256, 4096, (bf16*)(wl + WL_W1T), 0, r, scr, lane); continue; } r -= SEG_ITEMS[5];
        if (r < SEG_ITEMS[6]) { seg_item(P.cmp_w1 + (size_t)(l * 2 + 1) * 4096 * 256, 256, 0, 256, 4096, (bf16*)(wl + WL_W1T) + (size_t)256 * 4096, 0, r, scr, lane); continue; } r -= SEG_ITEMS[6];
        if (r < SEG_ITEMS[7]) { seg_item(P.w_nsa + (size_t)l * DM * DM, DM, 0, DM, DM, (bf16*)(wl + WL_WNSA), 0, r, scr, lane); continue; } r -= SEG_ITEMS[7];
        if (r < SEG_ITEMS[8]) { seg_item(P.w_out + (size_t)l * DM * DM, DM, 0, DM, DM, (bf16*)(wl + WL_WOUT), 0, r, scr, lane); continue; } r -= SEG_ITEMS[8];
        if (r < SEG_ITEMS[9]) { seg_item(P.w_up + (size_t)l * DM * FF, FF, 0, FF, DM, (bf16*)(wl + WL_WUP), 0, r, scr, lane); continue; } r -= SEG_ITEMS[9];
        seg_item(P.w_down + (size_t)l * FF * DM, DM, 0, DM, FF, (bf16*)(wl + WL_WDOWN), 0, r, scr, lane);
    }
    for (int it = gw; it < DEPTH * 2 * W2T_ITEMS; it += NGW) {
        const int m = it / W2T_ITEMS, r = it % W2T_ITEMS;
        seg_item(P.cmp_w2 + (size_t)m * 256 * 128, 128, 0, 128, 256, (bf16*)(P.ws + WS_W2T) + (size_t)m * 128 * 256, 0, r, scr, lane);
    }
    __syncthreads();
    {
        float* cosT = (float*)(P.ws + WS_COS); float* sinT = (float*)(P.ws + WS_SIN);
        for (int e = vcu * 512 + tid; e < S * 16; e += G * 512) {
            const int t = e >> 4, i = e & 15; float sn, cs; sincos_f64((double)P.pos[t] * ROPE_INVF[i], sn, cs); cosT[e] = cs; sinT[e] = sn;
        }
    }
    {
        LAS float* cact = (LAS float*)lds;
        for (int k = tid; k < DM; k += 512) { const float cv = P.c[k]; cact[k] = cv * sigm(cv); }
        __syncthreads();
        float* modp = (float*)(P.ws + WS_MODP);
        for (int e = vcu * 512 + tid; e < DEPTH * 8 * (6 * DM / 4); e += G * 512) {
            const int l = e / (8 * 3072), rem = e % (8 * 3072), kc = rem / 3072, c4 = rem % 3072;
            const float* w = P.ada_w + ((size_t)l * DM + kc * 256) * (6 * DM) + c4 * 4;
            f32x4 acc = {0.f, 0.f, 0.f, 0.f};
#pragma unroll 8
            for (int k = 0; k < 256; ++k) { const f32x4 wv = *(const f32x4*)(w + (size_t)k * (6 * DM)); acc += wv * cact[kc * 256 + k]; }
            *(f32x4*)(modp + ((size_t)(l * 8 + kc) * (6 * DM)) + c4 * 4) = acc;
        }
        __syncthreads();
    }
    for (int w = vcu; w < DEPTH * 2 * 32; w += G) {
        const int m = w >> 5, ch = w & 31;
        if (tid < 256) {
            const float* pe = P.cmp_pe + (size_t)m * 4096 + ch * 128; const float* w1 = P.cmp_w1 + ((size_t)m * 4096 + ch * 128) * 256 + tid;
            float acc = 0.f;
#pragma unroll 8
            for (int k = 0; k < 128; ++k) acc += pe[k] * w1[(size_t)k * 256];
            ((float*)(P.ws + WS_B1PART))[(size_t)w * 256 + tid] = acc;
        }
    }
}

__device__ __forceinline__ f32x4 modvec4(const Ptrs& P, int l, int off) {
    f32x4 v = *(const f32x4*)(P.ada_b + (size_t)l * 6 * DM + off);
    const float* mp = (const float*)(P.ws + WS_MODP) + (size_t)l * 8 * 6 * DM + off;
#pragma unroll
    for (int kc = 0; kc < 8; ++kc) v += *(const f32x4*)(mp + (size_t)kc * 6 * DM);
    return v;
}

template <bool HAS_Y>
__device__ __forceinline__ void resid_phase(const Ptrs& P, LAS unsigned char* lds, const void* xsrc_, const bool src_bf, void* xdst_, const bool dst_bf, const bf16* Y, bf16* H, const bool make_h,
                                            int lg, int gate_k, int gainA, int lh, int sc_k, int sh_k, int gainB, int vcu, int G, int wave, int lane, int tid) {
    LAS f32x4* vga = (LAS f32x4*)lds; LAS f32x4* vhb = vga + 512; LAS f32x4* vhc = vhb + 512;
    {
        const int c = 4 * tid;
        if (HAS_Y) vga[tid] = modvec4(P, lg, gate_k * DM + c) * *(const f32x4*)(P.gains + (size_t)(lg * 4 + gainA) * DM + c);
        if (make_h) { vhb[tid] = *(const f32x4*)(P.gains + (size_t)(lh * 4 + gainB) * DM + c) * (modvec4(P, lh, sc_k * DM + c) + 1.0f); vhc[tid] = modvec4(P, lh, sh_k * DM + c); }
    }
    __syncthreads();
    const int gw = vcu * NWAVES + wave, NGW = G * NWAVES;
    for (int m = gw; m < S; m += NGW) {
        f32x4 xv[8];
        if (src_bf) { const u32x2* xr = (const u32x2*)((const bf16*)xsrc_ + (size_t)m * DM) + lane;
#pragma unroll
            for (int j = 0; j < 8; ++j) { const u32x2 w = xr[64 * j]; xv[j] = (f32x4){bf_lo(w.x), bf_hi(w.x), bf_lo(w.y), bf_hi(w.y)}; }
        } else { const f32x4* xr = (const f32x4*)((const float*)xsrc_ + (size_t)m * DM) + lane;
#pragma unroll
            for (int j = 0; j < 8; ++j) xv[j] = xr[64 * j]; }
        if (HAS_Y) {
            f32x4 yv[8]; float s = 0.f;
            const u32x2* yr = (const u32x2*)(Y + (size_t)m * DM) + lane;
#pragma unroll
            for (int j = 0; j < 8; ++j) { const u32x2 w = yr[64 * j]; yv[j] = (f32x4){bf_lo(w.x), bf_hi(w.x), bf_lo(w.y), bf_hi(w.y)}; s += (yv[j].x * yv[j].x + yv[j].y * yv[j].y) + (yv[j].z * yv[j].z + yv[j].w * yv[j].w); }
            const float r = 1.0f / sqrtf(wave_sum(s) * (1.0f / DM) + NORM_EPS);
#pragma unroll
            for (int j = 0; j < 8; ++j) xv[j] += vga[lane + 64 * j] * (yv[j] * r);
            if (dst_bf) { u32x2* xo = (u32x2*)((bf16*)xdst_ + (size_t)m * DM) + lane;
#pragma unroll
                for (int j = 0; j < 8; ++j) { u32x2 w; w.x = pk2(xv[j].x, xv[j].y); w.y = pk2(xv[j].z, xv[j].w); xo[64 * j] = w;
                    xv[j] = (f32x4){bf_lo(w.x), bf_hi(w.x), bf_lo(w.y), bf_hi(w.y)}; }
            } else { f32x4* xo = (f32x4*)((float*)xdst_ + (size_t)m * DM) + lane;
#pragma unroll
                for (int j = 0; j < 8; ++j) xo[64 * j] = xv[j]; }
        }
        if (make_h) {
            float s = 0.f;
#pragma unroll
            for (int j = 0; j < 8; ++j) s += (xv[j].x * xv[j].x + xv[j].y * xv[j].y) + (xv[j].z * xv[j].z + xv[j].w * xv[j].w);
            const float r = 1.0f / sqrtf(wave_sum(s) * (1.0f / DM) + NORM_EPS);
            u32x2* ho = (u32x2*)(H + (size_t)m * DM) + lane;
#pragma unroll
            for (int j = 0; j < 8; ++j) { const f32x4 h = (xv[j] * r) * vhb[lane + 64 * j] + vhc[lane + 64 * j]; u32x2 w; w.x = pk2(h.x, h.y); w.y = pk2(h.z, h.w); ho[64 * j] = w; }
        }
    }
    __syncthreads();
}

__device__ __forceinline__ void rope8(float (&v)[8], const float (&p)[8], const float* cs, const float* sn, int ch  ) {
#pragma unroll
    for (int j = 0; j < 8; ++j) { const float c = cs[8 * (ch & 1) + j], s = sn[8 * (ch & 1) + j];
        v[j] = (ch < 2) ? (v[j] * c - p[j] * s) : (v[j] * c + p[j] * s); }
}
__device__ __forceinline__ void relayout_phase(const Ptrs& P, int l, LAS unsigned char* lds, int vcu, int G, int tid) {
    const bf16* Pm = (const bf16*)(P.ws + WS_P);
    const float* cosT = (const float*)(P.ws + WS_COS); const float* sinT = (const float*)(P.ws + WS_SIN);
    if (vcu == 0) {
        const float* part = (const float*)(P.ws + WS_B1PART) + (size_t)l * 2 * 32 * 256;
        const int kv = tid >> 8, col = tid & 255; float a = P.cmp_b1[(size_t)(l * 2 + kv) * 256 + col];
        for (int ch = 0; ch < 32; ++ch) a += part[(size_t)(kv * 32 + ch) * 256 + col];
        ((float*)(P.ws + WS_B1P))[tid] = a;
    }
    for (int b = vcu; b < S / 64; b += G) {
        const int t0 = b * 64;
        {
            const float* cw = P.conv_w + (size_t)l * 3 * CWID; bf16* CV = (bf16*)(P.ws + WS_CV);
            for (int e = tid; e < 64 * 128; e += 512) {
                const int tl = e >> 7, c8 = (e & 127) * 8, t = t0 + tl;
                float z[8] = {0.f, 0.f, 0.f, 0.f, 0.f, 0.f, 0.f, 0.f};
#pragma unroll
                for (int k = 0; k < 3; ++k) { const int tt = t - 2 + k;
                    if (tt >= 0) { float cg[8], xa[8]; unpack8(*(const u32x4*)(Pm + (size_t)tt * PW + C_CG + c8), cg); unpack8(*(const u32x4*)(Pm + (size_t)tt * PW + C_XA + c8), xa);
                        const f32x4 w0 = *(const f32x4*)(cw + k * CWID + c8), w1 = *(const f32x4*)(cw + k * CWID + c8 + 4);
#pragma unroll
                        for (int j = 0; j < 8; ++j) z[j] += (j < 4 ? w0[j] : w1[j - 4]) * (cg[j] * xa[j]); } }
                float bg[8]; unpack8(*(const u32x4*)(Pm + (size_t)t * PW + C_BG + c8), bg);
#pragma unroll
                for (int j = 0; j < 8; ++j) z[j] *= bg[j];
                *(u32x4*)(CV + (size_t)t * CWID + c8) = pack8(z);
            }
        }
        {
            bf16* QP = (bf16*)(P.ws + WS_QP);
            for (int e = tid; e < 64 * 256; e += 512) {
                const int tl = e >> 8, hh = (e >> 4) & 15, ch = e & 15, t = t0 + tl;
                const bf16* src = Pm + (size_t)t * PW + C_Q + hh * HD;
                float v[8]; unpack8(*(const u32x4*)(src + 8 * ch), v);
                if (ch < 4) { float p[8]; unpack8(*(const u32x4*)(src + 8 * (ch ^ 2)), p); rope8(v, p, cosT + (size_t)t * 16, sinT + (size_t)t * 16, ch); }
#pragma unroll
                for (int j = 0; j < 8; ++j) v[j] *= QSCALE;
                *(u32x4*)(QP + (size_t)t * DM + hh * HD + 8 * ch) = pack8(v);
            }
        }
        for (int e = tid; e < 4 * 4 * 64 * 16; e += 512) {
            const int pi = e >> 12, g = (e >> 10) & 3, kap = (e >> 4) & 63, ch = e & 15, t = t0 + kap;
            const int part = (pi == 0) ? 0 : (pi == 1) ? 2 : (pi == 2) ? 4 : 1;
            const bf16* src = Pm + (size_t)t * PW + C_KV + part * 512 + g * HD;
            float v[8]; unpack8(*(const u32x4*)(src + 8 * ch), v);
            if (part != 1 && ch < 4) { float p[8]; unpack8(*(const u32x4*)(src + 8 * (ch ^ 2)), p); rope8(v, p, cosT + (size_t)t * 16, sinT + (size_t)t * 16, ch); }
            const u32x4 w = pack8(v);
            if (part == 0) *(u32x4*)((bf16*)(P.ws + WS_KCR) + ((size_t)g * S + t) * HD + 8 * ch) = w;
            else if (part == 1) *(u32x4*)((bf16*)(P.ws + WS_VCR) + ((size_t)g * S + t) * HD + 8 * ch) = w;
            else { unsigned char* img = P.ws + (part == 2 ? WS_KSI : WS_KWI) + ((size_t)g * 256 + b) * 16384; *(u32x4*)(img + kimg_off(kap, ch)) = w; }
        }
        for (int vp = 0; vp < 2; ++vp) {
            const int part = 3 + 2 * vp;
            LAS unsigned short* tile = (LAS unsigned short*)lds;
            for (int e = tid; e < 4 * 64 * 16; e += 512) {
                const int g = e >> 10, kap = (e >> 4) & 63, ch = e & 15;
                const u32x4 w = *(const u32x4*)(Pm + (size_t)(t0 + kap) * PW + C_KV + part * 512 + g * HD + 8 * ch);
                *(LAS u32x4*)(tile + (g * 64 + kap) * 136 + 8 * ch) = w;
            }
            __syncthreads();
            for (int e = tid; e < 4 * 128 * 8; e += 512) {
                const int g = e >> 10, d = (e >> 3) & 127, kc = e & 7;
                const LAS unsigned short* s = tile + (g * 64 + 8 * kc) * 136 + d;
                u32x4 w; w.x = (unsigned)s[0] | ((unsigned)s[136] << 16); w.y = (unsigned)s[2 * 136] | ((unsigned)s[3 * 136] << 16);
                w.z = (unsigned)s[4 * 136] | ((unsigned)s[5 * 136] << 16); w.w = (unsigned)s[6 * 136] | ((unsigned)s[7 * 136] << 16);
                unsigned char* img = P.ws + (part == 3 ? WS_VSI : WS_VWI) + ((size_t)g * 256 + b) * 16384;
                *(u32x4*)(img + vimg_off(d, kc)) = w;
            }
            __syncthreads();
        }
        {
            float* GT = (float*)(P.ws + WS_GT);
            const bf16* Hb = (const bf16*)(P.ws + WS_H); const bf16* Wg = (const bf16*)(P.ws + WS_WL + (size_t)l * WL_BYTES + WL_WIN) + (size_t)C_GN * DM;
            const int wv = tid >> 6, ln = tid & 63, r16 = ln & 15, q4 = ln >> 4, rt = wv & 3, ct0 = (wv < 4) ? 0 : 2, nct = (wv < 4) ? 2 : 1;
            f32x4 acc[2] = {(f32x4){0.f, 0.f, 0.f, 0.f}, (f32x4){0.f, 0.f, 0.f, 0.f}};
            const bf16* ap = Hb + (size_t)(t0 + rt * 16 + r16) * DM + 8 * q4;
            const bf16* bp0 = Wg + (size_t)(ct0 * 16 + r16) * DM + 8 * q4; const bf16* bp1 = bp0 + (size_t)16 * DM;
#pragma unroll 4
            for (int ks = 0; ks < DM / 32; ++ks) {
                const bf16x8 af = *(const bf16x8*)(ap + 32 * ks);
                acc[0] = __builtin_amdgcn_mfma_f32_16x16x32_bf16(af, *(const bf16x8*)(bp0 + 32 * ks), acc[0], 0, 0, 0);
                if (nct == 2) acc[1] = __builtin_amdgcn_mfma_f32_16x16x32_bf16(af, *(const bf16x8*)(bp1 + 32 * ks), acc[1], 0, 0, 0);
            }
#pragma unroll
            for (int c = 0; c < 2; ++c) if (c < nct) {
#pragma unroll
                for (int i = 0; i < 4; ++i) GT[(size_t)(t0 + rt * 16 + 4 * q4 + i) * 48 + (ct0 + c) * 16 + r16] = sigm(acc[c][i]); }
        }
    }
}

__device__ __forceinline__ void cmp2_phase(const Ptrs& P, int l, int vcu, int G, int wave, int lane) {
    const int r16 = lane & 15, q = lane >> 4;
    for (int e = vcu; e < 128; e += G) {
        const int kv = e >> 6, g = (e >> 4) & 3, blk = e & 15;
        const bf16* HC = (const bf16*)(P.ws + WS_HC) + ((size_t)kv * 4096 + g * 1024 + blk * 64) * 256;
        const bf16* W2T = (const bf16*)(P.ws + WS_W2T) + (size_t)(l * 2 + kv) * 128 * 256;
        const float* b2 = P.cmp_b2 + (size_t)(l * 2 + kv) * 128;
        const int rt = wave & 3, ch = wave >> 2;
        bf16x8 af[8];
#pragma unroll
        for (int ks = 0; ks < 8; ++ks) af[ks] = *(const bf16x8*)(HC + (size_t)(rt * 16 + r16) * 256 + 32 * ks + 8 * q);
        unsigned char* img = P.ws + (kv == 0 ? WS_KCI : WS_VCI) + ((size_t)g * 16 + blk) * 16384;
#pragma unroll
        for (int ct = 0; ct < 4; ++ct) {
            const int n = ch * 64 + ct * 16 + r16;
            f32x4 acc = {0.f, 0.f, 0.f, 0.f};
#pragma unroll
            for (int ks = 0; ks < 8; ++ks) { const bf16x8 bfr = *(const bf16x8*)(W2T + (size_t)n * 256 + 32 * ks + 8 * q);
                acc = __builtin_amdgcn_mfma_f32_16x16x32_bf16(af[ks], bfr, acc, 0, 0, 0); }
            const float bb = b2[n];
            if (kv == 0) {
#pragma unroll
                for (int i = 0; i < 4; ++i) { const int kap = rt * 16 + 4 * q + i; *(bf16*)(img + kimg_off(kap, n >> 3) + (n & 7) * 2) = (bf16)f2bf(acc[i] + bb); }
            } else {
                const int kap0 = rt * 16 + 4 * q; u32x2 w; w.x = pk2(acc[0] + bb, acc[1] + bb); w.y = pk2(acc[2] + bb, acc[3] + bb);
                *(u32x2*)(img + vimg_off(n, kap0 >> 3) + (kap0 & 7) * 2) = w;
            }
        }
    }
}

#ifndef DBG_REP_SEL
#define DBG_REP_SEL 1
#endif
#ifndef DBG_BR
#define DBG_BR 7
#endif
#ifndef DBG_SANITIZE
#define DBG_SANITIZE 0
#endif
#ifndef DBG_DENSE_SEL
#define DBG_DENSE_SEL 0
#endif
struct AttnLane { unsigned kb, vb; int kx, vx; int q; };
#define AL_KOFF(L_, s_) ((L_).kb + 64u * (unsigned)((s_) ^ (L_).kx))
#define AL_VOFF(L_, a_) ((L_).vb + 64u * (unsigned)((a_) ^ (L_).vx))

__device__ __forceinline__ bf16x8 pack_p(const f32x4 a, const f32x4 b) {
    u32x4 w; w.x = pg8::cvt_pk_bf16(a[0], a[1]); w.y = pg8::cvt_pk_bf16(a[2], a[3]); w.z = pg8::cvt_pk_bf16(b[0], b[1]); w.w = pg8::cvt_pk_bf16(b[2], b[3]);
    return __builtin_bit_cast(bf16x8, w);
}
__device__ __forceinline__ void lds_fadd(LAS float* p, float v) { (void)__hip_atomic_fetch_add(p, v, __ATOMIC_RELAXED, __HIP_MEMORY_SCOPE_WORKGROUP); }
template <int CTRL> __device__ __forceinline__ unsigned dpp_u_(unsigned v) { return (unsigned)__builtin_amdgcn_update_dpp(0, (int)v, CTRL, 0xF, 0xF, false); }
__device__ __forceinline__ unsigned wave_umax(unsigned v) {
    v = max(v, dpp_u_<0xB1>(v)); v = max(v, dpp_u_<0x4E>(v)); v = max(v, dpp_u_<0x141>(v)); v = max(v, dpp_u_<0x140>(v));
    auto r16 = __builtin_amdgcn_permlane16_swap(v, v, false, false); v = max(r16[0], r16[1]);
    auto r32 = __builtin_amdgcn_permlane32_swap(v, v, false, false); return max(r32[0], r32[1]);
}
__device__ __forceinline__ unsigned wave_umin(unsigned v) {
    v = min(v, dpp_u_<0xB1>(v)); v = min(v, dpp_u_<0x4E>(v)); v = min(v, dpp_u_<0x141>(v)); v = min(v, dpp_u_<0x140>(v));
    auto r16 = __builtin_amdgcn_permlane16_swap(v, v, false, false); v = min(r16[0], r16[1]);
    auto r32 = __builtin_amdgcn_permlane32_swap(v, v, false, false); return min(r32[0], r32[1]);
}
__device__ __forceinline__ float quad_sum(float v) {
    v += __builtin_bit_cast(float, __builtin_amdgcn_update_dpp(0, __builtin_bit_cast(int, v), 0xB1, 0xF, 0xF, false));
    v += __builtin_bit_cast(float, __builtin_amdgcn_update_dpp(0, __builtin_bit_cast(int, v), 0x4E, 0xF, 0xF, false));
    return v;
}
__device__ __forceinline__ void ldsr128(bf16x8& d, unsigned addr) { asm volatile("ds_read_b128 %0, %1" : "=v"(d) : "v"(addr)); }
__device__ __forceinline__ void ldsr128o(bf16x8& d, unsigned addr, const int off) { asm volatile("ds_read_b128 %0, %1 offset:%2" : "=v"(d) : "v"(addr), "i"(off)); }
#define LDS_WAIT4(n, a, b, c, d) asm volatile("s_waitcnt lgkmcnt(" #n ")" : "+v"(a), "+v"(b), "+v"(c), "+v"(d))
template <bool T0, bool T1, int MODE>
__device__ __forceinline__ void block_step(LAS const unsigned char* Kb, LAS const unsigned char* Vb, const AttnLane& L, const bf16x8 (&qf)[2][4],
                                           f32x4 (&O)[2][8], float (&m)[2], float (&l)[2], const int (&limq)[2], const unsigned W,
                                           const float (&invl)[2], LAS float* const (&improw)[2], const int j0, const bool hzero, const bool MASKB) {
    AttnLane Lq = L; asm volatile("" : "+v"(Lq.kb), "+v"(Lq.vb));
    f32x4 st[2][4];
    const f32x4 z = {0.f, 0.f, 0.f, 0.f};
    {
        __builtin_amdgcn_s_setprio(1);
        const unsigned kbase = (unsigned)(uintptr_t)Kb;
        unsigned ka[4];
#pragma unroll
        for (int s = 0; s < 4; ++s) ka[s] = kbase + AL_KOFF(Lq, s);
        bf16x8 fa[4], fb[4];
#pragma unroll
        for (int s = 0; s < 4; ++s) ldsr128(fa[s], ka[s]);
#pragma unroll
        for (int kt = 0; kt < 4; ++kt) {
            if (kt < 3) {
#pragma unroll
                for (int s = 0; s < 4; ++s) { if ((kt & 1) == 0) ldsr128o(fb[s], ka[s], (kt + 1) * 4096); else ldsr128o(fa[s], ka[s], (kt + 1) * 4096); }
            }
            if ((kt & 1) == 0) { if (kt < 3) LDS_WAIT4(4, fa[0], fa[1], fa[2], fa[3]); else LDS_WAIT4(0, fa[0], fa[1], fa[2], fa[3]); }
            else               { if (kt < 3) LDS_WAIT4(4, fb[0], fb[1], fb[2], fb[3]); else LDS_WAIT4(0, fb[0], fb[1], fb[2], fb[3]); }
#pragma unroll
            for (int s = 0; s < 4; ++s) { const bf16x8 a = ((kt & 1) == 0) ? fa[s] : fb[s];
                if (T0) st[0][kt] = __builtin_amdgcn_mfma_f32_16x16x32_bf16(a, qf[0][s], s == 0 ? z : st[0][kt], 0, 0, 0);
                if (T1) st[1][kt] = __builtin_amdgcn_mfma_f32_16x16x32_bf16(a, qf[1][s], s == 0 ? z : st[1][kt], 0, 0, 0); }
        }
    }
    __builtin_amdgcn_s_setprio(0);
    bf16x8 pf[2][2];
#pragma unroll
    for (int ts = 0; ts < 2; ++ts) {
        if (!(ts == 0 ? T0 : T1)) continue;
        const float NEG = -__builtin_inff();
        if (MASKB) {
#pragma unroll
        for (int kt = 0; kt < 4; ++kt)
#pragma unroll
            for (int i = 0; i < 4; ++i) { const int kc = 32 * (kt >> 1) + 4 * (kt & 1) + i; if ((unsigned)(limq[ts] - kc) >= W) st[ts][kt][i] = NEG; }
        }
        if (MODE != 1) {
            float mx = fmaxf(fmaxf(st[ts][0][0], st[ts][0][1]), fmaxf(st[ts][0][2], st[ts][0][3]));
#pragma unroll
            for (int kt = 1; kt < 4; ++kt) mx = fmaxf(mx, fmaxf(fmaxf(st[ts][kt][0], st[ts][kt][1]), fmaxf(st[ts][kt][2], st[ts][kt][3])));
            { auto r16 = __builtin_amdgcn_permlane16_swap(__float_as_uint(mx), __float_as_uint(mx), false, false); mx = fmaxf(__uint_as_float(r16[0]), __uint_as_float(r16[1]));
              auto r32 = __builtin_amdgcn_permlane32_swap(__float_as_uint(mx), __float_as_uint(mx), false, false); mx = fmaxf(__uint_as_float(r32[0]), __uint_as_float(r32[1])); }
            const float mn = fmaxf(m[ts], mx), alpha = __builtin_amdgcn_exp2f(m[ts] - mn); m[ts] = mn;
            float sum = 0.f;
#pragma unroll
            for (int kt = 0; kt < 4; ++kt)
#pragma unroll
                for (int i = 0; i < 4; ++i) { const float pv = __builtin_amdgcn_exp2f(st[ts][kt][i] - mn); st[ts][kt][i] = pv; sum += pv; }
            l[ts] = l[ts] * alpha + sum;
            if (MODE == 2) {
#pragma unroll
                for (int dt = 0; dt < 8; ++dt) O[ts][dt] *= alpha;
            }
        } else {
#pragma unroll
            for (int kt = 0; kt < 4; ++kt)
#pragma unroll
                for (int i = 0; i < 4; ++i) st[ts][kt][i] = __builtin_amdgcn_exp2f(st[ts][kt][i] - m[ts]) * invl[ts];
            float A[4], B[4];
#pragma unroll
            for (int kt = 0; kt < 4; ++kt) { B[kt] = 0.5f * st[ts][kt][3]; A[kt] = quad_sum((st[ts][kt][0] + st[ts][kt][1]) + (st[ts][kt][2] + B[kt])); B[kt] = quad_sum(B[kt]); }
            if (hzero) { LAS float* ir = improw[ts] + j0;
                lds_fadd(ir + 0, A[0]); lds_fadd(ir + 1, B[0] + A[1]); lds_fadd(ir + 2, B[1]); lds_fadd(ir + 8, A[2]); lds_fadd(ir + 9, B[2] + A[3]); lds_fadd(ir + 10, B[3]); }
        }
        if (MODE != 0) { pf[ts][0] = pack_p(st[ts][0], st[ts][1]); pf[ts][1] = pack_p(st[ts][2], st[ts][3]); }
    }
    if (MODE != 0) {
        __builtin_amdgcn_s_setprio(1);
        const unsigned vbase = (unsigned)(uintptr_t)Vb;
        unsigned va[2];
#pragma unroll
        for (int a = 0; a < 2; ++a) va[a] = vbase + AL_VOFF(Lq, a);
        bf16x8 fa[4], fb[4];
#pragma unroll
        for (int j = 0; j < 4; ++j) ldsr128o(fa[j], va[j & 1], (j >> 1) * 2048);
#pragma unroll
        for (int dp = 0; dp < 4; ++dp) {
            if (dp < 3) {
#pragma unroll
                for (int j = 0; j < 4; ++j) { if ((dp & 1) == 0) ldsr128o(fb[j], va[j & 1], (2 * (dp + 1) + (j >> 1)) * 2048); else ldsr128o(fa[j], va[j & 1], (2 * (dp + 1) + (j >> 1)) * 2048); }
            }
            if ((dp & 1) == 0) { if (dp < 3) LDS_WAIT4(4, fa[0], fa[1], fa[2], fa[3]); else LDS_WAIT4(0, fa[0], fa[1], fa[2], fa[3]); }
            else               { if (dp < 3) LDS_WAIT4(4, fb[0], fb[1], fb[2], fb[3]); else LDS_WAIT4(0, fb[0], fb[1], fb[2], fb[3]); }
#pragma unroll
            for (int j = 0; j < 4; ++j) { const bf16x8 v = ((dp & 1) == 0) ? fa[j] : fb[j]; const int dt = 2 * dp + (j >> 1), a = j & 1;
                if (T0) O[0][dt] = __builtin_amdgcn_mfma_f32_16x16x32_bf16(v, pf[0][a], O[0][dt], 0, 0, 0);
                if (T1) O[1][dt] = __builtin_amdgcn_mfma_f32_16x16x32_bf16(v, pf[1][a], O[1][dt], 0, 0, 0); }
        }
        __builtin_amdgcn_s_setprio(0);
    }
}


constexpr float ATT_THR = 8.0f;
__device__ __forceinline__ float max3f_(float a, float b, float c) { return fmaxf(fmaxf(a, b), c); }
template <bool T0, bool T1>
__device__ __forceinline__ void step_online(LAS const unsigned char* Kb, LAS const unsigned char* Vb, const AttnLane& L, const bf16x8 (&qf)[2][4],
                                            f32x4 (&O)[2][8], float (&mref)[2], float (&l)[2], const int (&limq)[2], const unsigned W, const bool MASK, const bool START) {
    AttnLane Lq = L; asm volatile("" : "+v"(Lq.kb), "+v"(Lq.vb));
    f32x4 st[2][4];
    const float NEG = -__builtin_inff();
#pragma unroll
    for (int ts = 0; ts < 2; ++ts) { const float c0 = START ? 0.f : (limq[ts] > -500 ? -mref[ts] : NEG);
#pragma unroll
        for (int kt = 0; kt < 4; ++kt) st[ts][kt] = (f32x4){c0, c0, c0, c0}; }
    {
        __builtin_amdgcn_s_setprio(1);
        const unsigned kbase = (unsigned)(uintptr_t)Kb;
        unsigned ka[4];
#pragma unroll
        for (int s = 0; s < 4; ++s) ka[s] = kbase + AL_KOFF(Lq, s);
        bf16x8 fa[4], fb[4];
#pragma unroll
        for (int s = 0; s < 4; ++s) ldsr128(fa[s], ka[s]);
#pragma unroll
        for (int kt = 0; kt < 4; ++kt) {
            if (kt < 3) {
#pragma unroll
                for (int s = 0; s < 4; ++s) { if ((kt & 1) == 0) ldsr128o(fb[s], ka[s], (kt + 1) * 4096); else ldsr128o(fa[s], ka[s], (kt + 1) * 4096); }
            }
            if ((kt & 1) == 0) { if (kt < 3) LDS_WAIT4(4, fa[0], fa[1], fa[2], fa[3]); else LDS_WAIT4(0, fa[0], fa[1], fa[2], fa[3]); }
            else               { if (kt < 3) LDS_WAIT4(4, fb[0], fb[1], fb[2], fb[3]); else LDS_WAIT4(0, fb[0], fb[1], fb[2], fb[3]); }
#pragma unroll
            for (int s = 0; s < 4; ++s) { const bf16x8 a = ((kt & 1) == 0) ? fa[s] : fb[s];
                if (T0) st[0][kt] = __builtin_amdgcn_mfma_f32_16x16x32_bf16(a, qf[0][s], st[0][kt], 0, 0, 0);
                if (T1) st[1][kt] = __builtin_amdgcn_mfma_f32_16x16x32_bf16(a, qf[1][s], st[1][kt], 0, 0, 0); }
        }
    }
    __builtin_amdgcn_s_setprio(0);
    __builtin_amdgcn_sched_barrier(0);
    bf16x8 pf[2][2];
#pragma unroll
    for (int ts = 0; ts < 2; ++ts) {
        if (!(ts == 0 ? T0 : T1)) continue;
        if (MASK || START) {
#pragma unroll
            for (int kt = 0; kt < 4; ++kt)
#pragma unroll
                for (int i = 0; i < 4; ++i) { const int kc = 32 * (kt >> 1) + 4 * (kt & 1) + i; if ((unsigned)(limq[ts] - kc) >= W) st[ts][kt][i] = NEG; }
        }
        float mx = max3f_(st[ts][0][0], st[ts][0][1], st[ts][0][2]);
        mx = max3f_(mx, st[ts][0][3], st[ts][1][0]); mx = max3f_(mx, st[ts][1][1], st[ts][1][2]); mx = max3f_(mx, st[ts][1][3], st[ts][2][0]);
        mx = max3f_(mx, st[ts][2][1], st[ts][2][2]); mx = max3f_(mx, st[ts][2][3], st[ts][3][0]); mx = max3f_(mx, st[ts][3][1], st[ts][3][2]); mx = fmaxf(mx, st[ts][3][3]);
#define XLANE_MAX_(v_) do { auto r16 = __builtin_amdgcn_permlane16_swap(__float_as_uint(v_), __float_as_uint(v_), false, false); v_ = fmaxf(__uint_as_float(r16[0]), __uint_as_float(r16[1])); \
          auto r32 = __builtin_amdgcn_permlane32_swap(__float_as_uint(v_), __float_as_uint(v_), false, false); v_ = fmaxf(__uint_as_float(r32[0]), __uint_as_float(r32[1])); } while (0)
        if (START) {
            XLANE_MAX_(mx);
            const float m0 = fmaxf(mx, -1.0e4f); mref[ts] = m0;
#pragma unroll
            for (int kt = 0; kt < 4; ++kt) st[ts][kt] -= m0;
        } else if (__builtin_expect(__any(mx > ATT_THR), 0)) {
            XLANE_MAX_(mx);
            const float dl = fmaxf(mx, 0.f), f = __builtin_amdgcn_exp2f(-dl); mref[ts] += dl; l[ts] *= f;
#pragma unroll
            for (int kt = 0; kt < 4; ++kt) st[ts][kt] -= dl;
#pragma unroll
            for (int dt = 0; dt < 8; ++dt) O[ts][dt] *= f;
        }
        float sum = 0.f;
#pragma unroll
        for (int kt = 0; kt < 4; ++kt)
#pragma unroll
            for (int i = 0; i < 4; ++i) { const float pv = __builtin_amdgcn_exp2f(st[ts][kt][i]); st[ts][kt][i] = pv; sum += pv; }
        l[ts] += sum;
        pf[ts][0] = pack_p(st[ts][0], st[ts][1]); pf[ts][1] = pack_p(st[ts][2], st[ts][3]);
        __builtin_amdgcn_sched_barrier(0);
    }
    {
        __builtin_amdgcn_s_setprio(1);
        const unsigned vbase = (unsigned)(uintptr_t)Vb;
        unsigned va[2];
#pragma unroll
        for (int a = 0; a < 2; ++a) va[a] = vbase + AL_VOFF(Lq, a);
        bf16x8 fa[4], fb[4];
#pragma unroll
        for (int j = 0; j < 4; ++j) ldsr128o(fa[j], va[j & 1], (j >> 1) * 2048);
#pragma unroll
        for (int dp = 0; dp < 4; ++dp) {
            if (dp < 3) {
#pragma unroll
                for (int j = 0; j < 4; ++j) { if ((dp & 1) == 0) ldsr128o(fb[j], va[j & 1], (2 * (dp + 1) + (j >> 1)) * 2048); else ldsr128o(fa[j], va[j & 1], (2 * (dp + 1) + (j >> 1)) * 2048); }
            }
            if ((dp & 1) == 0) { if (dp < 3) LDS_WAIT4(4, fa[0], fa[1], fa[2], fa[3]); else LDS_WAIT4(0, fa[0], fa[1], fa[2], fa[3]); }
            else               { if (dp < 3) LDS_WAIT4(4, fb[0], fb[1], fb[2], fb[3]); else LDS_WAIT4(0, fb[0], fb[1], fb[2], fb[3]); }
#pragma unroll
            for (int j = 0; j < 4; ++j) { const bf16x8 v = ((dp & 1) == 0) ? fa[j] : fb[j]; const int dt = 2 * dp + (j >> 1), a = j & 1;
                if (T0) O[0][dt] = __builtin_amdgcn_mfma_f32_16x16x32_bf16(v, pf[0][a], O[0][dt], 0, 0, 0);
                if (T1) O[1][dt] = __builtin_amdgcn_mfma_f32_16x16x32_bf16(v, pf[1][a], O[1][dt], 0, 0, 0); }
        }
        __builtin_amdgcn_s_setprio(0);
    }
    __builtin_amdgcn_sched_barrier(0);
}
__device__ __forceinline__ void glds16(const void* gsrc, unsigned lds_dst) { unsigned keep;
    asm volatile("s_mov_b32 %0, m0\n\ts_mov_b32 m0, %2\n\ts_nop 0\n\tglobal_load_lds_dwordx4 %1, off\n\ts_mov_b32 m0, %0" : "=&s"(keep) : "v"(gsrc), "s"(lds_dst) : "memory"); }

__device__ __forceinline__ void glds16s(const void* sbase, unsigned voff, unsigned lds_dst) { unsigned keep;
    asm volatile("s_mov_b32 %0, m0\n\ts_mov_b32 m0, %3\n\ts_nop 0\n\tglobal_load_lds_dwordx4 %1, %2\n\ts_mov_b32 m0, %0" : "=&s"(keep) : "v"(voff), "s"(sbase), "s"(lds_dst) : "memory"); }

#define AT_BAR() do { asm volatile("s_waitcnt lgkmcnt(0)" ::: "memory"); __builtin_amdgcn_s_barrier(); asm volatile("" ::: "memory"); } while (0)
#define AT_STAGE(gsrc, ldsoff) do { unsigned _lo = (unsigned)lane * 16u; asm volatile("" : "+v"(_lo)); _Pragma("unroll") for (int _p = 0; _p < 2; ++_p) \
    glds16s((gsrc) + (_p * 8 + wave) * 1024, _lo, (unsigned)__builtin_amdgcn_readfirstlane((int)(ldsb + (unsigned)(ldsoff) + (unsigned)(_p * 8 + wave) * 1024u))); } while (0)
#define AT_WAITV(n) asm volatile("s_waitcnt vmcnt(" #n ")" ::: "memory")

__device__ __forceinline__ void attn_phase(const Ptrs& P, LAS unsigned char* lds, int vcu, int G, int wave, int lane) {
    const unsigned ldsb = (unsigned)(uintptr_t)lds;
    const bf16* QP = (const bf16*)(P.ws + WS_QP);
    const float* GT = (const float*)(P.ws + WS_GT);
    bf16* AO = (bf16*)(P.ws + WS_AO);
    LAS float* impw = (LAS float*)(lds + AT_IMP) + 8 * wave * IMP_STRIDE;
    LAS unsigned* selw = (LAS unsigned*)(lds + AT_SELW) + wave * 256;
#define AT_REGION() int ln_ = lane; asm volatile("" : "+v"(ln_)); const int c16 = ln_ & 15, q = ln_ >> 4, hh = c16 & 3, tq = c16 >> 2; AttnLane L; L.q = q; \
    L.kb = (unsigned)(c16 * 256 + (((q ^ c16) & 3) << 4)); L.kx = (c16 >> 2) & 3; L.vb = (unsigned)(c16 * 128 + (((q ^ (c16 >> 1)) & 3) << 4)); L.vx = (c16 >> 3) & 1; \
    const bool hzero = (hh == 0); const int tok0 = t0 + 8 * wave + tq; (void)hzero; (void)tok0; (void)L
#define tok_(ts_) (tok0 + 4 * (ts_))
#define GATE(ts_, br_) (GT[(size_t)tok_(ts_) * 48 + (4 * g + hh) * 3 + (br_)])
#define FSAT(k_) (*(f32x4*)(FSb + (fo_ + (unsigned)(k_) * 1024u)))
#define FS_OFF() unsigned fo_ = (unsigned)ln_ * 16u

    for (int e = vcu; e < 1024; e += G) {
        const int k4 = e >> 8, v = e & 255, xcd = v >> 5, g = xcd & 3, hi2 = xcd >> 2, j = v & 31;
        const int stepk = hi2 ? ((k4 == 0) ? 6 : (k4 == 1) ? 5 : (k4 == 2) ? 2 : 1) : ((k4 == 0) ? 7 : (k4 == 1) ? 4 : (k4 == 2) ? 3 : 0);
        const int tile = 32 * stepk + ((k4 & 1) ? 31 - j : j);
        const int t0 = tile * 64;
        unsigned char* FSb = P.ws + WS_FS + ((size_t)((vcu & 255) * 8 + wave)) * 16384;
        bf16x8 qf[2][4];
        f32x4 O[2][8];
        float l[2] = {0.f, 0.f};
        int limq[2];
        {
            AT_REGION();
#pragma unroll
            for (int ts = 0; ts < 2; ++ts) {
#pragma unroll
                for (int s = 0; s < 4; ++s) qf[ts][s] = *(const bf16x8*)(QP + (size_t)tok_(ts) * DM + (4 * g + hh) * HD + 32 * s + 8 * q);
            }
            for (int i = ln_; i < 8 * IMP_STRIDE; i += 64) impw[i] = 0.f;
            for (int i = ln_; i < 256; i += 64) selw[i] = 0u;
#pragma unroll
            for (int ts = 0; ts < 2; ++ts)
#pragma unroll
                for (int dt = 0; dt < 8; ++dt) O[ts][dt] = (f32x4){0.f, 0.f, 0.f, 0.f};
            float m[2] = {-1e30f, -1e30f}, invl[2] = {0.f, 0.f};
            LAS float* improw[2]; improw[0] = impw + tq * IMP_STRIDE; improw[1] = impw + (4 + tq) * IMP_STRIDE;
            VM_WAIT(); LDS_WAIT();
            const int nbc = (DBG_BR & 1) ? ((4 * tile + 2) >> 6) + 1 : 0;
            const unsigned char* kci = P.ws + WS_KCI + (size_t)g * 16 * 16384; const unsigned char* vci = P.ws + WS_VCI + (size_t)g * 16 * 16384;
            if (DBG_BR & 1) AT_STAGE(kci, AT_KV);
            for (int b = 0; b < nbc; ++b) {
                const int buf = (b & 1) * 32768;
                if (b + 1 < nbc) { AT_STAGE(kci + (size_t)(b + 1) * 16384, AT_KV + (buf ^ 32768)); AT_WAITV(2); }
                else AT_WAITV(0);
                AT_BAR();
#pragma unroll
                for (int ts = 0; ts < 2; ++ts) limq[ts] = ((tok_(ts) - 31) >> 4) - 64 * b - 8 * q;
                block_step<true, true, 0>(lds + AT_KV + buf, lds + AT_KV + buf + 16384, L, qf, O, m, l, limq, 0x80000000u, invl, improw, 0, hzero, b + 2 >= nbc);
                AT_BAR();
            }
#pragma unroll
            for (int ts = 0; ts < 2; ++ts) { float lt = l[ts]; lt += __shfl_xor(lt, 16); lt += __shfl_xor(lt, 32); invl[ts] = lt > 0.f ? 1.0f / lt : 0.f; }
            if (DBG_BR & 1) { AT_STAGE(kci, AT_KV); AT_STAGE(vci, AT_KV + 16384); }
            for (int b = 0; b < nbc; ++b) {
                const int buf = (b & 1) * 32768;
                if (b + 1 < nbc) { AT_STAGE(kci + (size_t)(b + 1) * 16384, AT_KV + (buf ^ 32768)); AT_STAGE(vci + (size_t)(b + 1) * 16384, AT_KV + (buf ^ 32768) + 16384); AT_WAITV(4); }
                else AT_WAITV(0);
                AT_BAR();
#pragma unroll
                for (int ts = 0; ts < 2; ++ts) limq[ts] = ((tok_(ts) - 31) >> 4) - 64 * b - 8 * q;
                block_step<true, true, 1>(lds + AT_KV + buf, lds + AT_KV + buf + 16384, L, qf, O, m, l, limq, 0x80000000u, invl, improw, 16 * b + 2 * q, hzero, b + 2 >= nbc);
                AT_BAR();
            }
            FS_OFF();
#pragma unroll
            for (int ts = 0; ts < 2; ++ts)
#pragma unroll
                for (int dt = 0; dt < 8; ++dt) FSAT(ts * 8 + dt) = O[ts][dt] * GATE(ts, 0);
        }
        LDS_WAIT();
        {
            const int Ksel = (!(DBG_BR & 2) || DBG_DENSE_SEL >= 2) ? 0 : (tile - 1) < 14 ? (tile - 1) : 14;
            int lane_k = lane; asm volatile("" : "+v"(lane_k));
            unsigned wsel[4] = {0u, 0u, 0u, 0u};
            bool cand[4];
#pragma unroll
            for (int e4 = 0; e4 < 4; ++e4) { const int jj = lane_k + 64 * e4; cand[e4] = (jj >= 1 && jj <= tile - 1); }
            if (Ksel > 0) {
                const bool all_sel = (tile - 1) <= 14;
                for (int tl = 0; tl < 8; ++tl) {
                    const LAS float* row = impw + tl * IMP_STRIDE;
                    unsigned val[4];
#pragma unroll
                    for (int e4 = 0; e4 < 4; ++e4) val[e4] = cand[e4] ? __float_as_uint(row[lane_k + 64 * e4]) : 0u;
                    bool sel[4];
                    if (all_sel) {
#pragma unroll
                        for (int e4 = 0; e4 < 4; ++e4) sel[e4] = cand[e4];
                    } else {
                        unsigned vmx = max(max(val[0], val[1]), max(val[2], val[3]));
                        unsigned vmn = min(min(cand[0] ? val[0] : 0xffffffffu, cand[1] ? val[1] : 0xffffffffu), min(cand[2] ? val[2] : 0xffffffffu, cand[3] ? val[3] : 0xffffffffu));
                        vmx = wave_umax(vmx); vmn = wave_umin(vmn);
                        const unsigned dif = (unsigned)__builtin_amdgcn_readfirstlane((int)(vmx ^ vmn));
                        const int hb = 31 - __builtin_clz(dif | 1u);
                        unsigned cur = (unsigned)__builtin_amdgcn_readfirstlane((int)vmx) & ~((2u << hb) - 1u);
                        for (int bit = (dif == 0u ? -1 : (hb > 30 ? 30 : hb)); bit >= 0; --bit) {
                            asm volatile("" : "+s"(cur), "+s"(bit));
                            const unsigned t = cur | (1u << bit); int cnt = 0;
#pragma unroll
                            for (int e4 = 0; e4 < 4; ++e4) cnt += __popcll(__builtin_amdgcn_uicmp(val[e4], t, 35  ));
                            if (cnt >= Ksel) cur = t;
                            if (cnt == Ksel) break;
                        }
                        int cgt = 0;
#pragma unroll
                        for (int e4 = 0; e4 < 4; ++e4) cgt += __popcll(__ballot(cand[e4] && val[e4] > cur));
                        const int need = Ksel - cgt; int prev = 0;
#pragma unroll
                        for (int e4 = 0; e4 < 4; ++e4) { const bool eq = cand[e4] && val[e4] == cur; const unsigned long long be = __ballot(eq);
                            const int rank = prev + (int)__builtin_amdgcn_mbcnt_hi((unsigned)(be >> 32), __builtin_amdgcn_mbcnt_lo((unsigned)be, 0u));
                            sel[e4] = (cand[e4] && val[e4] > cur) || (eq && rank < need); prev += __popcll(be); }
                    }
#pragma unroll
                    for (int e4 = 0; e4 < 4; ++e4) wsel[e4] |= sel[e4] ? (1u << tl) : 0u;
                }
            }
#pragma unroll
            for (int e4 = 0; e4 < 4; ++e4) { const int jj = lane_k + 64 * e4; if (jj == 0 || jj == tile) wsel[e4] = 0xffu; selw[jj] = wsel[e4]; }
            LDS_WAIT();
#if DBG_DENSE_SEL == 1
            for (int i = lane_k; i <= tile; i += 64) selw[i] = 0xffu;
            LDS_WAIT();
#elif DBG_DENSE_SEL == 4
            for (int i = lane_k; i <= tile; i += 64) selw[i] = (i == 0 || i >= tile - 14) ? 0xffu : 0u;
            LDS_WAIT();
#endif
        }
        float mref[2] = {0.f, 0.f};
#define AT_RING_LOOP(NB, KSRC, VSRC, PRE, ...) do { \
            const int nb_ = (NB); \
            _Pragma("unroll") for (int pb_ = 0; pb_ < 3; ++pb_) { if ((PRE) && pb_ == 2) AT_BAR(); \
                if (pb_ < nb_) { AT_STAGE((KSRC) + (size_t)pb_ * 16384, pb_ * 32768); AT_STAGE((VSRC) + (size_t)pb_ * 16384, pb_ * 32768 + 16384); } } \
            int bufo = 0, bufn = 98304; \
            for (int b = 0; b < nb_; ++b) { \
                const int ahead_ = nb_ - 1 - b; \
                if (ahead_ >= 2) AT_WAITV(8); else if (ahead_ == 1) AT_WAITV(4); else AT_WAITV(0); \
                AT_BAR(); \
                if (b + 3 < nb_) { AT_STAGE((KSRC) + (size_t)(b + 3) * 16384, bufn); AT_STAGE((VSRC) + (size_t)(b + 3) * 16384, bufn + 16384); } \
                LAS const unsigned char* Kb_ = lds + bufo; LAS const unsigned char* Vb_ = lds + bufo + 16384; \
                __VA_ARGS__ \
                bufo = (bufo == 98304) ? 0 : bufo + 32768; bufn = (bufn == 98304) ? 0 : bufn + 32768; \
            } \
            AT_BAR(); } while (0)
#define AT_DRIFT_LOOP(NB, KSRC, VSRC, ...) do { \
            const int nb_ = (NB); \
            volatile LAS unsigned* ldc_ = (volatile LAS unsigned*)(lds + MISC_OFF) + 32; \
            if (wave == 0 && ln_ < 4) ldc_[ln_] = 0u; \
            _Pragma("unroll") for (int pb_ = 0; pb_ < 2; ++pb_) if (pb_ < nb_) { AT_STAGE((KSRC) + (size_t)pb_ * 16384, pb_ * 32768); AT_STAGE((VSRC) + (size_t)pb_ * 16384, pb_ * 32768 + 16384); } \
            AT_BAR();                                                     \
            if (nb_ >= 2) AT_WAITV(4); else AT_WAITV(0); \
            if (ln_ == 0) (void)__hip_atomic_fetch_add((LAS unsigned*)ldc_, 1u, __ATOMIC_RELAXED, __HIP_MEMORY_SCOPE_WORKGROUP); \
            unsigned swn_ = (unsigned)__builtin_amdgcn_readfirstlane((int)selw[0]); \
            _Pragma("clang loop unroll(disable)") for (int b = 0; b < nb_; ++b) { \
                volatile LAS unsigned* lp_ = ldc_ + (b & 3); \
                const unsigned pr0_ = *lp_;                                                             \
                const unsigned swv_ = *(volatile LAS unsigned*)(selw + (b + 1 < 256 ? b + 1 : 255)); \
                if (b + 1 < nb_) { AT_WAITV(0); if (ln_ == 0) (void)__hip_atomic_fetch_add((LAS unsigned*)ldc_ + ((b + 1) & 3), 1u, __ATOMIC_RELAXED, __HIP_MEMORY_SCOPE_WORKGROUP); } \
                { const unsigned need_ = 8u * (unsigned)((b >> 2) + 1); unsigned pr_ = (unsigned)__builtin_amdgcn_readfirstlane((int)pr0_); \
                  while (pr_ < need_) { __builtin_amdgcn_s_sleep(1); pr_ = (unsigned)__builtin_amdgcn_readfirstlane((int)*lp_); } } \
                const unsigned sw = swn_; swn_ = (unsigned)__builtin_amdgcn_readfirstlane((int)swv_); \
                asm volatile("" ::: "memory"); \
                if (b + 2 < nb_) { const int sl_ = ((b + 2) & 3) * 32768; AT_STAGE((KSRC) + (size_t)(b + 2) * 16384, sl_); AT_STAGE((VSRC) + (size_t)(b + 2) * 16384, sl_ + 16384); } \
                LAS const unsigned char* Kb_ = lds + (b & 3) * 32768; LAS const unsigned char* Vb_ = Kb_ + 16384; \
                __VA_ARGS__ \
            } \
            AT_BAR(); } while (0)
        {
            AT_REGION();
            for (int rp_ = 0; rp_ < DBG_REP_SEL; ++rp_) {
#pragma unroll
            for (int ts = 0; ts < 2; ++ts) { l[ts] = 0.f; mref[ts] = 0.f;
#pragma unroll
                for (int dt = 0; dt < 8; ++dt) O[ts][dt] = (f32x4){0.f, 0.f, 0.f, 0.f}; }
            if (DBG_BR & 2) {
                const unsigned char* ksi = P.ws + WS_KSI + (size_t)g * 256 * 16384; const unsigned char* vsi = P.ws + WS_VSI + (size_t)g * 256 * 16384;
                VM_WAIT();
                AT_DRIFT_LOOP(tile + 1, ksi, vsi, {
                    _Pragma("unroll") for (int ts = 0; ts < 2; ++ts) limq[ts] = ((sw >> (4 * ts + tq)) & 1u) ? (tok_(ts) - 64 * b - 8 * q) : -1000;
                    const bool a0 = (sw & 0x0fu) != 0u, a1 = (sw & 0xf0u) != 0u;
                    const bool msk = (b == 0) || (b == tile);
                    if (a0) step_online<true, false>(Kb_, Vb_, L, qf, O, mref, l, limq, 0x80000000u, msk, b == 0);
                    if (a1) step_online<false, true>(Kb_, Vb_, L, qf, O, mref, l, limq, 0x80000000u, msk, b == 0);
                });
            }
            }
            FS_OFF();
#pragma unroll
            for (int ts = 0; ts < 2; ++ts) { float lt = l[ts]; lt += __shfl_xor(lt, 16); lt += __shfl_xor(lt, 32); const float sc = (DBG_BR & 2) ? GATE(ts, 1) / lt : 0.f;
#pragma unroll
                for (int dt = 0; dt < 8; ++dt) { FSAT(ts * 8 + dt) += O[ts][dt] * sc; if ((dt & 3) == 3) asm volatile("" ::: "memory"); } }
            VM_WAIT();
        }
        {
            AT_REGION();
#pragma unroll
            for (int ts = 0; ts < 2; ++ts) { l[ts] = 0.f;
#pragma unroll
                for (int dt = 0; dt < 8; ++dt) O[ts][dt] = (f32x4){0.f, 0.f, 0.f, 0.f}; }
            if (DBG_BR & 4) {
                const int b0 = tile >= 8 ? tile - 8 : 0;
                const unsigned char* kwi = P.ws + WS_KWI + ((size_t)g * 256 + b0) * 16384; const unsigned char* vwi = P.ws + WS_VWI + ((size_t)g * 256 + b0) * 16384;
                AT_RING_LOOP(tile - b0 + 1, kwi, vwi, false, {
                    _Pragma("unroll") for (int ts = 0; ts < 2; ++ts) limq[ts] = tok_(ts) - 64 * (b0 + b) - 8 * q;
                    step_online<true, true>(Kb_, Vb_, L, qf, O, mref, l, limq, 512u, (b == 0) || (b0 + b == tile), b == 0);
                });
            }
            FS_OFF();
#pragma unroll
            for (int ts = 0; ts < 2; ++ts) { float lt = l[ts]; lt += __shfl_xor(lt, 16); lt += __shfl_xor(lt, 32); const float sc = (DBG_BR & 4) ? GATE(ts, 2) / lt : 0.f;
                bf16* orow = AO + (size_t)tok_(ts) * DM + (4 * g + hh) * HD + 4 * q;
#pragma unroll
                for (int dt = 0; dt < 8; ++dt) { const f32x4 o = FSAT(ts * 8 + dt) + O[ts][dt] * sc;
                    u32x2 w; w.x = pk2(o[0], o[1]); w.y = pk2(o[2], o[3]); *(u32x2*)(orow + 16 * dt) = w; if ((dt & 3) == 3) asm volatile("" ::: "memory"); } }
        }
    }
#undef AT_REGION
#undef AT_RING_LOOP
#undef AT_DRIFT_LOOP
}

#ifndef DBG_CHECK
#define DBG_CHECK 0
#endif
#if DBG_CHECK
__device__ __forceinline__ float p_bf(const bf16* Pm, int t, int col) { return __uint_as_float((unsigned)Pm[(size_t)t * PW + col] << 16); }
__device__ __forceinline__ float roped(const bf16* Pm, const float* cosT, const float* sinT, int t, int colbase, int d) {
    const float x = p_bf(Pm, t, colbase + d);
    if (d >= 32) return x;
    const int i = d & 15; const float c = cosT[(size_t)t * 16 + i], sn = sinT[(size_t)t * 16 + i];
    return (d < 16) ? x * c - p_bf(Pm, t, colbase + d + 16) * sn : x * c + p_bf(Pm, t, colbase + d - 16) * sn;
}
__constant__ int TSAMP[28] = {0, 1, 5, 30, 31, 32, 47, 63, 64, 65, 100, 127, 128, 191, 200, 255, 300, 511, 512, 575, 1023, 1024, 1025, 2047, 4096, 8191, 12345, 16383};
__device__ __forceinline__ void attn_check(const Ptrs& P, int l, LAS unsigned char* lds, int vcu, int G, int tid, unsigned* flagword) {
    const int NS = 28;
    const bf16* Pm = (const bf16*)(P.ws + WS_P); const bf16* AO = (const bf16*)(P.ws + WS_AO);
    const float* cosT = (const float*)(P.ws + WS_COS); const float* sinT = (const float*)(P.ws + WS_SIN);
    LAS float* q = (LAS float*)lds;
    LAS float* blk = q + 512;
    LAS float* hh_ = blk + 4096;
    LAS float* kc = hh_ + 256;
    LAS float* vc = kc + 2048;
    LAS float* sc = vc + 2048;
    LAS float* fin = sc + 4096;
    LAS float* imp = fin + 512;
    LAS int* selb = (LAS int*)(imp + 256);
    LAS unsigned* red = (LAS unsigned*)(selb + 16);
    for (int item = vcu; item < NS * 4; item += G) {
        const int s = item >> 2, g = item & 3, t = TSAMP[s];
        const int cur = t >> 6;
        { const int r = tid >> 7, d = tid & 127; q[tid] = __uint_as_float((unsigned)((const bf16*)(P.ws + WS_QP))[(size_t)t * DM + (4 * g + r) * HD + d] << 16) * 0.6931471805599453f; fin[tid] = 0.f; }
        if (tid < 2) red[tid] = 0u;
        if (tid < 256) imp[tid] = 0.f;
        __syncthreads();
        const int nmax = (t - 31) >> 4;
        const bool small = t < 256;
        const unsigned char* kci = P.ws + WS_KCI + (size_t)g * 16 * 16384; const unsigned char* vci = P.ws + WS_VCI + (size_t)g * 16 * 16384;
        if (small) {
        for (int kv = 0; kv < 2; ++kv)
            for (int n = 0; n <= nmax; ++n) {
                for (int e = tid; e < 4096; e += 512) { const int l_ = e >> 7, d = e & 127, tok = 16 * n + l_;
                    const float x = (kv == 0) ? roped(Pm, cosT, sinT, tok, C_KV + 0 * 512 + g * HD, d) : p_bf(Pm, tok, C_KV + 1 * 512 + g * HD + d);
                    blk[e] = x + P.cmp_pe[((size_t)(l * 2 + kv) * 32 + l_) * 128 + d]; }
                __syncthreads();
                if (tid < 256) { const float* w1 = P.cmp_w1 + (size_t)(l * 2 + kv) * 4096 * 256 + tid; float a = P.cmp_b1[(size_t)(l * 2 + kv) * 256 + tid];
                    for (int e = 0; e < 4096; ++e) a += blk[e] * w1[(size_t)e * 256];
                    hh_[tid] = 0.5f * a * (1.0f + tanhf(0.7978845608028654f * (a + 0.044715f * a * a * a))); }
                __syncthreads();
                if (tid < 128) { const float* w2 = P.cmp_w2 + (size_t)(l * 2 + kv) * 256 * 128 + tid; float a = P.cmp_b2[(size_t)(l * 2 + kv) * 128 + tid];
                    for (int c = 0; c < 256; ++c) a += hh_[c] * w2[(size_t)c * 128];
                    (kv == 0 ? kc : vc)[n * 128 + tid] = a; }
                __syncthreads();
            }
        }
#define KC_AT(n, d) (small ? kc[(n) * 128 + (d)] : __uint_as_float((unsigned)*(const bf16*)(kci + (size_t)((n) >> 6) * 16384 + kimg_off((n) & 63, (d) >> 3) + ((d) & 7) * 2) << 16))
#define VC_AT(n, d) (small ? vc[(n) * 128 + (d)] : __uint_as_float((unsigned)*(const bf16*)(vci + (size_t)((n) >> 6) * 16384 + vimg_off((d), ((n) & 63) >> 3) + ((n) & 7) * 2) << 16))
        if (nmax >= 0) {
            for (int e = tid; e < 4 * 1024; e += 512) { const int r = e >> 10, n = e & 1023; float a = -1e30f;
                if (n <= nmax) { a = 0.f; for (int d = 0; d < 128; ++d) a += q[r * 128 + d] * KC_AT(n, d); } sc[e] = a; }
            __syncthreads();
            float mx = -1e30f, den = 0.f;
            { const int r = tid >> 7, d = tid & 127; for (int n = 0; n <= nmax; ++n) mx = fmaxf(mx, sc[r * 1024 + n]);
              float num = 0.f; for (int n = 0; n <= nmax; ++n) { const float p = expf(sc[r * 1024 + n] - mx); den += p; num += p * VC_AT(n, d); }
              if (DBG_BR & 1) fin[tid] += sigm(p_bf(Pm, t, C_GN + (4 * g + r) * 3 + 0)) * num / den; }
            __syncthreads();
            { const int r = tid >> 7; for (int n = (tid & 127); n <= nmax; n += 128) sc[r * 1024 + n] = expf(sc[r * 1024 + n] - mx) / den; }
            __syncthreads();
            if (tid <= cur) { const int j = tid; float a = 0.f;
                for (int r = 0; r < 4; ++r) for (int u = -1; u <= 3; ++u) { const int n = 4 * j + u; if (n >= 0 && n <= nmax) a += sc[r * 1024 + n] * ((u == -1 || u == 3) ? 0.5f : 1.0f); }
                imp[j] = a; }
            __syncthreads();
        }
        if (tid == 0) { int ns = 0; selb[ns++] = 0; if (cur > 0) selb[ns++] = cur;
            for (int rnd = 0; rnd < 14; ++rnd) { int bj = -1; float bv = -1.f;
                for (int j = 1; j < cur; ++j) { bool taken = false; for (int k = 0; k < ns; ++k) taken |= (selb[k] == j); if (!taken && imp[j] > bv) { bv = imp[j]; bj = j; } }
                if (bj < 0) break; selb[ns++] = bj; }
            for (; ns < 16; ++ns) selb[ns] = -1; }
        __syncthreads();
        if (DBG_BR & 2) {
            const int kcol = C_KV + 2 * 512 + g * HD, vcol = C_KV + 3 * 512 + g * HD;
            for (int e = tid; e < 4 * 1024; e += 512) { const int r = e >> 10, k = e & 1023, bsel = selb[k >> 6], kp = bsel * 64 + (k & 63); float a = -1e30f;
                if (bsel >= 0 && kp <= t) { a = 0.f; for (int d = 0; d < 128; ++d) a += q[r * 128 + d] * roped(Pm, cosT, sinT, kp, kcol, d); }
                sc[e] = a; }
            __syncthreads();
            { const int r = tid >> 7, d = tid & 127; float mx = -1e30f; for (int k = 0; k < 1024; ++k) mx = fmaxf(mx, sc[r * 1024 + k]);
              float den = 0.f, num = 0.f; for (int k = 0; k < 1024; ++k) { const float sv = sc[r * 1024 + k]; if (sv > -1e29f) { const float p = expf(sv - mx); den += p; num += p * p_bf(Pm, selb[k >> 6] * 64 + (k & 63), vcol + d); } }
              fin[tid] += sigm(p_bf(Pm, t, C_GN + (4 * g + r) * 3 + 1)) * num / den; }
            __syncthreads();
        }
        if (DBG_BR & 4) {
            const int kcol = C_KV + 4 * 512 + g * HD, vcol = C_KV + 5 * 512 + g * HD;
            for (int e = tid; e < 4 * 512; e += 512) { const int r = e >> 9, kp = t - (e & 511); float a = -1e30f;
                if (kp >= 0) { a = 0.f; for (int d = 0; d < 128; ++d) a += q[r * 128 + d] * roped(Pm, cosT, sinT, kp, kcol, d); }
                sc[r * 1024 + (e & 511)] = a; }
            __syncthreads();
            { const int r = tid >> 7, d = tid & 127; float mx = -1e30f; for (int k = 0; k < 512; ++k) mx = fmaxf(mx, sc[r * 1024 + k]);
              float den = 0.f, num = 0.f; for (int k = 0; k < 512; ++k) { const float sv = sc[r * 1024 + k]; if (sv > -1e29f) { const float p = expf(sv - mx); den += p; num += p * p_bf(Pm, t - k, vcol + d); } }
              fin[tid] += sigm(p_bf(Pm, t, C_GN + (4 * g + r) * 3 + 2)) * num / den; }
            __syncthreads();
        }
        { const int r = tid >> 7, d = tid & 127; const float ao = __uint_as_float((unsigned)AO[(size_t)t * DM + (4 * g + r) * HD + d] << 16);
          const float err = fabsf(fin[tid] - ao), mag = fabsf(fin[tid]);
          atomicMax((unsigned*)&red[0], __float_as_uint(err)); atomicMax((unsigned*)&red[1], __float_as_uint(mag)); }
        __syncthreads();
        if (tid == 0) { const float err = __uint_as_float(red[0]), mag = __uint_as_float(red[1]); if (!(err <= 0.03f * mag + 2e-3f)) atomicOr(flagword, 1u << s); }
        __syncthreads();
    }
#undef KC_AT
#undef VC_AT
}
#endif


#if DBG_CHECK
__constant__ int RSAMP[8] = {0, 1, 63, 64, 255, 256, 4097, 16383};
__device__ __forceinline__ int csamp(int ci, int N) { return ci == 63 ? N - 1 : (int)(((unsigned)ci * (unsigned)(N / 64) + ((unsigned)ci * 7u) % 61u) % (unsigned)N); }
__device__ __forceinline__ float bfv(const bf16* p, size_t i) { return __uint_as_float((unsigned)p[i] << 16); }
__device__ __forceinline__ float mod_naive(const Ptrs& P, int l, int k, int c) {
    float a = P.ada_b[(size_t)l * 6 * DM + k * DM + c];
    for (int j = 0; j < DM; ++j) { const float cv = P.c[j]; a += cv / (1.0f + expf(-cv)) * P.ada_w[((size_t)l * DM + j) * 6 * DM + k * DM + c]; }
    return a;
}
__device__ __forceinline__ void flag_if(bool bad, unsigned* flagword, int bit) { if (bad) { atomicOr(flagword, 1u << bit); if (bit == 4) { atomicMax(flagword + 1, 0xffffffffu - (unsigned)threadIdx.x); atomicAdd(flagword + 2, 1u); } } }
__device__ __forceinline__ bool mism(float got, float exp_) { return !(fabsf(got - exp_) <= 0.02f * fabsf(exp_) + 0.02f); }
__device__ __forceinline__ void main_check(const Ptrs& P, int which, int tid, unsigned* flagword) {
    const int l = 0, row = RSAMP[tid >> 6], ci = tid & 63;
    const bf16* Pm = (const bf16*)(P.ws + WS_P); const bf16* H = (const bf16*)(P.ws + WS_H); const float* Y = (const float*)(P.ws + WS_Y);
    if (which == 1 || which == 7) {
        const int c = csamp(ci, DM);
        const float* xr = (which == 1 ? P.x : P.out) + (size_t)row * DM;
        if (which == 7) {
            float ss = 0.f; for (int j = 0; j < DM; ++j) { const float y = Y[(size_t)row * DM + j]; ss += y * y; }
            const float e = P.x[(size_t)row * DM + c] + mod_naive(P, l, 2, c) * P.gains[(size_t)(l * 4 + 1) * DM + c] * Y[(size_t)row * DM + c] / sqrtf(ss / DM + NORM_EPS);
            flag_if(mism(xr[c], e), flagword, 16 + which);
        }
        float ss = 0.f; for (int j = 0; j < DM; ++j) ss += xr[j] * xr[j];
        const int gi = which == 1 ? 0 : 2, sck = which == 1 ? 1 : 4, shk = which == 1 ? 0 : 3;
        const float e = xr[c] / sqrtf(ss / DM + NORM_EPS) * P.gains[(size_t)(l * 4 + gi) * DM + c] * (1.0f + mod_naive(P, l, sck, c)) + mod_naive(P, l, shk, c);
        flag_if(mism(bfv(H, (size_t)row * DM + c), e), flagword, which);
    } else if (which == 2) {
        const int pc = (ci < 60) ? csamp(ci, 12288) : 12288 + (ci - 60) * 15;
        const int src = pc < 8192 ? pc : pc < 10240 ? 8240 + (pc - 8192) : pc < 12288 ? 10288 + (pc - 10240) : 8192 + (pc - 12288);
        float a = 0.f; for (int k = 0; k < DM; ++k) a += bfv(H, (size_t)row * DM + k) * P.w_in[((size_t)l * DM + k) * INW + src];
        flag_if(mism(bfv(Pm, (size_t)row * PW + pc), a), flagword, which);
    } else if (which == 3) {
        const int c = csamp(ci, CWID); float z = 0.f;
        for (int k = 0; k < 3; ++k) { const int tt = row - 2 + k; if (tt >= 0) z += P.conv_w[(size_t)l * 3 * CWID + k * CWID + c] * bfv(Pm, (size_t)tt * PW + C_CG + c) * bfv(Pm, (size_t)tt * PW + C_XA + c); }
        flag_if(mism(bfv((const bf16*)(P.ws + WS_CV), (size_t)row * CWID + c), z * bfv(Pm, (size_t)row * PW + C_BG + c)), flagword, which);
    } else if (which == 4) {
        const int c = csamp(ci, DM); const bf16* CV = (const bf16*)(P.ws + WS_CV);
        float a = 0.f; for (int k = 0; k < CWID; ++k) a += bfv(CV, (size_t)row * CWID + k) * P.w_conv_out[((size_t)l * CWID + k) * DM + c];
        flag_if(mism(bfv((const bf16*)(P.ws + WS_YA), (size_t)row * DM + c), a * sigm(bfv(Pm, (size_t)row * PW + C_GA + c))), flagword, which);
    } else if (which == 5 && row < 10000) {
        const int c = csamp(ci, DM); const bf16* AO = (const bf16*)(P.ws + WS_AO);
        float a = 0.f; for (int k = 0; k < DM; ++k) a += bfv(AO, (size_t)row * DM + k) * P.w_nsa[((size_t)l * DM + k) * DM + c];
        flag_if(mism(bfv((const bf16*)(P.ws + WS_MG), (size_t)row * DM + c), bfv((const bf16*)(P.ws + WS_YA), (size_t)row * DM + c) + a * sigm(bfv(Pm, (size_t)row * PW + C_GB + c))), flagword, which);
    } else if (which == 6) {
        const int c = csamp(ci, DM); const bf16* MG = (const bf16*)(P.ws + WS_MG);
        float a = 0.f; for (int k = 0; k < DM; ++k) a += bfv(MG, (size_t)row * DM + k) * P.w_out[((size_t)l * DM + k) * DM + c];
        flag_if(mism(Y[(size_t)row * DM + c], a), flagword, which);
    } else if (which == 8) {
        const int f = csamp(ci, FF);
        float a = 0.f; for (int k = 0; k < DM; ++k) a += bfv(H, (size_t)row * DM + k) * P.w_up[((size_t)l * DM + k) * FF + f];
        a = fmaxf(a, 0.f); flag_if(mism(bfv((const bf16*)(P.ws + WS_U), (size_t)row * FF + f), a * a), flagword, which);
    } else if (which == 9) {
        const int c = csamp(ci, DM); const bf16* U = (const bf16*)(P.ws + WS_U);
        float a = 0.f; for (int k = 0; k < FF; ++k) a += bfv(U, (size_t)row * FF + k) * P.w_down[((size_t)l * FF + k) * DM + c];
        flag_if(mism(Y[(size_t)row * DM + c], a), flagword, which);
    }
}
#define MAIN_CHECK(w) do { if (l == 0 && bx == 0) main_check(P, (w), OPQ_TID(), ctl + 64); } while (0)
#else
#define MAIN_CHECK(w) do { } while (0)
#endif
constexpr int NPH = 11;
constexpr int N_PHASES = 2 + DEPTH * NPH;
#ifndef DBG_CHECK_LAYER
#define DBG_CHECK_LAYER 0
#endif
#ifndef DBG_SKIP_ATTN
#define DBG_SKIP_ATTN 0
#endif
#ifndef DUP_MASK
#define DUP_MASK 0
#endif
#define DUPN(t) (1 + ((DUP_MASK >> (t)) & 1))
#ifndef MK_PER_PHASE
#define MK_PER_PHASE 0
#endif

__global__ void __launch_bounds__(NWAVES * 64, 2) nsa_fwd(Args args) {
    extern __shared__ __attribute__((aligned(16))) unsigned char lds_raw[];
    LAS unsigned char* lds = (LAS unsigned char*)lds_raw;
    const int tid = threadIdx.x, lane = tid & 63, wave = __builtin_amdgcn_readfirstlane(tid >> 6);
    const int G = gridDim.x; const int bx = blockIdx.x; const int vcu = (G % 8 == 0) ? (bx % 8) * (G / 8) + bx / 8 : bx;
    volatile LAS unsigned* MISC = (volatile LAS unsigned*)(lds + MISC_OFF);
    for (int u = tid; u < 128; u += NWAVES * 64) MISC[u] = 0u;
    __syncthreads();
    unsigned* ctl = (unsigned*)(args.ws + WS_CTL);
    XcdBarrier bar = xcd_barrier_post(ctl + CW_BAR, MISC + 8);
    const int lo = args.ph_lo, hi = args.ph_hi; (void)lo; (void)hi;
#ifndef ONLY_PHASE
#define ONLY_PHASE -1
#endif
#define PH_EN(t) (ONLY_PHASE < 0 || ONLY_PHASE == (t))
#if MK_PER_PHASE
#define IN(k) (lo <= (k) && (k) < hi)
#else
#define IN(k) true
#endif
#define LOADP() const Args GAS_K* ap_ = (const Args GAS_K*)__builtin_amdgcn_kernarg_segment_ptr(); asm volatile("" : "+s"(ap_)); Ptrs P; \
    P.x = (const float*)ap_->in[0]; P.c = (const float*)ap_->in[1]; P.pos = (const int*)ap_->in[2]; P.ada_w = (const float*)ap_->in[3]; P.ada_b = (const float*)ap_->in[4]; \
    P.gains = (const float*)ap_->in[5]; P.w_in = (const float*)ap_->in[6]; P.conv_w = (const float*)ap_->in[7]; P.w_conv_out = (const float*)ap_->in[8]; P.cmp_pe = (const float*)ap_->in[9]; \
    P.cmp_w1 = (const float*)ap_->in[10]; P.cmp_b1 = (const float*)ap_->in[11]; P.cmp_w2 = (const float*)ap_->in[12]; P.cmp_b2 = (const float*)ap_->in[13]; P.w_nsa = (const float*)ap_->in[14]; \
    P.w_out = (const float*)ap_->in[15]; P.w_up = (const float*)ap_->in[16]; P.w_down = (const float*)ap_->in[17]; P.out = ap_->out; P.ws = ap_->ws; \
    bf16* H = (bf16*)(P.ws + WS_H); bf16* Y = (bf16*)(P.ws + WS_Y); unsigned char* wl = P.ws + WS_WL + (size_t)l_ * WL_BYTES; const bf16* Pm = (const bf16*)(P.ws + WS_P); (void)H; (void)Y; (void)wl; (void)Pm
#define OPQ_S(x) ({ int _v = (x); asm volatile("" : "+s"(_v)); _v; })
#define OPQ_TID() ({ int _l; asm volatile("v_mbcnt_lo_u32_b32 %0, -1, 0\n\tv_mbcnt_hi_u32_b32 %0, -1, %0" : "=v"(_l)); int _t = (OPQ_S(wave) << 6) | _l; _t; })
#if MK_PER_PHASE
#define SEAM(k) do { } while (0)
#else
#define SEAM(k) do { if (IN((k) + 1) && rep_ + 1 == nrep_) xcd_barrier(bar); } while (0)
#endif

    { const int l_ = 0; (void)l_;
    if (PH_EN(0) && IN(0)) for (int rep_ = 0, nrep_ = (DUPN(0)); rep_ < nrep_; ++rep_) { LOADP(); { const int t_ = OPQ_TID(); p0_prologue(P, lds, OPQ_S(vcu), OPQ_S(G), OPQ_S(wave), t_ & 63, t_); } SEAM(0); }
    if (PH_EN(1) && IN(1)) for (int rep_ = 0, nrep_ = (1); rep_ < nrep_; ++rep_) { LOADP(); resid_phase<false>(P, lds, P.x, false, nullptr, false, nullptr, H, true, 0, 0, 0,  0,  1,  0,  0, OPQ_S(vcu), OPQ_S(G), OPQ_S(wave), OPQ_TID() & 63, OPQ_TID()); SEAM(1); }

    }
    for (int l = 0; l < DEPTH; ++l) {
        const int pb = 2 + l * NPH; const int l_ = l;
        if (PH_EN(2) && IN(pb + 0)) for (int rep_ = 0, nrep_ = (DUPN(2)); rep_ < nrep_; ++rep_) { LOADP();
            MAIN_CHECK(1);
            pg8::Gemm g{H, (const bf16*)(wl + WL_WIN), S, C_GN, DM, DM}; pg8::StaticOrder So; So.init(S, C_GN, OPQ_S(G), OPQ_S(bx));
            pg8::EpiB<0> E{(bf16*)(P.ws + WS_P), PW, nullptr, nullptr, 0, nullptr, 0};
            pg8::gemm_phase<pg8::EpiB<0>, pg8::StaticOrder, true, true>(lds, g, So, E, OPQ_TID());
            SEAM(pb + 0);
        }
        if (PH_EN(3) && IN(pb + 1)) for (int rep_ = 0, nrep_ = (DUPN(3)); rep_ < nrep_; ++rep_) { LOADP(); MAIN_CHECK(2); relayout_phase(P, l, lds, OPQ_S(vcu), OPQ_S(G), OPQ_TID()); SEAM(pb + 1); }
        if (PH_EN(4) && IN(pb + 2)) for (int rep_ = 0, nrep_ = (DUPN(4)); rep_ < nrep_; ++rep_) { LOADP();
            MAIN_CHECK(3);
            {   pg8::Gemm g{(const bf16*)(P.ws + WS_KCR), (const bf16*)(wl + WL_W1T), 8192, 512, 4096, 2048}; pg8::CmpOrder So{OPQ_S(bx)};
                pg8::EpiB<2, true> E{(bf16*)(P.ws + WS_HC), 256, (const float*)(P.ws + WS_B1P), nullptr, 0, nullptr, 0};
                pg8::gemm_phase<pg8::EpiB<2, true>, pg8::CmpOrder, false, true>(lds, g, So, E, OPQ_TID()); }
            {   pg8::Gemm g{(const bf16*)(P.ws + WS_CV), (const bf16*)(wl + WL_WCONV), S, DM, CWID, CWID}; pg8::StaticOrder So;
                So.init(S, DM, OPQ_S(G), OPQ_S(bx));
                pg8::EpiB<3> E{(bf16*)(P.ws + WS_YA), DM, nullptr, Pm + C_GA, PW, nullptr, 0};
                if (OPQ_S(G) == 256) { pg8::YaOrder Yo{So, OPQ_S(bx)}; pg8::gemm_phase<pg8::EpiB<3>, pg8::YaOrder, true, true>(lds, g, Yo, E, OPQ_TID()); }
                else pg8::gemm_phase<pg8::EpiB<3>, pg8::StaticOrder, true, true>(lds, g, So, E, OPQ_TID()); }
            SEAM(pb + 2);
        }
        if (PH_EN(5) && IN(pb + 3)) for (int rep_ = 0, nrep_ = (DUPN(5)); rep_ < nrep_; ++rep_) { LOADP(); MAIN_CHECK(4); cmp2_phase(P, l, OPQ_S(vcu), OPQ_S(G), OPQ_S(wave), OPQ_TID() & 63); SEAM(pb + 3); }
#if DBG_SKIP_ATTN
        if (PH_EN(6) && IN(pb + 4)) for (int rep_ = 0, nrep_ = (DUPN(6)); rep_ < nrep_; ++rep_) { LOADP(); u32x4* ao = (u32x4*)(P.ws + WS_AO); for (size_t i = (size_t)OPQ_S(vcu) * 512 + OPQ_TID(); i < (size_t)S * DM * 2 / 16; i += (size_t)OPQ_S(G) * 512) ao[i] = (u32x4){0u, 0u, 0u, 0u}; SEAM(pb + 4); }
#else
        if (PH_EN(6) && IN(pb + 4)) for (int rep_ = 0, nrep_ = (DUPN(6)); rep_ < nrep_; ++rep_) { LOADP(); attn_phase(P, lds, OPQ_S(vcu), OPQ_S(G), OPQ_S(wave), OPQ_TID() & 63);
            SEAM(pb + 4); }
#endif
        if (PH_EN(7) && IN(pb + 5)) for (int rep_ = 0, nrep_ = (DUPN(7)); rep_ < nrep_; ++rep_) { LOADP();
#if DBG_CHECK
            if (DBG_CHECK == 2 && l == DBG_CHECK_LAYER) { attn_check(P, l, lds, OPQ_S(vcu), OPQ_S(G), OPQ_TID(), ctl + 64); __syncthreads(); }
#endif
            pg8::Gemm g{(const bf16*)(P.ws + WS_AO), (const bf16*)(wl + WL_WNSA), S, DM, DM, DM}; pg8::StaticOrder So; So.init(S, DM, OPQ_S(G), OPQ_S(bx));
            pg8::EpiB<4> E{(bf16*)(P.ws + WS_MG), DM, nullptr, Pm + C_GB, PW, (const bf16*)(P.ws + WS_YA), DM};
            pg8::gemm_phase<pg8::EpiB<4>, pg8::StaticOrder, true, true>(lds, g, So, E, OPQ_TID());
            SEAM(pb + 5);
        }
        if (PH_EN(8) && IN(pb + 6)) for (int rep_ = 0, nrep_ = (DUPN(8)); rep_ < nrep_; ++rep_) { LOADP();
            MAIN_CHECK(5);
            pg8::Gemm g{(const bf16*)(P.ws + WS_MG), (const bf16*)(wl + WL_WOUT), S, DM, DM, DM}; pg8::StaticOrder So; So.init(S, DM, OPQ_S(G), OPQ_S(bx));
            pg8::EpiB<0> E{Y, DM, nullptr, nullptr, 0, nullptr, 0};
            pg8::gemm_phase<pg8::EpiB<0>, pg8::StaticOrder, true, true>(lds, g, So, E, OPQ_TID());
            SEAM(pb + 6);
        }
        if (PH_EN(9) && IN(pb + 7)) for (int rep_ = 0, nrep_ = (1); rep_ < nrep_; ++rep_) { LOADP(); MAIN_CHECK(6); resid_phase<true>(P, lds, l == 0 ? (const void*)P.x : (const void*)(P.ws + WS_XB), l != 0, (void*)(P.ws + WS_XB), true, Y, H, true, l, 2, 1, l, 4, 3, 2, OPQ_S(vcu), OPQ_S(G), OPQ_S(wave), OPQ_TID() & 63, OPQ_TID()); SEAM(pb + 7); }
        if (PH_EN(10) && IN(pb + 8)) for (int rep_ = 0, nrep_ = (DUPN(10)); rep_ < nrep_; ++rep_) { LOADP();
            MAIN_CHECK(7);
            pg8::Gemm g{H, (const bf16*)(wl + WL_WUP), S, FF, DM, DM}; pg8::StaticOrder So; So.init(S, FF, OPQ_S(G), OPQ_S(bx));
            pg8::EpiB<1> E{(bf16*)(P.ws + WS_U), FF, nullptr, nullptr, 0, nullptr, 0};
            pg8::gemm_phase<pg8::EpiB<1>, pg8::StaticOrder, true, true>(lds, g, So, E, OPQ_TID());
            SEAM(pb + 8);
        }
        if (PH_EN(11) && IN(pb + 9)) for (int rep_ = 0, nrep_ = (DUPN(11)); rep_ < nrep_; ++rep_) { LOADP();
            MAIN_CHECK(8);
            pg8::Gemm g{(const bf16*)(P.ws + WS_U), (const bf16*)(wl + WL_WDOWN), S, DM, FF, FF}; pg8::StaticOrder So; So.init(S, DM, OPQ_S(G), OPQ_S(bx));
            pg8::EpiB<0> E{Y, DM, nullptr, nullptr, 0, nullptr, 0};
            pg8::gemm_phase<pg8::EpiB<0>, pg8::StaticOrder, true, true>(lds, g, So, E, OPQ_TID());
            SEAM(pb + 9);
        }
        if (PH_EN(12) && IN(pb + 10)) for (int rep_ = 0, nrep_ = (1); rep_ < nrep_; ++rep_) { LOADP();
            MAIN_CHECK(9);
            resid_phase<true>(P, lds, (const void*)(P.ws + WS_XB), true, l + 1 < DEPTH ? (void*)(P.ws + WS_XB) : (void*)P.out, l + 1 < DEPTH, Y, H, l + 1 < DEPTH, l, 5, 3, (l + 1 < DEPTH) ? l + 1 : l, 1, 0, 0, OPQ_S(vcu), OPQ_S(G), OPQ_S(wave), OPQ_TID() & 63, OPQ_TID());
            if (l + 1 < DEPTH) SEAM(pb + 10);
#if DBG_CHECK
            else { __syncthreads(); if (OPQ_S(bx) == 0 && OPQ_TID() == 0) { __threadfence(); const unsigned f = __hip_atomic_load(ctl + 64, __ATOMIC_RELAXED, __HIP_MEMORY_SCOPE_AGENT);
                if (f) { const unsigned ft = (0xffffffffu - __hip_atomic_load(ctl + 65, __ATOMIC_RELAXED, __HIP_MEMORY_SCOPE_AGENT)) + 1u, cnt = 0u; (void)cnt;
                    P.out[0] = 2000.0f * ((((ft - 1u) & 63u) >> 3) + 1u); } } }
#endif
        }
    }
#undef IN
#undef SEAM
}

extern "C" void kernel_launch(void* const* d_in, const int* in_sizes, int n_in, void* d_out, int out_size, void* d_ws, size_t ws_size, hipStream_t stream) {
    static int grid = 0;
    if (grid == 0) {
        if (n_in != 18 || out_size != S * DM || ws_size < WS_END) { fprintf(stderr, "kernel_launch: unexpected problem (n_in %d, out %d, ws %zu, need %zu)\n", n_in, out_size, ws_size, (size_t)WS_END); grid = -1; return; }
        int dev = 0, cus = 0, per_cu = 0;
        if (hipGetDevice(&dev) != hipSuccess || hipDeviceGetAttribute(&cus, hipDeviceAttributeMultiprocessorCount, dev) != hipSuccess) { grid = -1; return; }
        if (hipFuncSetAttribute((const void*)nsa_fwd, hipFuncAttributeMaxDynamicSharedMemorySize, LDS_BYTES) != hipSuccess) { fprintf(stderr, "kernel_launch: hipFuncSetAttribute failed\n"); grid = -1; return; }
        if (hipOccupancyMaxActiveBlocksPerMultiprocessor(&per_cu, (const void*)nsa_fwd, NWAVES * 64, LDS_BYTES) != hipSuccess || per_cu < 1)
            fprintf(stderr, "kernel_launch: occupancy query reports %d workgroups per CU\n", per_cu);
        (void)hipGetLastError();
        grid = cus;
    }
    if (grid < 0) return;
    if (hipMemsetAsync((char*)d_ws + WS_CTL, 0, CTL_ZERO_BYTES, stream) != hipSuccess) { fprintf(stderr, "kernel_launch: memset failed\n"); return; }
    Args a{};
    for (int i = 0; i < 18; ++i) a.in[i] = d_in[i];
    a.out = (float*)d_out; a.ws = (unsigned char*)d_ws;
#if MK_PER_PHASE
    for (int ph = 0; ph < N_PHASES; ++ph) { a.ph_lo = ph; a.ph_hi = ph + 1; hipLaunchKernelGGL(nsa_fwd, dim3(grid), dim3(NWAVES * 64), LDS_BYTES, stream, a); }
#else
    a.ph_lo = 0; a.ph_hi = N_PHASES;
    hipLaunchKernelGGL(nsa_fwd, dim3(grid), dim3(NWAVES * 64), LDS_BYTES, stream, a);
#endif
    const hipError_t le = hipPeekAtLastError();
    if (le != hipSuccess) fprintf(stderr, "kernel_launch: launch failed: %s\n", hipGetErrorName(le));
}
```

```cpp
#include <hip/hip_runtime.h>
#include <cstdio>
#include <cstdint>

#define GAS __attribute__((address_space(1)))
#define GAS_K __attribute__((address_space(4)))
#define LAS __attribute__((address_space(3)))
typedef unsigned short bf16;
typedef short bf16x8 __attribute__((ext_vector_type(8)));
typedef float f32x4 __attribute__((ext_vector_type(4)));
typedef float f32x2 __attribute__((ext_vector_type(2)));
typedef unsigned u32x4 __attribute__((ext_vector_type(4)));
typedef unsigned u32x2 __attribute__((ext_vector_type(2)));

constexpr int S = 16384, DM = 2048, DEPTH = 4, CWID = 1024, NH = 16, NG = 4, HD = 128, FF = 8192;
constexpr int INW = 12336, PW = 12544;
constexpr int C_BG = 0, C_CG = 1024, C_XA = 2048, C_Q = 3072, C_KV = 5120, C_GA = 8192, C_GB = 10240, C_GN = 12288;
constexpr float NORM_EPS = 1e-6f;
constexpr float QSCALE = 0.12751743082459868f;
constexpr int NWAVES = 8;

namespace pg8 {
typedef unsigned short bf16_t;
constexpr int WGM_PROJ = 8, WGM_UP = 8, WGM_N2K = 4;
constexpr int BM = 256, BK = 64, HALF = 128, HTB = HALF * BK * 2, STAGE_BYTES = 8 * HTB, NXCD = 8, WGM = 4;
__host__ __device__ __forceinline__ int lds_byte(int r, int c) { const int st = (r >> 4) * 2 + (c >> 5), rr = r & 15, cc = c & 31, ob = rr * 64 + cc * 2; return st * 1024 + (ob ^ (((ob >> 9) & 1) << 5)); }
__host__ __device__ __forceinline__ void stage_rc(int b, int& R, int& C) { const int st = b / 1024, sb = b % 1024, swz = sb ^ (((sb >> 9) & 1) << 5); R = (st >> 1) * 16 + swz / 64; C = (st & 1) * 32 + (swz % 64) / 2; }
__host__ __device__ __forceinline__ int perm32(int rho) { const int n = rho >> 4, i = rho & 15; return 8 * (i >> 2) + 4 * n + (i & 3); }

struct Unit { int pm, pn; };
struct Gemm { const bf16_t* A; const bf16_t* Bt; int M, N, K, lda; };

struct StaticOrder {
    int nM, nN, nwg, G, c, wgm;
    __device__ void init(int M, int N, int G_, int c_, int wgm_ = WGM) { nM = M / BM; nN = N / BM; nwg = nM * nN; G = G_; c = c_; wgm = wgm_; if (c_ < 0 || c_ >= G_) nwg = 0; }
    __device__ bool next(int i, Unit& u) const { return map((long)i * G + c, u); }
    __device__ bool map(const long L, Unit& u) const {
        if (L >= nwg) return false;
        int wgid = (int)L; { const int q = nwg / NXCD, r = nwg % NXCD, xcd = wgid % NXCD, off = wgid / NXCD; wgid = (xcd < r ? xcd * (q + 1) : r * (q + 1) + (xcd - r) * q) + off; }
        const int nig = wgm * nN, gid = wgid / nig, fm = gid * wgm, gsz = (nM - fm) < wgm ? (nM - fm) : wgm;
        u.pm = fm + ((wgid % nig) % gsz); u.pn = (wgid % nig) / gsz; return true;
    }
    __device__ __forceinline__ void a_ready(const Unit&) const {}
    __device__ __forceinline__ void done(const Unit&) const {}
};

typedef float f32x2_t_ __attribute__((ext_vector_type(2))); typedef __bf16 bf16x2_t_ __attribute__((ext_vector_type(2)));
__device__ __forceinline__ unsigned cvt_pk_bf16(float lo, float hi) { const f32x2_t_ v = {lo, hi}; const bf16x2_t_ b = __builtin_convertvector(v, bf16x2_t_); return __builtin_bit_cast(unsigned, b); }
__device__ __forceinline__ float bflo(unsigned w) { return __uint_as_float(w << 16); }
__device__ __forceinline__ float bfhi(unsigned w) { return __uint_as_float(w & 0xffff0000u); }
__device__ __forceinline__ float sigmoidf_(float x) { return __builtin_amdgcn_rcpf(1.0f + __builtin_amdgcn_exp2f(-1.4426950408889634f * x)); }

struct YaOrder {
    StaticOrder base; int bx;
    __device__ bool next(int i, Unit& u) const {
        if (bx < 32) return false;
        if (i < 2) return base.next(i, u);
        if (i == 2 && bx < 96) { const int idx = bx - 32; return base.map(idx < 32 ? (long)idx : (long)(idx - 32) + base.G, u); }
        return false;
    }
    __device__ __forceinline__ void a_ready(const Unit&) const {}
    __device__ __forceinline__ void done(const Unit&) const {}
};
struct CmpOrder {
    int c;
    __device__ bool next(int i, Unit& u) const { if (i != 0 || c < 0 || c >= 32) return false; u.pm = c; u.pn = c >> 4; return true; }
    __device__ __forceinline__ void a_ready(const Unit&) const {}
    __device__ __forceinline__ void done(const Unit&) const {}
};
struct EpiF32 {
    static constexpr bool PERM = false, AFTER_DRAIN = false;
    float* C; int ldc;
    __device__ __forceinline__ void operator()(const f32x4 (&acc)[2][2][4][2], const Unit& u, int wr, int wc, int fr, int fq) const {
        const int row0 = u.pm * BM + wr * 64 + fr, col0 = u.pn * BM + wc * 32 + 4 * fq;
#pragma unroll
        for (int ai = 0; ai < 2; ++ai)
#pragma unroll
            for (int m = 0; m < 4; ++m) { float* rowp = C + (size_t)(row0 + ai * HALF + m * 16) * ldc + col0;
#pragma unroll
                for (int bj = 0; bj < 2; ++bj)
#pragma unroll
                    for (int n = 0; n < 2; ++n) *(f32x4*)(rowp + bj * HALF + n * 16) = acc[ai][bj][m][n]; }
    }
};
template <int MODE, bool COLWRAP = false> struct EpiB {
    static constexpr bool PERM = true, AFTER_DRAIN = false;
    bf16_t* O; int ldc; const float* bias; const bf16_t* G; int ldg; const bf16_t* ADD; int ldadd;
    __device__ __forceinline__ void operator()(const f32x4 (&acc)[2][2][4][2], const Unit& u, int wr, int wc, int fr, int fq) const {
        const int row0 = u.pm * BM + wr * 64 + fr, col0 = u.pn * BM + wc * 32 + 8 * fq;
#pragma unroll
        for (int ai = 0; ai < 2; ++ai)
#pragma unroll
            for (int m = 0; m < 4; ++m) { const int row = row0 + ai * HALF + m * 16;
#pragma unroll
                for (int bj = 0; bj < 2; ++bj) { const int col = col0 + bj * HALF;
                    float v[8];
#pragma unroll
                    for (int e = 0; e < 4; ++e) { v[e] = acc[ai][bj][m][0][e]; v[4 + e] = acc[ai][bj][m][1][e]; }
                    if (MODE == 1) {
#pragma unroll
                        for (int e = 0; e < 8; ++e) { const float t = fmaxf(v[e], 0.f); v[e] = t * t; }
                    }
                    if (MODE == 2) { const f32x4 b0 = *(const f32x4*)(bias + col), b1 = *(const f32x4*)(bias + col + 4);
#pragma unroll
                        for (int e = 0; e < 8; ++e) { const float x = v[e] + (e < 4 ? b0[e] : b1[e - 4]); v[e] = x * sigmoidf_(1.5957691216057308f * (x + 0.044715f * x * x * x)); }
                    }
                    if (MODE == 3 || MODE == 4) { const u32x4 gw = *(const u32x4*)(G + (size_t)row * ldg + col);
#pragma unroll
                        for (int e = 0; e < 4; ++e) { v[2 * e] *= sigmoidf_(bflo(gw[e])); v[2 * e + 1] *= sigmoidf_(bfhi(gw[e])); }
                    }
                    if (MODE == 4) { const u32x4 aw = *(const u32x4*)(ADD + (size_t)row * ldadd + col);
#pragma unroll
                        for (int e = 0; e < 4; ++e) { v[2 * e] += bflo(aw[e]); v[2 * e + 1] += bfhi(aw[e]); }
                    }
                    u32x4 w; w.x = cvt_pk_bf16(v[0], v[1]); w.y = cvt_pk_bf16(v[2], v[3]); w.z = cvt_pk_bf16(v[4], v[5]); w.w = cvt_pk_bf16(v[6], v[7]);
                    *(u32x4*)(O + (size_t)row * ldc + (COLWRAP ? (col & 255) : col)) = w; } }
    }
};

template <class Epi, class Sched, bool ALIGN_EPI = false, bool SP2 = false>
__device__ __forceinline__ void gemm_phase(LAS unsigned char* lds, const Gemm g, const Sched& S, const Epi& E, const int tid) {
    const int wid = __builtin_amdgcn_readfirstlane(tid >> 6), lane = tid & 63, wr = wid >> 2, wc = wid & 3, fr = lane & 15, fq = lane >> 4;
    const int K = g.K, nt = K / BK;
    unsigned voffA[2], voffB[2];
#pragma unroll
    for (int i = 0; i < 2; ++i) { int R, C; stage_rc(tid * 16 + i * 8192, R, C); const int Rb = Epi::PERM ? ((R & ~31) + perm32(R & 31)) : R;
        voffA[i] = (unsigned)(R * g.lda + C) * 2u; voffB[i] = (unsigned)(Rb * K + C) * 2u; }
    const size_t kstep = (size_t)(BK * 2);
    const size_t hstepA = (size_t)HALF * g.lda * 2, hstepB = (size_t)HALF * K * 2;
    const size_t tstepA = 2 * hstepA, tstepB = 2 * hstepB;
    const unsigned ldsw = (unsigned)wid * 1024u;
    const int aoff = lds_byte(wr * 64 + fr, fq * 8), boff = lds_byte(wc * 32 + fr, fq * 8);
#define PG8_SA(b, h) (((b) * 2 + (h)) * HTB)
#define PG8_SB(b, h) ((4 + (b) * 2 + (h)) * HTB)
#define PG8_STAGE(bufoff, gbase, voff) do { _Pragma("unroll") for (int _i = 0; _i < 2; ++_i) \
        __builtin_amdgcn_global_load_lds((const unsigned*)((const char*)(gbase) + (voff)[_i]), (LAS unsigned*)(lds + (bufoff) + ldsw + _i * 8192), 16, 0, 0); } while (0)
#define PG8_LDA(dst, b, h) do { _Pragma("unroll") for (int m = 0; m < 4; ++m) _Pragma("unroll") for (int k = 0; k < 2; ++k) dst[m][k] = *(const LAS bf16x8*)(lds + PG8_SA(b, h) + aoff + m * 2048 + k * 1024); } while (0)
#define PG8_LDB(dst, b, h) do { _Pragma("unroll") for (int n = 0; n < 2; ++n) _Pragma("unroll") for (int k = 0; k < 2; ++k) dst[n][k] = *(const LAS bf16x8*)(lds + PG8_SB(b, h) + boff + n * 2048 + k * 1024); } while (0)
#define PG8_MMA(ai, bj, At, Bt) do { __builtin_amdgcn_s_setprio(1); _Pragma("unroll") for (int m = 0; m < 4; ++m) _Pragma("unroll") for (int n = 0; n < 2; ++n) _Pragma("unroll") for (int k = 0; k < 2; ++k) \
        acc[ai][bj][m][n] = __builtin_amdgcn_mfma_f32_16x16x32_bf16(Bt[n][k], At[m][k], acc[ai][bj][m][n], 0, 0, 0); __builtin_amdgcn_s_setprio(0); } while (0)
#define PG8_WAIT_V(n) asm volatile("s_waitcnt vmcnt(" #n ")" ::: "memory")
#define PG8_WAIT_L(n) asm volatile("s_waitcnt lgkmcnt(" #n ")" ::: "memory")
#define PG8_BAR __builtin_amdgcn_s_barrier()
#define PG8_SCHED __builtin_amdgcn_sched_barrier(0)
    Unit cur, nxt; int ui = 0;
    if (!S.next(0, cur)) return;
    f32x4 acc[2][2][4][2];
#pragma unroll
    for (int a = 0; a < 2; ++a)
#pragma unroll
        for (int b = 0; b < 2; ++b)
#pragma unroll
            for (int m = 0; m < 4; ++m)
#pragma unroll
                for (int n = 0; n < 2; ++n) acc[a][b][m][n] = (f32x4){0.f, 0.f, 0.f, 0.f};
    bf16x8 At[4][2], B0[2][2], B1[2][2];
    const char* cA = (const char*)g.A + (size_t)cur.pm * tstepA; const char* cB = (const char*)g.Bt + (size_t)cur.pn * tstepB;
    S.a_ready(cur);
    if constexpr (SP2) {
        PG8_STAGE(PG8_SB(0, 0), cB, voffB); PG8_STAGE(PG8_SB(0, 1), cB + hstepB, voffB); PG8_STAGE(PG8_SA(0, 0), cA, voffA); PG8_STAGE(PG8_SA(0, 1), cA + hstepA, voffA);
        if (wr == 1) PG8_BAR;
        PG8_WAIT_V(2); PG8_BAR;
        PG8_STAGE(PG8_SB(1, 0), cB + kstep, voffB); PG8_STAGE(PG8_SA(1, 0), cA + kstep, voffA); PG8_STAGE(PG8_SB(1, 1), cB + hstepB + kstep, voffB);
        PG8_WAIT_V(6); PG8_BAR;
    } else {
        PG8_STAGE(PG8_SB(0, 0), cB, voffB); PG8_STAGE(PG8_SA(0, 0), cA, voffA); PG8_STAGE(PG8_SB(0, 1), cB + hstepB, voffB); PG8_STAGE(PG8_SA(0, 1), cA + hstepA, voffA);
        if (wr == 1) PG8_BAR;
        PG8_WAIT_V(4); PG8_BAR;
        PG8_STAGE(PG8_SB(1, 0), cB + kstep, voffB); PG8_STAGE(PG8_SA(1, 0), cA + kstep, voffA); PG8_STAGE(PG8_SB(1, 1), cB + hstepB + kstep, voffB);
        PG8_WAIT_V(6); PG8_BAR;
    }
    for (;;) {
        const bool has_next = S.next(ui + 1, nxt);
        const char* nA = has_next ? (const char*)g.A + (size_t)nxt.pm * tstepA : cA; const char* nB = has_next ? (const char*)g.Bt + (size_t)nxt.pn * tstepB : cB;
        for (int t = 0; t < nt; t += 2) {
            const bool last = (t == nt - 2);
            const char* a1 = cA + (size_t)(t + 1) * kstep;
            const char* a2 = last ? nA : cA + (size_t)(t + 2) * kstep; const char* b2 = last ? nB : cB + (size_t)(t + 2) * kstep;
            const char* a3 = a2 + kstep; const char* b3 = b2 + kstep;
            if (last && has_next) S.a_ready(nxt);
            if constexpr (SP2) {
            PG8_LDB(B0, 0, 0); PG8_LDB(B1, 0, 1); PG8_SCHED; PG8_LDA(At, 0, 0); PG8_STAGE(PG8_SA(1, 1), a1 + hstepA, voffA);
            PG8_WAIT_V(8); PG8_WAIT_L(0); PG8_BAR; PG8_MMA(0, 0, At, B0); PG8_MMA(0, 1, At, B1); PG8_BAR; PG8_SCHED;
            PG8_LDA(At, 0, 1); PG8_STAGE(PG8_SB(0, 0), b2, voffB); PG8_STAGE(PG8_SB(0, 1), b2 + hstepB, voffB); PG8_STAGE(PG8_SA(0, 0), a2, voffA);
            PG8_WAIT_V(8); PG8_WAIT_L(0); PG8_BAR; PG8_MMA(1, 0, At, B0); PG8_MMA(1, 1, At, B1); PG8_BAR; PG8_SCHED;
            PG8_LDB(B0, 1, 0); PG8_LDB(B1, 1, 1); PG8_SCHED; PG8_LDA(At, 1, 0); PG8_STAGE(PG8_SA(0, 1), a2 + hstepA, voffA);
            PG8_WAIT_V(8); PG8_WAIT_L(0); PG8_BAR; PG8_MMA(0, 0, At, B0); PG8_MMA(0, 1, At, B1); PG8_BAR; PG8_SCHED;
            PG8_LDA(At, 1, 1); PG8_STAGE(PG8_SB(1, 0), b3, voffB); PG8_STAGE(PG8_SB(1, 1), b3 + hstepB, voffB); PG8_STAGE(PG8_SA(1, 0), a3, voffA);
            PG8_WAIT_V(8); PG8_WAIT_L(0); PG8_BAR; PG8_MMA(1, 0, At, B0); PG8_MMA(1, 1, At, B1); PG8_BAR; PG8_SCHED;
            } else {
            PG8_LDB(B0, 0, 0); PG8_SCHED; PG8_LDA(At, 0, 0); PG8_STAGE(PG8_SA(1, 1), a1 + hstepA, voffA);
            PG8_WAIT_L(8); PG8_BAR; PG8_WAIT_L(0); PG8_MMA(0, 0, At, B0); PG8_BAR; PG8_SCHED;
            PG8_LDB(B1, 0, 1); PG8_STAGE(PG8_SB(0, 0), b2, voffB);
            PG8_BAR; PG8_WAIT_L(0); PG8_MMA(0, 1, At, B1); PG8_BAR;
            PG8_LDA(At, 0, 1); PG8_STAGE(PG8_SA(0, 0), a2, voffA);
            PG8_BAR; PG8_WAIT_L(0); PG8_MMA(1, 0, At, B0); PG8_BAR; PG8_SCHED;
            PG8_STAGE(PG8_SB(0, 1), b2 + hstepB, voffB);
            PG8_WAIT_V(6); PG8_BAR; PG8_MMA(1, 1, At, B1); PG8_BAR;
            PG8_LDB(B0, 1, 0); PG8_SCHED; PG8_LDA(At, 1, 0); PG8_STAGE(PG8_SA(0, 1), a2 + hstepA, voffA);
            PG8_WAIT_L(8); PG8_BAR; PG8_WAIT_L(0); PG8_MMA(0, 0, At, B0); PG8_BAR; PG8_SCHED;
            PG8_LDB(B1, 1, 1); PG8_STAGE(PG8_SB(1, 0), b3, voffB);
            PG8_BAR; PG8_WAIT_L(0); PG8_MMA(0, 1, At, B1); PG8_BAR;
            PG8_LDA(At, 1, 1); PG8_STAGE(PG8_SA(1, 0), a3, voffA);
            PG8_BAR; PG8_WAIT_L(0); PG8_MMA(1, 0, At, B0); PG8_BAR; PG8_SCHED;
            PG8_STAGE(PG8_SB(1, 1), b3 + hstepB, voffB);
            PG8_WAIT_V(6); PG8_BAR; PG8_MMA(1, 1, At, B1); PG8_BAR;
            }
        }
        if constexpr (ALIGN_EPI) { if (wr == 0) PG8_BAR; }
        E(acc, cur, wr, wc, fr, fq); S.done(cur);
        if (!has_next) break;
#pragma unroll
        for (int a = 0; a < 2; ++a)
#pragma unroll
            for (int b = 0; b < 2; ++b)
#pragma unroll
                for (int m = 0; m < 4; ++m)
#pragma unroll
                    for (int n = 0; n < 2; ++n) acc[a][b][m][n] = (f32x4){0.f, 0.f, 0.f, 0.f};
        cur = nxt; cA = nA; cB = nB; ++ui;
        if constexpr (ALIGN_EPI) { if (wr == 1) PG8_BAR; }
    }
    PG8_WAIT_V(0);
    if constexpr (!ALIGN_EPI) { if (wr == 0) PG8_BAR; }
    PG8_BAR;
#undef PG8_SA
#undef PG8_SB
#undef PG8_STAGE
#undef PG8_LDA
#undef PG8_LDB
#undef PG8_MMA
#undef PG8_WAIT_V
#undef PG8_WAIT_L
#undef PG8_BAR
#undef PG8_SCHED
}
}

constexpr size_t al4k(size_t x) { return (x + 4095) & ~(size_t)4095; }
constexpr size_t WS_CTL = 0, CTL_ZERO_BYTES = 1u << 20;
constexpr size_t WS_MODP = CTL_ZERO_BYTES;
constexpr size_t WS_B1PART = al4k(WS_MODP + (size_t)DEPTH * 8 * 6 * DM * 4);
constexpr size_t WS_B1P = al4k(WS_B1PART + (size_t)DEPTH * 2 * 32 * 256 * 4);
constexpr size_t WS_COS = al4k(WS_B1P + 2 * 256 * 4);
constexpr size_t WS_SIN = al4k(WS_COS + (size_t)S * 16 * 4);
constexpr size_t WS_GT = al4k(WS_SIN + (size_t)S * 16 * 4);
constexpr size_t WS_W2T = al4k(WS_GT + (size_t)S * 48 * 4);
constexpr size_t WS_KCI = al4k(WS_W2T + (size_t)DEPTH * 2 * 128 * 256 * 2);
constexpr size_t WS_VCI = al4k(WS_KCI + (size_t)NG * 16 * 16384);
constexpr size_t WS_HC = al4k(WS_VCI + (size_t)NG * 16 * 16384);
constexpr size_t WS_WL = al4k(WS_HC + (size_t)2 * 4096 * 256 * 2);
constexpr size_t WL_WIN = 0;
constexpr size_t WL_WCONV = WL_WIN + (size_t)PW * DM * 2;
constexpr size_t WL_W1T = WL_WCONV + (size_t)DM * CWID * 2;
constexpr size_t WL_WNSA = WL_W1T + (size_t)2 * 256 * 4096 * 2;
constexpr size_t WL_WOUT = WL_WNSA + (size_t)DM * DM * 2;
constexpr size_t WL_WUP = WL_WOUT + (size_t)DM * DM * 2;
constexpr size_t WL_WDOWN = WL_WUP + (size_t)FF * DM * 2;
constexpr size_t WL_BYTES = al4k(WL_WDOWN + (size_t)DM * FF * 2);
constexpr size_t WS_P = al4k(WS_WL + DEPTH * WL_BYTES);
constexpr size_t WS_U = WS_P;
constexpr size_t WS_Y = WS_P + (size_t)S * FF * 2;
constexpr size_t P_REGION = (size_t)S * PW * 2;
static_assert((size_t)S * FF * 2 + (size_t)S * DM * 4 <= P_REGION, "U + Y fit in P's region");
constexpr size_t WS_H = al4k(WS_P + P_REGION);
constexpr size_t WS_QP = al4k(WS_H + (size_t)S * DM * 2);
constexpr size_t WS_MG = WS_QP;
constexpr size_t WS_KSI = al4k(WS_QP + (size_t)S * DM * 2);
constexpr size_t WS_VSI = WS_KSI + (size_t)NG * 256 * 16384;
constexpr size_t WS_KWI = WS_VSI + (size_t)NG * 256 * 16384;
constexpr size_t WS_VWI = WS_KWI + (size_t)NG * 256 * 16384;
constexpr size_t WS_KCR = WS_VWI + (size_t)NG * 256 * 16384;
constexpr size_t WS_VCR = WS_KCR + (size_t)NG * S * HD * 2;
constexpr size_t WS_CV = al4k(WS_VCR + (size_t)NG * S * HD * 2 + 65536);
constexpr size_t WS_AO = al4k(WS_CV + (size_t)S * CWID * 2);
constexpr size_t WS_YA = al4k(WS_AO + (size_t)S * DM * 2);
constexpr size_t WS_FS = al4k(WS_YA + (size_t)S * DM * 2);
constexpr size_t WS_XB = al4k(WS_FS + (size_t)256 * 8 * 16384);
constexpr size_t WS_END = al4k(WS_XB + (size_t)S * DM * 2);

constexpr int CW_BAR = 4096;

constexpr int RING_BYTES = 131072;
constexpr int AT_KV = 0, AT_IMP = 65536, IMP_STRIDE = 257, AT_SELW = AT_IMP + 64 * IMP_STRIDE * 4;
constexpr int MISC_OFF = AT_SELW + NWAVES * 256 * 4;
constexpr int LDS_BYTES = 147456;
static_assert(MISC_OFF + 512 <= LDS_BYTES && MISC_OFF >= RING_BYTES, "LDS map");

typedef GAS unsigned gu32;
#define RLX_AGENT __ATOMIC_RELAXED, __HIP_MEMORY_SCOPE_AGENT
#define LDS_WAIT() asm volatile("s_waitcnt lgkmcnt(0)" ::: "memory")
#define VM_WAIT() asm volatile("s_waitcnt vmcnt(0)" ::: "memory")

#define XB_TMO      128
#define XB_XCNT(j)  (256  + 64 * (j))
#define XB_XSUB(j)  (1280 + 64 * (j))
#define XB_XGEN(j)  (2304 + 64 * (j))
#define XB_TOP      3328
#define XB_TOPGEN   3392
#define XCD_BAR_WORDS 3456
#define XB_SPIN_CAP (1u << 22)

__device__ __forceinline__ unsigned xb_ld(unsigned* p)              { return __hip_atomic_load(p, __ATOMIC_RELAXED, __HIP_MEMORY_SCOPE_AGENT); }
__device__ __forceinline__ unsigned xb_add(unsigned* p, unsigned v) { return __hip_atomic_fetch_add(p, v, __ATOMIC_RELAXED, __HIP_MEMORY_SCOPE_AGENT); }
__device__ __forceinline__ unsigned xb_xcc_id() { return (unsigned)__builtin_amdgcn_s_getreg((3 << 11) | 20) & 0xFu; }
#define XB_SPIN(cond, bar) do { unsigned _sp = 0; while (cond) { __builtin_amdgcn_s_sleep(1); \
    if ((++_sp & 255u) == 0u) { if (xb_ld(&(bar)[XB_TMO])) break; if (_sp > XB_SPIN_CAP) { atomicAdd(&(bar)[XB_TMO], 1u); break; } } } } while (0)

struct XcdBarrier { unsigned* bar; unsigned x; volatile LAS unsigned* st; };

__device__ __forceinline__ XcdBarrier xcd_barrier_post(unsigned* bar, volatile LAS unsigned* st) {
    XcdBarrier b; b.bar = bar; b.x = xb_xcc_id(); b.st = st;
    if (threadIdx.x == 0) (void)xb_add(&bar[XB_XCNT(b.x)], 1u);
    return b;
}
__device__ __forceinline__ void xcd_barrier_complete(unsigned* bar, unsigned x, unsigned& nloc, unsigned& nx) {
    const unsigned G = gridDim.x * gridDim.y * gridDim.z;
    unsigned sum, cnt, mine, sp = 0u;
    for (;;) {
        sum = 0u; cnt = 0u; mine = 0u;
#pragma unroll
        for (unsigned j = 0; j < 16; ++j) { const unsigned c = xb_ld(&bar[XB_XCNT(j)]); sum += c; cnt += (c > 0u) ? 1u : 0u; mine = (j == x) ? c : mine; }
        if (sum == G) break;
        __builtin_amdgcn_s_sleep(1);
        if ((++sp & 255u) == 0u) { if (xb_ld(&bar[XB_TMO])) break; if (sp > XB_SPIN_CAP) { atomicAdd(&bar[XB_TMO], 1u); break; } }
    }
    nloc = mine > 0u ? mine : 1u; nx = cnt > 0u ? cnt : 1u;
}
__device__ __forceinline__ void xcd_barrier(const XcdBarrier& b) {
    asm volatile("s_waitcnt vmcnt(0)" ::: "memory");
    __syncthreads();
    if (threadIdx.x == 0) {
        unsigned* bar = b.bar;
        __builtin_amdgcn_s_waitcnt(0);
        unsigned nloc = b.st[0], nx = b.st[1];
        if (nloc == 0u) { xcd_barrier_complete(bar, b.x, nloc, nx); b.st[0] = nloc; b.st[1] = nx; }
        const unsigned old = xb_add(&bar[XB_XSUB(b.x)], 1u);
        const unsigned gen = old / nloc;
        if (old + 1u == (gen + 1u) * nloc) {
            __builtin_amdgcn_fence(__ATOMIC_RELEASE, "agent");
            asm volatile("s_waitcnt vmcnt(0)" ::: "memory");
            const unsigned og = xb_add(&bar[XB_TOP], 1u);
            const unsigned tg = og / nx;
            if (og + 1u == (tg + 1u) * nx) xb_add(&bar[XB_TOPGEN], 1u);
            else XB_SPIN(xb_ld(&bar[XB_TOPGEN]) == tg, bar);
            __builtin_amdgcn_fence(__ATOMIC_ACQUIRE, "agent");
            xb_add(&bar[XB_XGEN(b.x)], 1u);
            asm volatile("s_waitcnt vmcnt(0)" ::: "memory");
        } else {
            XB_SPIN(xb_ld(&bar[XB_XGEN(b.x)]) == gen, bar);
            __builtin_amdgcn_fence(__ATOMIC_ACQUIRE, "agent");
            asm volatile("s_waitcnt vmcnt(0)" ::: "memory");
        }
    }
    __syncthreads();
}

__device__ __forceinline__ unsigned f2bf(float f) { unsigned u = __builtin_bit_cast(unsigned, f); return (u + 0x7fffu + ((u >> 16) & 1u)) >> 16; }
__device__ __forceinline__ unsigned pk2(float lo, float hi) { return f2bf(lo) | (f2bf(hi) << 16); }
__device__ __forceinline__ float bf_lo(unsigned w) { return __uint_as_float(w << 16); }
__device__ __forceinline__ float bf_hi(unsigned w) { return __uint_as_float(w & 0xffff0000u); }
__device__ __forceinline__ float wave_sum(float v) {
#pragma unroll
    for (int o = 1; o < 64; o <<= 1) v += __shfl_xor(v, o);
    return v;
}
__device__ __forceinline__ float sigm(float x) { return __builtin_amdgcn_rcpf(1.0f + __builtin_amdgcn_exp2f(-1.4426950408889634f * x)); }
__device__ __forceinline__ void unpack8(const u32x4 w, float (&v)[8]) {
    v[0] = bf_lo(w.x); v[1] = bf_hi(w.x); v[2] = bf_lo(w.y); v[3] = bf_hi(w.y); v[4] = bf_lo(w.z); v[5] = bf_hi(w.z); v[6] = bf_lo(w.w); v[7] = bf_hi(w.w);
}
__device__ __forceinline__ u32x4 pack8(const float (&v)[8]) { u32x4 w; w.x = pk2(v[0], v[1]); w.y = pk2(v[2], v[3]); w.z = pk2(v[4], v[5]); w.w = pk2(v[6], v[7]); return w; }

__device__ __forceinline__ int k_rho(int kappa) { const int a = kappa >> 5, q = (kappa >> 3) & 3, h = (kappa >> 2) & 1, i = kappa & 3; return 16 * (2 * a + h) + 4 * q + i; }
__device__ __forceinline__ int kimg_off(int kappa, int ch  ) { const int rho = k_rho(kappa); return rho * 256 + ((ch ^ (rho & 15)) << 4); }
__device__ __forceinline__ int vimg_off(int d, int kc  ) { return d * 128 + ((kc ^ ((d >> 1) & 7)) << 4); }

struct Ptrs {
    const float *x, *c, *ada_w, *ada_b, *gains, *w_in, *conv_w, *w_conv_out, *cmp_pe, *cmp_w1, *cmp_b1, *cmp_w2, *cmp_b2, *w_nsa, *w_out, *w_up, *w_down;
    const int* pos;
    float* out; unsigned char* ws;
};
struct Args { const void* in[18]; float* out; unsigned char* ws; int ph_lo, ph_hi; };
static_assert(sizeof(Args) == 18 * 8 + 8 + 8 + 8, "Args has no padding");

__device__ __forceinline__ void transpose_item(const float* W, int ldw, int csrc0, int nvalid, int K, bf16* WT, int drow0, int k0, LAS float* scr, int lane) {
    const int col = lane & 31;
#pragma unroll 8
    for (int i = 0; i < 32; ++i) { const int kk = 2 * i + (lane >> 5); scr[kk * 33 + col] = (col < nvalid) ? W[(size_t)(k0 + kk) * ldw + csrc0 + col] : 0.f; }
    LDS_WAIT(); asm volatile("" ::: "memory");
    const int c = lane & 7;
#pragma unroll
    for (int j = 0; j < 4; ++j) { const int n = (lane >> 3) + 8 * j; const LAS float* s = scr + (8 * c) * 33 + n;
        u32x4 o; o.x = pk2(s[0 * 33], s[1 * 33]); o.y = pk2(s[2 * 33], s[3 * 33]); o.z = pk2(s[4 * 33], s[5 * 33]); o.w = pk2(s[6 * 33], s[7 * 33]);
        *(GAS u32x4*)(WT + (size_t)(drow0 + n) * K + k0 + 8 * c) = o; }
    LDS_WAIT(); asm volatile("" ::: "memory");
}
__device__ __forceinline__ void seg_item(const float* W, int ldw, int c0, int ncols, int K, bf16* WT, int r0, int item, LAS float* scr, int lane) {
    const int nblk = (ncols + 31) / 32, kb = item / nblk, nb = item % nblk;
    const int nv = ncols - 32 * nb;
    transpose_item(W, ldw, c0 + 32 * nb, nv < 32 ? nv : 32, K, WT, r0 + 32 * nb, 64 * kb, scr, lane);
}

__constant__ double ROPE_INVF[16] = {1.0, 0.44036660267178046, 0.19392274474868576, 0.08539710028576561, 0.03760603093086393, 0.016560440080994446, 0.007292664737217109,
    0.003211445994752591, 0.001414213562373095, 0.000622772421914596, 0.0002742481756762073, 0.00012076973741146504, 5.318295896944988e-05, 2.341999896140934e-05,
    1.031338537721246e-05, 4.5416704806078695e-06};

__device__ __forceinline__ void sincos_f64(double x, float& sn, float& cs) {
    const double k = __builtin_rint(x * 0.6366197723675814);
    double r = __builtin_fma(-k, 1.5707963267948966, x); r = __builtin_fma(-k, 6.123233995736766e-17, r);
    const double r2 = r * r;
    double ps = -1.0 / 1307674368000.0; ps = ps * r2 + 1.0 / 6227020800.0; ps = ps * r2 - 1.0 / 39916800.0; ps = ps * r2 + 1.0 / 362880.0; ps = ps * r2 - 1.0 / 5040.0; ps = ps * r2 + 1.0 / 120.0; ps = ps * r2 - 1.0 / 6.0; ps = ps * r2 + 1.0;
    const double s = ps * r;
    double pc = 1.0 / 20922789888000.0; pc = pc * r2 - 1.0 / 87178291200.0; pc = pc * r2 + 1.0 / 479001600.0; pc = pc * r2 - 1.0 / 3628800.0; pc = pc * r2 + 1.0 / 40320.0; pc = pc * r2 - 1.0 / 720.0; pc = pc * r2 + 1.0 / 24.0; pc = pc * r2 - 0.5; pc = pc * r2 + 1.0;
    const int n = ((int)(long long)k) & 3;
    const double so = (n == 0) ? s : (n == 1) ? pc : (n == 2) ? -s : -pc;
    const double co = (n == 0) ? pc : (n == 1) ? -s : (n == 2) ? -pc : s;
    sn = (float)so; cs = (float)co;
}

constexpr int SEG_ITEMS[11] = {32 * 256, 32 * 64, 32 * 64, 32 * 2, 16 * 64, 64 * 8, 64 * 8, 32 * 64, 32 * 64, 32 * 256, 128 * 64};
constexpr int ITEMS_PER_LAYER = 8192 + 2048 + 2048 + 64 + 1024 + 512 + 512 + 2048 + 2048 + 8192 + 8192;
constexpr int W2T_ITEMS = 4 * 4;

__device__ __forceinline__ void p0_prologue(const Ptrs& P, LAS unsigned char* lds, int vcu, int G, int wave, int lane, int tid) {
    LAS float* scr = (LAS float*)(lds + wave * 16384);
    const int gw = vcu * NWAVES + wave, NGW = G * NWAVES;
    for (int it = gw; it < DEPTH * ITEMS_PER_LAYER; it += NGW) {
        const int l = it / ITEMS_PER_LAYER; int r = it % ITEMS_PER_LAYER;
        unsigned char* wl = P.ws + WS_WL + (size_t)l * WL_BYTES;
        const float* win = P.w_in + (size_t)l * DM * INW;
        if (r < SEG_ITEMS[0]) { seg_item(win, INW, 0, 8192, DM, (bf16*)(wl + WL_WIN), 0, r, scr, lane); continue; } r -= SEG_ITEMS[0];
        if (r < SEG_ITEMS[1]) { seg_item(win, INW, 8240, 2048, DM, (bf16*)(wl + WL_WIN), C_GA, r, scr, lane); continue; } r -= SEG_ITEMS[1];
        if (r < SEG_ITEMS[2]) { seg_item(win, INW, 10288, 2048, DM, (bf16*)(wl + WL_WIN), C_GB, r, scr, lane); continue; } r -= SEG_ITEMS[2];
        if (r < SEG_ITEMS[3]) { seg_item(win, INW, 8192, 48, DM, (bf16*)(wl + WL_WIN), C_GN, r, scr, lane); continue; } r -= SEG_ITEMS[3];
        if (r < SEG_ITEMS[4]) { seg_item(P.w_conv_out + (size_t)l * CWID * DM, DM, 0, DM, CWID, (bf16*)(wl + WL_WCONV), 0, r, scr, lane); continue; } r -= SEG_ITEMS[4];
        if (r < SEG_ITEMS[5]) { seg_item(P.cmp_w1 + (size_t)(l * 2 + 0) * 4096 * 256, 256, 0, 256, 4096, (bf16*)(wl + WL_W1T), 0, r, scr, lane); continue; } r -= SEG_ITEMS[5];
        if (r < SEG_ITEMS[6]) { seg_item(P.cmp_w1 + (size_t)(l * 2 + 1) * 4096 * 256, 256, 0, 256, 4096, (bf16*)(wl + WL_W1T) + (size_t)256 * 4096, 0, r, scr, lane); continue; } r -= SEG_ITEMS[6];
        if (r < SEG_ITEMS[7]) { seg_item(P.w_nsa + (size_t)l * DM * DM, DM, 0, DM, DM, (bf16*)(wl + WL_WNSA), 0, r, scr, lane); continue; } r -= SEG_ITEMS[7];
        if (r < SEG_ITEMS[8]) { seg_item(P.w_out + (size_t)l * DM * DM, DM, 0, DM, DM, (bf16*)(wl + WL_WOUT), 0, r, scr, lane); continue; } r -= SEG_ITEMS[8];
        if (r < SEG_ITEMS[9]) { seg_item(P.w_up + (size_t)l * DM * FF, FF, 0, FF, DM, (bf16*)(wl + WL_WUP), 0, r, scr, lane); continue; } r -= SEG_ITEMS[9];
        seg_item(P.w_down + (size_t)l * FF * DM, DM, 0, DM, FF, (bf16*)(wl + WL_WDOWN), 0, r, scr, lane);
    }
    for (int it = gw; it < DEPTH * 2 * W2T_ITEMS; it += NGW) {
        const int m = it / W2T_ITEMS, r = it % W2T_ITEMS;
        seg_item(P.cmp_w2 + (size_t)m * 256 * 128, 128, 0, 128, 256, (bf16*)(P.ws + WS_W2T) + (size_t)m * 128 * 256, 0, r, scr, lane);
    }
    __syncthreads();
    {
        float* cosT = (float*)(P.ws + WS_COS); float* sinT = (float*)(P.ws + WS_SIN);
        for (int e = vcu * 512 + tid; e < S * 16; e += G * 512) {
            const int t = e >> 4, i = e & 15; float sn, cs; sincos_f64((double)P.pos[t] * ROPE_INVF[i], sn, cs); cosT[e] = cs; sinT[e] = sn;
        }
    }
    {
        LAS float* cact = (LAS float*)lds;
        for (int k = tid; k < DM; k += 512) { const float cv = P.c[k]; cact[k] = cv * sigm(cv); }
        __syncthreads();
        float* modp = (float*)(P.ws + WS_MODP);
        for (int e = vcu * 512 + tid; e < DEPTH * 8 * (6 * DM / 4); e += G * 512) {
            const int l = e / (8 * 3072), rem = e % (8 * 3072), kc = rem / 3072, c4 = rem % 3072;
            const float* w = P.ada_w + ((size_t)l * DM + kc * 256) * (6 * DM) + c4 * 4;
            f32x4 acc = {0.f, 0.f, 0.f, 0.f};
#pragma unroll 8
            for (int k = 0; k < 256; ++k) { const f32x4 wv = *(const f32x4*)(w + (size_t)k * (6 * DM)); acc += wv * cact[kc * 256 + k]; }
            *(f32x4*)(modp + ((size_t)(l * 8 + kc) * (6 * DM)) + c4 * 4) = acc;
        }
        __syncthreads();
    }
    for (int w = vcu; w < DEPTH * 2 * 32; w += G) {
        const int m = w >> 5, ch = w & 31;
        if (tid < 256) {
            const float* pe = P.cmp_pe + (size_t)m * 4096 + ch * 128; const float* w1 = P.cmp_w1 + ((size_t)m * 4096 + ch * 128) * 256 + tid;
            float acc = 0.f;
#pragma unroll 8
            for (int k = 0; k < 128; ++k) acc += pe[k] * w1[(size_t)k * 256];
            ((float*)(P.ws + WS_B1PART))[(size_t)w * 256 + tid] = acc;
        }
    }
}

__device__ __forceinline__ f32x4 modvec4(const Ptrs& P, int l, int off) {
    f32x4 v = *(const f32x4*)(P.ada_b + (size_t)l * 6 * DM + off);
    const float* mp = (const float*)(P.ws + WS_MODP) + (size_t)l * 8 * 6 * DM + off;
#pragma unroll
    for (int kc = 0; kc < 8; ++kc) v += *(const f32x4*)(mp + (size_t)kc * 6 * DM);
    return v;
}

template <bool HAS_Y>
__device__ __forceinline__ void resid_phase(const Ptrs& P, LAS unsigned char* lds, const void* xsrc_, const bool src_bf, void* xdst_, const bool dst_bf, const bf16* Y, bf16* H, const bool make_h,
                                            int lg, int gate_k, int gainA, int lh, int sc_k, int sh_k, int gainB, int vcu, int G, int wave, int lane, int tid) {
    LAS f32x4* vga = (LAS f32x4*)lds; LAS f32x4* vhb = vga + 512; LAS f32x4* vhc = vhb + 512;
    {
        const int c = 4 * tid;
        if (HAS_Y) vga[tid] = modvec4(P, lg, gate_k * DM + c) * *(const f32x4*)(P.gains + (size_t)(lg * 4 + gainA) * DM + c);
        if (make_h) { vhb[tid] = *(const f32x4*)(P.gains + (size_t)(lh * 4 + gainB) * DM + c) * (modvec4(P, lh, sc_k * DM + c) + 1.0f); vhc[tid] = modvec4(P, lh, sh_k * DM + c); }
    }
    __syncthreads();
    const int gw = vcu * NWAVES + wave, NGW = G * NWAVES;
    for (int m = gw; m < S; m += NGW) {
        f32x4 xv[8];
        if (src_bf) { const u32x2* xr = (const u32x2*)((const bf16*)xsrc_ + (size_t)m * DM) + lane;
#pragma unroll
            for (int j = 0; j < 8; ++j) { const u32x2 w = xr[64 * j]; xv[j] = (f32x4){bf_lo(w.x), bf_hi(w.x), bf_lo(w.y), bf_hi(w.y)}; }
        } else { const f32x4* xr = (const f32x4*)((const float*)xsrc_ + (size_t)m * DM) + lane;
#pragma unroll
            for (int j = 0; j < 8; ++j) xv[j] = xr[64 * j]; }
        if (HAS_Y) {
            f32x4 yv[8]; float s = 0.f;
            const u32x2* yr = (const u32x2*)(Y + (size_t)m * DM) + lane;
#pragma unroll
            for (int j = 0; j < 8; ++j) { const u32x2 w = yr[64 * j]; yv[j] = (f32x4){bf_lo(w.x), bf_hi(w.x), bf_lo(w.y), bf_hi(w.y)}; s += (yv[j].x * yv[j].x + yv[j].y * yv[j].y) + (yv[j].z * yv[j].z + yv[j].w * yv[j].w); }
            const float r = 1.0f / sqrtf(wave_sum(s) * (1.0f / DM) + NORM_EPS);
#pragma unroll
            for (int j = 0; j < 8; ++j) xv[j] += vga[lane + 64 * j] * (yv[j] * r);
            if (dst_bf) { u32x2* xo = (u32x2*)((bf16*)xdst_ + (size_t)m * DM) + lane;
#pragma unroll
                for (int j = 0; j < 8; ++j) { u32x2 w; w.x = pk2(xv[j].x, xv[j].y); w.y = pk2(xv[j].z, xv[j].w); xo[64 * j] = w;
                    xv[j] = (f32x4){bf_lo(w.x), bf_hi(w.x), bf_lo(w.y), bf_hi(w.y)}; }
            } else { f32x4* xo = (f32x4*)((float*)xdst_ + (size_t)m * DM) + lane;
#pragma unroll
                for (int j = 0; j < 8; ++j) xo[64 * j] = xv[j]; }
        }
        if (make_h) {
            float s = 0.f;
#pragma unroll
            for (int j = 0; j < 8; ++j) s += (xv[j].x * xv[j].x + xv[j].y * xv[j].y) + (xv[j].z * xv[j].z + xv[j].w * xv[j].w);
            const float r = 1.0f / sqrtf(wave_sum(s) * (1.0f / DM) + NORM_EPS);
            u32x2* ho = (u32x2*)(H + (size_t)m * DM) + lane;
#pragma unroll
            for (int j = 0; j < 8; ++j) { const f32x4 h = (xv[j] * r) * vhb[lane + 64 * j] + vhc[lane + 64 * j]; u32x2 w; w.x = pk2(h.x, h.y); w.y = pk2(h.z, h.w); ho[64 * j] = w; }
        }
    }
    __syncthreads();
}

__device__ __forceinline__ void rope8(float (&v)[8], const float (&p)[8], const float* cs, const float* sn, int ch  ) {
#pragma unroll
    for (int j = 0; j < 8; ++j) { const float c = cs[8 * (ch & 1) + j], s = sn[8 * (ch & 1) + j];
        v[j] = (ch < 2) ? (v[j] * c - p[j] * s) : (v[j] * c + p[j] * s); }
}
__device__ __forceinline__ void relayout_phase(const Ptrs& P, int l, LAS unsigned char* lds, int vcu, int G, int tid) {
    const bf16* Pm = (const bf16*)(P.ws + WS_P);
    const float* cosT = (const float*)(P.ws + WS_COS); const float* sinT = (const float*)(P.ws + WS_SIN);
    if (vcu == 0) {
        const float* part = (const float*)(P.ws + WS_B1PART) + (size_t)l * 2 * 32 * 256;
        const int kv = tid >> 8, col = tid & 255; float a = P.cmp_b1[(size_t)(l * 2 + kv) * 256 + col];
        for (int ch = 0; ch < 32; ++ch) a += part[(size_t)(kv * 32 + ch) * 256 + col];
        ((float*)(P.ws + WS_B1P))[tid] = a;
    }
    for (int b = vcu; b < S / 64; b += G) {
        const int t0 = b * 64;
        {
            const float* cw = P.conv_w + (size_t)l * 3 * CWID; bf16* CV = (bf16*)(P.ws + WS_CV);
            for (int e = tid; e < 64 * 128; e += 512) {
                const int tl = e >> 7, c8 = (e & 127) * 8, t = t0 + tl;
                float z[8] = {0.f, 0.f, 0.f, 0.f, 0.f, 0.f, 0.f, 0.f};
#pragma unroll
                for (int k = 0; k < 3; ++k) { const int tt = t - 2 + k;
                    if (tt >= 0) { float cg[8], xa[8]; unpack8(*(const u32x4*)(Pm + (size_t)tt * PW + C_CG + c8), cg); unpack8(*(const u32x4*)(Pm + (size_t)tt * PW + C_XA + c8), xa);
                        const f32x4 w0 = *(const f32x4*)(cw + k * CWID + c8), w1 = *(const f32x4*)(cw + k * CWID + c8 + 4);
#pragma unroll
                        for (int j = 0; j < 8; ++j) z[j] += (j < 4 ? w0[j] : w1[j - 4]) * (cg[j] * xa[j]); } }
                float bg[8]; unpack8(*(const u32x4*)(Pm + (size_t)t * PW + C_BG + c8), bg);
#pragma unroll
                for (int j = 0; j < 8; ++j) z[j] *= bg[j];
                *(u32x4*)(CV + (size_t)t * CWID + c8) = pack8(z);
            }
        }
        {
            bf16* QP = (bf16*)(P.ws + WS_QP);
            for (int e = tid; e < 64 * 256; e += 512) {
                const int tl = e >> 8, hh = (e >> 4) & 15, ch = e & 15, t = t0 + tl;
                const bf16* src = Pm + (size_t)t * PW + C_Q + hh * HD;
                float v[8]; unpack8(*(const u32x4*)(src + 8 * ch), v);
                if (ch < 4) { float p[8]; unpack8(*(const u32x4*)(src + 8 * (ch ^ 2)), p); rope8(v, p, cosT + (size_t)t * 16, sinT + (size_t)t * 16, ch); }
#pragma unroll
                for (int j = 0; j < 8; ++j) v[j] *= QSCALE;
                *(u32x4*)(QP + (size_t)t * DM + hh * HD + 8 * ch) = pack8(v);
            }
        }
        for (int e = tid; e < 4 * 4 * 64 * 16; e += 512) {
            const int pi = e >> 12, g = (e >> 10) & 3, kap = (e >> 4) & 63, ch = e & 15, t = t0 + kap;
            const int part = (pi == 0) ? 0 : (pi == 1) ? 2 : (pi == 2) ? 4 : 1;
            const bf16* src = Pm + (size_t)t * PW + C_KV + part * 512 + g * HD;
            float v[8]; unpack8(*(const u32x4*)(src + 8 * ch), v);
            if (part != 1 && ch < 4) { float p[8]; unpack8(*(const u32x4*)(src + 8 * (ch ^ 2)), p); rope8(v, p, cosT + (size_t)t * 16, sinT + (size_t)t * 16, ch); }
            const u32x4 w = pack8(v);
            if (part == 0) *(u32x4*)((bf16*)(P.ws + WS_KCR) + ((size_t)g * S + t) * HD + 8 * ch) = w;
            else if (part == 1) *(u32x4*)((bf16*)(P.ws + WS_VCR) + ((size_t)g * S + t) * HD + 8 * ch) = w;
            else { unsigned char* img = P.ws + (part == 2 ? WS_KSI : WS_KWI) + ((size_t)g * 256 + b) * 16384; *(u32x4*)(img + kimg_off(kap, ch)) = w; }
        }
        for (int vp = 0; vp < 2; ++vp) {
            const int part = 3 + 2 * vp;
            LAS unsigned short* tile = (LAS unsigned short*)lds;
            for (int e = tid; e < 4 * 64 * 16; e += 512) {
                const int g = e >> 10, kap = (e >> 4) & 63, ch = e & 15;
                const u32x4 w = *(const u32x4*)(Pm + (size_t)(t0 + kap) * PW + C_KV + part * 512 + g * HD + 8 * ch);
                *(LAS u32x4*)(tile + (g * 64 + kap) * 136 + 8 * ch) = w;
            }
            __syncthreads();
            for (int e = tid; e < 4 * 128 * 8; e += 512) {
                const int g = e >> 10, d = (e >> 3) & 127, kc = e & 7;
                const LAS unsigned short* s = tile + (g * 64 + 8 * kc) * 136 + d;
                u32x4 w; w.x = (unsigned)s[0] | ((unsigned)s[136] << 16); w.y = (unsigned)s[2 * 136] | ((unsigned)s[3 * 136] << 16);
                w.z = (unsigned)s[4 * 136] | ((unsigned)s[5 * 136] << 16); w.w = (unsigned)s[6 * 136] | ((unsigned)s[7 * 136] << 16);
                unsigned char* img = P.ws + (part == 3 ? WS_VSI : WS_VWI) + ((size_t)g * 256 + b) * 16384;
                *(u32x4*)(img + vimg_off(d, kc)) = w;
            }
            __syncthreads();
        }
        {
            float* GT = (float*)(P.ws + WS_GT);
            const bf16* Hb = (const bf16*)(P.ws + WS_H); const bf16* Wg = (const bf16*)(P.ws + WS_WL + (size_t)l * WL_BYTES + WL_WIN) + (size_t)C_GN * DM;
            const int wv = tid >> 6, ln = tid & 63, r16 = ln & 15, q4 = ln >> 4, rt = wv & 3, ct0 = (wv < 4) ? 0 : 2, nct = (wv < 4) ? 2 : 1;
            f32x4 acc[2] = {(f32x4){0.f, 0.f, 0.f, 0.f}, (f32x4){0.f, 0.f, 0.f, 0.f}};
            const bf16* ap = Hb + (size_t)(t0 + rt * 16 + r16) * DM + 8 * q4;
            const bf16* bp0 = Wg + (size_t)(ct0 * 16 + r16) * DM + 8 * q4; const bf16* bp1 = bp0 + (size_t)16 * DM;
#pragma unroll 4
            for (int ks = 0; ks < DM / 32; ++ks) {
                const bf16x8 af = *(const bf16x8*)(ap + 32 * ks);
                acc[0] = __builtin_amdgcn_mfma_f32_16x16x32_bf16(af, *(const bf16x8*)(bp0 + 32 * ks), acc[0], 0, 0, 0);
                if (nct == 2) acc[1] = __builtin_amdgcn_mfma_f32_16x16x32_bf16(af, *(const bf16x8*)(bp1 + 32 * ks), acc[1], 0, 0, 0);
            }
#pragma unroll
            for (int c = 0; c < 2; ++c) if (c < nct) {
#pragma unroll
                for (int i = 0; i < 4; ++i) GT[(size_t)(t0 + rt * 16 + 4 * q4 + i) * 48 + (ct0 + c) * 16 + r16] = sigm(acc[c][i]); }
        }
    }
}

__device__ __forceinline__ void cmp2_phase(const Ptrs& P, int l, int vcu, int G, int wave, int lane) {
    const int r16 = lane & 15, q = lane >> 4;
    for (int e = vcu; e < 128; e += G) {
        const int kv = e >> 6, g = (e >> 4) & 3, blk = e & 15;
        const bf16* HC = (const bf16*)(P.ws + WS_HC) + ((size_t)kv * 4096 + g * 1024 + blk * 64) * 256;
        const bf16* W2T = (const bf16*)(P.ws + WS_W2T) + (size_t)(l * 2 + kv) * 128 * 256;
        const float* b2 = P.cmp_b2 + (size_t)(l * 2 + kv) * 128;
        const int rt = wave & 3, ch = wave >> 2;
        bf16x8 af[8];
#pragma unroll
        for (int ks = 0; ks < 8; ++ks) af[ks] = *(const bf16x8*)(HC + (size_t)(rt * 16 + r16) * 256 + 32 * ks + 8 * q);
        unsigned char* img = P.ws + (kv == 0 ? WS_KCI : WS_VCI) + ((size_t)g * 16 + blk) * 16384;
#pragma unroll
        for (int ct = 0; ct < 4; ++ct) {
            const int n = ch * 64 + ct * 16 + r16;
            f32x4 acc = {0.f, 0.f, 0.f, 0.f};
#pragma unroll
            for (int ks = 0; ks < 8; ++ks) { const bf16x8 bfr = *(const bf16x8*)(W2T + (size_t)n * 256 + 32 * ks + 8 * q);
                acc = __builtin_amdgcn_mfma_f32_16x16x32_bf16(af[ks], bfr, acc, 0, 0, 0); }
            const float bb = b2[n];
            if (kv == 0) {
#pragma unroll
                for (int i = 0; i < 4; ++i) { const int kap = rt * 16 + 4 * q + i; *(bf16*)(img + kimg_off(kap, n >> 3) + (n & 7) * 2) = (bf16)f2bf(acc[i] + bb); }
            } else {
                const int kap0 = rt * 16 + 4 * q; u32x2 w; w.x = pk2(acc[0] + bb, acc[1] + bb); w.y = pk2(acc[2] + bb, acc[3] + bb);
                *(u32x2*)(img + vimg_off(n, kap0 >> 3) + (kap0 & 7) * 2) = w;
            }
        }
    }
}

#ifndef DBG_REP_SEL
#define DBG_REP_SEL 1
#endif
#ifndef DBG_BR
#define DBG_BR 7
#endif
#ifndef DBG_SANITIZE
#define DBG_SANITIZE 0
#endif
#ifndef DBG_DENSE_SEL
#define DBG_DENSE_SEL 0
#endif
struct AttnLane { unsigned kb, vb; int kx, vx; int q; };
#define AL_KOFF(L_, s_) ((L_).kb + 64u * (unsigned)((s_) ^ (L_).kx))
#define AL_VOFF(L_, a_) ((L_).vb + 64u * (unsigned)((a_) ^ (L_).vx))

__device__ __forceinline__ bf16x8 pack_p(const f32x4 a, const f32x4 b) {
    u32x4 w; w.x = pg8::cvt_pk_bf16(a[0], a[1]); w.y = pg8::cvt_pk_bf16(a[2], a[3]); w.z = pg8::cvt_pk_bf16(b[0], b[1]); w.w = pg8::cvt_pk_bf16(b[2], b[3]);
    return __builtin_bit_cast(bf16x8, w);
}
__device__ __forceinline__ void lds_fadd(LAS float* p, float v) { (void)__hip_atomic_fetch_add(p, v, __ATOMIC_RELAXED, __HIP_MEMORY_SCOPE_WORKGROUP); }
template <int CTRL> __device__ __forceinline__ unsigned dpp_u_(unsigned v) { return (unsigned)__builtin_amdgcn_update_dpp(0, (int)v, CTRL, 0xF, 0xF, false); }
__device__ __forceinline__ unsigned wave_umax(unsigned v) {
    v = max(v, dpp_u_<0xB1>(v)); v = max(v, dpp_u_<0x4E>(v)); v = max(v, dpp_u_<0x141>(v)); v = max(v, dpp_u_<0x140>(v));
    auto r16 = __builtin_amdgcn_permlane16_swap(v, v, false, false); v = max(r16[0], r16[1]);
    auto r32 = __builtin_amdgcn_permlane32_swap(v, v, false, false); return max(r32[0], r32[1]);
}
__device__ __forceinline__ unsigned wave_umin(unsigned v) {
    v = min(v, dpp_u_<0xB1>(v)); v = min(v, dpp_u_<0x4E>(v)); v = min(v, dpp_u_<0x141>(v)); v = min(v, dpp_u_<0x140>(v));
    auto r16 = __builtin_amdgcn_permlane16_swap(v, v, false, false); v = min(r16[0], r16[1]);
    auto r32 = __builtin_amdgcn_permlane32_swap(v, v, false, false); return min(r32[0], r32[1]);
}
__device__ __forceinline__ float quad_sum(float v) {
    v += __builtin_bit_cast(float, __builtin_amdgcn_update_dpp(0, __builtin_bit_cast(int, v), 0xB1, 0xF, 0xF, false));
    v += __builtin_bit_cast(float, __builtin_amdgcn_update_dpp(0, __builtin_bit_cast(int, v), 0x4E, 0xF, 0xF, false));
    return v;
}
__device__ __forceinline__ void ldsr128(bf16x8& d, unsigned addr) { asm volatile("ds_read_b128 %0, %1" : "=v"(d) : "v"(addr)); }
__device__ __forceinline__ void ldsr128o(bf16x8& d, unsigned addr, const int off) { asm volatile("ds_read_b128 %0, %1 offset:%2" : "=v"(d) : "v"(addr), "i"(off)); }
#define LDS_WAIT4(n, a, b, c, d) asm volatile("s_waitcnt lgkmcnt(" #n ")" : "+v"(a), "+v"(b), "+v"(c), "+v"(d))
template <bool T0, bool T1, int MODE>
__device__ __forceinline__ void block_step(LAS const unsigned char* Kb, LAS const unsigned char* Vb, const AttnLane& L, const bf16x8 (&qf)[2][4],
                                           f32x4 (&O)[2][8], float (&m)[2], float (&l)[2], const int (&limq)[2], const unsigned W,
                                           const float (&invl)[2], LAS float* const (&improw)[2], const int j0, const bool hzero, const bool MASKB) {
    AttnLane Lq = L; asm volatile("" : "+v"(Lq.kb), "+v"(Lq.vb));
    f32x4 st[2][4];
    const f32x4 z = {0.f, 0.f, 0.f, 0.f};
    {
        __builtin_amdgcn_s_setprio(1);
        const unsigned kbase = (unsigned)(uintptr_t)Kb;
        unsigned ka[4];
#pragma unroll
        for (int s = 0; s < 4; ++s) ka[s] = kbase + AL_KOFF(Lq, s);
        bf16x8 fa[4], fb[4];
#pragma unroll
        for (int s = 0; s < 4; ++s) ldsr128(fa[s], ka[s]);
#pragma unroll
        for (int kt = 0; kt < 4; ++kt) {
            if (kt < 3) {
#pragma unroll
                for (int s = 0; s < 4; ++s) { if ((kt & 1) == 0) ldsr128o(fb[s], ka[s], (kt + 1) * 4096); else ldsr128o(fa[s], ka[s], (kt + 1) * 4096); }
            }
            if ((kt & 1) == 0) { if (kt < 3) LDS_WAIT4(4, fa[0], fa[1], fa[2], fa[3]); else LDS_WAIT4(0, fa[0], fa[1], fa[2], fa[3]); }
            else               { if (kt < 3) LDS_WAIT4(4, fb[0], fb[1], fb[2], fb[3]); else LDS_WAIT4(0, fb[0], fb[1], fb[2], fb[3]); }
#pragma unroll
            for (int s = 0; s < 4; ++s) { const bf16x8 a = ((kt & 1) == 0) ? fa[s] : fb[s];
                if (T0) st[0][kt] = __builtin_amdgcn_mfma_f32_16x16x32_bf16(a, qf[0][s], s == 0 ? z : st[0][kt], 0, 0, 0);
                if (T1) st[1][kt] = __builtin_amdgcn_mfma_f32_16x16x32_bf16(a, qf[1][s], s == 0 ? z : st[1][kt], 0, 0, 0); }
        }
    }
    __builtin_amdgcn_s_setprio(0);
    bf16x8 pf[2][2];
#pragma unroll
    for (int ts = 0; ts < 2; ++ts) {
        if (!(ts == 0 ? T0 : T1)) continue;
        const float NEG = -__builtin_inff();
        if (MASKB) {
#pragma unroll
        for (int kt = 0; kt < 4; ++kt)
#pragma unroll
            for (int i = 0; i < 4; ++i) { const int kc = 32 * (kt >> 1) + 4 * (kt & 1) + i; if ((unsigned)(limq[ts] - kc) >= W) st[ts][kt][i] = NEG; }
        }
        if (MODE != 1) {
            float mx = fmaxf(fmaxf(st[ts][0][0], st[ts][0][1]), fmaxf(st[ts][0][2], st[ts][0][3]));
#pragma unroll
            for (int kt = 1; kt < 4; ++kt) mx = fmaxf(mx, fmaxf(fmaxf(st[ts][kt][0], st[ts][kt][1]), fmaxf(st[ts][kt][2], st[ts][kt][3])));
            { auto r16 = __builtin_amdgcn_permlane16_swap(__float_as_uint(mx), __float_as_uint(mx), false, false); mx = fmaxf(__uint_as_float(r16[0]), __uint_as_float(r16[1]));
              auto r32 = __builtin_amdgcn_permlane32_swap(__float_as_uint(mx), __float_as_uint(mx), false, false); mx = fmaxf(__uint_as_float(r32[0]), __uint_as_float(r32[1])); }
            const float mn = fmaxf(m[ts], mx), alpha = __builtin_amdgcn_exp2f(m[ts] - mn); m[ts] = mn;
            float sum = 0.f;
#pragma unroll
            for (int kt = 0; kt < 4; ++kt)
#pragma unroll
                for (int i = 0; i < 4; ++i) { const float pv = __builtin_amdgcn_exp2f(st[ts][kt][i] - mn); st[ts][kt][i] = pv; sum += pv; }
            l[ts] = l[ts] * alpha + sum;
            if (MODE == 2) {
#pragma unroll
                for (int dt = 0; dt < 8; ++dt) O[ts][dt] *= alpha;
            }
        } else {
#pragma unroll
            for (int kt = 0; kt < 4; ++kt)
#pragma unroll
                for (int i = 0; i < 4; ++i) st[ts][kt][i] = __builtin_amdgcn_exp2f(st[ts][kt][i] - m[ts]) * invl[ts];
            float A[4], B[4];
#pragma unroll
            for (int kt = 0; kt < 4; ++kt) { B[kt] = 0.5f * st[ts][kt][3]; A[kt] = quad_sum((st[ts][kt][0] + st[ts][kt][1]) + (st[ts][kt][2] + B[kt])); B[kt] = quad_sum(B[kt]); }
            if (hzero) { LAS float* ir = improw[ts] + j0;
                lds_fadd(ir + 0, A[0]); lds_fadd(ir + 1, B[0] + A[1]); lds_fadd(ir + 2, B[1]); lds_fadd(ir + 8, A[2]); lds_fadd(ir + 9, B[2] + A[3]); lds_fadd(ir + 10, B[3]); }
        }
        if (MODE != 0) { pf[ts][0] = pack_p(st[ts][0], st[ts][1]); pf[ts][1] = pack_p(st[ts][2], st[ts][3]); }
    }
    if (MODE != 0) {
        __builtin_amdgcn_s_setprio(1);
        const unsigned vbase = (unsigned)(uintptr_t)Vb;
        unsigned va[2];
#pragma unroll
        for (int a = 0; a < 2; ++a) va[a] = vbase + AL_VOFF(Lq, a);
        bf16x8 fa[4], fb[4];
#pragma unroll
        for (int j = 0; j < 4; ++j) ldsr128o(fa[j], va[j & 1], (j >> 1) * 2048);
#pragma unroll
        for (int dp = 0; dp < 4; ++dp) {
            if (dp < 3) {
#pragma unroll
                for (int j = 0; j < 4; ++j) { if ((dp & 1) == 0) ldsr128o(fb[j], va[j & 1], (2 * (dp + 1) + (j >> 1)) * 2048); else ldsr128o(fa[j], va[j & 1], (2 * (dp + 1) + (j >> 1)) * 2048); }
            }
            if ((dp & 1) == 0) { if (dp < 3) LDS_WAIT4(4, fa[0], fa[1], fa[2], fa[3]); else LDS_WAIT4(0, fa[0], fa[1], fa[2], fa[3]); }
            else               { if (dp < 3) LDS_WAIT4(4, fb[0], fb[1], fb[2], fb[3]); else LDS_WAIT4(0, fb[0], fb[1], fb[2], fb[3]); }
#pragma unroll
            for (int j = 0; j < 4; ++j) { const bf16x8 v = ((dp & 1) == 0) ? fa[j] : fb[j]; const int dt = 2 * dp + (j >> 1), a = j & 1;
                if (T0) O[0][dt] = __builtin_amdgcn_mfma_f32_16x16x32_bf16(v, pf[0][a], O[0][dt], 0, 0, 0);
                if (T1) O[1][dt] = __builtin_amdgcn_mfma_f32_16x16x32_bf16(v, pf[1][a], O[1][dt], 0, 0, 0); }
        }
        __builtin_amdgcn_s_setprio(0);
    }
}


constexpr float ATT_THR = 8.0f;
__device__ __forceinline__ float max3f_(float a, float b, float c) { return fmaxf(fmaxf(a, b), c); }
template <bool T0, bool T1>
__device__ __forceinline__ void step_online(LAS const unsigned char* Kb, LAS const unsigned char* Vb, const AttnLane& L, const bf16x8 (&qf)[2][4],
                                            f32x4 (&O)[2][8], float (&mref)[2], float (&l)[2], const int (&limq)[2], const unsigned W, const bool MASK, const bool START) {
    AttnLane Lq = L; asm volatile("" : "+v"(Lq.kb), "+v"(Lq.vb));
    f32x4 st[2][4];
    const float NEG = -__builtin_inff();
#pragma unroll
    for (int ts = 0; ts < 2; ++ts) { const float c0 = START ? 0.f : (limq[ts] > -500 ? -mref[ts] : NEG);
#pragma unroll
        for (int kt = 0; kt < 4; ++kt) st[ts][kt] = (f32x4){c0, c0, c0, c0}; }
    {
        __builtin_amdgcn_s_setprio(1);
        const unsigned kbase = (unsigned)(uintptr_t)Kb;
        unsigned ka[4];
#pragma unroll
        for (int s = 0; s < 4; ++s) ka[s] = kbase + AL_KOFF(Lq, s);
        bf16x8 fa[4], fb[4];
#pragma unroll
        for (int s = 0; s < 4; ++s) ldsr128(fa[s], ka[s]);
#pragma unroll
        for (int kt = 0; kt < 4; ++kt) {
            if (kt < 3) {
#pragma unroll
                for (int s = 0; s < 4; ++s) { if ((kt & 1) == 0) ldsr128o(fb[s], ka[s], (kt + 1) * 4096); else ldsr128o(fa[s], ka[s], (kt + 1) * 4096); }
            }
            if ((kt & 1) == 0) { if (kt < 3) LDS_WAIT4(4, fa[0], fa[1], fa[2], fa[3]); else LDS_WAIT4(0, fa[0], fa[1], fa[2], fa[3]); }
            else               { if (kt < 3) LDS_WAIT4(4, fb[0], fb[1], fb[2], fb[3]); else LDS_WAIT4(0, fb[0], fb[1], fb[2], fb[3]); }
#pragma unroll
            for (int s = 0; s < 4; ++s) { const bf16x8 a = ((kt & 1) == 0) ? fa[s] : fb[s];
                if (T0) st[0][kt] = __builtin_amdgcn_mfma_f32_16x16x32_bf16(a, qf[0][s], st[0][kt], 0, 0, 0);
                if (T1) st[1][kt] = __builtin_amdgcn_mfma_f32_16x16x32_bf16(a, qf[1][s], st[1][kt], 0, 0, 0); }
        }
    }
    __builtin_amdgcn_s_setprio(0);
    __builtin_amdgcn_sched_barrier(0);
    bf16x8 pf[2][2];
#pragma unroll
    for (int ts = 0; ts < 2; ++ts) {
        if (!(ts == 0 ? T0 : T1)) continue;
        if (MASK || START) {
#pragma unroll
            for (int kt = 0; kt < 4; ++kt)
#pragma unroll
                for (int i = 0; i < 4; ++i) { const int kc = 32 * (kt >> 1) + 4 * (kt & 1) + i; if ((unsigned)(limq[ts] - kc) >= W) st[ts][kt][i] = NEG; }
        }
        float mx = max3f_(st[ts][0][0], st[ts][0][1], st[ts][0][2]);
        mx = max3f_(mx, st[ts][0][3], st[ts][1][0]); mx = max3f_(mx, st[ts][1][1], st[ts][1][2]); mx = max3f_(mx, st[ts][1][3], st[ts][2][0]);
        mx = max3f_(mx, st[ts][2][1], st[ts][2][2]); mx = max3f_(mx, st[ts][2][3], st[ts][3][0]); mx = max3f_(mx, st[ts][3][1], st[ts][3][2]); mx = fmaxf(mx, st[ts][3][3]);
#define XLANE_MAX_(v_) do { auto r16 = __builtin_amdgcn_permlane16_swap(__float_as_uint(v_), __float_as_uint(v_), false, false); v_ = fmaxf(__uint_as_float(r16[0]), __uint_as_float(r16[1])); \
          auto r32 = __builtin_amdgcn_permlane32_swap(__float_as_uint(v_), __float_as_uint(v_), false, false); v_ = fmaxf(__uint_as_float(r32[0]), __uint_as_float(r32[1])); } while (0)
        if (START) {
            XLANE_MAX_(mx);
            const float m0 = fmaxf(mx, -1.0e4f); mref[ts] = m0;
#pragma unroll
            for (int kt = 0; kt < 4; ++kt) st[ts][kt] -= m0;
        } else if (__builtin_expect(__any(mx > ATT_THR), 0)) {
            XLANE_MAX_(mx);
            const float dl = fmaxf(mx, 0.f), f = __builtin_amdgcn_exp2f(-dl); mref[ts] += dl; l[ts] *= f;
#pragma unroll
            for (int kt = 0; kt < 4; ++kt) st[ts][kt] -= dl;
#pragma unroll
            for (int dt = 0; dt < 8; ++dt) O[ts][dt] *= f;
        }
        float sum = 0.f;
#pragma unroll
        for (int kt = 0; kt < 4; ++kt)
#pragma unroll
            for (int i = 0; i < 4; ++i) { const float pv = __builtin_amdgcn_exp2f(st[ts][kt][i]); st[ts][kt][i] = pv; sum += pv; }
        l[ts] += sum;
        pf[ts][0] = pack_p(st[ts][0], st[ts][1]); pf[ts][1] = pack_p(st[ts][2], st[ts][3]);
        __builtin_amdgcn_sched_barrier(0);
    }
    {
        __builtin_amdgcn_s_setprio(1);
        const unsigned vbase = (unsigned)(uintptr_t)Vb;
        unsigned va[2];
#pragma unroll
        for (int a = 0; a < 2; ++a) va[a] = vbase + AL_VOFF(Lq, a);
        bf16x8 fa[4], fb[4];
#pragma unroll
        for (int j = 0; j < 4; ++j) ldsr128o(fa[j], va[j & 1], (j >> 1) * 2048);
#pragma unroll
        for (int dp = 0; dp < 4; ++dp) {
            if (dp < 3) {
#pragma unroll
                for (int j = 0; j < 4; ++j) { if ((dp & 1) == 0) ldsr128o(fb[j], va[j & 1], (2 * (dp + 1) + (j >> 1)) * 2048); else ldsr128o(fa[j], va[j & 1], (2 * (dp + 1) + (j >> 1)) * 2048); }
            }
            if ((dp & 1) == 0) { if (dp < 3) LDS_WAIT4(4, fa[0], fa[1], fa[2], fa[3]); else LDS_WAIT4(0, fa[0], fa[1], fa[2], fa[3]); }
            else               { if (dp < 3) LDS_WAIT4(4, fb[0], fb[1], fb[2], fb[3]); else LDS_WAIT4(0, fb[0], fb[1], fb[2], fb[3]); }
#pragma unroll
            for (int j = 0; j < 4; ++j) { const bf16x8 v = ((dp & 1) == 0) ? fa[j] : fb[j]; const int dt = 2 * dp + (j >> 1), a = j & 1;
                if (T0) O[0][dt] = __builtin_amdgcn_mfma_f32_16x16x32_bf16(v, pf[0][a], O[0][dt], 0, 0, 0);
                if (T1) O[1][dt] = __builtin_amdgcn_mfma_f32_16x16x32_bf16(v, pf[1][a], O[1][dt], 0, 0, 0); }
        }
        __builtin_amdgcn_s_setprio(0);
    }
    __builtin_amdgcn_sched_barrier(0);
}
__device__ __forceinline__ void glds16(const void* gsrc, unsigned lds_dst) { unsigned keep;
    asm volatile("s_mov_b32 %0, m0\n\ts_mov_b32 m0, %2\n\ts_nop 0\n\tglobal_load_lds_dwordx4 %1, off\n\ts_mov_b32 m0, %0" : "=&s"(keep) : "v"(gsrc), "s"(lds_dst) : "memory"); }

__device__ __forceinline__ void glds16s(const void* sbase, unsigned voff, unsigned lds_dst) { unsigned keep;
    asm volatile("s_mov_b32 %0, m0\n\ts_mov_b32 m0, %3\n\ts_nop 0\n\tglobal_load_lds_dwordx4 %1, %2\n\ts_mov_b32 m0, %0" : "=&s"(keep) : "v"(voff), "s"(sbase), "s"(lds_dst) : "memory"); }

#define AT_BAR() do { asm volatile("s_waitcnt lgkmcnt(0)" ::: "memory"); __builtin_amdgcn_s_barrier(); asm volatile("" ::: "memory"); } while (0)
#define AT_STAGE(gsrc, ldsoff) do { unsigned _lo = (unsigned)lane * 16u; asm volatile("" : "+v"(_lo)); _Pragma("unroll") for (int _p = 0; _p < 2; ++_p) \
    glds16s((gsrc) + (_p * 8 + wave) * 1024, _lo, (unsigned)__builtin_amdgcn_readfirstlane((int)(ldsb + (unsigned)(ldsoff) + (unsigned)(_p * 8 + wave) * 1024u))); } while (0)
#define AT_WAITV(n) asm volatile("s_waitcnt vmcnt(" #n ")" ::: "memory")

__device__ __forceinline__ void attn_phase(const Ptrs& P, LAS unsigned char* lds, int vcu, int G, int wave, int lane) {
    const unsigned ldsb = (unsigned)(uintptr_t)lds;
    const bf16* QP = (const bf16*)(P.ws + WS_QP);
    const float* GT = (const float*)(P.ws + WS_GT);
    bf16* AO = (bf16*)(P.ws + WS_AO);
    LAS float* impw = (LAS float*)(lds + AT_IMP) + 8 * wave * IMP_STRIDE;
    LAS unsigned* selw = (LAS unsigned*)(lds + AT_SELW) + wave * 256;
#define AT_REGION() int ln_ = lane; asm volatile("" : "+v"(ln_)); const int c16 = ln_ & 15, q = ln_ >> 4, hh = c16 & 3, tq = c16 >> 2; AttnLane L; L.q = q; \
    L.kb = (unsigned)(c16 * 256 + (((q ^ c16) & 3) << 4)); L.kx = (c16 >> 2) & 3; L.vb = (unsigned)(c16 * 128 + (((q ^ (c16 >> 1)) & 3) << 4)); L.vx = (c16 >> 3) & 1; \
    const bool hzero = (hh == 0); const int tok0 = t0 + 8 * wave + tq; (void)hzero; (void)tok0; (void)L
#define tok_(ts_) (tok0 + 4 * (ts_))
#define GATE(ts_, br_) (GT[(size_t)tok_(ts_) * 48 + (4 * g + hh) * 3 + (br_)])
#define FSAT(k_) (*(f32x4*)(FSb + (fo_ + (unsigned)(k_) * 1024u)))
#define FS_OFF() unsigned fo_ = (unsigned)ln_ * 16u

    for (int e = vcu; e < 1024; e += G) {
        const int k4 = e >> 8, v = e & 255, xcd = v >> 5, g = xcd & 3, hi2 = xcd >> 2, j = v & 31;
        const int stepk = hi2 ? ((k4 == 0) ? 6 : (k4 == 1) ? 5 : (k4 == 2) ? 2 : 1) : ((k4 == 0) ? 7 : (k4 == 1) ? 4 : (k4 == 2) ? 3 : 0);
        const int tile = 32 * stepk + ((k4 & 1) ? 31 - j : j);
        const int t0 = tile * 64;
        unsigned char* FSb = P.ws + WS_FS + ((size_t)((vcu & 255) * 8 + wave)) * 16384;
        bf16x8 qf[2][4];
        f32x4 O[2][8];
        float l[2] = {0.f, 0.f};
        int limq[2];
        {
            AT_REGION();
#pragma unroll
            for (int ts = 0; ts < 2; ++ts) {
#pragma unroll
                for (int s = 0; s < 4; ++s) qf[ts][s] = *(const bf16x8*)(QP + (size_t)tok_(ts) * DM + (4 * g + hh) * HD + 32 * s + 8 * q);
            }
            for (int i = ln_; i < 8 * IMP_STRIDE; i += 64) impw[i] = 0.f;
            for (int i = ln_; i < 256; i += 64) selw[i] = 0u;
#pragma unroll
            for (int ts = 0; ts < 2; ++ts)
#pragma unroll
                for (int dt = 0; dt < 8; ++dt) O[ts][dt] = (f32x4){0.f, 0.f, 0.f, 0.f};
            float m[2] = {-1e30f, -1e30f}, invl[2] = {0.f, 0.f};
            LAS float* improw[2]; improw[0] = impw + tq * IMP_STRIDE; improw[1] = impw + (4 + tq) * IMP_STRIDE;
            VM_WAIT(); LDS_WAIT();
            const int nbc = (DBG_BR & 1) ? ((4 * tile + 2) >> 6) + 1 : 0;
            const unsigned char* kci = P.ws + WS_KCI + (size_t)g * 16 * 16384; const unsigned char* vci = P.ws + WS_VCI + (size_t)g * 16 * 16384;
            if (DBG_BR & 1) AT_STAGE(kci, AT_KV);
            for (int b = 0; b < nbc; ++b) {
                const int buf = (b & 1) * 32768;
                if (b + 1 < nbc) { AT_STAGE(kci + (size_t)(b + 1) * 16384, AT_KV + (buf ^ 32768)); AT_WAITV(2); }
                else AT_WAITV(0);
                AT_BAR();
#pragma unroll
                for (int ts = 0; ts < 2; ++ts) limq[ts] = ((tok_(ts) - 31) >> 4) - 64 * b - 8 * q;
                block_step<true, true, 0>(lds + AT_KV + buf, lds + AT_KV + buf + 16384, L, qf, O, m, l, limq, 0x80000000u, invl, improw, 0, hzero, b + 2 >= nbc);
                AT_BAR();
            }
#pragma unroll
            for (int ts = 0; ts < 2; ++ts) { float lt = l[ts]; lt += __shfl_xor(lt, 16); lt += __shfl_xor(lt, 32); invl[ts] = lt > 0.f ? 1.0f / lt : 0.f; }
            if (DBG_BR & 1) { AT_STAGE(kci, AT_KV); AT_STAGE(vci, AT_KV + 16384); }
            for (int b = 0; b < nbc; ++b) {
                const int buf = (b & 1) * 32768;
                if (b + 1 < nbc) { AT_STAGE(kci + (size_t)(b + 1) * 16384, AT_KV + (buf ^ 32768)); AT_STAGE(vci + (size_t)(b + 1) * 16384, AT_KV + (buf ^ 32768) + 16384); AT_WAITV(4); }
                else AT_WAITV(0);
                AT_BAR();
#pragma unroll
                for (int ts = 0; ts < 2; ++ts) limq[ts] = ((tok_(ts) - 31) >> 4) - 64 * b - 8 * q;
                block_step<true, true, 1>(lds + AT_KV + buf, lds + AT_KV + buf + 16384, L, qf, O, m, l, limq, 0x80000000u, invl, improw, 16 * b + 2 * q, hzero, b + 2 >= nbc);
                AT_BAR();
            }
            FS_OFF();
#pragma unroll
            for (int ts = 0; ts < 2; ++ts)
#pragma unroll
                for (int dt = 0; dt < 8; ++dt) FSAT(ts * 8 + dt) = O[ts][dt] * GATE(ts, 0);
        }
        LDS_WAIT();
        {
            const int Ksel = (!(DBG_BR & 2) || DBG_DENSE_SEL >= 2) ? 0 : (tile - 1) < 14 ? (tile - 1) : 14;
            int lane_k = lane; asm volatile("" : "+v"(lane_k));
            unsigned wsel[4] = {0u, 0u, 0u, 0u};
            bool cand[4];
#pragma unroll
            for (int e4 = 0; e4 < 4; ++e4) { const int jj = lane_k + 64 * e4; cand[e4] = (jj >= 1 && jj <= tile - 1); }
            if (Ksel > 0) {
                const bool all_sel = (tile - 1) <= 14;
                for (int tl = 0; tl < 8; ++tl) {
                    const LAS float* row = impw + tl * IMP_STRIDE;
                    unsigned val[4];
#pragma unroll
                    for (int e4 = 0; e4 < 4; ++e4) val[e4] = cand[e4] ? __float_as_uint(row[lane_k + 64 * e4]) : 0u;
                    bool sel[4];
                    if (all_sel) {
#pragma unroll
                        for (int e4 = 0; e4 < 4; ++e4) sel[e4] = cand[e4];
                    } else {
                        unsigned vmx = max(max(val[0], val[1]), max(val[2], val[3]));
                        unsigned vmn = min(min(cand[0] ? val[0] : 0xffffffffu, cand[1] ? val[1] : 0xffffffffu), min(cand[2] ? val[2] : 0xffffffffu, cand[3] ? val[3] : 0xffffffffu));
                        vmx = wave_umax(vmx); vmn = wave_umin(vmn);
                        const unsigned dif = (unsigned)__builtin_amdgcn_readfirstlane((int)(vmx ^ vmn));
                        const int hb = 31 - __builtin_clz(dif | 1u);
                        unsigned cur = (unsigned)__builtin_amdgcn_readfirstlane((int)vmx) & ~((2u << hb) - 1u);
                        for (int bit = (dif == 0u ? -1 : (hb > 30 ? 30 : hb)); bit >= 0; --bit) {
                            asm volatile("" : "+s"(cur), "+s"(bit));
                            const unsigned t = cur | (1u << bit); int cnt = 0;
#pragma unroll
                            for (int e4 = 0; e4 < 4; ++e4) cnt += __popcll(__builtin_amdgcn_uicmp(val[e4], t, 35  ));
                            if (cnt >= Ksel) cur = t;
                            if (cnt == Ksel) break;
                        }
                        int cgt = 0;
#pragma unroll
                        for (int e4 = 0; e4 < 4; ++e4) cgt += __popcll(__ballot(cand[e4] && val[e4] > cur));
                        const int need = Ksel - cgt; int prev = 0;
#pragma unroll
                        for (int e4 = 0; e4 < 4; ++e4) { const bool eq = cand[e4] && val[e4] == cur; const unsigned long long be = __ballot(eq);
                            const int rank = prev + (int)__builtin_amdgcn_mbcnt_hi((unsigned)(be >> 32), __builtin_amdgcn_mbcnt_lo((unsigned)be, 0u));
                            sel[e4] = (cand[e4] && val[e4] > cur) || (eq && rank < need); prev += __popcll(be); }
                    }
#pragma unroll
                    for (int e4 = 0; e4 < 4; ++e4) wsel[e4] |= sel[e4] ? (1u << tl) : 0u;
                }
            }
#pragma unroll
            for (int e4 = 0; e4 < 4; ++e4) { const int jj = lane_k + 64 * e4; if (jj == 0 || jj == tile) wsel[e4] = 0xffu; selw[jj] = wsel[e4]; }
            LDS_WAIT();
#if DBG_DENSE_SEL == 1
            for (int i = lane_k; i <= tile; i += 64) selw[i] = 0xffu;
            LDS_WAIT();
#elif DBG_DENSE_SEL == 4
            for (int i = lane_k; i <= tile; i += 64) selw[i] = (i == 0 || i >= tile - 14) ? 0xffu : 0u;
            LDS_WAIT();
#endif
        }
        float mref[2] = {0.f, 0.f};
#define AT_RING_LOOP(NB, KSRC, VSRC, PRE, ...) do { \
            const int nb_ = (NB); \
            _Pragma("unroll") for (int pb_ = 0; pb_ < 3; ++pb_) { if ((PRE) && pb_ == 2) AT_BAR(); \
                if (pb_ < nb_) { AT_STAGE((KSRC) + (size_t)pb_ * 16384, pb_ * 32768); AT_STAGE((VSRC) + (size_t)pb_ * 16384, pb_ * 32768 + 16384); } } \
            int bufo = 0, bufn = 98304; \
            for (int b = 0; b < nb_; ++b) { \
                const int ahead_ = nb_ - 1 - b; \
                if (ahead_ >= 2) AT_WAITV(8); else if (ahead_ == 1) AT_WAITV(4); else AT_WAITV(0); \
                AT_BAR(); \
                if (b + 3 < nb_) { AT_STAGE((KSRC) + (size_t)(b + 3) * 16384, bufn); AT_STAGE((VSRC) + (size_t)(b + 3) * 16384, bufn + 16384); } \
                LAS const unsigned char* Kb_ = lds + bufo; LAS const unsigned char* Vb_ = lds + bufo + 16384; \
                __VA_ARGS__ \
                bufo = (bufo == 98304) ? 0 : bufo + 32768; bufn = (bufn == 98304) ? 0 : bufn + 32768; \
            } \
            AT_BAR(); } while (0)
#define AT_DRIFT_LOOP(NB, KSRC, VSRC, ...) do { \
            const int nb_ = (NB); \
            volatile LAS unsigned* ldc_ = (volatile LAS unsigned*)(lds + MISC_OFF) + 32; \
            if (wave == 0 && ln_ < 4) ldc_[ln_] = 0u; \
            _Pragma("unroll") for (int pb_ = 0; pb_ < 2; ++pb_) if (pb_ < nb_) { AT_STAGE((KSRC) + (size_t)pb_ * 16384, pb_ * 32768); AT_STAGE((VSRC) + (size_t)pb_ * 16384, pb_ * 32768 + 16384); } \
            AT_BAR();                                                     \
            if (nb_ >= 2) AT_WAITV(4); else AT_WAITV(0); \
            if (ln_ == 0) (void)__hip_atomic_fetch_add((LAS unsigned*)ldc_, 1u, __ATOMIC_RELAXED, __HIP_MEMORY_SCOPE_WORKGROUP); \
            unsigned swn_ = (unsigned)__builtin_amdgcn_readfirstlane((int)selw[0]); \
            _Pragma("clang loop unroll(disable)") for (int b = 0; b < nb_; ++b) { \
                volatile LAS unsigned* lp_ = ldc_ + (b & 3); \
                const unsigned pr0_ = *lp_;                                                             \
                const unsigned swv_ = *(volatile LAS unsigned*)(selw + (b + 1 < 256 ? b + 1 : 255)); \
                if (b + 1 < nb_) { AT_WAITV(0); if (ln_ == 0) (void)__hip_atomic_fetch_add((LAS unsigned*)ldc_ + ((b + 1) & 3), 1u, __ATOMIC_RELAXED, __HIP_MEMORY_SCOPE_WORKGROUP); } \
                { const unsigned need_ = 8u * (unsigned)((b >> 2) + 1); unsigned pr_ = (unsigned)__builtin_amdgcn_readfirstlane((int)pr0_); \
                  while (pr_ < need_) { __builtin_amdgcn_s_sleep(1); pr_ = (unsigned)__builtin_amdgcn_readfirstlane((int)*lp_); } } \
                const unsigned sw = swn_; swn_ = (unsigned)__builtin_amdgcn_readfirstlane((int)swv_); \
                asm volatile("" ::: "memory"); \
                if (b + 2 < nb_) { const int sl_ = ((b + 2) & 3) * 32768; AT_STAGE((KSRC) + (size_t)(b + 2) * 16384, sl_); AT_STAGE((VSRC) + (size_t)(b + 2) * 16384, sl_ + 16384); } \
                LAS const unsigned char* Kb_ = lds + (b & 3) * 32768; LAS const unsigned char* Vb_ = Kb_ + 16384; \
                __VA_ARGS__ \
            } \
            AT_BAR(); } while (0)
        {
            AT_REGION();
            for (int rp_ = 0; rp_ < DBG_REP_SEL; ++rp_) {
#pragma unroll
            for (int ts = 0; ts < 2; ++ts) { l[ts] = 0.f; mref[ts] = 0.f;
#pragma unroll
                for (int dt = 0; dt < 8; ++dt) O[ts][dt] = (f32x4){0.f, 0.f, 0.f, 0.f}; }
            if (DBG_BR & 2) {
                const unsigned char* ksi = P.ws + WS_KSI + (size_t)g * 256 * 16384; const unsigned char* vsi = P.ws + WS_VSI + (size_t)g * 256 * 16384;
                VM_WAIT();
                AT_DRIFT_LOOP(tile + 1, ksi, vsi, {
                    _Pragma("unroll") for (int ts = 0; ts < 2; ++ts) limq[ts] = ((sw >> (4 * ts + tq)) & 1u) ? (tok_(ts) - 64 * b - 8 * q) : -1000;
                    const bool a0 = (sw & 0x0fu) != 0u, a1 = (sw & 0xf0u) != 0u;
                    const bool msk = (b == 0) || (b == tile);
                    if (a0) step_online<true, false>(Kb_, Vb_, L, qf, O, mref, l, limq, 0x80000000u, msk, b == 0);
                    if (a1) step_online<false, true>(Kb_, Vb_, L, qf, O, mref, l, limq, 0x80000000u, msk, b == 0);
                });
            }
            }
            FS_OFF();
#pragma unroll
            for (int ts = 0; ts < 2; ++ts) { float lt = l[ts]; lt += __shfl_xor(lt, 16); lt += __shfl_xor(lt, 32); const float sc = (DBG_BR & 2) ? GATE(ts, 1) / lt : 0.f;
#pragma unroll
                for (int dt = 0; dt < 8; ++dt) { FSAT(ts * 8 + dt) += O[ts][dt] * sc; if ((dt & 3) == 3) asm volatile("" ::: "memory"); } }
            VM_WAIT();
        }
        {
            AT_REGION();
#pragma unroll
            for (int ts = 0; ts < 2; ++ts) { l[ts] = 0.f;
#pragma unroll
                for (int dt = 0; dt < 8; ++dt) O[ts][dt] = (f32x4){0.f, 0.f, 0.f, 0.f}; }
            if (DBG_BR & 4) {
                const int b0 = tile >= 8 ? tile - 8 : 0;
                const unsigned char* kwi = P.ws + WS_KWI + ((size_t)g * 256 + b0) * 16384; const unsigned char* vwi = P.ws + WS_VWI + ((size_t)g * 256 + b0) * 16384;
                AT_RING_LOOP(tile - b0 + 1, kwi, vwi, false, {
                    _Pragma("unroll") for (int ts = 0; ts < 2; ++ts) limq[ts] = tok_(ts) - 64 * (b0 + b) - 8 * q;
                    step_online<true, true>(Kb_, Vb_, L, qf, O, mref, l, limq, 512u, (b == 0) || (b0 + b == tile), b == 0);
                });
            }
            FS_OFF();
#pragma unroll
            for (int ts = 0; ts < 2; ++ts) { float lt = l[ts]; lt += __shfl_xor(lt, 16); lt += __shfl_xor(lt, 32); const float sc = (DBG_BR & 4) ? GATE(ts, 2) / lt : 0.f;
                bf16* orow = AO + (size_t)tok_(ts) * DM + (4 * g + hh) * HD + 4 * q;
#pragma unroll
                for (int dt = 0; dt < 8; ++dt) { const f32x4 o = FSAT(ts * 8 + dt) + O[ts][dt] * sc;
                    u32x2 w; w.x = pk2(o[0], o[1]); w.y = pk2(o[2], o[3]); *(u32x2*)(orow + 16 * dt) = w; if ((dt & 3) == 3) asm volatile("" ::: "memory"); } }
        }
    }
#undef AT_REGION
#undef AT_RING_LOOP
#undef AT_DRIFT_LOOP
}

#ifndef DBG_CHECK
#define DBG_CHECK 0
#endif
#if DBG_CHECK
__device__ __forceinline__ float p_bf(const bf16* Pm, int t, int col) { return __uint_as_float((unsigned)Pm[(size_t)t * PW + col] << 16); }
__device__ __forceinline__ float roped(const bf16* Pm, const float* cosT, const float* sinT, int t, int colbase, int d) {
    const float x = p_bf(Pm, t, colbase + d);
    if (d >= 32) return x;
    const int i = d & 15; const float c = cosT[(size_t)t * 16 + i], sn = sinT[(size_t)t * 16 + i];
    return (d < 16) ? x * c - p_bf(Pm, t, colbase + d + 16) * sn : x * c + p_bf(Pm, t, colbase + d - 16) * sn;
}
__constant__ int TSAMP[28] = {0, 1, 5, 30, 31, 32, 47, 63, 64, 65, 100, 127, 128, 191, 200, 255, 300, 511, 512, 575, 1023, 1024, 1025, 2047, 4096, 8191, 12345, 16383};
__device__ __forceinline__ void attn_check(const Ptrs& P, int l, LAS unsigned char* lds, int vcu, int G, int tid, unsigned* flagword) {
    const int NS = 28;
    const bf16* Pm = (const bf16*)(P.ws + WS_P); const bf16* AO = (const bf16*)(P.ws + WS_AO);
    const float* cosT = (const float*)(P.ws + WS_COS); const float* sinT = (const float*)(P.ws + WS_SIN);
    LAS float* q = (LAS float*)lds;
    LAS float* blk = q + 512;
    LAS float* hh_ = blk + 4096;
    LAS float* kc = hh_ + 256;
    LAS float* vc = kc + 2048;
    LAS float* sc = vc + 2048;
    LAS float* fin = sc + 4096;
    LAS float* imp = fin + 512;
    LAS int* selb = (LAS int*)(imp + 256);
    LAS unsigned* red = (LAS unsigned*)(selb + 16);
    for (int item = vcu; item < NS * 4; item += G) {
        const int s = item >> 2, g = item & 3, t = TSAMP[s];
        const int cur = t >> 6;
        { const int r = tid >> 7, d = tid & 127; q[tid] = __uint_as_float((unsigned)((const bf16*)(P.ws + WS_QP))[(size_t)t * DM + (4 * g + r) * HD + d] << 16) * 0.6931471805599453f; fin[tid] = 0.f; }
        if (tid < 2) red[tid] = 0u;
        if (tid < 256) imp[tid] = 0.f;
        __syncthreads();
        const int nmax = (t - 31) >> 4;
        const bool small = t < 256;
        const unsigned char* kci = P.ws + WS_KCI + (size_t)g * 16 * 16384; const unsigned char* vci = P.ws + WS_VCI + (size_t)g * 16 * 16384;
        if (small) {
        for (int kv = 0; kv < 2; ++kv)
            for (int n = 0; n <= nmax; ++n) {
                for (int e = tid; e < 4096; e += 512) { const int l_ = e >> 7, d = e & 127, tok = 16 * n + l_;
                    const float x = (kv == 0) ? roped(Pm, cosT, sinT, tok, C_KV + 0 * 512 + g * HD, d) : p_bf(Pm, tok, C_KV + 1 * 512 + g * HD + d);
                    blk[e] = x + P.cmp_pe[((size_t)(l * 2 + kv) * 32 + l_) * 128 + d]; }
                __syncthreads();
                if (tid < 256) { const float* w1 = P.cmp_w1 + (size_t)(l * 2 + kv) * 4096 * 256 + tid; float a = P.cmp_b1[(size_t)(l * 2 + kv) * 256 + tid];
                    for (int e = 0; e < 4096; ++e) a += blk[e] * w1[(size_t)e * 256];
                    hh_[tid] = 0.5f * a * (1.0f + tanhf(0.7978845608028654f * (a + 0.044715f * a * a * a))); }
                __syncthreads();
                if (tid < 128) { const float* w2 = P.cmp_w2 + (size_t)(l * 2 + kv) * 256 * 128 + tid; float a = P.cmp_b2[(size_t)(l * 2 + kv) * 128 + tid];
                    for (int c = 0; c < 256; ++c) a += hh_[c] * w2[(size_t)c * 128];
                    (kv == 0 ? kc : vc)[n * 128 + tid] = a; }
                __syncthreads();
            }
        }
#define KC_AT(n, d) (small ? kc[(n) * 128 + (d)] : __uint_as_float((unsigned)*(const bf16*)(kci + (size_t)((n) >> 6) * 16384 + kimg_off((n) & 63, (d) >> 3) + ((d) & 7) * 2) << 16))
#define VC_AT(n, d) (small ? vc[(n) * 128 + (d)] : __uint_as_float((unsigned)*(const bf16*)(vci + (size_t)((n) >> 6) * 16384 + vimg_off((d), ((n) & 63) >> 3) + ((n) & 7) * 2) << 16))
        if (nmax >= 0) {
            for (int e = tid; e < 4 * 1024; e += 512) { const int r = e >> 10, n = e & 1023; float a = -1e30f;
                if (n <= nmax) { a = 0.f; for (int d = 0; d < 128; ++d) a += q[r * 128 + d] * KC_AT(n, d); } sc[e] = a; }
            __syncthreads();
            float mx = -1e30f, den = 0.f;
            { const int r = tid >> 7, d = tid & 127; for (int n = 0; n <= nmax; ++n) mx = fmaxf(mx, sc[r * 1024 + n]);
              float num = 0.f; for (int n = 0; n <= nmax; ++n) { const float p = expf(sc[r * 1024 + n] - mx); den += p; num += p * VC_AT(n, d); }
              if (DBG_BR & 1) fin[tid] += sigm(p_bf(Pm, t, C_GN + (4 * g + r) * 3 + 0)) * num / den; }
            __syncthreads();
            { const int r = tid >> 7; for (int n = (tid & 127); n <= nmax; n += 128) sc[r * 1024 + n] = expf(sc[r * 1024 + n] - mx) / den; }
            __syncthreads();
            if (tid <= cur) { const int j = tid; float a = 0.f;
                for (int r = 0; r < 4; ++r) for (int u = -1; u <= 3; ++u) { const int n = 4 * j + u; if (n >= 0 && n <= nmax) a += sc[r * 1024 + n] * ((u == -1 || u == 3) ? 0.5f : 1.0f); }
                imp[j] = a; }
            __syncthreads();
        }
        if (tid == 0) { int ns = 0; selb[ns++] = 0; if (cur > 0) selb[ns++] = cur;
            for (int rnd = 0; rnd < 14; ++rnd) { int bj = -1; float bv = -1.f;
                for (int j = 1; j < cur; ++j) { bool taken = false; for (int k = 0; k < ns; ++k) taken |= (selb[k] == j); if (!taken && imp[j] > bv) { bv = imp[j]; bj = j; } }
                if (bj < 0) break; selb[ns++] = bj; }
            for (; ns < 16; ++ns) selb[ns] = -1; }
        __syncthreads();
        if (DBG_BR & 2) {
            const int kcol = C_KV + 2 * 512 + g * HD, vcol = C_KV + 3 * 512 + g * HD;
            for (int e = tid; e < 4 * 1024; e += 512) { const int r = e >> 10, k = e & 1023, bsel = selb[k >> 6], kp = bsel * 64 + (k & 63); float a = -1e30f;
                if (bsel >= 0 && kp <= t) { a = 0.f; for (int d = 0; d < 128; ++d) a += q[r * 128 + d] * roped(Pm, cosT, sinT, kp, kcol, d); }
                sc[e] = a; }
            __syncthreads();
            { const int r = tid >> 7, d = tid & 127; float mx = -1e30f; for (int k = 0; k < 1024; ++k) mx = fmaxf(mx, sc[r * 1024 + k]);
              float den = 0.f, num = 0.f; for (int k = 0; k < 1024; ++k) { const float sv = sc[r * 1024 + k]; if (sv > -1e29f) { const float p = expf(sv - mx); den += p; num += p * p_bf(Pm, selb[k >> 6] * 64 + (k & 63), vcol + d); } }
              fin[tid] += sigm(p_bf(Pm, t, C_GN + (4 * g + r) * 3 + 1)) * num / den; }
            __syncthreads();
        }
        if (DBG_BR & 4) {
            const int kcol = C_KV + 4 * 512 + g * HD, vcol = C_KV + 5 * 512 + g * HD;
            for (int e = tid; e < 4 * 512; e += 512) { const int r = e >> 9, kp = t - (e & 511); float a = -1e30f;
                if (kp >= 0) { a = 0.f; for (int d = 0; d < 128; ++d) a += q[r * 128 + d] * roped(Pm, cosT, sinT, kp, kcol, d); }
                sc[r * 1024 + (e & 511)] = a; }
            __syncthreads();
            { const int r = tid >> 7, d = tid & 127; float mx = -1e30f; for (int k = 0; k < 512; ++k) mx = fmaxf(mx, sc[r * 1024 + k]);
              float den = 0.f, num = 0.f; for (int k = 0; k < 512; ++k) { const float sv = sc[r * 1024 + k]; if (sv > -1e29f) { const float p = expf(sv - mx); den += p; num += p * p_bf(Pm, t - k, vcol + d); } }
              fin[tid] += sigm(p_bf(Pm, t, C_GN + (4 * g + r) * 3 + 2)) * num / den; }
            __syncthreads();
        }
        { const int r = tid >> 7, d = tid & 127; const float ao = __uint_as_float((unsigned)AO[(size_t)t * DM + (4 * g + r) * HD + d] << 16);
          const float err = fabsf(fin[tid] - ao), mag = fabsf(fin[tid]);
          atomicMax((unsigned*)&red[0], __float_as_uint(err)); atomicMax((unsigned*)&red[1], __float_as_uint(mag)); }
        __syncthreads();
        if (tid == 0) { const float err = __uint_as_float(red[0]), mag = __uint_as_float(red[1]); if (!(err <= 0.03f * mag + 2e-3f)) atomicOr(flagword, 1u << s); }
        __syncthreads();
    }
#undef KC_AT
#undef VC_AT
}
#endif


#if DBG_CHECK
__constant__ int RSAMP[8] = {0, 1, 63, 64, 255, 256, 4097, 16383};
__device__ __forceinline__ int csamp(int ci, int N) { return ci == 63 ? N - 1 : (int)(((unsigned)ci * (unsigned)(N / 64) + ((unsigned)ci * 7u) % 61u) % (unsigned)N); }
__device__ __forceinline__ float bfv(const bf16* p, size_t i) { return __uint_as_float((unsigned)p[i] << 16); }
__device__ __forceinline__ float mod_naive(const Ptrs& P, int l, int k, int c) {
    float a = P.ada_b[(size_t)l * 6 * DM + k * DM + c];
    for (int j = 0; j < DM; ++j) { const float cv = P.c[j]; a += cv / (1.0f + expf(-cv)) * P.ada_w[((size_t)l * DM + j) * 6 * DM + k * DM + c]; }
    return a;
}
__device__ __forceinline__ void flag_if(bool bad, unsigned* flagword, int bit) { if (bad) { atomicOr(flagword, 1u << bit); if (bit == 4) { atomicMax(flagword + 1, 0xffffffffu - (unsigned)threadIdx.x); atomicAdd(flagword + 2, 1u); } } }
__device__ __forceinline__ bool mism(float got, float exp_) { return !(fabsf(got - exp_) <= 0.02f * fabsf(exp_) + 0.02f); }
__device__ __forceinline__ void main_check(const Ptrs& P, int which, int tid, unsigned* flagword) {
    const int l = 0, row = RSAMP[tid >> 6], ci = tid & 63;
    const bf16* Pm = (const bf16*)(P.ws + WS_P); const bf16* H = (const bf16*)(P.ws + WS_H); const float* Y = (const float*)(P.ws + WS_Y);
    if (which == 1 || which == 7) {
        const int c = csamp(ci, DM);
        const float* xr = (which == 1 ? P.x : P.out) + (size_t)row * DM;
        if (which == 7) {
            float ss = 0.f; for (int j = 0; j < DM; ++j) { const float y = Y[(size_t)row * DM + j]; ss += y * y; }
            const float e = P.x[(size_t)row * DM + c] + mod_naive(P, l, 2, c) * P.gains[(size_t)(l * 4 + 1) * DM + c] * Y[(size_t)row * DM + c] / sqrtf(ss / DM + NORM_EPS);
            flag_if(mism(xr[c], e), flagword, 16 + which);
        }
        float ss = 0.f; for (int j = 0; j < DM; ++j) ss += xr[j] * xr[j];
        const int gi = which == 1 ? 0 : 2, sck = which == 1 ? 1 : 4, shk = which == 1 ? 0 : 3;
        const float e = xr[c] / sqrtf(ss / DM + NORM_EPS) * P.gains[(size_t)(l * 4 + gi) * DM + c] * (1.0f + mod_naive(P, l, sck, c)) + mod_naive(P, l, shk, c);
        flag_if(mism(bfv(H, (size_t)row * DM + c), e), flagword, which);
    } else if (which == 2) {
        const int pc = (ci < 60) ? csamp(ci, 12288) : 12288 + (ci - 60) * 15;
        const int src = pc < 8192 ? pc : pc < 10240 ? 8240 + (pc - 8192) : pc < 12288 ? 10288 + (pc - 10240) : 8192 + (pc - 12288);
        float a = 0.f; for (int k = 0; k < DM; ++k) a += bfv(H, (size_t)row * DM + k) * P.w_in[((size_t)l * DM + k) * INW + src];
        flag_if(mism(bfv(Pm, (size_t)row * PW + pc), a), flagword, which);
    } else if (which == 3) {
        const int c = csamp(ci, CWID); float z = 0.f;
        for (int k = 0; k < 3; ++k) { const int tt = row - 2 + k; if (tt >= 0) z += P.conv_w[(size_t)l * 3 * CWID + k * CWID + c] * bfv(Pm, (size_t)tt * PW + C_CG + c) * bfv(Pm, (size_t)tt * PW + C_XA + c); }
        flag_if(mism(bfv((const bf16*)(P.ws + WS_CV), (size_t)row * CWID + c), z * bfv(Pm, (size_t)row * PW + C_BG + c)), flagword, which);
    } else if (which == 4) {
        const int c = csamp(ci, DM); const bf16* CV = (const bf16*)(P.ws + WS_CV);
        float a = 0.f; for (int k = 0; k < CWID; ++k) a += bfv(CV, (size_t)row * CWID + k) * P.w_conv_out[((size_t)l * CWID + k) * DM + c];
        flag_if(mism(bfv((const bf16*)(P.ws + WS_YA), (size_t)row * DM + c), a * sigm(bfv(Pm, (size_t)row * PW + C_GA + c))), flagword, which);
    } else if (which == 5 && row < 10000) {
        const int c = csamp(ci, DM); const bf16* AO = (const bf16*)(P.ws + WS_AO);
        float a = 0.f; for (int k = 0; k < DM; ++k) a += bfv(AO, (size_t)row * DM + k) * P.w_nsa[((size_t)l * DM + k) * DM + c];
        flag_if(mism(bfv((const bf16*)(P.ws + WS_MG), (size_t)row * DM + c), bfv((const bf16*)(P.ws + WS_YA), (size_t)row * DM + c) + a * sigm(bfv(Pm, (size_t)row * PW + C_GB + c))), flagword, which);
    } else if (which == 6) {
        const int c = csamp(ci, DM); const bf16* MG = (const bf16*)(P.ws + WS_MG);
        float a = 0.f; for (int k = 0; k < DM; ++k) a += bfv(MG, (size_t)row * DM + k) * P.w_out[((size_t)l * DM + k) * DM + c];
        flag_if(mism(Y[(size_t)row * DM + c], a), flagword, which);
    } else if (which == 8) {
        const int f = csamp(ci, FF);
        float a = 0.f; for (int k = 0; k < DM; ++k) a += bfv(H, (size_t)row * DM + k) * P.w_up[((size_t)l * DM + k) * FF + f];
        a = fmaxf(a, 0.f); flag_if(mism(bfv((const bf16*)(P.ws + WS_U), (size_t)row * FF + f), a * a), flagword, which);
    } else if (which == 9) {
        const int c = csamp(ci, DM); const bf16* U = (const bf16*)(P.ws + WS_U);
        float a = 0.f; for (int k = 0; k < FF; ++k) a += bfv(U, (size_t)row * FF + k) * P.w_down[((size_t)l * FF + k) * DM + c];
        flag_if(mism(Y[(size_t)row * DM + c], a), flagword, which);
    }
}
#define MAIN_CHECK(w) do { if (l == 0 && bx == 0) main_check(P, (w), OPQ_TID(), ctl + 64); } while (0)
#else
#define MAIN_CHECK(w) do { } while (0)
#endif
constexpr int NPH = 11;
constexpr int N_PHASES = 2 + DEPTH * NPH;
#ifndef DBG_CHECK_LAYER
#define DBG_CHECK_LAYER 0
#endif
#ifndef DBG_SKIP_ATTN
#define DBG_SKIP_ATTN 0
#endif
#ifndef DUP_MASK
#define DUP_MASK 0
#endif
#define DUPN(t) (1 + ((DUP_MASK >> (t)) & 1))
#ifndef MK_PER_PHASE
#define MK_PER_PHASE 0
#endif

__global__ void __launch_bounds__(NWAVES * 64, 2) nsa_fwd(Args args) {
    extern __shared__ __attribute__((aligned(16))) unsigned char lds_raw[];
    LAS unsigned char* lds = (LAS unsigned char*)lds_raw;
    const int tid = threadIdx.x, lane = tid & 63, wave = __builtin_amdgcn_readfirstlane(tid >> 6);
    const int G = gridDim.x; const int bx = blockIdx.x; const int vcu = (G % 8 == 0) ? (bx % 8) * (G / 8) + bx / 8 : bx;
    volatile LAS unsigned* MISC = (volatile LAS unsigned*)(lds + MISC_OFF);
    for (int u = tid; u < 128; u += NWAVES * 64) MISC[u] = 0u;
    __syncthreads();
    unsigned* ctl = (unsigned*)(args.ws + WS_CTL);
    XcdBarrier bar = xcd_barrier_post(ctl + CW_BAR, MISC + 8);
    const int lo = args.ph_lo, hi = args.ph_hi; (void)lo; (void)hi;
#ifndef ONLY_PHASE
#define ONLY_PHASE -1
#endif
#define PH_EN(t) (ONLY_PHASE < 0 || ONLY_PHASE == (t))
#if MK_PER_PHASE
#define IN(k) (lo <= (k) && (k) < hi)
#else
#define IN(k) true
#endif
#define LOADP() const Args GAS_K* ap_ = (const Args GAS_K*)__builtin_amdgcn_kernarg_segment_ptr(); asm volatile("" : "+s"(ap_)); Ptrs P; \
    P.x = (const float*)ap_->in[0]; P.c = (const float*)ap_->in[1]; P.pos = (const int*)ap_->in[2]; P.ada_w = (const float*)ap_->in[3]; P.ada_b = (const float*)ap_->in[4]; \
    P.gains = (const float*)ap_->in[5]; P.w_in = (const float*)ap_->in[6]; P.conv_w = (const float*)ap_->in[7]; P.w_conv_out = (const float*)ap_->in[8]; P.cmp_pe = (const float*)ap_->in[9]; \
    P.cmp_w1 = (const float*)ap_->in[10]; P.cmp_b1 = (const float*)ap_->in[11]; P.cmp_w2 = (const float*)ap_->in[12]; P.cmp_b2 = (const float*)ap_->in[13]; P.w_nsa = (const float*)ap_->in[14]; \
    P.w_out = (const float*)ap_->in[15]; P.w_up = (const float*)ap_->in[16]; P.w_down = (const float*)ap_->in[17]; P.out = ap_->out; P.ws = ap_->ws; \
    bf16* H = (bf16*)(P.ws + WS_H); bf16* Y = (bf16*)(P.ws + WS_Y); unsigned char* wl = P.ws + WS_WL + (size_t)l_ * WL_BYTES; const bf16* Pm = (const bf16*)(P.ws + WS_P); (void)H; (void)Y; (void)wl; (void)Pm
#define OPQ_S(x) ({ int _v = (x); asm volatile("" : "+s"(_v)); _v; })
#define OPQ_TID() ({ int _l; asm volatile("v_mbcnt_lo_u32_b32 %0, -1, 0\n\tv_mbcnt_hi_u32_b32 %0, -1, %0" : "=v"(_l)); int _t = (OPQ_S(wave) << 6) | _l; _t; })
#if MK_PER_PHASE
#define SEAM(k) do { } while (0)
#else
#define SEAM(k) do { if (IN((k) + 1) && rep_ + 1 == nrep_) xcd_barrier(bar); } while (0)
#endif

    { const int l_ = 0; (void)l_;
    if (PH_EN(0) && IN(0)) for (int rep_ = 0, nrep_ = (DUPN(0)); rep_ < nrep_; ++rep_) { LOADP(); { const int t_ = OPQ_TID(); p0_prologue(P, lds, OPQ_S(vcu), OPQ_S(G), OPQ_S(wave), t_ & 63, t_); } SEAM(0); }
    if (PH_EN(1) && IN(1)) for (int rep_ = 0, nrep_ = (1); rep_ < nrep_; ++rep_) { LOADP(); resid_phase<false>(P, lds, P.x, false, nullptr, false, nullptr, H, true, 0, 0, 0,  0,  1,  0,  0, OPQ_S(vcu), OPQ_S(G), OPQ_S(wave), OPQ_TID() & 63, OPQ_TID()); SEAM(1); }

    }
    for (int l = 0; l < DEPTH; ++l) {
        const int pb = 2 + l * NPH; const int l_ = l;
        if (PH_EN(2) && IN(pb + 0)) for (int rep_ = 0, nrep_ = (DUPN(2)); rep_ < nrep_; ++rep_) { LOADP();
            MAIN_CHECK(1);
            pg8::Gemm g{H, (const bf16*)(wl + WL_WIN), S, C_GN, DM, DM}; pg8::StaticOrder So; So.init(S, C_GN, OPQ_S(G), OPQ_S(bx), pg8::WGM_PROJ);
            pg8::EpiB<0> E{(bf16*)(P.ws + WS_P), PW, nullptr, nullptr, 0, nullptr, 0};
            pg8::gemm_phase<pg8::EpiB<0>, pg8::StaticOrder, true, true>(lds, g, So, E, OPQ_TID());
            SEAM(pb + 0);
        }
        if (PH_EN(3) && IN(pb + 1)) for (int rep_ = 0, nrep_ = (DUPN(3)); rep_ < nrep_; ++rep_) { LOADP(); MAIN_CHECK(2); relayout_phase(P, l, lds, OPQ_S(vcu), OPQ_S(G), OPQ_TID()); SEAM(pb + 1); }
        if (PH_EN(4) && IN(pb + 2)) for (int rep_ = 0, nrep_ = (DUPN(4)); rep_ < nrep_; ++rep_) { LOADP();
            MAIN_CHECK(3);
            {   pg8::Gemm g{(const bf16*)(P.ws + WS_KCR), (const bf16*)(wl + WL_W1T), 8192, 512, 4096, 2048}; pg8::CmpOrder So{OPQ_S(bx)};
                pg8::EpiB<2, true> E{(bf16*)(P.ws + WS_HC), 256, (const float*)(P.ws + WS_B1P), nullptr, 0, nullptr, 0};
                pg8::gemm_phase<pg8::EpiB<2, true>, pg8::CmpOrder, false, true>(lds, g, So, E, OPQ_TID()); }
            {   pg8::Gemm g{(const bf16*)(P.ws + WS_CV), (const bf16*)(wl + WL_WCONV), S, DM, CWID, CWID}; pg8::StaticOrder So;
                So.init(S, DM, OPQ_S(G), OPQ_S(bx), pg8::WGM_N2K);
                pg8::EpiB<3> E{(bf16*)(P.ws + WS_YA), DM, nullptr, Pm + C_GA, PW, nullptr, 0};
                if (OPQ_S(G) == 256) { pg8::YaOrder Yo{So, OPQ_S(bx)}; pg8::gemm_phase<pg8::EpiB<3>, pg8::YaOrder, true, true>(lds, g, Yo, E, OPQ_TID()); }
                else pg8::gemm_phase<pg8::EpiB<3>, pg8::StaticOrder, true, true>(lds, g, So, E, OPQ_TID()); }
            SEAM(pb + 2);
        }
        if (PH_EN(5) && IN(pb + 3)) for (int rep_ = 0, nrep_ = (DUPN(5)); rep_ < nrep_; ++rep_) { LOADP(); MAIN_CHECK(4); cmp2_phase(P, l, OPQ_S(vcu), OPQ_S(G), OPQ_S(wave), OPQ_TID() & 63); SEAM(pb + 3); }
#if DBG_SKIP_ATTN
        if (PH_EN(6) && IN(pb + 4)) for (int rep_ = 0, nrep_ = (DUPN(6)); rep_ < nrep_; ++rep_) { LOADP(); u32x4* ao = (u32x4*)(P.ws + WS_AO); for (size_t i = (size_t)OPQ_S(vcu) * 512 + OPQ_TID(); i < (size_t)S * DM * 2 / 16; i += (size_t)OPQ_S(G) * 512) ao[i] = (u32x4){0u, 0u, 0u, 0u}; SEAM(pb + 4); }
#else
        if (PH_EN(6) && IN(pb + 4)) for (int rep_ = 0, nrep_ = (DUPN(6)); rep_ < nrep_; ++rep_) { LOADP(); attn_phase(P, lds, OPQ_S(vcu), OPQ_S(G), OPQ_S(wave), OPQ_TID() & 63);
            SEAM(pb + 4); }
#endif
        if (PH_EN(7) && IN(pb + 5)) for (int rep_ = 0, nrep_ = (DUPN(7)); rep_ < nrep_; ++rep_) { LOADP();
#if DBG_CHECK
            if (DBG_CHECK == 2 && l == DBG_CHECK_LAYER) { attn_check(P, l, lds, OPQ_S(vcu), OPQ_S(G), OPQ_TID(), ctl + 64); __syncthreads(); }
#endif
            pg8::Gemm g{(const bf16*)(P.ws + WS_AO), (const bf16*)(wl + WL_WNSA), S, DM, DM, DM}; pg8::StaticOrder So; So.init(S, DM, OPQ_S(G), OPQ_S(bx), pg8::WGM_N2K);
            pg8::EpiB<4> E{(bf16*)(P.ws + WS_MG), DM, nullptr, Pm + C_GB, PW, (const bf16*)(P.ws + WS_YA), DM};
            pg8::gemm_phase<pg8::EpiB<4>, pg8::StaticOrder, true, true>(lds, g, So, E, OPQ_TID());
            SEAM(pb + 5);
        }
        if (PH_EN(8) && IN(pb + 6)) for (int rep_ = 0, nrep_ = (DUPN(8)); rep_ < nrep_; ++rep_) { LOADP();
            MAIN_CHECK(5);
            pg8::Gemm g{(const bf16*)(P.ws + WS_MG), (const bf16*)(wl + WL_WOUT), S, DM, DM, DM}; pg8::StaticOrder So; So.init(S, DM, OPQ_S(G), OPQ_S(bx), pg8::WGM_N2K);
            pg8::EpiB<0> E{Y, DM, nullptr, nullptr, 0, nullptr, 0};
            pg8::gemm_phase<pg8::EpiB<0>, pg8::StaticOrder, true, true>(lds, g, So, E, OPQ_TID());
            SEAM(pb + 6);
        }
        if (PH_EN(9) && IN(pb + 7)) for (int rep_ = 0, nrep_ = (1); rep_ < nrep_; ++rep_) { LOADP(); MAIN_CHECK(6); resid_phase<true>(P, lds, l == 0 ? (const void*)P.x : (const void*)(P.ws + WS_XB), l != 0, (void*)(P.ws + WS_XB), true, Y, H, true, l, 2, 1, l, 4, 3, 2, OPQ_S(vcu), OPQ_S(G), OPQ_S(wave), OPQ_TID() & 63, OPQ_TID()); SEAM(pb + 7); }
        if (PH_EN(10) && IN(pb + 8)) for (int rep_ = 0, nrep_ = (DUPN(10)); rep_ < nrep_; ++rep_) { LOADP();
            MAIN_CHECK(7);
            pg8::Gemm g{H, (const bf16*)(wl + WL_WUP), S, FF, DM, DM}; pg8::StaticOrder So; So.init(S, FF, OPQ_S(G), OPQ_S(bx), pg8::WGM_UP);
            pg8::EpiB<1> E{(bf16*)(P.ws + WS_U), FF, nullptr, nullptr, 0, nullptr, 0};
            pg8::gemm_phase<pg8::EpiB<1>, pg8::StaticOrder, true, true>(lds, g, So, E, OPQ_TID());
            SEAM(pb + 8);
        }
        if (PH_EN(11) && IN(pb + 9)) for (int rep_ = 0, nrep_ = (DUPN(11)); rep_ < nrep_; ++rep_) { LOADP();
            MAIN_CHECK(8);
            pg8::Gemm g{(const bf16*)(P.ws + WS_U), (const bf16*)(wl + WL_WDOWN), S, DM, FF, FF}; pg8::StaticOrder So; So.init(S, DM, OPQ_S(G), OPQ_S(bx), pg8::WGM_N2K);
            pg8::EpiB<0> E{Y, DM, nullptr, nullptr, 0, nullptr, 0};
            pg8::gemm_phase<pg8::EpiB<0>, pg8::StaticOrder, true, true>(lds, g, So, E, OPQ_TID());
            SEAM(pb + 9);
        }
        if (PH_EN(12) && IN(pb + 10)) for (int rep_ = 0, nrep_ = (1); rep_ < nrep_; ++rep_) { LOADP();
            MAIN_CHECK(9);
            resid_phase<true>(P, lds, (const void*)(P.ws + WS_XB), true, l + 1 < DEPTH ? (void*)(P.ws + WS_XB) : (void*)P.out, l + 1 < DEPTH, Y, H, l + 1 < DEPTH, l, 5, 3, (l + 1 < DEPTH) ? l + 1 : l, 1, 0, 0, OPQ_S(vcu), OPQ_S(G), OPQ_S(wave), OPQ_TID() & 63, OPQ_TID());
            if (l + 1 < DEPTH) SEAM(pb + 10);
#if DBG_CHECK
            else { __syncthreads(); if (OPQ_S(bx) == 0 && OPQ_TID() == 0) { __threadfence(); const unsigned f = __hip_atomic_load(ctl + 64, __ATOMIC_RELAXED, __HIP_MEMORY_SCOPE_AGENT);
                if (f) { const unsigned ft = (0xffffffffu - __hip_atomic_load(ctl + 65, __ATOMIC_RELAXED, __HIP_MEMORY_SCOPE_AGENT)) + 1u, cnt = 0u; (void)cnt;
                    P.out[0] = 2000.0f * ((((ft - 1u) & 63u) >> 3) + 1u); } } }
#endif
        }
    }
#undef IN
#undef SEAM
}

extern "C" void kernel_launch(void* const* d_in, const int* in_sizes, int n_in, void* d_out, int out_size, void* d_ws, size_t ws_size, hipStream_t stream) {
    static int grid = 0;
    if (grid == 0) {
        if (n_in != 18 || out_size != S * DM || ws_size < WS_END) { fprintf(stderr, "kernel_launch: unexpected problem (n_in %d, out %d, ws %zu, need %zu)\n", n_in, out_size, ws_size, (size_t)WS_END); grid = -1; return; }
        int dev = 0, cus = 0, per_cu = 0;
        if (hipGetDevice(&dev) != hipSuccess || hipDeviceGetAttribute(&cus, hipDeviceAttributeMultiprocessorCount, dev) != hipSuccess) { grid = -1; return; }
        if (hipFuncSetAttribute((const void*)nsa_fwd, hipFuncAttributeMaxDynamicSharedMemorySize, LDS_BYTES) != hipSuccess) { fprintf(stderr, "kernel_launch: hipFuncSetAttribute failed\n"); grid = -1; return; }
        if (hipOccupancyMaxActiveBlocksPerMultiprocessor(&per_cu, (const void*)nsa_fwd, NWAVES * 64, LDS_BYTES) != hipSuccess || per_cu < 1)
            fprintf(stderr, "kernel_launch: occupancy query reports %d workgroups per CU\n", per_cu);
        (void)hipGetLastError();
        grid = cus;
    }
    if (grid < 0) return;
    if (hipMemsetAsync((char*)d_ws + WS_CTL, 0, CTL_ZERO_BYTES, stream) != hipSuccess) { fprintf(stderr, "kernel_launch: memset failed\n"); return; }
    Args a{};
    for (int i = 0; i < 18; ++i) a.in[i] = d_in[i];
    a.out = (float*)d_out; a.ws = (unsigned char*)d_ws;
#if MK_PER_PHASE
    for (int ph = 0; ph < N_PHASES; ++ph) { a.ph_lo = ph; a.ph_hi = ph + 1; hipLaunchKernelGGL(nsa_fwd, dim3(grid), dim3(NWAVES * 64), LDS_BYTES, stream, a); }
#else
    a.ph_lo = 0; a.ph_hi = N_PHASES;
    hipLaunchKernelGGL(nsa_fwd, dim3(grid), dim3(NWAVES * 64), LDS_BYTES, stream, a);
#endif
    const hipError_t le = hipPeekAtLastError();
    if (le != hipSuccess) fprintf(stderr, "kernel_launch: launch failed: %s\n", hipGetErrorName(le));
}
```

```cpp
#include <hip/hip_runtime.h>
#include <cstdio>
#include <cstdint>

#define GAS __attribute__((address_space(1)))
#define GAS_K __attribute__((address_space(4)))
#define LAS __attribute__((address_space(3)))
typedef unsigned short bf16;
typedef short bf16x8 __attribute__((ext_vector_type(8)));
typedef float f32x4 __attribute__((ext_vector_type(4)));
typedef float f32x2 __attribute__((ext_vector_type(2)));
typedef unsigned u32x4 __attribute__((ext_vector_type(4)));
typedef unsigned u32x2 __attribute__((ext_vector_type(2)));

constexpr int S = 16384, DM = 2048, DEPTH = 4, CWID = 1024, NH = 16, NG = 4, HD = 128, FF = 8192;
constexpr int INW = 12336, PW = 12544;
constexpr int C_BG = 0, C_CG = 1024, C_XA = 2048, C_Q = 3072, C_KV = 5120, C_GA = 8192, C_GB = 10240, C_GN = 12288;
constexpr float NORM_EPS = 1e-6f;
constexpr float QSCALE = 0.12751743082459868f;
constexpr int NWAVES = 8;

namespace pg8 {
typedef unsigned short bf16_t;
constexpr int WGM_PROJ = 8, WGM_UP = 4, WGM_N2K = 4;
constexpr int BM = 256, BK = 64, HALF = 128, HTB = HALF * BK * 2, STAGE_BYTES = 8 * HTB, NXCD = 8, WGM = 4;
__host__ __device__ __forceinline__ int lds_byte(int r, int c) { const int st = (r >> 4) * 2 + (c >> 5), rr = r & 15, cc = c & 31, ob = rr * 64 + cc * 2; return st * 1024 + (ob ^ (((ob >> 9) & 1) << 5)); }
__host__ __device__ __forceinline__ void stage_rc(int b, int& R, int& C) { const int st = b / 1024, sb = b % 1024, swz = sb ^ (((sb >> 9) & 1) << 5); R = (st >> 1) * 16 + swz / 64; C = (st & 1) * 32 + (swz % 64) / 2; }
__host__ __device__ __forceinline__ int perm32(int rho) { const int n = rho >> 4, i = rho & 15; return 8 * (i >> 2) + 4 * n + (i & 3); }

struct Unit { int pm, pn; };
struct Gemm { const bf16_t* A; const bf16_t* Bt; int M, N, K, lda; };

struct StaticOrder {
    int nM, nN, nwg, G, c, wgm;
    __device__ void init(int M, int N, int G_, int c_, int wgm_ = WGM) { nM = M / BM; nN = N / BM; nwg = nM * nN; G = G_; c = c_; wgm = wgm_; if (c_ < 0 || c_ >= G_) nwg = 0; }
    __device__ bool next(int i, Unit& u) const { return map((long)i * G + c, u); }
    __device__ bool map(const long L, Unit& u) const {
        if (L >= nwg) return false;
        int wgid = (int)L; { const int q = nwg / NXCD, r = nwg % NXCD, xcd = wgid % NXCD, off = wgid / NXCD; wgid = (xcd < r ? xcd * (q + 1) : r * (q + 1) + (xcd - r) * q) + off; }
        const int nig = wgm * nN, gid = wgid / nig, fm = gid * wgm, gsz = (nM - fm) < wgm ? (nM - fm) : wgm;
        u.pm = fm + ((wgid % nig) % gsz); u.pn = (wgid % nig) / gsz; return true;
    }
    __device__ __forceinline__ void a_ready(const Unit&) const {}
    __device__ __forceinline__ void done(const Unit&) const {}
};

typedef float f32x2_t_ __attribute__((ext_vector_type(2))); typedef __bf16 bf16x2_t_ __attribute__((ext_vector_type(2)));
__device__ __forceinline__ unsigned cvt_pk_bf16(float lo, float hi) { const f32x2_t_ v = {lo, hi}; const bf16x2_t_ b = __builtin_convertvector(v, bf16x2_t_); return __builtin_bit_cast(unsigned, b); }
__device__ __forceinline__ float bflo(unsigned w) { return __uint_as_float(w << 16); }
__device__ __forceinline__ float bfhi(unsigned w) { return __uint_as_float(w & 0xffff0000u); }
__device__ __forceinline__ float sigmoidf_(float x) { return __builtin_amdgcn_rcpf(1.0f + __builtin_amdgcn_exp2f(-1.4426950408889634f * x)); }

struct YaOrder {
    StaticOrder base; int bx;
    __device__ bool next(int i, Unit& u) const {
        if (bx < 32) return false;
        if (i < 2) return base.next(i, u);
        if (i == 2 && bx < 96) { const int idx = bx - 32; return base.map(idx < 32 ? (long)idx : (long)(idx - 32) + base.G, u); }
        return false;
    }
    __device__ __forceinline__ void a_ready(const Unit&) const {}
    __device__ __forceinline__ void done(const Unit&) const {}
};
struct CmpOrder {
    int c;
    __device__ bool next(int i, Unit& u) const { if (i != 0 || c < 0 || c >= 32) return false; u.pm = c; u.pn = c >> 4; return true; }
    __device__ __forceinline__ void a_ready(const Unit&) const {}
    __device__ __forceinline__ void done(const Unit&) const {}
};
struct EpiF32 {
    static constexpr bool PERM = false, AFTER_DRAIN = false;
    float* C; int ldc;
    __device__ __forceinline__ void operator()(const f32x4 (&acc)[2][2][4][2], const Unit& u, int wr, int wc, int fr, int fq) const {
        const int row0 = u.pm * BM + wr * 64 + fr, col0 = u.pn * BM + wc * 32 + 4 * fq;
#pragma unroll
        for (int ai = 0; ai < 2; ++ai)
#pragma unroll
            for (int m = 0; m < 4; ++m) { float* rowp = C + (size_t)(row0 + ai * HALF + m * 16) * ldc + col0;
#pragma unroll
                for (int bj = 0; bj < 2; ++bj)
#pragma unroll
                    for (int n = 0; n < 2; ++n) *(f32x4*)(rowp + bj * HALF + n * 16) = acc[ai][bj][m][n]; }
    }
};
template <int MODE, bool COLWRAP = false> struct EpiB {
    static constexpr bool PERM = true, AFTER_DRAIN = false;
    bf16_t* O; int ldc; const float* bias; const bf16_t* G; int ldg; const bf16_t* ADD; int ldadd;
    __device__ __forceinline__ void operator()(const f32x4 (&acc)[2][2][4][2], const Unit& u, int wr, int wc, int fr, int fq) const {
        const int row0 = u.pm * BM + wr * 64 + fr, col0 = u.pn * BM + wc * 32 + 8 * fq;
#pragma unroll
        for (int ai = 0; ai < 2; ++ai)
#pragma unroll
            for (int m = 0; m < 4; ++m) { const int row = row0 + ai * HALF + m * 16;
#pragma unroll
                for (int bj = 0; bj < 2; ++bj) { const int col = col0 + bj * HALF;
                    float v[8];
#pragma unroll
                    for (int e = 0; e < 4; ++e) { v[e] = acc[ai][bj][m][0][e]; v[4 + e] = acc[ai][bj][m][1][e]; }
                    if (MODE == 1) {
#pragma unroll
                        for (int e = 0; e < 8; ++e) { const float t = fmaxf(v[e], 0.f); v[e] = t * t; }
                    }
                    if (MODE == 2) { const f32x4 b0 = *(const f32x4*)(bias + col), b1 = *(const f32x4*)(bias + col + 4);
#pragma unroll
                        for (int e = 0; e < 8; ++e) { const float x = v[e] + (e < 4 ? b0[e] : b1[e - 4]); v[e] = x * sigmoidf_(1.5957691216057308f * (x + 0.044715f * x * x * x)); }
                    }
                    if (MODE == 3 || MODE == 4) { const u32x4 gw = *(const u32x4*)(G + (size_t)row * ldg + col);
#pragma unroll
                        for (int e = 0; e < 4; ++e) { v[2 * e] *= sigmoidf_(bflo(gw[e])); v[2 * e + 1] *= sigmoidf_(bfhi(gw[e])); }
                    }
                    if (MODE == 4) { const u32x4 aw = *(const u32x4*)(ADD + (size_t)row * ldadd + col);
#pragma unroll
                        for (int e = 0; e < 4; ++e) { v[2 * e] += bflo(aw[e]); v[2 * e + 1] += bfhi(aw[e]); }
                    }
                    u32x4 w; w.x = cvt_pk_bf16(v[0], v[1]); w.y = cvt_pk_bf16(v[2], v[3]); w.z = cvt_pk_bf16(v[4], v[5]); w.w = cvt_pk_bf16(v[6], v[7]);
                    *(u32x4*)(O + (size_t)row * ldc + (COLWRAP ? (col & 255) : col)) = w; } }
    }
};

template <class Epi, class Sched, bool ALIGN_EPI = false, bool SP2 = false>
__device__ __forceinline__ void gemm_phase(LAS unsigned char* lds, const Gemm g, const Sched& S, const Epi& E, const int tid) {
    const int wid = __builtin_amdgcn_readfirstlane(tid >> 6), lane = tid & 63, wr = wid >> 2, wc = wid & 3, fr = lane & 15, fq = lane >> 4;
    const int K = g.K, nt = K / BK;
    unsigned voffA[2], voffB[2];
#pragma unroll
    for (int i = 0; i < 2; ++i) { int R, C; stage_rc(tid * 16 + i * 8192, R, C); const int Rb = Epi::PERM ? ((R & ~31) + perm32(R & 31)) : R;
        voffA[i] = (unsigned)(R * g.lda + C) * 2u; voffB[i] = (unsigned)(Rb * K + C) * 2u; }
    const size_t kstep = (size_t)(BK * 2);
    const size_t hstepA = (size_t)HALF * g.lda * 2, hstepB = (size_t)HALF * K * 2;
    const size_t tstepA = 2 * hstepA, tstepB = 2 * hstepB;
    const unsigned ldsw = (unsigned)wid * 1024u;
    const int aoff = lds_byte(wr * 64 + fr, fq * 8), boff = lds_byte(wc * 32 + fr, fq * 8);
#define PG8_SA(b, h) (((b) * 2 + (h)) * HTB)
#define PG8_SB(b, h) ((4 + (b) * 2 + (h)) * HTB)
#define PG8_STAGE(bufoff, gbase, voff) do { _Pragma("unroll") for (int _i = 0; _i < 2; ++_i) \
        __builtin_amdgcn_global_load_lds((const unsigned*)((const char*)(gbase) + (voff)[_i]), (LAS unsigned*)(lds + (bufoff) + ldsw + _i * 8192), 16, 0, 0); } while (0)
#define PG8_LDA(dst, b, h) do { _Pragma("unroll") for (int m = 0; m < 4; ++m) _Pragma("unroll") for (int k = 0; k < 2; ++k) dst[m][k] = *(const LAS bf16x8*)(lds + PG8_SA(b, h) + aoff + m * 2048 + k * 1024); } while (0)
#define PG8_LDB(dst, b, h) do { _Pragma("unroll") for (int n = 0; n < 2; ++n) _Pragma("unroll") for (int k = 0; k < 2; ++k) dst[n][k] = *(const LAS bf16x8*)(lds + PG8_SB(b, h) + boff + n * 2048 + k * 1024); } while (0)
#define PG8_MMA(ai, bj, At, Bt) do { __builtin_amdgcn_s_setprio(1); _Pragma("unroll") for (int m = 0; m < 4; ++m) _Pragma("unroll") for (int n = 0; n < 2; ++n) _Pragma("unroll") for (int k = 0; k < 2; ++k) \
        acc[ai][bj][m][n] = __builtin_amdgcn_mfma_f32_16x16x32_bf16(Bt[n][k], At[m][k], acc[ai][bj][m][n], 0, 0, 0); __builtin_amdgcn_s_setprio(0); } while (0)
#define PG8_WAIT_V(n) asm volatile("s_waitcnt vmcnt(" #n ")" ::: "memory")
#define PG8_WAIT_L(n) asm volatile("s_waitcnt lgkmcnt(" #n ")" ::: "memory")
#define PG8_BAR __builtin_amdgcn_s_barrier()
#define PG8_SCHED __builtin_amdgcn_sched_barrier(0)
    Unit cur, nxt; int ui = 0;
    if (!S.next(0, cur)) return;
    f32x4 acc[2][2][4][2];
#pragma unroll
    for (int a = 0; a < 2; ++a)
#pragma unroll
        for (int b = 0; b < 2; ++b)
#pragma unroll
            for (int m = 0; m < 4; ++m)
#pragma unroll
                for (int n = 0; n < 2; ++n) acc[a][b][m][n] = (f32x4){0.f, 0.f, 0.f, 0.f};
    bf16x8 At[4][2], B0[2][2], B1[2][2];
    const char* cA = (const char*)g.A + (size_t)cur.pm * tstepA; const char* cB = (const char*)g.Bt + (size_t)cur.pn * tstepB;
    S.a_ready(cur);
    if constexpr (SP2) {
        PG8_STAGE(PG8_SB(0, 0), cB, voffB); PG8_STAGE(PG8_SB(0, 1), cB + hstepB, voffB); PG8_STAGE(PG8_SA(0, 0), cA, voffA); PG8_STAGE(PG8_SA(0, 1), cA + hstepA, voffA);
        if (wr == 1) PG8_BAR;
        PG8_WAIT_V(2); PG8_BAR;
        PG8_STAGE(PG8_SB(1, 0), cB + kstep, voffB); PG8_STAGE(PG8_SA(1, 0), cA + kstep, voffA); PG8_STAGE(PG8_SB(1, 1), cB + hstepB + kstep, voffB);
        PG8_WAIT_V(6); PG8_BAR;
    } else {
        PG8_STAGE(PG8_SB(0, 0), cB, voffB); PG8_STAGE(PG8_SA(0, 0), cA, voffA); PG8_STAGE(PG8_SB(0, 1), cB + hstepB, voffB); PG8_STAGE(PG8_SA(0, 1), cA + hstepA, voffA);
        if (wr == 1) PG8_BAR;
        PG8_WAIT_V(4); PG8_BAR;
        PG8_STAGE(PG8_SB(1, 0), cB + kstep, voffB); PG8_STAGE(PG8_SA(1, 0), cA + kstep, voffA); PG8_STAGE(PG8_SB(1, 1), cB + hstepB + kstep, voffB);
        PG8_WAIT_V(6); PG8_BAR;
    }
    for (;;) {
        const bool has_next = S.next(ui + 1, nxt);
        const char* nA = has_next ? (const char*)g.A + (size_t)nxt.pm * tstepA : cA; const char* nB = has_next ? (const char*)g.Bt + (size_t)nxt.pn * tstepB : cB;
        for (int t = 0; t < nt; t += 2) {
            const bool last = (t == nt - 2);
            const char* a1 = cA + (size_t)(t + 1) * kstep;
            const char* a2 = last ? nA : cA + (size_t)(t + 2) * kstep; const char* b2 = last ? nB : cB + (size_t)(t + 2) * kstep;
            const char* a3 = a2 + kstep; const char* b3 = b2 + kstep;
            if (last && has_next) S.a_ready(nxt);
            if constexpr (SP2) {
            PG8_LDB(B0, 0, 0); PG8_LDB(B1, 0, 1); PG8_SCHED; PG8_LDA(At, 0, 0); PG8_STAGE(PG8_SA(1, 1), a1 + hstepA, voffA);
            PG8_WAIT_V(8); PG8_WAIT_L(0); PG8_BAR; PG8_MMA(0, 0, At, B0); PG8_MMA(0, 1, At, B1); PG8_BAR; PG8_SCHED;
            PG8_LDA(At, 0, 1); PG8_STAGE(PG8_SB(0, 0), b2, voffB); PG8_STAGE(PG8_SB(0, 1), b2 + hstepB, voffB); PG8_STAGE(PG8_SA(0, 0), a2, voffA);
            PG8_WAIT_V(8); PG8_WAIT_L(0); PG8_BAR; PG8_MMA(1, 0, At, B0); PG8_MMA(1, 1, At, B1); PG8_BAR; PG8_SCHED;
            PG8_LDB(B0, 1, 0); PG8_LDB(B1, 1, 1); PG8_SCHED; PG8_LDA(At, 1, 0); PG8_STAGE(PG8_SA(0, 1), a2 + hstepA, voffA);
            PG8_WAIT_V(8); PG8_WAIT_L(0); PG8_BAR; PG8_MMA(0, 0, At, B0); PG8_MMA(0, 1, At, B1); PG8_BAR; PG8_SCHED;
            PG8_LDA(At, 1, 1); PG8_STAGE(PG8_SB(1, 0), b3, voffB); PG8_STAGE(PG8_SB(1, 1), b3 + hstepB, voffB); PG8_STAGE(PG8_SA(1, 0), a3, voffA);
            PG8_WAIT_V(8); PG8_WAIT_L(0); PG8_BAR; PG8_MMA(1, 0, At, B0); PG8_MMA(1, 1, At, B1); PG8_BAR; PG8_SCHED;
            } else {
            PG8_LDB(B0, 0, 0); PG8_SCHED; PG8_LDA(At, 0, 0); PG8_STAGE(PG8_SA(1, 1), a1 + hstepA, voffA);
            PG8_WAIT_L(8); PG8_BAR; PG8_WAIT_L(0); PG8_MMA(0, 0, At, B0); PG8_BAR; PG8_SCHED;
            PG8_LDB(B1, 0, 1); PG8_STAGE(PG8_SB(0, 0), b2, voffB);
            PG8_BAR; PG8_WAIT_L(0); PG8_MMA(0, 1, At, B1); PG8_BAR;
            PG8_LDA(At, 0, 1); PG8_STAGE(PG8_SA(0, 0), a2, voffA);
            PG8_BAR; PG8_WAIT_L(0); PG8_MMA(1, 0, At, B0); PG8_BAR; PG8_SCHED;
            PG8_STAGE(PG8_SB(0, 1), b2 + hstepB, voffB);
            PG8_WAIT_V(6); PG8_BAR; PG8_MMA(1, 1, At, B1); PG8_BAR;
            PG8_LDB(B0, 1, 0); PG8_SCHED; PG8_LDA(At, 1, 0); PG8_STAGE(PG8_SA(0, 1), a2 + hstepA, voffA);
            PG8_WAIT_L(8); PG8_BAR; PG8_WAIT_L(0); PG8_MMA(0, 0, At, B0); PG8_BAR; PG8_SCHED;
            PG8_LDB(B1, 1, 1); PG8_STAGE(PG8_SB(1, 0), b3, voffB);
            PG8_BAR; PG8_WAIT_L(0); PG8_MMA(0, 1, At, B1); PG8_BAR;
            PG8_LDA(At, 1, 1); PG8_STAGE(PG8_SA(1, 0), a3, voffA);
            PG8_BAR; PG8_WAIT_L(0); PG8_MMA(1, 0, At, B0); PG8_BAR; PG8_SCHED;
            PG8_STAGE(PG8_SB(1, 1), b3 + hstepB, voffB);
            PG8_WAIT_V(6); PG8_BAR; PG8_MMA(1, 1, At, B1); PG8_BAR;
            }
        }
        if constexpr (ALIGN_EPI) { if (wr == 0) PG8_BAR; }
        E(acc, cur, wr, wc, fr, fq); S.done(cur);
        if (!has_next) break;
#pragma unroll
        for (int a = 0; a < 2; ++a)
#pragma unroll
            for (int b = 0; b < 2; ++b)
#pragma unroll
                for (int m = 0; m < 4; ++m)
#pragma unroll
                    for (int n = 0; n < 2; ++n) acc[a][b][m][n] = (f32x4){0.f, 0.f, 0.f, 0.f};
        cur = nxt; cA = nA; cB = nB; ++ui;
        if constexpr (ALIGN_EPI) { if (wr == 1) PG8_BAR; }
    }
    PG8_WAIT_V(0);
    if constexpr (!ALIGN_EPI) { if (wr == 0) PG8_BAR; }
    PG8_BAR;
#undef PG8_SA
#undef PG8_SB
#undef PG8_STAGE
#undef PG8_LDA
#undef PG8_LDB
#undef PG8_MMA
#undef PG8_WAIT_V
#undef PG8_WAIT_L
#undef PG8_BAR
#undef PG8_SCHED
}
}

constexpr size_t al4k(size_t x) { return (x + 4095) & ~(size_t)4095; }
constexpr size_t WS_CTL = 0, CTL_ZERO_BYTES = 1u << 20;
constexpr size_t WS_MODP = CTL_ZERO_BYTES;
constexpr size_t WS_B1PART = al4k(WS_MODP + (size_t)DEPTH * 8 * 6 * DM * 4);
constexpr size_t WS_B1P = al4k(WS_B1PART + (size_t)DEPTH * 2 * 32 * 256 * 4);
constexpr size_t WS_COS = al4k(WS_B1P + 2 * 256 * 4);
constexpr size_t WS_SIN = al4k(WS_COS + (size_t)S * 16 * 4);
constexpr size_t WS_GT = al4k(WS_SIN + (size_t)S * 16 * 4);
constexpr size_t WS_W2T = al4k(WS_GT + (size_t)S * 48 * 4);
constexpr size_t WS_KCI = al4k(WS_W2T + (size_t)DEPTH * 2 * 128 * 256 * 2);
constexpr size_t WS_VCI = al4k(WS_KCI + (size_t)NG * 16 * 16384);
constexpr size_t WS_HC = al4k(WS_VCI + (size_t)NG * 16 * 16384);
constexpr size_t WS_WL = al4k(WS_HC + (size_t)2 * 4096 * 256 * 2);
constexpr size_t WL_WIN = 0;
constexpr size_t WL_WCONV = WL_WIN + (size_t)PW * DM * 2;
constexpr size_t WL_W1T = WL_WCONV + (size_t)DM * CWID * 2;
constexpr size_t WL_WNSA = WL_W1T + (size_t)2 * 256 * 4096 * 2;
constexpr size_t WL_WOUT = WL_WNSA + (size_t)DM * DM * 2;
constexpr size_t WL_WUP = WL_WOUT + (size_t)DM * DM * 2;
constexpr size_t WL_WDOWN = WL_WUP + (size_t)FF * DM * 2;
constexpr size_t WL_BYTES = al4k(WL_WDOWN + (size_t)DM * FF * 2);
constexpr size_t WS_P = al4k(WS_WL + DEPTH * WL_BYTES);
constexpr size_t WS_U = WS_P;
constexpr size_t WS_Y = WS_P + (size_t)S * FF * 2;
constexpr size_t P_REGION = (size_t)S * PW * 2;
static_assert((size_t)S * FF * 2 + (size_t)S * DM * 4 <= P_REGION, "U + Y fit in P's region");
constexpr size_t WS_H = al4k(WS_P + P_REGION);
constexpr size_t WS_QP = al4k(WS_H + (size_t)S * DM * 2);
constexpr size_t WS_MG = WS_QP;
constexpr size_t WS_KSI = al4k(WS_QP + (size_t)S * DM * 2);
constexpr size_t WS_VSI = WS_KSI + (size_t)NG * 256 * 16384;
constexpr size_t WS_KWI = WS_VSI + (size_t)NG * 256 * 16384;
constexpr size_t WS_VWI = WS_KWI + (size_t)NG * 256 * 16384;
constexpr size_t WS_KCR = WS_VWI + (size_t)NG * 256 * 16384;
constexpr size_t WS_VCR = WS_KCR + (size_t)NG * S * HD * 2;
constexpr size_t WS_CV = al4k(WS_VCR + (size_t)NG * S * HD * 2 + 65536);
constexpr size_t WS_AO = al4k(WS_CV + (size_t)S * CWID * 2);
constexpr size_t WS_YA = al4k(WS_AO + (size_t)S * DM * 2);
constexpr size_t WS_FS = al4k(WS_YA + (size_t)S * DM * 2);
constexpr size_t WS_XB = al4k(WS_FS + (size_t)256 * 8 * 16384);
constexpr size_t WS_END = al4k(WS_XB + (size_t)S * DM * 2);

constexpr int CW_BAR = 4096;

constexpr int RING_BYTES = 131072;
constexpr int AT_KV = 0, AT_IMP = 65536, IMP_STRIDE = 257, AT_SELW = AT_IMP + 64 * IMP_STRIDE * 4;
constexpr int MISC_OFF = AT_SELW + NWAVES * 256 * 4;
constexpr int LDS_BYTES = 147456;
static_assert(MISC_OFF + 512 <= LDS_BYTES && MISC_OFF >= RING_BYTES, "LDS map");

typedef GAS unsigned gu32;
#define RLX_AGENT __ATOMIC_RELAXED, __HIP_MEMORY_SCOPE_AGENT
#define LDS_WAIT() asm volatile("s_waitcnt lgkmcnt(0)" ::: "memory")
#define VM_WAIT() asm volatile("s_waitcnt vmcnt(0)" ::: "memory")

#define XB_TMO      128
#define XB_XCNT(j)  (256  + 64 * (j))
#define XB_XSUB(j)  (1280 + 64 * (j))
#define XB_XGEN(j)  (2304 + 64 * (j))
#define XB_TOP      3328
#define XB_TOPGEN   3392
#define XCD_BAR_WORDS 3456
#define XB_SPIN_CAP (1u << 22)

__device__ __forceinline__ unsigned xb_ld(unsigned* p)              { return __hip_atomic_load(p, __ATOMIC_RELAXED, __HIP_MEMORY_SCOPE_AGENT); }
__device__ __forceinline__ unsigned xb_add(unsigned* p, unsigned v) { return __hip_atomic_fetch_add(p, v, __ATOMIC_RELAXED, __HIP_MEMORY_SCOPE_AGENT); }
__device__ __forceinline__ unsigned xb_xcc_id() { return (unsigned)__builtin_amdgcn_s_getreg((3 << 11) | 20) & 0xFu; }
#define XB_SPIN(cond, bar) do { unsigned _sp = 0; while (cond) { __builtin_amdgcn_s_sleep(1); \
    if ((++_sp & 255u) == 0u) { if (xb_ld(&(bar)[XB_TMO])) break; if (_sp > XB_SPIN_CAP) { atomicAdd(&(bar)[XB_TMO], 1u); break; } } } } while (0)

struct XcdBarrier { unsigned* bar; unsigned x; volatile LAS unsigned* st; };

__device__ __forceinline__ XcdBarrier xcd_barrier_post(unsigned* bar, volatile LAS unsigned* st) {
    XcdBarrier b; b.bar = bar; b.x = xb_xcc_id(); b.st = st;
    if (threadIdx.x == 0) (void)xb_add(&bar[XB_XCNT(b.x)], 1u);
    return b;
}
__device__ __forceinline__ void xcd_barrier_complete(unsigned* bar, unsigned x, unsigned& nloc, unsigned& nx) {
    const unsigned G = gridDim.x * gridDim.y * gridDim.z;
    unsigned sum, cnt, mine, sp = 0u;
    for (;;) {
        sum = 0u; cnt = 0u; mine = 0u;
#pragma unroll
        for (unsigned j = 0; j < 16; ++j) { const unsigned c = xb_ld(&bar[XB_XCNT(j)]); sum += c; cnt += (c > 0u) ? 1u : 0u; mine = (j == x) ? c : mine; }
        if (sum == G) break;
        __builtin_amdgcn_s_sleep(1);
        if ((++sp & 255u) == 0u) { if (xb_ld(&bar[XB_TMO])) break; if (sp > XB_SPIN_CAP) { atomicAdd(&bar[XB_TMO], 1u); break; } }
    }
    nloc = mine > 0u ? mine : 1u; nx = cnt > 0u ? cnt : 1u;
}
__device__ __forceinline__ void xcd_barrier(const XcdBarrier& b) {
    asm volatile("s_waitcnt vmcnt(0)" ::: "memory");
    __syncthreads();
    if (threadIdx.x == 0) {
        unsigned* bar = b.bar;
        __builtin_amdgcn_s_waitcnt(0);
        unsigned nloc = b.st[0], nx = b.st[1];
        if (nloc == 0u) { xcd_barrier_complete(bar, b.x, nloc, nx); b.st[0] = nloc; b.st[1] = nx; }
        const unsigned old = xb_add(&bar[XB_XSUB(b.x)], 1u);
        const unsigned gen = old / nloc;
        if (old + 1u == (gen + 1u) * nloc) {
            __builtin_amdgcn_fence(__ATOMIC_RELEASE, "agent");
            asm volatile("s_waitcnt vmcnt(0)" ::: "memory");
            const unsigned og = xb_add(&bar[XB_TOP], 1u);
            const unsigned tg = og / nx;
            if (og + 1u == (tg + 1u) * nx) xb_add(&bar[XB_TOPGEN], 1u);
            else XB_SPIN(xb_ld(&bar[XB_TOPGEN]) == tg, bar);
            __builtin_amdgcn_fence(__ATOMIC_ACQUIRE, "agent");
            xb_add(&bar[XB_XGEN(b.x)], 1u);
            asm volatile("s_waitcnt vmcnt(0)" ::: "memory");
        } else {
            XB_SPIN(xb_ld(&bar[XB_XGEN(b.x)]) == gen, bar);
            __builtin_amdgcn_fence(__ATOMIC_ACQUIRE, "agent");
            asm volatile("s_waitcnt vmcnt(0)" ::: "memory");
        }
    }
    __syncthreads();
}

__device__ __forceinline__ unsigned f2bf(float f) { unsigned u = __builtin_bit_cast(unsigned, f); return (u + 0x7fffu + ((u >> 16) & 1u)) >> 16; }
__device__ __forceinline__ unsigned pk2(float lo, float hi) { return f2bf(lo) | (f2bf(hi) << 16); }
__device__ __forceinline__ float bf_lo(unsigned w) { return __uint_as_float(w << 16); }
__device__ __forceinline__ float bf_hi(unsigned w) { return __uint_as_float(w & 0xffff0000u); }
__device__ __forceinline__ float wave_sum(float v) {
#pragma unroll
    for (int o = 1; o < 64; o <<= 1) v += __shfl_xor(v, o);
    return v;
}
__device__ __forceinline__ float sigm(float x) { return __builtin_amdgcn_rcpf(1.0f + __builtin_amdgcn_exp2f(-1.4426950408889634f * x)); }
__device__ __forceinline__ void unpack8(const u32x4 w, float (&v)[8]) {
    v[0] = bf_lo(w.x); v[1] = bf_hi(w.x); v[2] = bf_lo(w.y); v[3] = bf_hi(w.y); v[4] = bf_lo(w.z); v[5] = bf_hi(w.z); v[6] = bf_lo(w.w); v[7] = bf_hi(w.w);
}
__device__ __forceinline__ u32x4 pack8(const float (&v)[8]) { u32x4 w; w.x = pk2(v[0], v[1]); w.y = pk2(v[2], v[3]); w.z = pk2(v[4], v[5]); w.w = pk2(v[6], v[7]); return w; }

__device__ __forceinline__ int k_rho(int kappa) { const int a = kappa >> 5, q = (kappa >> 3) & 3, h = (kappa >> 2) & 1, i = kappa & 3; return 16 * (2 * a + h) + 4 * q + i; }
__device__ __forceinline__ int kimg_off(int kappa, int ch  ) { const int rho = k_rho(kappa); return rho * 256 + ((ch ^ (rho & 15)) << 4); }
__device__ __forceinline__ int vimg_off(int d, int kc  ) { return d * 128 + ((kc ^ ((d >> 1) & 7)) << 4); }

struct Ptrs {
    const float *x, *c, *ada_w, *ada_b, *gains, *w_in, *conv_w, *w_conv_out, *cmp_pe, *cmp_w1, *cmp_b1, *cmp_w2, *cmp_b2, *w_nsa, *w_out, *w_up, *w_down;
    const int* pos;
    float* out; unsigned char* ws;
};
struct Args { const void* in[18]; float* out; unsigned char* ws; int ph_lo, ph_hi; };
static_assert(sizeof(Args) == 18 * 8 + 8 + 8 + 8, "Args has no padding");

__device__ __forceinline__ void transpose_item(const float* W, int ldw, int csrc0, int nvalid, int K, bf16* WT, int drow0, int k0, LAS float* scr, int lane) {
    const int col = lane & 31;
#pragma unroll 8
    for (int i = 0; i < 32; ++i) { const int kk = 2 * i + (lane >> 5); scr[kk * 33 + col] = (col < nvalid) ? W[(size_t)(k0 + kk) * ldw + csrc0 + col] : 0.f; }
    LDS_WAIT(); asm volatile("" ::: "memory");
    const int c = lane & 7;
#pragma unroll
    for (int j = 0; j < 4; ++j) { const int n = (lane >> 3) + 8 * j; const LAS float* s = scr + (8 * c) * 33 + n;
        u32x4 o; o.x = pk2(s[0 * 33], s[1 * 33]); o.y = pk2(s[2 * 33], s[3 * 33]); o.z = pk2(s[4 * 33], s[5 * 33]); o.w = pk2(s[6 * 33], s[7 * 33]);
        *(GAS u32x4*)(WT + (size_t)(drow0 + n) * K + k0 + 8 * c) = o; }
    LDS_WAIT(); asm volatile("" ::: "memory");
}
__device__ __forceinline__ void seg_item(const float* W, int ldw, int c0, int ncols, int K, bf16* WT, int r0, int item, LAS float* scr, int lane) {
    const int nblk = (ncols + 31) / 32, kb = item / nblk, nb = item % nblk;
    const int nv = ncols - 32 * nb;
    transpose_item(W, ldw, c0 + 32 * nb, nv < 32 ? nv : 32, K, WT, r0 + 32 * nb, 64 * kb, scr, lane);
}

__constant__ double ROPE_INVF[16] = {1.0, 0.44036660267178046, 0.19392274474868576, 0.08539710028576561, 0.03760603093086393, 0.016560440080994446, 0.007292664737217109,
    0.003211445994752591, 0.001414213562373095, 0.000622772421914596, 0.0002742481756762073, 0.00012076973741146504, 5.318295896944988e-05, 2.341999896140934e-05,
    1.031338537721246e-05, 4.5416704806078695e-06};

__device__ __forceinline__ void sincos_f64(double x, float& sn, float& cs) {
    const double k = __builtin_rint(x * 0.6366197723675814);
    double r = __builtin_fma(-k, 1.5707963267948966, x); r = __builtin_fma(-k, 6.123233995736766e-17, r);
    const double r2 = r * r;
    double ps = -1.0 / 1307674368000.0; ps = ps * r2 + 1.0 / 6227020800.0; ps = ps * r2 - 1.0 / 39916800.0; ps = ps * r2 + 1.0 / 362880.0; ps = ps * r2 - 1.0 / 5040.0; ps = ps * r2 + 1.0 / 120.0; ps = ps * r2 - 1.0 / 6.0; ps = ps * r2 + 1.0;
    const double s = ps * r;
    double pc = 1.0 / 20922789888000.0; pc = pc * r2 - 1.0 / 87178291200.0; pc = pc * r2 + 1.0 / 479001600.0; pc = pc * r2 - 1.0 / 3628800.0; pc = pc * r2 + 1.0 / 40320.0; pc = pc * r2 - 1.0 / 720.0; pc = pc * r2 + 1.0 / 24.0; pc = pc * r2 - 0.5; pc = pc * r2 + 1.0;
    const int n = ((int)(long long)k) & 3;
    const double so = (n == 0) ? s : (n == 1) ? pc : (n == 2) ? -s : -pc;
    const double co = (n == 0) ? pc : (n == 1) ? -s : (n == 2) ? -pc : s;
    sn = (float)so; cs = (float)co;
}

constexpr int SEG_ITEMS[11] = {32 * 256, 32 * 64, 32 * 64, 32 * 2, 16 * 64, 64 * 8, 64 * 8, 32 * 64, 32 * 64, 32 * 256, 128 * 64};
constexpr int ITEMS_PER_LAYER = 8192 + 2048 + 2048 + 64 + 1024 + 512 + 512 + 2048 + 2048 + 8192 + 8192;
constexpr int W2T_ITEMS = 4 * 4;

__device__ __forceinline__ void p0_prologue(const Ptrs& P, LAS unsigned char* lds, int vcu, int G, int wave, int lane, int tid) {
    LAS float* scr = (LAS float*)(lds + wave * 16384);
    const int gw = vcu * NWAVES + wave, NGW = G * NWAVES;
    for (int it = gw; it < DEPTH * ITEMS_PER_LAYER; it += NGW) {
        const int l = it / ITEMS_PER_LAYER; int r = it % ITEMS_PER_LAYER;
        unsigned char* wl = P.ws + WS_WL + (size_t)l * WL_BYTES;
        const float* win = P.w_in + (size_t)l * DM * INW;
        if (r < SEG_ITEMS[0]) { seg_item(win, INW, 0, 8192, DM, (bf16*)(wl + WL_WIN), 0, r, scr, lane); continue; } r -= SEG_ITEMS[0];
        if (r < SEG_ITEMS[1]) { seg_item(win, INW, 8240, 2048, DM, (bf16*)(wl + WL_WIN), C_GA, r, scr, lane); continue; } r -= SEG_ITEMS[1];
        if (r < SEG_ITEMS[2]) { seg_item(win, INW, 10288, 2048, DM, (bf16*)(wl + WL_WIN), C_GB, r, scr, lane); continue; } r -= SEG_ITEMS[2];
        if (r < SEG_ITEMS[3]) { seg_item(win, INW, 8192, 48, DM, (bf16*)(wl + WL_WIN), C_GN, r, scr, lane); continue; } r -= SEG_ITEMS[3];
        if (r < SEG_ITEMS[4]) { seg_item(P.w_conv_out + (size_t)l * CWID * DM, DM, 0, DM, CWID, (bf16*)(wl + WL_WCONV), 0, r, scr, lane); continue; } r -= SEG_ITEMS[4];
        if (r < SEG_ITEMS[5]) { seg_item(P.cmp_w1 + (size_t)(l * 2 + 0) * 4096 * 256, 256, 0, 256, 4096, (bf16*)(wl + WL_W1T), 0, r, scr, lane); continue; } r -= SEG_ITEMS[5];
        if (r < SEG_ITEMS[6]) { seg_item(P.cmp_w1 + (size_t)(l * 2 + 1) * 4096 * 256, 256, 0, 256, 4096, (bf16*)(wl + WL_W1T) + (size_t)256 * 4096, 0, r, scr, lane); continue; } r -= SEG_ITEMS[6];
        if (r < SEG_ITEMS[7]) { seg_item(P.w_nsa + (size_t)l * DM * DM, DM, 0, DM, DM, (bf16*)(wl + WL_WNSA), 0, r, scr, lane); continue; } r -= SEG_ITEMS[7];
        if (r < SEG_ITEMS[8]) { seg_item(P.w_out + (size_t)l * DM * DM, DM, 0, DM, DM, (bf16*)(wl + WL_WOUT), 0, r, scr, lane); continue; } r -= SEG_ITEMS[8];
        if (r < SEG_ITEMS[9]) { seg_item(P.w_up + (size_t)l * DM * FF, FF, 0, FF, DM, (bf16*)(wl + WL_WUP), 0, r, scr, lane); continue; } r -= SEG_ITEMS[9];
        seg_item(P.w_down + (size_t)l * FF * DM, DM, 0, DM, FF, (bf16*)(wl + WL_WDOWN), 0, r, scr, lane);
    }
    for (int it = gw; it < DEPTH * 2 * W2T_ITEMS; it += NGW) {
        const int m = it / W2T_ITEMS, r = it % W2T_ITEMS;
        seg_item(P.cmp_w2 + (size_t)m * 256 * 128, 128, 0, 128, 256, (bf16*)(P.ws + WS_W2T) + (size_t)m * 128 * 256, 0, r, scr, lane);
    }
    __syncthreads();
    {
        float* cosT = (float*)(P.ws + WS_COS); float* sinT = (float*)(P.ws + WS_SIN);
        for (int e = vcu * 512 + tid; e < S * 16; e += G * 512) {
            const int t = e >> 4, i = e & 15; float sn, cs; sincos_f64((double)P.pos[t] * ROPE_INVF[i], sn, cs); cosT[e] = cs; sinT[e] = sn;
        }
    }
    {
        LAS float* cact = (LAS float*)lds;
        for (int k = tid; k < DM; k += 512) { const float cv = P.c[k]; cact[k] = cv * sigm(cv); }
        __syncthreads();
        float* modp = (float*)(P.ws + WS_MODP);
        for (int e = vcu * 512 + tid; e < DEPTH * 8 * (6 * DM / 4); e += G * 512) {
            const int l = e / (8 * 3072), rem = e % (8 * 3072), kc = rem / 3072, c4 = rem % 3072;
            const float* w = P.ada_w + ((size_t)l * DM + kc * 256) * (6 * DM) + c4 * 4;
            f32x4 acc = {0.f, 0.f, 0.f, 0.f};
#pragma unroll 8
            for (int k = 0; k < 256; ++k) { const f32x4 wv = *(const f32x4*)(w + (size_t)k * (6 * DM)); acc += wv * cact[kc * 256 + k]; }
            *(f32x4*)(modp + ((size_t)(l * 8 + kc) * (6 * DM)) + c4 * 4) = acc;
        }
        __syncthreads();
    }
    for (int w = vcu; w < DEPTH * 2 * 32; w += G) {
        const int m = w >> 5, ch = w & 31;
        if (tid < 256) {
            const float* pe = P.cmp_pe + (size_t)m * 4096 + ch * 128; const float* w1 = P.cmp_w1 + ((size_t)m * 4096 + ch * 128) * 256 + tid;
            float acc = 0.f;
#pragma unroll 8
            for (int k = 0; k < 128; ++k) acc += pe[k] * w1[(size_t)k * 256];
            ((float*)(P.ws + WS_B1PART))[(size_t)w * 256 + tid] = acc;
        }
    }
}

__device__ __forceinline__ f32x4 modvec4(const Ptrs& P, int l, int off) {
    f32x4 v = *(const f32x4*)(P.ada_b + (size_t)l * 6 * DM + off);
    const float* mp = (const float*)(P.ws + WS_MODP) + (size_t)l * 8 * 6 * DM + off;
#pragma unroll
    for (int kc = 0; kc < 8; ++kc) v += *(const f32x4*)(mp + (size_t)kc * 6 * DM);
    return v;
}

template <bool HAS_Y>
__device__ __forceinline__ void resid_phase(const Ptrs& P, LAS unsigned char* lds, const void* xsrc_, const bool src_bf, void* xdst_, const bool dst_bf, const bf16* Y, bf16* H, const bool make_h,
                                            int lg, int gate_k, int gainA, int lh, int sc_k, int sh_k, int gainB, int vcu, int G, int wave, int lane, int tid) {
    LAS f32x4* vga = (LAS f32x4*)lds; LAS f32x4* vhb = vga + 512; LAS f32x4* vhc = vhb + 512;
    {
        const int c = 4 * tid;
        if (HAS_Y) vga[tid] = modvec4(P, lg, gate_k * DM + c) * *(const f32x4*)(P.gains + (size_t)(lg * 4 + gainA) * DM + c);
        if (make_h) { vhb[tid] = *(const f32x4*)(P.gains + (size_t)(lh * 4 + gainB) * DM + c) * (modvec4(P, lh, sc_k * DM + c) + 1.0f); vhc[tid] = modvec4(P, lh, sh_k * DM + c); }
    }
    __syncthreads();
    const int gw = vcu * NWAVES + wave, NGW = G * NWAVES;
    for (int m = gw; m < S; m += NGW) {
        f32x4 xv[8];
        if (src_bf) { const u32x2* xr = (const u32x2*)((const bf16*)xsrc_ + (size_t)m * DM) + lane;
#pragma unroll
            for (int j = 0; j < 8; ++j) { const u32x2 w = xr[64 * j]; xv[j] = (f32x4){bf_lo(w.x), bf_hi(w.x), bf_lo(w.y), bf_hi(w.y)}; }
        } else { const f32x4* xr = (const f32x4*)((const float*)xsrc_ + (size_t)m * DM) + lane;
#pragma unroll
            for (int j = 0; j < 8; ++j) xv[j] = xr[64 * j]; }
        if (HAS_Y) {
            f32x4 yv[8]; float s = 0.f;
            const u32x2* yr = (const u32x2*)(Y + (size_t)m * DM) + lane;
#pragma unroll
            for (int j = 0; j < 8; ++j) { const u32x2 w = yr[64 * j]; yv[j] = (f32x4){bf_lo(w.x), bf_hi(w.x), bf_lo(w.y), bf_hi(w.y)}; s += (yv[j].x * yv[j].x + yv[j].y * yv[j].y) + (yv[j].z * yv[j].z + yv[j].w * yv[j].w); }
            const float r = 1.0f / sqrtf(wave_sum(s) * (1.0f / DM) + NORM_EPS);
#pragma unroll
            for (int j = 0; j < 8; ++j) xv[j] += vga[lane + 64 * j] * (yv[j] * r);
            if (dst_bf) { u32x2* xo = (u32x2*)((bf16*)xdst_ + (size_t)m * DM) + lane;
#pragma unroll
                for (int j = 0; j < 8; ++j) { u32x2 w; w.x = pk2(xv[j].x, xv[j].y); w.y = pk2(xv[j].z, xv[j].w); xo[64 * j] = w;
                    xv[j] = (f32x4){bf_lo(w.x), bf_hi(w.x), bf_lo(w.y), bf_hi(w.y)}; }
            } else { f32x4* xo = (f32x4*)((float*)xdst_ + (size_t)m * DM) + lane;
#pragma unroll
                for (int j = 0; j < 8; ++j) xo[64 * j] = xv[j]; }
        }
        if (make_h) {
            float s = 0.f;
#pragma unroll
            for (int j = 0; j < 8; ++j) s += (xv[j].x * xv[j].x + xv[j].y * xv[j].y) + (xv[j].z * xv[j].z + xv[j].w * xv[j].w);
            const float r = 1.0f / sqrtf(wave_sum(s) * (1.0f / DM) + NORM_EPS);
            u32x2* ho = (u32x2*)(H + (size_t)m * DM) + lane;
#pragma unroll
            for (int j = 0; j < 8; ++j) { const f32x4 h = (xv[j] * r) * vhb[lane + 64 * j] + vhc[lane + 64 * j]; u32x2 w; w.x = pk2(h.x, h.y); w.y = pk2(h.z, h.w); ho[64 * j] = w; }
        }
    }
    __syncthreads();
}

__device__ __forceinline__ void rope8(float (&v)[8], const float (&p)[8], const float* cs, const float* sn, int ch  ) {
#pragma unroll
    for (int j = 0; j < 8; ++j) { const float c = cs[8 * (ch & 1) + j], s = sn[8 * (ch & 1) + j];
        v[j] = (ch < 2) ? (v[j] * c - p[j] * s) : (v[j] * c + p[j] * s); }
}
__device__ __forceinline__ void relayout_phase(const Ptrs& P, int l, LAS unsigned char* lds, int vcu, int G, int tid) {
    const bf16* Pm = (const bf16*)(P.ws + WS_P);
    const float* cosT = (const float*)(P.ws + WS_COS); const float* sinT = (const float*)(P.ws + WS_SIN);
    if (vcu == 0) {
        const float* part = (const float*)(P.ws + WS_B1PART) + (size_t)l * 2 * 32 * 256;
        const int kv = tid >> 8, col = tid & 255; float a = P.cmp_b1[(size_t)(l * 2 + kv) * 256 + col];
        for (int ch = 0; ch < 32; ++ch) a += part[(size_t)(kv * 32 + ch) * 256 + col];
        ((float*)(P.ws + WS_B1P))[tid] = a;
    }
    for (int b = vcu; b < S / 64; b += G) {
        const int t0 = b * 64;
        {
            const float* cw = P.conv_w + (size_t)l * 3 * CWID; bf16* CV = (bf16*)(P.ws + WS_CV);
            for (int e = tid; e < 64 * 128; e += 512) {
                const int tl = e >> 7, c8 = (e & 127) * 8, t = t0 + tl;
                float z[8] = {0.f, 0.f, 0.f, 0.f, 0.f, 0.f, 0.f, 0.f};
#pragma unroll
                for (int k = 0; k < 3; ++k) { const int tt = t - 2 + k;
                    if (tt >= 0) { float cg[8], xa[8]; unpack8(*(const u32x4*)(Pm + (size_t)tt * PW + C_CG + c8), cg); unpack8(*(const u32x4*)(Pm + (size_t)tt * PW + C_XA + c8), xa);
                        const f32x4 w0 = *(const f32x4*)(cw + k * CWID + c8), w1 = *(const f32x4*)(cw + k * CWID + c8 + 4);
#pragma unroll
                        for (int j = 0; j < 8; ++j) z[j] += (j < 4 ? w0[j] : w1[j - 4]) * (cg[j] * xa[j]); } }
                float bg[8]; unpack8(*(const u32x4*)(Pm + (size_t)t * PW + C_BG + c8), bg);
#pragma unroll
                for (int j = 0; j < 8; ++j) z[j] *= bg[j];
                *(u32x4*)(CV + (size_t)t * CWID + c8) = pack8(z);
            }
        }
        {
            bf16* QP = (bf16*)(P.ws + WS_QP);
            for (int e = tid; e < 64 * 256; e += 512) {
                const int tl = e >> 8, hh = (e >> 4) & 15, ch = e & 15, t = t0 + tl;
                const bf16* src = Pm + (size_t)t * PW + C_Q + hh * HD;
                float v[8]; unpack8(*(const u32x4*)(src + 8 * ch), v);
                if (ch < 4) { float p[8]; unpack8(*(const u32x4*)(src + 8 * (ch ^ 2)), p); rope8(v, p, cosT + (size_t)t * 16, sinT + (size_t)t * 16, ch); }
#pragma unroll
                for (int j = 0; j < 8; ++j) v[j] *= QSCALE;
                *(u32x4*)(QP + (size_t)t * DM + hh * HD + 8 * ch) = pack8(v);
            }
        }
        for (int e = tid; e < 4 * 4 * 64 * 16; e += 512) {
            const int pi = e >> 12, g = (e >> 10) & 3, kap = (e >> 4) & 63, ch = e & 15, t = t0 + kap;
            const int part = (pi == 0) ? 0 : (pi == 1) ? 2 : (pi == 2) ? 4 : 1;
            const bf16* src = Pm + (size_t)t * PW + C_KV + part * 512 + g * HD;
            float v[8]; unpack8(*(const u32x4*)(src + 8 * ch), v);
            if (part != 1 && ch < 4) { float p[8]; unpack8(*(const u32x4*)(src + 8 * (ch ^ 2)), p); rope8(v, p, cosT + (size_t)t * 16, sinT + (size_t)t * 16, ch); }
            const u32x4 w = pack8(v);
            if (part == 0) *(u32x4*)((bf16*)(P.ws + WS_KCR) + ((size_t)g * S + t) * HD + 8 * ch) = w;
            else if (part == 1) *(u32x4*)((bf16*)(P.ws + WS_VCR) + ((size_t)g * S + t) * HD + 8 * ch) = w;
            else { unsigned char* img = P.ws + (part == 2 ? WS_KSI : WS_KWI) + ((size_t)g * 256 + b) * 16384; *(u32x4*)(img + kimg_off(kap, ch)) = w; }
        }
        for (int vp = 0; vp < 2; ++vp) {
            const int part = 3 + 2 * vp;
            LAS unsigned short* tile = (LAS unsigned short*)lds;
            for (int e = tid; e < 4 * 64 * 16; e += 512) {
                const int g = e >> 10, kap = (e >> 4) & 63, ch = e & 15;
                const u32x4 w = *(const u32x4*)(Pm + (size_t)(t0 + kap) * PW + C_KV + part * 512 + g * HD + 8 * ch);
                *(LAS u32x4*)(tile + (g * 64 + kap) * 136 + 8 * ch) = w;
            }
            __syncthreads();
            for (int e = tid; e < 4 * 128 * 8; e += 512) {
                const int g = e >> 10, d = (e >> 3) & 127, kc = e & 7;
                const LAS unsigned short* s = tile + (g * 64 + 8 * kc) * 136 + d;
                u32x4 w; w.x = (unsigned)s[0] | ((unsigned)s[136] << 16); w.y = (unsigned)s[2 * 136] | ((unsigned)s[3 * 136] << 16);
                w.z = (unsigned)s[4 * 136] | ((unsigned)s[5 * 136] << 16); w.w = (unsigned)s[6 * 136] | ((unsigned)s[7 * 136] << 16);
                unsigned char* img = P.ws + (part == 3 ? WS_VSI : WS_VWI) + ((size_t)g * 256 + b) * 16384;
                *(u32x4*)(img + vimg_off(d, kc)) = w;
            }
            __syncthreads();
        }
        {
            float* GT = (float*)(P.ws + WS_GT);
            const bf16* Hb = (const bf16*)(P.ws + WS_H); const bf16* Wg = (const bf16*)(P.ws + WS_WL + (size_t)l * WL_BYTES + WL_WIN) + (size_t)C_GN * DM;
            const int wv = tid >> 6, ln = tid & 63, r16 = ln & 15, q4 = ln >> 4, rt = wv & 3, ct0 = (wv < 4) ? 0 : 2, nct = (wv < 4) ? 2 : 1;
            f32x4 acc[2] = {(f32x4){0.f, 0.f, 0.f, 0.f}, (f32x4){0.f, 0.f, 0.f, 0.f}};
            const bf16* ap = Hb + (size_t)(t0 + rt * 16 + r16) * DM + 8 * q4;
            const bf16* bp0 = Wg + (size_t)(ct0 * 16 + r16) * DM + 8 * q4; const bf16* bp1 = bp0 + (size_t)16 * DM;
#pragma unroll 4
            for (int ks = 0; ks < DM / 32; ++ks) {
                const bf16x8 af = *(const bf16x8*)(ap + 32 * ks);
                acc[0] = __builtin_amdgcn_mfma_f32_16x16x32_bf16(af, *(const bf16x8*)(bp0 + 32 * ks), acc[0], 0, 0, 0);
                if (nct == 2) acc[1] = __builtin_amdgcn_mfma_f32_16x16x32_bf16(af, *(const bf16x8*)(bp1 + 32 * ks), acc[1], 0, 0, 0);
            }
#pragma unroll
            for (int c = 0; c < 2; ++c) if (c < nct) {
#pragma unroll
                for (int i = 0; i < 4; ++i) GT[(size_t)(t0 + rt * 16 + 4 * q4 + i) * 48 + (ct0 + c) * 16 + r16] = sigm(acc[c][i]); }
        }
    }
}

__device__ __forceinline__ void cmp2_phase(const Ptrs& P, int l, int vcu, int G, int wave, int lane) {
    const int r16 = lane & 15, q = lane >> 4;
    for (int e = vcu; e < 128; e += G) {
        const int kv = e >> 6, g = (e >> 4) & 3, blk = e & 15;
        const bf16* HC = (const bf16*)(P.ws + WS_HC) + ((size_t)kv * 4096 + g * 1024 + blk * 64) * 256;
        const bf16* W2T = (const bf16*)(P.ws + WS_W2T) + (size_t)(l * 2 + kv) * 128 * 256;
        const float* b2 = P.cmp_b2 + (size_t)(l * 2 + kv) * 128;
        const int rt = wave & 3, ch = wave >> 2;
        bf16x8 af[8];
#pragma unroll
        for (int ks = 0; ks < 8; ++ks) af[ks] = *(const bf16x8*)(HC + (size_t)(rt * 16 + r16) * 256 + 32 * ks + 8 * q);
        unsigned char* img = P.ws + (kv == 0 ? WS_KCI : WS_VCI) + ((size_t)g * 16 + blk) * 16384;
#pragma unroll
        for (int ct = 0; ct < 4; ++ct) {
            const int n = ch * 64 + ct * 16 + r16;
            f32x4 acc = {0.f, 0.f, 0.f, 0.f};
#pragma unroll
            for (int ks = 0; ks < 8; ++ks) { const bf16x8 bfr = *(const bf16x8*)(W2T + (size_t)n * 256 + 32 * ks + 8 * q);
                acc = __builtin_amdgcn_mfma_f32_16x16x32_bf16(af[ks], bfr, acc, 0, 0, 0); }
            const float bb = b2[n];
            if (kv == 0) {
#pragma unroll
                for (int i = 0; i < 4; ++i) { const int kap = rt * 16 + 4 * q + i; *(bf16*)(img + kimg_off(kap, n >> 3) + (n & 7) * 2) = (bf16)f2bf(acc[i] + bb); }
            } else {
                const int kap0 = rt * 16 + 4 * q; u32x2 w; w.x = pk2(acc[0] + bb, acc[1] + bb); w.y = pk2(acc[2] + bb, acc[3] + bb);
                *(u32x2*)(img + vimg_off(n, kap0 >> 3) + (kap0 & 7) * 2) = w;
            }
        }
    }
}

#ifndef DBG_REP_SEL
#define DBG_REP_SEL 1
#endif
#ifndef DBG_BR
#define DBG_BR 7
#endif
#ifndef DBG_SANITIZE
#define DBG_SANITIZE 0
#endif
#ifndef DBG_DENSE_SEL
#define DBG_DENSE_SEL 0
#endif
struct AttnLane { unsigned kb, vb; int kx, vx; int q; };
#define AL_KOFF(L_, s_) ((L_).kb + 64u * (unsigned)((s_) ^ (L_).kx))
#define AL_VOFF(L_, a_) ((L_).vb + 64u * (unsigned)((a_) ^ (L_).vx))

__device__ __forceinline__ bf16x8 pack_p(const f32x4 a, const f32x4 b) {
    u32x4 w; w.x = pg8::cvt_pk_bf16(a[0], a[1]); w.y = pg8::cvt_pk_bf16(a[2], a[3]); w.z = pg8::cvt_pk_bf16(b[0], b[1]); w.w = pg8::cvt_pk_bf16(b[2], b[3]);
    return __builtin_bit_cast(bf16x8, w);
}
__device__ __forceinline__ void lds_fadd(LAS float* p, float v) { (void)__hip_atomic_fetch_add(p, v, __ATOMIC_RELAXED, __HIP_MEMORY_SCOPE_WORKGROUP); }
template <int CTRL> __device__ __forceinline__ unsigned dpp_u_(unsigned v) { return (unsigned)__builtin_amdgcn_update_dpp(0, (int)v, CTRL, 0xF, 0xF, false); }
__device__ __forceinline__ unsigned wave_umax(unsigned v) {
    v = max(v, dpp_u_<0xB1>(v)); v = max(v, dpp_u_<0x4E>(v)); v = max(v, dpp_u_<0x141>(v)); v = max(v, dpp_u_<0x140>(v));
    auto r16 = __builtin_amdgcn_permlane16_swap(v, v, false, false); v = max(r16[0], r16[1]);
    auto r32 = __builtin_amdgcn_permlane32_swap(v, v, false, false); return max(r32[0], r32[1]);
}
__device__ __forceinline__ unsigned wave_umin(unsigned v) {
    v = min(v, dpp_u_<0xB1>(v)); v = min(v, dpp_u_<0x4E>(v)); v = min(v, dpp_u_<0x141>(v)); v = min(v, dpp_u_<0x140>(v));
    auto r16 = __builtin_amdgcn_permlane16_swap(v, v, false, false); v = min(r16[0], r16[1]);
    auto r32 = __builtin_amdgcn_permlane32_swap(v, v, false, false); return min(r32[0], r32[1]);
}
__device__ __forceinline__ float quad_sum(float v) {
    v += __builtin_bit_cast(float, __builtin_amdgcn_update_dpp(0, __builtin_bit_cast(int, v), 0xB1, 0xF, 0xF, false));
    v += __builtin_bit_cast(float, __builtin_amdgcn_update_dpp(0, __builtin_bit_cast(int, v), 0x4E, 0xF, 0xF, false));
    return v;
}
__device__ __forceinline__ void ldsr128(bf16x8& d, unsigned addr) { asm volatile("ds_read_b128 %0, %1" : "=v"(d) : "v"(addr)); }
__device__ __forceinline__ void ldsr128o(bf16x8& d, unsigned addr, const int off) { asm volatile("ds_read_b128 %0, %1 offset:%2" : "=v"(d) : "v"(addr), "i"(off)); }
#define LDS_WAIT4(n, a, b, c, d) asm volatile("s_waitcnt lgkmcnt(" #n ")" : "+v"(a), "+v"(b), "+v"(c), "+v"(d))
template <bool T0, bool T1, int MODE>
__device__ __forceinline__ void block_step(LAS const unsigned char* Kb, LAS const unsigned char* Vb, const AttnLane& L, const bf16x8 (&qf)[2][4],
                                           f32x4 (&O)[2][8], float (&m)[2], float (&l)[2], const int (&limq)[2], const unsigned W,
                                           const float (&invl)[2], LAS float* const (&improw)[2], const int j0, const bool hzero, const bool MASKB) {
    AttnLane Lq = L; asm volatile("" : "+v"(Lq.kb), "+v"(Lq.vb));
    f32x4 st[2][4];
    const f32x4 z = {0.f, 0.f, 0.f, 0.f};
    {
        __builtin_amdgcn_s_setprio(1);
        const unsigned kbase = (unsigned)(uintptr_t)Kb;
        unsigned ka[4];
#pragma unroll
        for (int s = 0; s < 4; ++s) ka[s] = kbase + AL_KOFF(Lq, s);
        bf16x8 fa[4], fb[4];
#pragma unroll
        for (int s = 0; s < 4; ++s) ldsr128(fa[s], ka[s]);
#pragma unroll
        for (int kt = 0; kt < 4; ++kt) {
            if (kt < 3) {
#pragma unroll
                for (int s = 0; s < 4; ++s) { if ((kt & 1) == 0) ldsr128o(fb[s], ka[s], (kt + 1) * 4096); else ldsr128o(fa[s], ka[s], (kt + 1) * 4096); }
            }
            if ((kt & 1) == 0) { if (kt < 3) LDS_WAIT4(4, fa[0], fa[1], fa[2], fa[3]); else LDS_WAIT4(0, fa[0], fa[1], fa[2], fa[3]); }
            else               { if (kt < 3) LDS_WAIT4(4, fb[0], fb[1], fb[2], fb[3]); else LDS_WAIT4(0, fb[0], fb[1], fb[2], fb[3]); }
#pragma unroll
            for (int s = 0; s < 4; ++s) { const bf16x8 a = ((kt & 1) == 0) ? fa[s] : fb[s];
                if (T0) st[0][kt] = __builtin_amdgcn_mfma_f32_16x16x32_bf16(a, qf[0][s], s == 0 ? z : st[0][kt], 0, 0, 0);
                if (T1) st[1][kt] = __builtin_amdgcn_mfma_f32_16x16x32_bf16(a, qf[1][s], s == 0 ? z : st[1][kt], 0, 0, 0); }
        }
    }
    __builtin_amdgcn_s_setprio(0);
    bf16x8 pf[2][2];
#pragma unroll
    for (int ts = 0; ts < 2; ++ts) {
        if (!(ts == 0 ? T0 : T1)) continue;
        const float NEG = -__builtin_inff();
        if (MASKB) {
#pragma unroll
        for (int kt = 0; kt < 4; ++kt)
#pragma unroll
            for (int i = 0; i < 4; ++i) { const int kc = 32 * (kt >> 1) + 4 * (kt & 1) + i; if ((unsigned)(limq[ts] - kc) >= W) st[ts][kt][i] = NEG; }
        }
        if (MODE != 1) {
            float mx = fmaxf(fmaxf(st[ts][0][0], st[ts][0][1]), fmaxf(st[ts][0][2], st[ts][0][3]));
#pragma unroll
            for (int kt = 1; kt < 4; ++kt) mx = fmaxf(mx, fmaxf(fmaxf(st[ts][kt][0], st[ts][kt][1]), fmaxf(st[ts][kt][2], st[ts][kt][3])));
            { auto r16 = __builtin_amdgcn_permlane16_swap(__float_as_uint(mx), __float_as_uint(mx), false, false); mx = fmaxf(__uint_as_float(r16[0]), __uint_as_float(r16[1]));
              auto r32 = __builtin_amdgcn_permlane32_swap(__float_as_uint(mx), __float_as_uint(mx), false, false); mx = fmaxf(__uint_as_float(r32[0]), __uint_as_float(r32[1])); }
            const float mn = fmaxf(m[ts], mx), alpha = __builtin_amdgcn_exp2f(m[ts] - mn); m[ts] = mn;
            float sum = 0.f;
#pragma unroll
            for (int kt = 0; kt < 4; ++kt)
#pragma unroll
                for (int i = 0; i < 4; ++i) { const float pv = __builtin_amdgcn_exp2f(st[ts][kt][i] - mn); st[ts][kt][i] = pv; sum += pv; }
            l[ts] = l[ts] * alpha + sum;
            if (MODE == 2) {
#pragma unroll
                for (int dt = 0; dt < 8; ++dt) O[ts][dt] *= alpha;
            }
        } else {
#pragma unroll
            for (int kt = 0; kt < 4; ++kt)
#pragma unroll
                for (int i = 0; i < 4; ++i) st[ts][kt][i] = __builtin_amdgcn_exp2f(st[ts][kt][i] - m[ts]) * invl[ts];
            float A[4], B[4];
#pragma unroll
            for (int kt = 0; kt < 4; ++kt) { B[kt] = 0.5f * st[ts][kt][3]; A[kt] = quad_sum((st[ts][kt][0] + st[ts][kt][1]) + (st[ts][kt][2] + B[kt])); B[kt] = quad_sum(B[kt]); }
            if (hzero) { LAS float* ir = improw[ts] + j0;
                lds_fadd(ir + 0, A[0]); lds_fadd(ir + 1, B[0] + A[1]); lds_fadd(ir + 2, B[1]); lds_fadd(ir + 8, A[2]); lds_fadd(ir + 9, B[2] + A[3]); lds_fadd(ir + 10, B[3]); }
        }
        if (MODE != 0) { pf[ts][0] = pack_p(st[ts][0], st[ts][1]); pf[ts][1] = pack_p(st[ts][2], st[ts][3]); }
    }
    if (MODE != 0) {
        __builtin_amdgcn_s_setprio(1);
        const unsigned vbase = (unsigned)(uintptr_t)Vb;
        unsigned va[2];
#pragma unroll
        for (int a = 0; a < 2; ++a) va[a] = vbase + AL_VOFF(Lq, a);
        bf16x8 fa[4], fb[4];
#pragma unroll
        for (int j = 0; j < 4; ++j) ldsr128o(fa[j], va[j & 1], (j >> 1) * 2048);
#pragma unroll
        for (int dp = 0; dp < 4; ++dp) {
            if (dp < 3) {
#pragma unroll
                for (int j = 0; j < 4; ++j) { if ((dp & 1) == 0) ldsr128o(fb[j], va[j & 1], (2 * (dp + 1) + (j >> 1)) * 2048); else ldsr128o(fa[j], va[j & 1], (2 * (dp + 1) + (j >> 1)) * 2048); }
            }
            if ((dp & 1) == 0) { if (dp < 3) LDS_WAIT4(4, fa[0], fa[1], fa[2], fa[3]); else LDS_WAIT4(0, fa[0], fa[1], fa[2], fa[3]); }
            else               { if (dp < 3) LDS_WAIT4(4, fb[0], fb[1], fb[2], fb[3]); else LDS_WAIT4(0, fb[0], fb[1], fb[2], fb[3]); }
#pragma unroll
            for (int j = 0; j < 4; ++j) { const bf16x8 v = ((dp & 1) == 0) ? fa[j] : fb[j]; const int dt = 2 * dp + (j >> 1), a = j & 1;
                if (T0) O[0][dt] = __builtin_amdgcn_mfma_f32_16x16x32_bf16(v, pf[0][a], O[0][dt], 0, 0, 0);
                if (T1) O[1][dt] = __builtin_amdgcn_mfma_f32_16x16x32_bf16(v, pf[1][a], O[1][dt], 0, 0, 0); }
        }
        __builtin_amdgcn_s_setprio(0);
    }
}


constexpr float ATT_THR = 8.0f;
__device__ __forceinline__ float max3f_(float a, float b, float c) { return fmaxf(fmaxf(a, b), c); }
template <bool T0, bool T1>
__device__ __forceinline__ void step_online(LAS const unsigned char* Kb, LAS const unsigned char* Vb, const AttnLane& L, const bf16x8 (&qf)[2][4],
                                            f32x4 (&O)[2][8], float (&mref)[2], float (&l)[2], const int (&limq)[2], const unsigned W, const bool MASK, const bool START) {
    AttnLane Lq = L; asm volatile("" : "+v"(Lq.kb), "+v"(Lq.vb));
    f32x4 st[2][4];
    const float NEG = -__builtin_inff();
#pragma unroll
    for (int ts = 0; ts < 2; ++ts) { const float c0 = START ? 0.f : (limq[ts] > -500 ? -mref[ts] : NEG);
#pragma unroll
        for (int kt = 0; kt < 4; ++kt) st[ts][kt] = (f32x4){c0, c0, c0, c0}; }
    {
        __builtin_amdgcn_s_setprio(1);
        const unsigned kbase = (unsigned)(uintptr_t)Kb;
        unsigned ka[4];
#pragma unroll
        for (int s = 0; s < 4; ++s) ka[s] = kbase + AL_KOFF(Lq, s);
        bf16x8 fa[4], fb[4];
#pragma unroll
        for (int s = 0; s < 4; ++s) ldsr128(fa[s], ka[s]);
#pragma unroll
        for (int kt = 0; kt < 4; ++kt) {
            if (kt < 3) {
#pragma unroll
                for (int s = 0; s < 4; ++s) { if ((kt & 1) == 0) ldsr128o(fb[s], ka[s], (kt + 1) * 4096); else ldsr128o(fa[s], ka[s], (kt + 1) * 4096); }
            }
            if ((kt & 1) == 0) { if (kt < 3) LDS_WAIT4(4, fa[0], fa[1], fa[2], fa[3]); else LDS_WAIT4(0, fa[0], fa[1], fa[2], fa[3]); }
            else               { if (kt < 3) LDS_WAIT4(4, fb[0], fb[1], fb[2], fb[3]); else LDS_WAIT4(0, fb[0], fb[1], fb[2], fb[3]); }
#pragma unroll
            for (int s = 0; s < 4; ++s) { const bf16x8 a = ((kt & 1) == 0) ? fa[s] : fb[s];
                if (T0) st[0][kt] = __builtin_amdgcn_mfma_f32_16x16x32_bf16(a, qf[0][s], st[0][kt], 0, 0, 0);
                if (T1) st[1][kt] = __builtin_amdgcn_mfma_f32_16x16x32_bf16(a, qf[1][s], st[1][kt], 0, 0, 0); }
        }
    }
    __builtin_amdgcn_s_setprio(0);
    __builtin_amdgcn_sched_barrier(0);
    bf16x8 pf[2][2];
#pragma unroll
    for (int ts = 0; ts < 2; ++ts) {
        if (!(ts == 0 ? T0 : T1)) continue;
        if (MASK || START) {
#pragma unroll
            for (int kt = 0; kt < 4; ++kt)
#pragma unroll
                for (int i = 0; i < 4; ++i) { const int kc = 32 * (kt >> 1) + 4 * (kt & 1) + i; if ((unsigned)(limq[ts] - kc) >= W) st[ts][kt][i] = NEG; }
        }
        float mx = max3f_(st[ts][0][0], st[ts][0][1], st[ts][0][2]);
        mx = max3f_(mx, st[ts][0][3], st[ts][1][0]); mx = max3f_(mx, st[ts][1][1], st[ts][1][2]); mx = max3f_(mx, st[ts][1][3], st[ts][2][0]);
        mx = max3f_(mx, st[ts][2][1], st[ts][2][2]); mx = max3f_(mx, st[ts][2][3], st[ts][3][0]); mx = max3f_(mx, st[ts][3][1], st[ts][3][2]); mx = fmaxf(mx, st[ts][3][3]);
#define XLANE_MAX_(v_) do { auto r16 = __builtin_amdgcn_permlane16_swap(__float_as_uint(v_), __float_as_uint(v_), false, false); v_ = fmaxf(__uint_as_float(r16[0]), __uint_as_float(r16[1])); \
          auto r32 = __builtin_amdgcn_permlane32_swap(__float_as_uint(v_), __float_as_uint(v_), false, false); v_ = fmaxf(__uint_as_float(r32[0]), __uint_as_float(r32[1])); } while (0)
        if (START) {
            XLANE_MAX_(mx);
            const float m0 = fmaxf(mx, -1.0e4f); mref[ts] = m0;
#pragma unroll
            for (int kt = 0; kt < 4; ++kt) st[ts][kt] -= m0;
        } else if (__builtin_expect(__any(mx > ATT_THR), 0)) {
            XLANE_MAX_(mx);
            const float dl = fmaxf(mx, 0.f), f = __builtin_amdgcn_exp2f(-dl); mref[ts] += dl; l[ts] *= f;
#pragma unroll
            for (int kt = 0; kt < 4; ++kt) st[ts][kt] -= dl;
#pragma unroll
            for (int dt = 0; dt < 8; ++dt) O[ts][dt] *= f;
        }
        float sum = 0.f;
#pragma unroll
        for (int kt = 0; kt < 4; ++kt)
#pragma unroll
            for (int i = 0; i < 4; ++i) { const float pv = __builtin_amdgcn_exp2f(st[ts][kt][i]); st[ts][kt][i] = pv; sum += pv; }
        l[ts] += sum;
        pf[ts][0] = pack_p(st[ts][0], st[ts][1]); pf[ts][1] = pack_p(st[ts][2], st[ts][3]);
        __builtin_amdgcn_sched_barrier(0);
    }
    {
        __builtin_amdgcn_s_setprio(1);
        const unsigned vbase = (unsigned)(uintptr_t)Vb;
        unsigned va[2];
#pragma unroll
        for (int a = 0; a < 2; ++a) va[a] = vbase + AL_VOFF(Lq, a);
        bf16x8 fa[4], fb[4];
#pragma unroll
        for (int j = 0; j < 4; ++j) ldsr128o(fa[j], va[j & 1], (j >> 1) * 2048);
#pragma unroll
        for (int dp = 0; dp < 4; ++dp) {
            if (dp < 3) {
#pragma unroll
                for (int j = 0; j < 4; ++j) { if ((dp & 1) == 0) ldsr128o(fb[j], va[j & 1], (2 * (dp + 1) + (j >> 1)) * 2048); else ldsr128o(fa[j], va[j & 1], (2 * (dp + 1) + (j >> 1)) * 2048); }
            }
            if ((dp & 1) == 0) { if (dp < 3) LDS_WAIT4(4, fa[0], fa[1], fa[2], fa[3]); else LDS_WAIT4(0, fa[0], fa[1], fa[2], fa[3]); }
            else               { if (dp < 3) LDS_WAIT4(4, fb[0], fb[1], fb[2], fb[3]); else LDS_WAIT4(0, fb[0], fb[1], fb[2], fb[3]); }
#pragma unroll
            for (int j = 0; j < 4; ++j) { const bf16x8 v = ((dp & 1) == 0) ? fa[j] : fb[j]; const int dt = 2 * dp + (j >> 1), a = j & 1;
                if (T0) O[0][dt] = __builtin_amdgcn_mfma_f32_16x16x32_bf16(v, pf[0][a], O[0][dt], 0, 0, 0);
                if (T1) O[1][dt] = __builtin_amdgcn_mfma_f32_16x16x32_bf16(v, pf[1][a], O[1][dt], 0, 0, 0); }
        }
        __builtin_amdgcn_s_setprio(0);
    }
    __builtin_amdgcn_sched_barrier(0);
}
__device__ __forceinline__ void glds16(const void* gsrc, unsigned lds_dst) { unsigned keep;
    asm volatile("s_mov_b32 %0, m0\n\ts_mov_b32 m0, %2\n\ts_nop 0\n\tglobal_load_lds_dwordx4 %1, off\n\ts_mov_b32 m0, %0" : "=&s"(keep) : "v"(gsrc), "s"(lds_dst) : "memory"); }

__device__ __forceinline__ void glds16s(const void* sbase, unsigned voff, unsigned lds_dst) { unsigned keep;
    asm volatile("s_mov_b32 %0, m0\n\ts_mov_b32 m0, %3\n\ts_nop 0\n\tglobal_load_lds_dwordx4 %1, %2\n\ts_mov_b32 m0, %0" : "=&s"(keep) : "v"(voff), "s"(sbase), "s"(lds_dst) : "memory"); }

#define AT_BAR() do { asm volatile("s_waitcnt lgkmcnt(0)" ::: "memory"); __builtin_amdgcn_s_barrier(); asm volatile("" ::: "memory"); } while (0)
#define AT_STAGE(gsrc, ldsoff) do { unsigned _lo = (unsigned)lane * 16u; asm volatile("" : "+v"(_lo)); _Pragma("unroll") for (int _p = 0; _p < 2; ++_p) \
    glds16s((gsrc) + (_p * 8 + wave) * 1024, _lo, (unsigned)__builtin_amdgcn_readfirstlane((int)(ldsb + (unsigned)(ldsoff) + (unsigned)(_p * 8 + wave) * 1024u))); } while (0)
#define AT_WAITV(n) asm volatile("s_waitcnt vmcnt(" #n ")" ::: "memory")

__device__ __forceinline__ void attn_phase(const Ptrs& P, LAS unsigned char* lds, int vcu, int G, int wave, int lane) {
    const unsigned ldsb = (unsigned)(uintptr_t)lds;
    const bf16* QP = (const bf16*)(P.ws + WS_QP);
    const float* GT = (const float*)(P.ws + WS_GT);
    bf16* AO = (bf16*)(P.ws + WS_AO);
    LAS float* impw = (LAS float*)(lds + AT_IMP) + 8 * wave * IMP_STRIDE;
    LAS unsigned* selw = (LAS unsigned*)(lds + AT_SELW) + wave * 256;
#define AT_REGION() int ln_ = lane; asm volatile("" : "+v"(ln_)); const int c16 = ln_ & 15, q = ln_ >> 4, hh = c16 & 3, tq = c16 >> 2; AttnLane L; L.q = q; \
    L.kb = (unsigned)(c16 * 256 + (((q ^ c16) & 3) << 4)); L.kx = (c16 >> 2) & 3; L.vb = (unsigned)(c16 * 128 + (((q ^ (c16 >> 1)) & 3) << 4)); L.vx = (c16 >> 3) & 1; \
    const bool hzero = (hh == 0); const int tok0 = t0 + 8 * wave + tq; (void)hzero; (void)tok0; (void)L
#define tok_(ts_) (tok0 + 4 * (ts_))
#define GATE(ts_, br_) (GT[(size_t)tok_(ts_) * 48 + (4 * g + hh) * 3 + (br_)])
#define FSAT(k_) (*(f32x4*)(FSb + (fo_ + (unsigned)(k_) * 1024u)))
#define FS_OFF() unsigned fo_ = (unsigned)ln_ * 16u

    for (int e = vcu; e < 1024; e += G) {
        const int k4 = e >> 8, v = e & 255, xcd = v >> 5, g = xcd & 3, hi2 = xcd >> 2, j = v & 31;
        const int stepk = hi2 ? ((k4 == 0) ? 6 : (k4 == 1) ? 5 : (k4 == 2) ? 2 : 1) : ((k4 == 0) ? 7 : (k4 == 1) ? 4 : (k4 == 2) ? 3 : 0);
        const int tile = 32 * stepk + ((k4 & 1) ? 31 - j : j);
        const int t0 = tile * 64;
        unsigned char* FSb = P.ws + WS_FS + ((size_t)((vcu & 255) * 8 + wave)) * 16384;
        bf16x8 qf[2][4];
        f32x4 O[2][8];
        float l[2] = {0.f, 0.f};
        int limq[2];
        {
            AT_REGION();
#pragma unroll
            for (int ts = 0; ts < 2; ++ts) {
#pragma unroll
                for (int s = 0; s < 4; ++s) qf[ts][s] = *(const bf16x8*)(QP + (size_t)tok_(ts) * DM + (4 * g + hh) * HD + 32 * s + 8 * q);
            }
            for (int i = ln_; i < 8 * IMP_STRIDE; i += 64) impw[i] = 0.f;
            for (int i = ln_; i < 256; i += 64) selw[i] = 0u;
#pragma unroll
            for (int ts = 0; ts < 2; ++ts)
#pragma unroll
                for (int dt = 0; dt < 8; ++dt) O[ts][dt] = (f32x4){0.f, 0.f, 0.f, 0.f};
            float m[2] = {-1e30f, -1e30f}, invl[2] = {0.f, 0.f};
            LAS float* improw[2]; improw[0] = impw + tq * IMP_STRIDE; improw[1] = impw + (4 + tq) * IMP_STRIDE;
            VM_WAIT(); LDS_WAIT();
            const int nbc = (DBG_BR & 1) ? ((4 * tile + 2) >> 6) + 1 : 0;
            const unsigned char* kci = P.ws + WS_KCI + (size_t)g * 16 * 16384; const unsigned char* vci = P.ws + WS_VCI + (size_t)g * 16 * 16384;
            if (DBG_BR & 1) AT_STAGE(kci, AT_KV);
            for (int b = 0; b < nbc; ++b) {
                const int buf = (b & 1) * 32768;
                if (b + 1 < nbc) { AT_STAGE(kci + (size_t)(b + 1) * 16384, AT_KV + (buf ^ 32768)); AT_WAITV(2); }
                else AT_WAITV(0);
                AT_BAR();
#pragma unroll
                for (int ts = 0; ts < 2; ++ts) limq[ts] = ((tok_(ts) - 31) >> 4) - 64 * b - 8 * q;
                block_step<true, true, 0>(lds + AT_KV + buf, lds + AT_KV + buf + 16384, L, qf, O, m, l, limq, 0x80000000u, invl, improw, 0, hzero, b + 2 >= nbc);
                AT_BAR();
            }
#pragma unroll
            for (int ts = 0; ts < 2; ++ts) { float lt = l[ts]; lt += __shfl_xor(lt, 16); lt += __shfl_xor(lt, 32); invl[ts] = lt > 0.f ? 1.0f / lt : 0.f; }
            if (DBG_BR & 1) { AT_STAGE(kci, AT_KV); AT_STAGE(vci, AT_KV + 16384); }
            for (int b = 0; b < nbc; ++b) {
                const int buf = (b & 1) * 32768;
                if (b + 1 < nbc) { AT_STAGE(kci + (size_t)(b + 1) * 16384, AT_KV + (buf ^ 32768)); AT_STAGE(vci + (size_t)(b + 1) * 16384, AT_KV + (buf ^ 32768) + 16384); AT_WAITV(4); }
                else AT_WAITV(0);
                AT_BAR();
#pragma unroll
                for (int ts = 0; ts < 2; ++ts) limq[ts] = ((tok_(ts) - 31) >> 4) - 64 * b - 8 * q;
                block_step<true, true, 1>(lds + AT_KV + buf, lds + AT_KV + buf + 16384, L, qf, O, m, l, limq, 0x80000000u, invl, improw, 16 * b + 2 * q, hzero, b + 2 >= nbc);
                AT_BAR();
            }
            FS_OFF();
#pragma unroll
            for (int ts = 0; ts < 2; ++ts)
#pragma unroll
                for (int dt = 0; dt < 8; ++dt) FSAT(ts * 8 + dt) = O[ts][dt] * GATE(ts, 0);
        }
        LDS_WAIT();
        {
            const int Ksel = (!(DBG_BR & 2) || DBG_DENSE_SEL >= 2) ? 0 : (tile - 1) < 14 ? (tile - 1) : 14;
            int lane_k = lane; asm volatile("" : "+v"(lane_k));
            unsigned wsel[4] = {0u, 0u, 0u, 0u};
            bool cand[4];
#pragma unroll
            for (int e4 = 0; e4 < 4; ++e4) { const int jj = lane_k + 64 * e4; cand[e4] = (jj >= 1 && jj <= tile - 1); }
            if (Ksel > 0) {
                const bool all_sel = (tile - 1) <= 14;
                for (int tl = 0; tl < 8; ++tl) {
                    const LAS float* row = impw + tl * IMP_STRIDE;
                    unsigned val[4];
#pragma unroll
                    for (int e4 = 0; e4 < 4; ++e4) val[e4] = cand[e4] ? __float_as_uint(row[lane_k + 64 * e4]) : 0u;
                    bool sel[4];
                    if (all_sel) {
#pragma unroll
                        for (int e4 = 0; e4 < 4; ++e4) sel[e4] = cand[e4];
                    } else {
                        unsigned vmx = max(max(val[0], val[1]), max(val[2], val[3]));
                        unsigned vmn = min(min(cand[0] ? val[0] : 0xffffffffu, cand[1] ? val[1] : 0xffffffffu), min(cand[2] ? val[2] : 0xffffffffu, cand[3] ? val[3] : 0xffffffffu));
                        vmx = wave_umax(vmx); vmn = wave_umin(vmn);
                        const unsigned dif = (unsigned)__builtin_amdgcn_readfirstlane((int)(vmx ^ vmn));
                        const int hb = 31 - __builtin_clz(dif | 1u);
                        unsigned cur = (unsigned)__builtin_amdgcn_readfirstlane((int)vmx) & ~((2u << hb) - 1u);
                        for (int bit = (dif == 0u ? -1 : (hb > 30 ? 30 : hb)); bit >= 0; --bit) {
                            asm volatile("" : "+s"(cur), "+s"(bit));
                            const unsigned t = cur | (1u << bit); int cnt = 0;
#pragma unroll
                            for (int e4 = 0; e4 < 4; ++e4) cnt += __popcll(__builtin_amdgcn_uicmp(val[e4], t, 35  ));
                            if (cnt >= Ksel) cur = t;
                            if (cnt == Ksel) break;
                        }
                        int cgt = 0;
#pragma unroll
                        for (int e4 = 0; e4 < 4; ++e4) cgt += __popcll(__ballot(cand[e4] && val[e4] > cur));
                        const int need = Ksel - cgt; int prev = 0;
#pragma unroll
                        for (int e4 = 0; e4 < 4; ++e4) { const bool eq = cand[e4] && val[e4] == cur; const unsigned long long be = __ballot(eq);
                            const int rank = prev + (int)__builtin_amdgcn_mbcnt_hi((unsigned)(be >> 32), __builtin_amdgcn_mbcnt_lo((unsigned)be, 0u));
                            sel[e4] = (cand[e4] && val[e4] > cur) || (eq && rank < need); prev += __popcll(be); }
                    }
#pragma unroll
                    for (int e4 = 0; e4 < 4; ++e4) wsel[e4] |= sel[e4] ? (1u << tl) : 0u;
                }
            }
#pragma unroll
            for (int e4 = 0; e4 < 4; ++e4) { const int jj = lane_k + 64 * e4; if (jj == 0 || jj == tile) wsel[e4] = 0xffu; selw[jj] = wsel[e4]; }
            LDS_WAIT();
#if DBG_DENSE_SEL == 1
            for (int i = lane_k; i <= tile; i += 64) selw[i] = 0xffu;
            LDS_WAIT();
#elif DBG_DENSE_SEL == 4
            for (int i = lane_k; i <= tile; i += 64) selw[i] = (i == 0 || i >= tile - 14) ? 0xffu : 0u;
            LDS_WAIT();
#endif
        }
        float mref[2] = {0.f, 0.f};
#define AT_RING_LOOP(NB, KSRC, VSRC, PRE, ...) do { \
            const int nb_ = (NB); \
            _Pragma("unroll") for (int pb_ = 0; pb_ < 3; ++pb_) { if ((PRE) && pb_ == 2) AT_BAR(); \
                if (pb_ < nb_) { AT_STAGE((KSRC) + (size_t)pb_ * 16384, pb_ * 32768); AT_STAGE((VSRC) + (size_t)pb_ * 16384, pb_ * 32768 + 16384); } } \
            int bufo = 0, bufn = 98304; \
            for (int b = 0; b < nb_; ++b) { \
                const int ahead_ = nb_ - 1 - b; \
                if (ahead_ >= 2) AT_WAITV(8); else if (ahead_ == 1) AT_WAITV(4); else AT_WAITV(0); \
                AT_BAR(); \
                if (b + 3 < nb_) { AT_STAGE((KSRC) + (size_t)(b + 3) * 16384, bufn); AT_STAGE((VSRC) + (size_t)(b + 3) * 16384, bufn + 16384); } \
                LAS const unsigned char* Kb_ = lds + bufo; LAS const unsigned char* Vb_ = lds + bufo + 16384; \
                __VA_ARGS__ \
                bufo = (bufo == 98304) ? 0 : bufo + 32768; bufn = (bufn == 98304) ? 0 : bufn + 32768; \
            } \
            AT_BAR(); } while (0)
#define AT_DRIFT_LOOP(NB, KSRC, VSRC, ...) do { \
            const int nb_ = (NB); \
            volatile LAS unsigned* ldc_ = (volatile LAS unsigned*)(lds + MISC_OFF) + 32; \
            if (wave == 0 && ln_ < 4) ldc_[ln_] = 0u; \
            _Pragma("unroll") for (int pb_ = 0; pb_ < 2; ++pb_) if (pb_ < nb_) { AT_STAGE((KSRC) + (size_t)pb_ * 16384, pb_ * 32768); AT_STAGE((VSRC) + (size_t)pb_ * 16384, pb_ * 32768 + 16384); } \
            AT_BAR();                                                     \
            if (nb_ >= 2) AT_WAITV(4); else AT_WAITV(0); \
            if (ln_ == 0) (void)__hip_atomic_fetch_add((LAS unsigned*)ldc_, 1u, __ATOMIC_RELAXED, __HIP_MEMORY_SCOPE_WORKGROUP); \
            unsigned swn_ = (unsigned)__builtin_amdgcn_readfirstlane((int)selw[0]); \
            _Pragma("clang loop unroll(disable)") for (int b = 0; b < nb_; ++b) { \
                volatile LAS unsigned* lp_ = ldc_ + (b & 3); \
                const unsigned pr0_ = *lp_;                                                             \
                const unsigned swv_ = *(volatile LAS unsigned*)(selw + (b + 1 < 256 ? b + 1 : 255)); \
                if (b + 1 < nb_) { AT_WAITV(0); if (ln_ == 0) (void)__hip_atomic_fetch_add((LAS unsigned*)ldc_ + ((b + 1) & 3), 1u, __ATOMIC_RELAXED, __HIP_MEMORY_SCOPE_WORKGROUP); } \
                { const unsigned need_ = 8u * (unsigned)((b >> 2) + 1); unsigned pr_ = (unsigned)__builtin_amdgcn_readfirstlane((int)pr0_); \
                  while (pr_ < need_) { __builtin_amdgcn_s_sleep(1); pr_ = (unsigned)__builtin_amdgcn_readfirstlane((int)*lp_); } } \
                const unsigned sw = swn_; swn_ = (unsigned)__builtin_amdgcn_readfirstlane((int)swv_); \
                asm volatile("" ::: "memory"); \
                if (b + 2 < nb_) { const int sl_ = ((b + 2) & 3) * 32768; AT_STAGE((KSRC) + (size_t)(b + 2) * 16384, sl_); AT_STAGE((VSRC) + (size_t)(b + 2) * 16384, sl_ + 16384); } \
                LAS const unsigned char* Kb_ = lds + (b & 3) * 32768; LAS const unsigned char* Vb_ = Kb_ + 16384; \
                __VA_ARGS__ \
            } \
            AT_BAR(); } while (0)
        {
            AT_REGION();
            for (int rp_ = 0; rp_ < DBG_REP_SEL; ++rp_) {
#pragma unroll
            for (int ts = 0; ts < 2; ++ts) { l[ts] = 0.f; mref[ts] = 0.f;
#pragma unroll
                for (int dt = 0; dt < 8; ++dt) O[ts][dt] = (f32x4){0.f, 0.f, 0.f, 0.f}; }
            if (DBG_BR & 2) {
                const unsigned char* ksi = P.ws + WS_KSI + (size_t)g * 256 * 16384; const unsigned char* vsi = P.ws + WS_VSI + (size_t)g * 256 * 16384;
                VM_WAIT();
                AT_DRIFT_LOOP(tile + 1, ksi, vsi, {
                    _Pragma("unroll") for (int ts = 0; ts < 2; ++ts) limq[ts] = ((sw >> (4 * ts + tq)) & 1u) ? (tok_(ts) - 64 * b - 8 * q) : -1000;
                    const bool a0 = (sw & 0x0fu) != 0u, a1 = (sw & 0xf0u) != 0u;
                    const bool msk = (b == 0) || (b == tile);
                    if (a0) step_online<true, false>(Kb_, Vb_, L, qf, O, mref, l, limq, 0x80000000u, msk, b == 0);
                    if (a1) step_online<false, true>(Kb_, Vb_, L, qf, O, mref, l, limq, 0x80000000u, msk, b == 0);
                });
            }
            }
            FS_OFF();
#pragma unroll
            for (int ts = 0; ts < 2; ++ts) { float lt = l[ts]; lt += __shfl_xor(lt, 16); lt += __shfl_xor(lt, 32); const float sc = (DBG_BR & 2) ? GATE(ts, 1) / lt : 0.f;
#pragma unroll
                for (int dt = 0; dt < 8; ++dt) { FSAT(ts * 8 + dt) += O[ts][dt] * sc; if ((dt & 3) == 3) asm volatile("" ::: "memory"); } }
            VM_WAIT();
        }
        {
            AT_REGION();
#pragma unroll
            for (int ts = 0; ts < 2; ++ts) { l[ts] = 0.f;
#pragma unroll
                for (int dt = 0; dt < 8; ++dt) O[ts][dt] = (f32x4){0.f, 0.f, 0.f, 0.f}; }
            if (DBG_BR & 4) {
                const int b0 = tile >= 8 ? tile - 8 : 0;
                const unsigned char* kwi = P.ws + WS_KWI + ((size_t)g * 256 + b0) * 16384; const unsigned char* vwi = P.ws + WS_VWI + ((size_t)g * 256 + b0) * 16384;
                AT_RING_LOOP(tile - b0 + 1, kwi, vwi, false, {
                    _Pragma("unroll") for (int ts = 0; ts < 2; ++ts) limq[ts] = tok_(ts) - 64 * (b0 + b) - 8 * q;
                    step_online<true, true>(Kb_, Vb_, L, qf, O, mref, l, limq, 512u, (b == 0) || (b0 + b == tile), b == 0);
                });
            }
            FS_OFF();
#pragma unroll
            for (int ts = 0; ts < 2; ++ts) { float lt = l[ts]; lt += __shfl_xor(lt, 16); lt += __shfl_xor(lt, 32); const float sc = (DBG_BR & 4) ? GATE(ts, 2) / lt : 0.f;
                bf16* orow = AO + (size_t)tok_(ts) * DM + (4 * g + hh) * HD + 4 * q;
#pragma unroll
                for (int dt = 0; dt < 8; ++dt) { const f32x4 o = FSAT(ts * 8 + dt) + O[ts][dt] * sc;
                    u32x2 w; w.x = pk2(o[0], o[1]); w.y = pk2(o[2], o[3]); *(u32x2*)(orow + 16 * dt) = w; if ((dt & 3) == 3) asm volatile("" ::: "memory"); } }
        }
    }
#undef AT_REGION
#undef AT_RING_LOOP
#undef AT_DRIFT_LOOP
}

#ifndef DBG_CHECK
#define DBG_CHECK 0
#endif
#if DBG_CHECK
__device__ __forceinline__ float p_bf(const bf16* Pm, int t, int col) { return __uint_as_float((unsigned)Pm[(size_t)t * PW + col] << 16); }
__device__ __forceinline__ float roped(const bf16* Pm, const float* cosT, const float* sinT, int t, int colbase, int d) {
    const float x = p_bf(Pm, t, colbase + d);
    if (d >= 32) return x;
    const int i = d & 15; const float c = cosT[(size_t)t * 16 + i], sn = sinT[(size_t)t * 16 + i];
    return (d < 16) ? x * c - p_bf(Pm, t, colbase + d + 16) * sn : x * c + p_bf(Pm, t, colbase + d - 16) * sn;
}
__constant__ int TSAMP[28] = {0, 1, 5, 30, 31, 32, 47, 63, 64, 65, 100, 127, 128, 191, 200, 255, 300, 511, 512, 575, 1023, 1024, 1025, 2047, 4096, 8191, 12345, 16383};
__device__ __forceinline__ void attn_check(const Ptrs& P, int l, LAS unsigned char* lds, int vcu, int G, int tid, unsigned* flagword) {
    const int NS = 28;
    const bf16* Pm = (const bf16*)(P.ws + WS_P); const bf16* AO = (const bf16*)(P.ws + WS_AO);
    const float* cosT = (const float*)(P.ws + WS_COS); const float* sinT = (const float*)(P.ws + WS_SIN);
    LAS float* q = (LAS float*)lds;
    LAS float* blk = q + 512;
    LAS float* hh_ = blk + 4096;
    LAS float* kc = hh_ + 256;
    LAS float* vc = kc + 2048;
    LAS float* sc = vc + 2048;
    LAS float* fin = sc + 4096;
    LAS float* imp = fin + 512;
    LAS int* selb = (LAS int*)(imp + 256);
    LAS unsigned* red = (LAS unsigned*)(selb + 16);
    for (int item = vcu; item < NS * 4; item += G) {
        const int s = item >> 2, g = item & 3, t = TSAMP[s];
        const int cur = t >> 6;
        { const int r = tid >> 7, d = tid & 127; q[tid] = __uint_as_float((unsigned)((const bf16*)(P.ws + WS_QP))[(size_t)t * DM + (4 * g + r) * HD + d] << 16) * 0.6931471805599453f; fin[tid] = 0.f; }
        if (tid < 2) red[tid] = 0u;
        if (tid < 256) imp[tid] = 0.f;
        __syncthreads();
        const int nmax = (t - 31) >> 4;
        const bool small = t < 256;
        const unsigned char* kci = P.ws + WS_KCI + (size_t)g * 16 * 16384; const unsigned char* vci = P.ws + WS_VCI + (size_t)g * 16 * 16384;
        if (small) {
        for (int kv = 0; kv < 2; ++kv)
            for (int n = 0; n <= nmax; ++n) {
                for (int e = tid; e < 4096; e += 512) { const int l_ = e >> 7, d = e & 127, tok = 16 * n + l_;
                    const float x = (kv == 0) ? roped(Pm, cosT, sinT, tok, C_KV + 0 * 512 + g * HD, d) : p_bf(Pm, tok, C_KV + 1 * 512 + g * HD + d);
                    blk[e] = x + P.cmp_pe[((size_t)(l * 2 + kv) * 32 + l_) * 128 + d]; }
                __syncthreads();
                if (tid < 256) { const float* w1 = P.cmp_w1 + (size_t)(l * 2 + kv) * 4096 * 256 + tid; float a = P.cmp_b1[(size_t)(l * 2 + kv) * 256 + tid];
                    for (int e = 0; e < 4096; ++e) a += blk[e] * w1[(size_t)e * 256];
                    hh_[tid] = 0.5f * a * (1.0f + tanhf(0.7978845608028654f * (a + 0.044715f * a * a * a))); }
                __syncthreads();
                if (tid < 128) { const float* w2 = P.cmp_w2 + (size_t)(l * 2 + kv) * 256 * 128 + tid; float a = P.cmp_b2[(size_t)(l * 2 + kv) * 128 + tid];
                    for (int c = 0; c < 256; ++c) a += hh_[c] * w2[(size_t)c * 128];
                    (kv == 0 ? kc : vc)[n * 128 + tid] = a; }
                __syncthreads();
            }
        }
#define KC_AT(n, d) (small ? kc[(n) * 128 + (d)] : __uint_as_float((unsigned)*(const bf16*)(kci + (size_t)((n) >> 6) * 16384 + kimg_off((n) & 63, (d) >> 3) + ((d) & 7) * 2) << 16))
#define VC_AT(n, d) (small ? vc[(n) * 128 + (d)] : __uint_as_float((unsigned)*(const bf16*)(vci + (size_t)((n) >> 6) * 16384 + vimg_off((d), ((n) & 63) >> 3) + ((n) & 7) * 2) << 16))
        if (nmax >= 0) {
            for (int e = tid; e < 4 * 1024; e += 512) { const int r = e >> 10, n = e & 1023; float a = -1e30f;
                if (n <= nmax) { a = 0.f; for (int d = 0; d < 128; ++d) a += q[r * 128 + d] * KC_AT(n, d); } sc[e] = a; }
            __syncthreads();
            float mx = -1e30f, den = 0.f;
            { const int r = tid >> 7, d = tid & 127; for (int n = 0; n <= nmax; ++n) mx = fmaxf(mx, sc[r * 1024 + n]);
              float num = 0.f; for (int n = 0; n <= nmax; ++n) { const float p = expf(sc[r * 1024 + n] - mx); den += p; num += p * VC_AT(n, d); }
              if (DBG_BR & 1) fin[tid] += sigm(p_bf(Pm, t, C_GN + (4 * g + r) * 3 + 0)) * num / den; }
            __syncthreads();
            { const int r = tid >> 7; for (int n = (tid & 127); n <= nmax; n += 128) sc[r * 1024 + n] = expf(sc[r * 1024 + n] - mx) / den; }
            __syncthreads();
            if (tid <= cur) { const int j = tid; float a = 0.f;
                for (int r = 0; r < 4; ++r) for (int u = -1; u <= 3; ++u) { const int n = 4 * j + u; if (n >= 0 && n <= nmax) a += sc[r * 1024 + n] * ((u == -1 || u == 3) ? 0.5f : 1.0f); }
                imp[j] = a; }
            __syncthreads();
        }
        if (tid == 0) { int ns = 0; selb[ns++] = 0; if (cur > 0) selb[ns++] = cur;
            for (int rnd = 0; rnd < 14; ++rnd) { int bj = -1; float bv = -1.f;
                for (int j = 1; j < cur; ++j) { bool taken = false; for (int k = 0; k < ns; ++k) taken |= (selb[k] == j); if (!taken && imp[j] > bv) { bv = imp[j]; bj = j; } }
                if (bj < 0) break; selb[ns++] = bj; }
            for (; ns < 16; ++ns) selb[ns] = -1; }
        __syncthreads();
        if (DBG_BR & 2) {
            const int kcol = C_KV + 2 * 512 + g * HD, vcol = C_KV + 3 * 512 + g * HD;
            for (int e = tid; e < 4 * 1024; e += 512) { const int r = e >> 10, k = e & 1023, bsel = selb[k >> 6], kp = bsel * 64 + (k & 63); float a = -1e30f;
                if (bsel >= 0 && kp <= t) { a = 0.f; for (int d = 0; d < 128; ++d) a += q[r * 128 + d] * roped(Pm, cosT, sinT, kp, kcol, d); }
                sc[e] = a; }
            __syncthreads();
            { const int r = tid >> 7, d = tid & 127; float mx = -1e30f; for (int k = 0; k < 1024; ++k) mx = fmaxf(mx, sc[r * 1024 + k]);
              float den = 0.f, num = 0.f; for (int k = 0; k < 1024; ++k) { const float sv = sc[r * 1024 + k]; if (sv > -1e29f) { const float p = expf(sv - mx); den += p; num += p * p_bf(Pm, selb[k >> 6] * 64 + (k & 63), vcol + d); } }
              fin[tid] += sigm(p_bf(Pm, t, C_GN + (4 * g + r) * 3 + 1)) * num / den; }
            __syncthreads();
        }
        if (DBG_BR & 4) {
            const int kcol = C_KV + 4 * 512 + g * HD, vcol = C_KV + 5 * 512 + g * HD;
            for (int e = tid; e < 4 * 512; e += 512) { const int r = e >> 9, kp = t - (e & 511); float a = -1e30f;
                if (kp >= 0) { a = 0.f; for (int d = 0; d < 128; ++d) a += q[r * 128 + d] * roped(Pm, cosT, sinT, kp, kcol, d); }
                sc[r * 1024 + (e & 511)] = a; }
            __syncthreads();
            { const int r = tid >> 7, d = tid & 127; float mx = -1e30f; for (int k = 0; k < 512; ++k) mx = fmaxf(mx, sc[r * 1024 + k]);
              float den = 0.f, num = 0.f; for (int k = 0; k < 512; ++k) { const float sv = sc[r * 1024 + k]; if (sv > -1e29f) { const float p = expf(sv - mx); den += p; num += p * p_bf(Pm, t - k, vcol + d); } }
              fin[tid] += sigm(p_bf(Pm, t, C_GN + (4 * g + r) * 3 + 2)) * num / den; }
            __syncthreads();
        }
        { const int r = tid >> 7, d = tid & 127; const float ao = __uint_as_float((unsigned)AO[(size_t)t * DM + (4 * g + r) * HD + d] << 16);
          const float err = fabsf(fin[tid] - ao), mag = fabsf(fin[tid]);
          atomicMax((unsigned*)&red[0], __float_as_uint(err)); atomicMax((unsigned*)&red[1], __float_as_uint(mag)); }
        __syncthreads();
        if (tid == 0) { const float err = __uint_as_float(red[0]), mag = __uint_as_float(red[1]); if (!(err <= 0.03f * mag + 2e-3f)) atomicOr(flagword, 1u << s); }
        __syncthreads();
    }
#undef KC_AT
#undef VC_AT
}
#endif


#if DBG_CHECK
__constant__ int RSAMP[8] = {0, 1, 63, 64, 255, 256, 4097, 16383};
__device__ __forceinline__ int csamp(int ci, int N) { return ci == 63 ? N - 1 : (int)(((unsigned)ci * (unsigned)(N / 64) + ((unsigned)ci * 7u) % 61u) % (unsigned)N); }
__device__ __forceinline__ float bfv(const bf16* p, size_t i) { return __uint_as_float((unsigned)p[i] << 16); }
__device__ __forceinline__ float mod_naive(const Ptrs& P, int l, int k, int c) {
    float a = P.ada_b[(size_t)l * 6 * DM + k * DM + c];
    for (int j = 0; j < DM; ++j) { const float cv = P.c[j]; a += cv / (1.0f + expf(-cv)) * P.ada_w[((size_t)l * DM + j) * 6 * DM + k * DM + c]; }
    return a;
}
__device__ __forceinline__ void flag_if(bool bad, unsigned* flagword, int bit) { if (bad) { atomicOr(flagword, 1u << bit); if (bit == 4) { atomicMax(flagword + 1, 0xffffffffu - (unsigned)threadIdx.x); atomicAdd(flagword + 2, 1u); } } }
__device__ __forceinline__ bool mism(float got, float exp_) { return !(fabsf(got - exp_) <= 0.02f * fabsf(exp_) + 0.02f); }
__device__ __forceinline__ void main_check(const Ptrs& P, int which, int tid, unsigned* flagword) {
    const int l = 0, row = RSAMP[tid >> 6], ci = tid & 63;
    const bf16* Pm = (const bf16*)(P.ws + WS_P); const bf16* H = (const bf16*)(P.ws + WS_H); const float* Y = (const float*)(P.ws + WS_Y);
    if (which == 1 || which == 7) {
        const int c = csamp(ci, DM);
        const float* xr = (which == 1 ? P.x : P.out) + (size_t)row * DM;
        if (which == 7) {
            float ss = 0.f; for (int j = 0; j < DM; ++j) { const float y = Y[(size_t)row * DM + j]; ss += y * y; }
            const float e = P.x[(size_t)row * DM + c] + mod_naive(P, l, 2, c) * P.gains[(size_t)(l * 4 + 1) * DM + c] * Y[(size_t)row * DM + c] / sqrtf(ss / DM + NORM_EPS);
            flag_if(mism(xr[c], e), flagword, 16 + which);
        }
        float ss = 0.f; for (int j = 0; j < DM; ++j) ss += xr[j] * xr[j];
        const int gi = which == 1 ? 0 : 2, sck = which == 1 ? 1 : 4, shk = which == 1 ? 0 : 3;
        const float e = xr[c] / sqrtf(ss / DM + NORM_EPS) * P.gains[(size_t)(l * 4 + gi) * DM + c] * (1.0f + mod_naive(P, l, sck, c)) + mod_naive(P, l, shk, c);
        flag_if(mism(bfv(H, (size_t)row * DM + c), e), flagword, which);
    } else if (which == 2) {
        const int pc = (ci < 60) ? csamp(ci, 12288) : 12288 + (ci - 60) * 15;
        const int src = pc < 8192 ? pc : pc < 10240 ? 8240 + (pc - 8192) : pc < 12288 ? 10288 + (pc - 10240) : 8192 + (pc - 12288);
        float a = 0.f; for (int k = 0; k < DM; ++k) a += bfv(H, (size_t)row * DM + k) * P.w_in[((size_t)l * DM + k) * INW + src];
        flag_if(mism(bfv(Pm, (size_t)row * PW + pc), a), flagword, which);
    } else if (which == 3) {
        const int c = csamp(ci, CWID); float z = 0.f;
        for (int k = 0; k < 3; ++k) { const int tt = row - 2 + k; if (tt >= 0) z += P.conv_w[(size_t)l * 3 * CWID + k * CWID + c] * bfv(Pm, (size_t)tt * PW + C_CG + c) * bfv(Pm, (size_t)tt * PW + C_XA + c); }
        flag_if(mism(bfv((const bf16*)(P.ws + WS_CV), (size_t)row * CWID + c), z * bfv(Pm, (size_t)row * PW + C_BG + c)), flagword, which);
    } else if (which == 4) {
        const int c = csamp(ci, DM); const bf16* CV = (const bf16*)(P.ws + WS_CV);
        float a = 0.f; for (int k = 0; k < CWID; ++k) a += bfv(CV, (size_t)row * CWID + k) * P.w_conv_out[((size_t)l * CWID + k) * DM + c];
        flag_if(mism(bfv((const bf16*)(P.ws + WS_YA), (size_t)row * DM + c), a * sigm(bfv(Pm, (size_t)row * PW + C_GA + c))), flagword, which);
    } else if (which == 5 && row < 10000) {
        const int c = csamp(ci, DM); const bf16* AO = (const bf16*)(P.ws + WS_AO);
        float a = 0.f; for (int k = 0; k < DM; ++k) a += bfv(AO, (size_t)row * DM + k) * P.w_nsa[((size_t)l * DM + k) * DM + c];
        flag_if(mism(bfv((const bf16*)(P.ws + WS_MG), (size_t)row * DM + c), bfv((const bf16*)(P.ws + WS_YA), (size_t)row * DM + c) + a * sigm(bfv(Pm, (size_t)row * PW + C_GB + c))), flagword, which);
    } else if (which == 6) {
        const int c = csamp(ci, DM); const bf16* MG = (const bf16*)(P.ws + WS_MG);
        float a = 0.f; for (int k = 0; k < DM; ++k) a += bfv(MG, (size_t)row * DM + k) * P.w_out[((size_t)l * DM + k) * DM + c];
        flag_if(mism(Y[(size_t)row * DM + c], a), flagword, which);
    } else if (which == 8) {
        const int f = csamp(ci, FF);
        float a = 0.f; for (int k = 0; k < DM; ++k) a += bfv(H, (size_t)row * DM + k) * P.w_up[((size_t)l * DM + k) * FF + f];
        a = fmaxf(a, 0.f); flag_if(mism(bfv((const bf16*)(P.ws + WS_U), (size_t)row * FF + f), a * a), flagword, which);
    } else if (which == 9) {
        const int c = csamp(ci, DM); const bf16* U = (const bf16*)(P.ws + WS_U);
        float a = 0.f; for (int k = 0; k < FF; ++k) a += bfv(U, (size_t)row * FF + k) * P.w_down[((size_t)l * FF + k) * DM + c];
        flag_if(mism(Y[(size_t)row * DM + c], a), flagword, which);
    }
}
#define MAIN_CHECK(w) do { if (l == 0 && bx == 0) main_check(P, (w), OPQ_TID(), ctl + 64); } while (0)
#else
#define MAIN_CHECK(w) do { } while (0)
#endif
constexpr int NPH = 11;
constexpr int N_PHASES = 2 + DEPTH * NPH;
#ifndef DBG_CHECK_LAYER
#define DBG_CHECK_LAYER 0
#endif
#ifndef DBG_SKIP_ATTN
#define DBG_SKIP_ATTN 0
#endif
#ifndef DUP_MASK
#define DUP_MASK 0
#endif
#define DUPN(t) (1 + ((DUP_MASK >> (t)) & 1))
#ifndef MK_PER_PHASE
#define MK_PER_PHASE 0
#endif

__global__ void __launch_bounds__(NWAVES * 64, 2) nsa_fwd(Args args) {
    extern __shared__ __attribute__((aligned(16))) unsigned char lds_raw[];
    LAS unsigned char* lds = (LAS unsigned char*)lds_raw;
    const int tid = threadIdx.x, lane = tid & 63, wave = __builtin_amdgcn_readfirstlane(tid >> 6);
    const int G = gridDim.x; const int bx = blockIdx.x; const int vcu = (G % 8 == 0) ? (bx % 8) * (G / 8) + bx / 8 : bx;
    volatile LAS unsigned* MISC = (volatile LAS unsigned*)(lds + MISC_OFF);
    for (int u = tid; u < 128; u += NWAVES * 64) MISC[u] = 0u;
    __syncthreads();
    unsigned* ctl = (unsigned*)(args.ws + WS_CTL);
    XcdBarrier bar = xcd_barrier_post(ctl + CW_BAR, MISC + 8);
    const int lo = args.ph_lo, hi = args.ph_hi; (void)lo; (void)hi;
#ifndef ONLY_PHASE
#define ONLY_PHASE -1
#endif
#define PH_EN(t) (ONLY_PHASE < 0 || ONLY_PHASE == (t))
#if MK_PER_PHASE
#define IN(k) (lo <= (k) && (k) < hi)
#else
#define IN(k) true
#endif
#define LOADP() const Args GAS_K* ap_ = (const Args GAS_K*)__builtin_amdgcn_kernarg_segment_ptr(); asm volatile("" : "+s"(ap_)); Ptrs P; \
    P.x = (const float*)ap_->in[0]; P.c = (const float*)ap_->in[1]; P.pos = (const int*)ap_->in[2]; P.ada_w = (const float*)ap_->in[3]; P.ada_b = (const float*)ap_->in[4]; \
    P.gains = (const float*)ap_->in[5]; P.w_in = (const float*)ap_->in[6]; P.conv_w = (const float*)ap_->in[7]; P.w_conv_out = (const float*)ap_->in[8]; P.cmp_pe = (const float*)ap_->in[9]; \
    P.cmp_w1 = (const float*)ap_->in[10]; P.cmp_b1 = (const float*)ap_->in[11]; P.cmp_w2 = (const float*)ap_->in[12]; P.cmp_b2 = (const float*)ap_->in[13]; P.w_nsa = (const float*)ap_->in[14]; \
    P.w_out = (const float*)ap_->in[15]; P.w_up = (const float*)ap_->in[16]; P.w_down = (const float*)ap_->in[17]; P.out = ap_->out; P.ws = ap_->ws; \
    bf16* H = (bf16*)(P.ws + WS_H); bf16* Y = (bf16*)(P.ws + WS_Y); unsigned char* wl = P.ws + WS_WL + (size_t)l_ * WL_BYTES; const bf16* Pm = (const bf16*)(P.ws + WS_P); (void)H; (void)Y; (void)wl; (void)Pm
#define OPQ_S(x) ({ int _v = (x); asm volatile("" : "+s"(_v)); _v; })
#define OPQ_TID() ({ int _l; asm volatile("v_mbcnt_lo_u32_b32 %0, -1, 0\n\tv_mbcnt_hi_u32_b32 %0, -1, %0" : "=v"(_l)); int _t = (OPQ_S(wave) << 6) | _l; _t; })
#if MK_PER_PHASE
#define SEAM(k) do { } while (0)
#else
#define SEAM(k) do { if (IN((k) + 1) && rep_ + 1 == nrep_) xcd_barrier(bar); } while (0)
#endif

    { const int l_ = 0; (void)l_;
    if (PH_EN(0) && IN(0)) for (int rep_ = 0, nrep_ = (DUPN(0)); rep_ < nrep_; ++rep_) { LOADP(); { const int t_ = OPQ_TID(); p0_prologue(P, lds, OPQ_S(vcu), OPQ_S(G), OPQ_S(wave), t_ & 63, t_); } SEAM(0); }
    if (PH_EN(1) && IN(1)) for (int rep_ = 0, nrep_ = (1); rep_ < nrep_; ++rep_) { LOADP(); resid_phase<false>(P, lds, P.x, false, nullptr, false, nullptr, H, true, 0, 0, 0,  0,  1,  0,  0, OPQ_S(vcu), OPQ_S(G), OPQ_S(wave), OPQ_TID() & 63, OPQ_TID()); SEAM(1); }

    }
    for (int l = 0; l < DEPTH; ++l) {
        const int pb = 2 + l * NPH; const int l_ = l;
        if (PH_EN(2) && IN(pb + 0)) for (int rep_ = 0, nrep_ = (DUPN(2)); rep_ < nrep_; ++rep_) { LOADP();
            MAIN_CHECK(1);
            pg8::Gemm g{H, (const bf16*)(wl + WL_WIN), S, C_GN, DM, DM}; pg8::StaticOrder So; So.init(S, C_GN, OPQ_S(G), OPQ_S(bx), pg8::WGM_PROJ);
            pg8::EpiB<0> E{(bf16*)(P.ws + WS_P), PW, nullptr, nullptr, 0, nullptr, 0};
            pg8::gemm_phase<pg8::EpiB<0>, pg8::StaticOrder, true, true>(lds, g, So, E, OPQ_TID());
            SEAM(pb + 0);
        }
        if (PH_EN(3) && IN(pb + 1)) for (int rep_ = 0, nrep_ = (DUPN(3)); rep_ < nrep_; ++rep_) { LOADP(); MAIN_CHECK(2); relayout_phase(P, l, lds, OPQ_S(vcu), OPQ_S(G), OPQ_TID()); SEAM(pb + 1); }
        if (PH_EN(4) && IN(pb + 2)) for (int rep_ = 0, nrep_ = (DUPN(4)); rep_ < nrep_; ++rep_) { LOADP();
            MAIN_CHECK(3);
            {   pg8::Gemm g{(const bf16*)(P.ws + WS_KCR), (const bf16*)(wl + WL_W1T), 8192, 512, 4096, 2048}; pg8::CmpOrder So{OPQ_S(bx)};
                pg8::EpiB<2, true> E{(bf16*)(P.ws + WS_HC), 256, (const float*)(P.ws + WS_B1P), nullptr, 0, nullptr, 0};
                pg8::gemm_phase<pg8::EpiB<2, true>, pg8::CmpOrder, false, true>(lds, g, So, E, OPQ_TID()); }
            {   pg8::Gemm g{(const bf16*)(P.ws + WS_CV), (const bf16*)(wl + WL_WCONV), S, DM, CWID, CWID}; pg8::StaticOrder So;
                So.init(S, DM, OPQ_S(G), OPQ_S(bx), pg8::WGM_N2K);
                pg8::EpiB<3> E{(bf16*)(P.ws + WS_YA), DM, nullptr, Pm + C_GA, PW, nullptr, 0};
                if (OPQ_S(G) == 256) { pg8::YaOrder Yo{So, OPQ_S(bx)}; pg8::gemm_phase<pg8::EpiB<3>, pg8::YaOrder, true, true>(lds, g, Yo, E, OPQ_TID()); }
                else pg8::gemm_phase<pg8::EpiB<3>, pg8::StaticOrder, true, true>(lds, g, So, E, OPQ_TID()); }
            SEAM(pb + 2);
        }
        if (PH_EN(5) && IN(pb + 3)) for (int rep_ = 0, nrep_ = (DUPN(5)); rep_ < nrep_; ++rep_) { LOADP(); MAIN_CHECK(4); cmp2_phase(P, l, OPQ_S(vcu), OPQ_S(G), OPQ_S(wave), OPQ_TID() & 63); SEAM(pb + 3); }
#if DBG_SKIP_ATTN
        if (PH_EN(6) && IN(pb + 4)) for (int rep_ = 0, nrep_ = (DUPN(6)); rep_ < nrep_; ++rep_) { LOADP(); u32x4* ao = (u32x4*)(P.ws + WS_AO); for (size_t i = (size_t)OPQ_S(vcu) * 512 + OPQ_TID(); i < (size_t)S * DM * 2 / 16; i += (size_t)OPQ_S(G) * 512) ao[i] = (u32x4){0u, 0u, 0u, 0u}; SEAM(pb + 4); }
#else
        if (PH_EN(6) && IN(pb + 4)) for (int rep_ = 0, nrep_ = (DUPN(6)); rep_ < nrep_; ++rep_) { LOADP(); attn_phase(P, lds, OPQ_S(vcu), OPQ_S(G), OPQ_S(wave), OPQ_TID() & 63);
            SEAM(pb + 4); }
#endif
        if (PH_EN(7) && IN(pb + 5)) for (int rep_ = 0, nrep_ = (DUPN(7)); rep_ < nrep_; ++rep_) { LOADP();
#if DBG_CHECK
            if (DBG_CHECK == 2 && l == DBG_CHECK_LAYER) { attn_check(P, l, lds, OPQ_S(vcu), OPQ_S(G), OPQ_TID(), ctl + 64); __syncthreads(); }
#endif
            pg8::Gemm g{(const bf16*)(P.ws + WS_AO), (const bf16*)(wl + WL_WNSA), S, DM, DM, DM}; pg8::StaticOrder So; So.init(S, DM, OPQ_S(G), OPQ_S(bx), pg8::WGM_N2K);
            pg8::EpiB<4> E{(bf16*)(P.ws + WS_MG), DM, nullptr, Pm + C_GB, PW, (const bf16*)(P.ws + WS_YA), DM};
            pg8::gemm_phase<pg8::EpiB<4>, pg8::StaticOrder, true, true>(lds, g, So, E, OPQ_TID());
            SEAM(pb + 5);
        }
        if (PH_EN(8) && IN(pb + 6)) for (int rep_ = 0, nrep_ = (DUPN(8)); rep_ < nrep_; ++rep_) { LOADP();
            MAIN_CHECK(5);
            pg8::Gemm g{(const bf16*)(P.ws + WS_MG), (const bf16*)(wl + WL_WOUT), S, DM, DM, DM}; pg8::StaticOrder So; So.init(S, DM, OPQ_S(G), OPQ_S(bx), pg8::WGM_N2K);
            pg8::EpiB<0> E{Y, DM, nullptr, nullptr, 0, nullptr, 0};
            pg8::gemm_phase<pg8::EpiB<0>, pg8::StaticOrder, true, true>(lds, g, So, E, OPQ_TID());
            SEAM(pb + 6);
        }
        if (PH_EN(9) && IN(pb + 7)) for (int rep_ = 0, nrep_ = (1); rep_ < nrep_; ++rep_) { LOADP(); MAIN_CHECK(6); resid_phase<true>(P, lds, l == 0 ? (const void*)P.x : (const void*)(P.ws + WS_XB), l != 0, (void*)(P.ws + WS_XB), true, Y, H, true, l, 2, 1, l, 4, 3, 2, OPQ_S(vcu), OPQ_S(G), OPQ_S(wave), OPQ_TID() & 63, OPQ_TID()); SEAM(pb + 7); }
        if (PH_EN(10) && IN(pb + 8)) for (int rep_ = 0, nrep_ = (DUPN(10)); rep_ < nrep_; ++rep_) { LOADP();
            MAIN_CHECK(7);
            pg8::Gemm g{H, (const bf16*)(wl + WL_WUP), S, FF, DM, DM}; pg8::StaticOrder So; So.init(S, FF, OPQ_S(G), OPQ_S(bx), pg8::WGM_UP);
            pg8::EpiB<1> E{(bf16*)(P.ws + WS_U), FF, nullptr, nullptr, 0, nullptr, 0};
            pg8::gemm_phase<pg8::EpiB<1>, pg8::StaticOrder, true, true>(lds, g, So, E, OPQ_TID());
            SEAM(pb + 8);
        }
        if (PH_EN(11) && IN(pb + 9)) for (int rep_ = 0, nrep_ = (DUPN(11)); rep_ < nrep_; ++rep_) { LOADP();
            MAIN_CHECK(8);
            pg8::Gemm g{(const bf16*)(P.ws + WS_U), (const bf16*)(wl + WL_WDOWN), S, DM, FF, FF}; pg8::StaticOrder So; So.init(S, DM, OPQ_S(G), OPQ_S(bx), pg8::WGM_N2K);
            pg8::EpiB<0> E{Y, DM, nullptr, nullptr, 0, nullptr, 0};
            pg8::gemm_phase<pg8::EpiB<0>, pg8::StaticOrder, true, true>(lds, g, So, E, OPQ_TID());
            SEAM(pb + 9);
        }
        if (PH_EN(12) && IN(pb + 10)) for (int rep_ = 0, nrep_ = (1); rep_ < nrep_; ++rep_) { LOADP();
            MAIN_CHECK(9);
            resid_phase<true>(P, lds, (const void*)(P.ws + WS_XB), true, l + 1 < DEPTH ? (void*)(P.ws + WS_XB) : (void*)P.out, l + 1 < DEPTH, Y, H, l + 1 < DEPTH, l, 5, 3, (l + 1 < DEPTH) ? l + 1 : l, 1, 0, 0, OPQ_S(vcu), OPQ_S(G), OPQ_S(wave), OPQ_TID() & 63, OPQ_TID());
            if (l + 1 < DEPTH) SEAM(pb + 10);
#if DBG_CHECK
            else { __syncthreads(); if (OPQ_S(bx) == 0 && OPQ_TID() == 0) { __threadfence(); const unsigned f = __hip_atomic_load(ctl + 64, __ATOMIC_RELAXED, __HIP_MEMORY_SCOPE_AGENT);
                if (f) { const unsigned ft = (0xffffffffu - __hip_atomic_load(ctl + 65, __ATOMIC_RELAXED, __HIP_MEMORY_SCOPE_AGENT)) + 1u, cnt = 0u; (void)cnt;
                    P.out[0] = 2000.0f * ((((ft - 1u) & 63u) >> 3) + 1u); } } }
#endif
        }
    }
#undef IN
#undef SEAM
}

extern "C" void kernel_launch(void* const* d_in, const int* in_sizes, int n_in, void* d_out, int out_size, void* d_ws, size_t ws_size, hipStream_t stream) {
    static int grid = 0;
    if (grid == 0) {
        if (n_in != 18 || out_size != S * DM || ws_size < WS_END) { fprintf(stderr, "kernel_launch: unexpected problem (n_in %d, out %d, ws %zu, need %zu)\n", n_in, out_size, ws_size, (size_t)WS_END); grid = -1; return; }
        int dev = 0, cus = 0, per_cu = 0;
        if (hipGetDevice(&dev) != hipSuccess || hipDeviceGetAttribute(&cus, hipDeviceAttributeMultiprocessorCount, dev) != hipSuccess) { grid = -1; return; }
        if (hipFuncSetAttribute((const void*)nsa_fwd, hipFuncAttributeMaxDynamicSharedMemorySize, LDS_BYTES) != hipSuccess) { fprintf(stderr, "kernel_launch: hipFuncSetAttribute failed\n"); grid = -1; return; }
        if (hipOccupancyMaxActiveBlocksPerMultiprocessor(&per_cu, (const void*)nsa_fwd, NWAVES * 64, LDS_BYTES) != hipSuccess || per_cu < 1)
            fprintf(stderr, "kernel_launch: occupancy query reports %d workgroups per CU\n", per_cu);
        (void)hipGetLastError();
        grid = cus;
    }
    if (grid < 0) return;
    if (hipMemsetAsync((char*)d_ws + WS_CTL, 0, CTL_ZERO_BYTES, stream) != hipSuccess) { fprintf(stderr, "kernel_launch: memset failed\n"); return; }
    Args a{};
    for (int i = 0; i < 18; ++i) a.in[i] = d_in[i];
    a.out = (float*)d_out; a.ws = (unsigned char*)d_ws;
#if MK_PER_PHASE
    for (int ph = 0; ph < N_PHASES; ++ph) { a.ph_lo = ph; a.ph_hi = ph + 1; hipLaunchKernelGGL(nsa_fwd, dim3(grid), dim3(NWAVES * 64), LDS_BYTES, stream, a); }
#else
    a.ph_lo = 0; a.ph_hi = N_PHASES;
    hipLaunchKernelGGL(nsa_fwd, dim3(grid), dim3(NWAVES * 64), LDS_BYTES, stream, a);
#endif
    const hipError_t le = hipPeekAtLastError();
    if (le != hipSuccess) fprintf(stderr, "kernel_launch: launch failed: %s\n", hipGetErrorName(le));
}
```
